# Optimizing an MI355X kernel written in HIP

```python
import math
import jax, jax.numpy as jnp
from jax import lax
import numpy as np

D_MODEL = 1024
BATCH = 16
SEQ = 2048
DEPTH = 4

GRID_W = 64
CTX_LEN = 256
N_MIXERS = 3
HEAD_DIM = 64
ROPE_BASE = 10000.0
Q_BLOCK = 128
DA_HEADS = 8
DA_WIDTH = DA_HEADS * 2 * HEAD_DIM
WA_Q_HEADS = 16
WA_KV_HEADS = 4
WINDOW = 128
SSM_GROUP = 16
SSM_GROUPS = D_MODEL // SSM_GROUP
SSM_STATE = 64
SSM_STEP_MIN = 1e-3
SSM_STEP_MAX = 1e-1
PEER_HEADS = 8
PEER_NKEYS = 128
PEER_EXPERTS = PEER_NKEYS * PEER_NKEYS
PEER_QDIM = 256
PEER_TOPK = 16
PEER_CHUNK = 128
LN_EPS = 1e-5
DEEPNORM_ALPHA = (2 * DEPTH) ** 0.25
DEEPNORM_BETA = (8 * DEPTH) ** -0.25

kernel_name = 'hybrid_diffattn_swa_s5_peer_trunk'


def layer_norm(x, g, b):
    xf = x.astype(jnp.float32)
    mu = jnp.mean(xf, -1, keepdims=True)
    var = jnp.mean(jnp.square(xf - mu), -1, keepdims=True)
    return ((xf - mu) * lax.rsqrt(var + LN_EPS) * g + b).astype(x.dtype)


def modulate(h, shift, scale):
    return h * (1 + scale) + shift


def axial_rope_tables(n_tok, dim):
    rows = n_tok // GRID_W
    row = jnp.repeat(jnp.arange(rows, dtype=jnp.float32), GRID_W)
    col = jnp.tile(jnp.arange(GRID_W, dtype=jnp.float32), rows)
    n_freq = dim // 4
    inv = ROPE_BASE ** (-jnp.arange(n_freq, dtype=jnp.float32) / n_freq)
    ang = jnp.concatenate([row[:, None] * inv, col[:, None] * inv], -1)
    return jnp.cos(ang), jnp.sin(ang)


def apply_rope(x, cos, sin):
    shape = x.shape
    half = shape[-1] // 2
    bshape = (1, shape[1]) + (1,) * (len(shape) - 3) + (half,)
    cs, sn = cos.reshape(bshape), sin.reshape(bshape)
    xf = x.astype(jnp.float32).reshape(shape[:-1] + (half, 2))
    xe, xo = xf[..., 0], xf[..., 1]
    out = jnp.stack([xe * cs - xo * sn, xe * sn + xo * cs], -1)
    return out.reshape(shape).astype(x.dtype)


def diff_attention(hc, hl, w_qkv, w_o, lam_p, subln_g, lam_init, cos, sin, ctx_out):
    B, T, _ = hl.shape
    lp = lam_p.astype(jnp.float32)
    lam = jnp.exp(jnp.sum(lp[0] * lp[1])) - jnp.exp(jnp.sum(lp[2] * lp[3])) + lam_init
    scale = HEAD_DIM ** -0.5

    def project(h):
        S = h.shape[1]
        q, k, v = jnp.split(h @ w_qkv, 3, axis=-1)
        return (q.reshape(B, S, DA_HEADS, 2, HEAD_DIM), k.reshape(B, S, DA_HEADS, 2, HEAD_DIM),
                v.reshape(B, S, DA_HEADS, 2 * HEAD_DIM))

    def attend(q, k, v):
        s = jnp.einsum('bqhjd,bkhjd->bhjqk', q, k).astype(jnp.float32) * scale
        p = jax.nn.softmax(s, axis=-1)
        a = p[:, :, 0] - lam * p[:, :, 1]
        o = jnp.einsum('bhqk,bkhe->bqhe', a, v.astype(jnp.float32))
        o = o * lax.rsqrt(jnp.mean(o * o, -1, keepdims=True) + LN_EPS) * subln_g * (1.0 - lam_init)
        return o.reshape(o.shape[0], o.shape[1], -1).astype(hl.dtype)

    qc, kc, vc = project(hc)
    ql, kl, vl = project(hl)
    ql = apply_rope(ql, cos, sin)
    kl = apply_rope(kl, cos, sin)
    k_all = jnp.concatenate([kc, kl], 1)
    v_all = jnp.concatenate([vc, vl], 1)
    nb = T // Q_BLOCK
    q_blocks = jnp.moveaxis(ql.reshape(B, nb, Q_BLOCK, DA_HEADS, 2, HEAD_DIM), 1, 0)
    o_blocks = lax.map(lambda qb: attend(qb, k_all, v_all), q_blocks)
    ol = jnp.moveaxis(o_blocks, 0, 1).reshape(B, T, -1) @ w_o
    oc = attend(qc, kc, vc) @ w_o if ctx_out else None
    return oc, ol


def window_attention(hc, hl, w_qkv, w_o, sink, cos, sin, ctx_out):
    B, T, _ = hl.shape
    L = hc.shape[1]
    R = WA_Q_HEADS // WA_KV_HEADS
    scale = HEAD_DIM ** -0.5
    sink_g = sink.astype(jnp.float32).reshape(WA_KV_HEADS, R)

    def project(h):
        S = h.shape[1]
        q, k, v = jnp.split(h @ w_qkv, [WA_Q_HEADS * HEAD_DIM, (WA_Q_HEADS + WA_KV_HEADS) * HEAD_DIM], axis=-1)
        return (q.reshape(B, S, WA_Q_HEADS, HEAD_DIM), k.reshape(B, S, WA_KV_HEADS, HEAD_DIM),
                v.reshape(B, S, WA_KV_HEADS, HEAD_DIM))

    def attend(q, k, v, mask):
        Q = q.shape[1]
        qg = q.reshape(B, Q, WA_KV_HEADS, R, HEAD_DIM)
        s = jnp.einsum('bqgrd,bkgd->bgrqk', qg, k).astype(jnp.float32) * scale
        if mask is not None:
            s = jnp.where(mask, s, -jnp.inf)
        sink_col = jnp.broadcast_to(sink_g[None, :, :, None, None], s.shape[:-1] + (1,))
        p = jax.nn.softmax(jnp.concatenate([s, sink_col], -1), axis=-1)[..., :-1]
        o = jnp.einsum('bgrqk,bkgd->bqgrd', p, v.astype(jnp.float32))
        return o.reshape(B, Q, -1).astype(hl.dtype)

    qc, kc, vc = project(hc)
    ql, kl, vl = project(hl)
    ql = apply_rope(ql, cos, sin)
    kl = apply_rope(kl, cos, sin)
    pad = ((0, 0), (WINDOW, WINDOW), (0, 0), (0, 0))
    k_pad, v_pad = jnp.pad(kl, pad), jnp.pad(vl, pad)
    span = Q_BLOCK + 2 * WINDOW
    nb = T // Q_BLOCK
    q_blocks = jnp.moveaxis(ql.reshape(B, nb, Q_BLOCK, WA_Q_HEADS, HEAD_DIM), 1, 0)

    def block(args):
        qb, b = args
        start = b * Q_BLOCK
        kb = lax.dynamic_slice_in_dim(k_pad, start, span, axis=1)
        vb = lax.dynamic_slice_in_dim(v_pad, start, span, axis=1)
        q_pos = start + jnp.arange(Q_BLOCK)
        k_pos = start - WINDOW + jnp.arange(span)
        band = ((jnp.abs(q_pos[:, None] - k_pos[None, :]) <= WINDOW)
                & (k_pos >= 0)[None, :] & (k_pos < T)[None, :])
        mask = jnp.concatenate([jnp.ones((Q_BLOCK, L), dtype=bool), band], 1)
        return attend(qb, jnp.concatenate([kc, kb], 1), jnp.concatenate([vc, vb], 1), mask)

    o_blocks = lax.map(block, (q_blocks, jnp.arange(nb)))
    ol = jnp.moveaxis(o_blocks, 0, 1).reshape(B, T, -1) @ w_o
    oc = attend(qc, kc, vc, None) @ w_o if ctx_out else None
    return oc, ol


def diag_scan(lam_bar, bu, reverse):
    a = jnp.broadcast_to(lam_bar, (1, bu.shape[1]) + lam_bar.shape)

    def combine(e1, e2):
        a1, b1 = e1
        a2, b2 = e2
        return a1 * a2, a2 * b1 + b2

    _, x = lax.associative_scan(combine, (a, bu), reverse=reverse, axis=1)
    return x


def s5_mixer(hc, hl, lam_re, lam_im, log_step, b_re, b_im, c_re, c_im, d_skip, w_glu, ctx_out):
    B, T, D = hl.shape
    L = hc.shape[1]
    u_c = hc.astype(jnp.float32).reshape(B, L, SSM_GROUPS, SSM_GROUP)
    u_l = hl.astype(jnp.float32).reshape(B, T, SSM_GROUPS, SSM_GROUP)
    d = d_skip.astype(jnp.float32).reshape(SSM_GROUPS, SSM_GROUP)
    y_l = d * u_l
    y_c = d * u_c if ctx_out else None
    for r, reverse in ((0, False), (1, True)):
        lam = lax.complex(lam_re[r].astype(jnp.float32), lam_im[r].astype(jnp.float32))
        step = jnp.exp(log_step[r].astype(jnp.float32))[:, None]
        lam_bar = jnp.exp(lam * step)
        b_bar = lax.complex(b_re[r].astype(jnp.float32), b_im[r].astype(jnp.float32)) * ((lam_bar - 1) / lam)[..., None]
        c_mat = lax.complex(c_re[r].astype(jnp.float32), c_im[r].astype(jnp.float32))
        x_c = diag_scan(lam_bar, jnp.einsum('blgh,gph->blgp', u_c.astype(jnp.complex64), b_bar), reverse)
        s0 = x_c[:, 0] if reverse else x_c[:, -1]
        bu_l = jnp.einsum('btgh,gph->btgp', u_l.astype(jnp.complex64), b_bar)
        bu_l = bu_l.at[:, -1 if reverse else 0].add(lam_bar * s0)
        x_l = diag_scan(lam_bar, bu_l, reverse)
        y_l = y_l + jnp.real(jnp.einsum('btgp,ghp->btgh', x_l, c_mat))
        if ctx_out:
            y_c = y_c + jnp.real(jnp.einsum('blgp,ghp->blgh', x_c, c_mat))

    def glu_out(y, S):
        z = jax.nn.gelu(y.reshape(B, S, D)).astype(hl.dtype) @ w_glu
        a, g = jnp.split(z, 2, axis=-1)
        return a * jax.nn.sigmoid(g)

    return (glu_out(y_c, L) if ctx_out else None), glu_out(y_l, T)


def peer_ffn(h, w_q, sub_keys, u_tab, v_tab):
    B, S, D = h.shape
    tokens = h.reshape(-1, PEER_CHUNK, D)

    def chunk(xc):
        n = xc.shape[0]
        q = (xc @ w_q).reshape(n, PEER_HEADS, 2, PEER_QDIM // 2)
        s = jnp.einsum('nhjc,jhkc->nhjk', q, sub_keys).astype(jnp.float32)
        sv, si = lax.top_k(s, PEER_TOPK)
        comb = (sv[:, :, 0, :, None] + sv[:, :, 1, None, :]).reshape(n, PEER_HEADS, -1)
        cidx = (si[:, :, 0, :, None] * PEER_NKEYS + si[:, :, 1, None, :]).reshape(n, PEER_HEADS, -1)
        top_s, pos = lax.top_k(comb, PEER_TOPK)
        eidx = jnp.take_along_axis(cidx, pos, -1)
        g = jax.nn.softmax(top_s, axis=-1)
        act = jax.nn.gelu(jnp.einsum('nd,nhkd->nhk', xc, u_tab[eidx]).astype(jnp.float32))
        return jnp.einsum('nhk,nhkd->nd', (g * act).astype(xc.dtype), v_tab[eidx])

    return lax.map(chunk, tokens).reshape(B, S, D)


def setup_inputs(seed: int = 0) -> dict:
    key = jax.random.key(seed)
    ks = jax.random.split(key, 32)
    f32 = jnp.float32
    D = D_MODEL
    n_a = len(range(0, DEPTH, N_MIXERS))
    n_b = len(range(1, DEPTH, N_MIXERS))
    n_c = len(range(2, DEPTH, N_MIXERS))
    s_in = D ** -0.5
    beta = DEEPNORM_BETA

    def nrm(k, shape, s):
        return s * jax.random.normal(k, shape, f32)

    G, P, Hg = SSM_GROUPS, SSM_STATE, SSM_GROUP
    lam_im = jnp.pi * jnp.arange(P, dtype=f32) + nrm(ks[24], (n_c, 2, G, P), 0.01)
    return {
        'x': nrm(ks[0], (BATCH, SEQ, D), 1.0),
        'c': nrm(ks[1], (BATCH, D), 1.0),
        'ctx': nrm(ks[2], (BATCH, CTX_LEN, D), 1.0),
        'c_ctx': nrm(ks[3], (D,), 1.0),
        'mod_w': nrm(ks[4], (DEPTH, D, 6 * D), s_in),
        'mod_b': nrm(ks[5], (DEPTH, 6 * D), 0.02),
        'ln_g': 1.0 + nrm(ks[6], (DEPTH, 2, D), 0.02),
        'ln_b': nrm(ks[7], (DEPTH, 2, D), 0.02),
        'peer_wq': nrm(ks[8], (DEPTH, D, PEER_HEADS * PEER_QDIM), s_in),
        'peer_keys': nrm(ks[9], (DEPTH, 2, PEER_HEADS, PEER_NKEYS, PEER_QDIM // 2), (PEER_QDIM // 2) ** -0.5),
        'peer_u': nrm(ks[10], (DEPTH, PEER_EXPERTS, D), s_in),
        'peer_v': nrm(ks[11], (DEPTH, PEER_EXPERTS, D), beta),
        'da_wqkv': jnp.concatenate([nrm(ks[12], (n_a, D, 2 * DA_WIDTH), s_in),
                                    nrm(ks[13], (n_a, D, DA_WIDTH), s_in * beta)], -1),
        'da_wo': nrm(ks[14], (n_a, DA_WIDTH, D), DA_WIDTH ** -0.5 * beta),
        'da_lambda': nrm(ks[15], (n_a, 4, HEAD_DIM), 0.1),
        'da_subln': 1.0 + nrm(ks[16], (n_a, 2 * HEAD_DIM), 0.02),
        'wa_wqkv': jnp.concatenate([nrm(ks[17], (n_b, D, (WA_Q_HEADS + WA_KV_HEADS) * HEAD_DIM), s_in),
                                    nrm(ks[18], (n_b, D, WA_KV_HEADS * HEAD_DIM), s_in * beta)], -1),
        'wa_wo': nrm(ks[19], (n_b, WA_Q_HEADS * HEAD_DIM, D), (WA_Q_HEADS * HEAD_DIM) ** -0.5 * beta),
        'wa_sink': nrm(ks[20], (n_b, WA_Q_HEADS), 1.0),
        'ssm_lam_re': -0.5 + nrm(ks[21], (n_c, 2, G, P), 0.01),
        'ssm_lam_im': lam_im,
        'ssm_log_step': jax.random.uniform(ks[22], (n_c, 2, G), f32, math.log(SSM_STEP_MIN), math.log(SSM_STEP_MAX)),
        'ssm_b_re': nrm(ks[23], (n_c, 2, G, P, Hg), (2 * Hg) ** -0.5),
        'ssm_b_im': nrm(ks[25], (n_c, 2, G, P, Hg), (2 * Hg) ** -0.5),
        'ssm_c_re': nrm(ks[26], (n_c, 2, G, Hg, P), P ** -0.5),
        'ssm_c_im': nrm(ks[27], (n_c, 2, G, Hg, P), P ** -0.5),
        'ssm_d': nrm(ks[28], (n_c, D), 1.0),
        'ssm_w_glu': nrm(ks[29], (n_c, D, 2 * D), s_in * beta),
    }


def reference(x, c, ctx, c_ctx, mod_w, mod_b, ln_g, ln_b, peer_wq, peer_keys, peer_u, peer_v,
              da_wqkv, da_wo, da_lambda, da_subln, wa_wqkv, wa_wo, wa_sink,
              ssm_lam_re, ssm_lam_im, ssm_log_step, ssm_b_re, ssm_b_im, ssm_c_re, ssm_c_im, ssm_d, ssm_w_glu):
    B, T, D = x.shape
    L = ctx.shape[1]
    cos, sin = axial_rope_tables(T, HEAD_DIM)
    silu_c = jax.nn.silu(c)
    silu_cc = jax.nn.silu(c_ctx)
    lat, cx = x, ctx
    for i in range(DEPTH):
        kind, j = i % N_MIXERS, i // N_MIXERS
        last = i == DEPTH - 1
        m_l = [t[:, None] for t in jnp.split(silu_c @ mod_w[i] + mod_b[i], 6, axis=-1)]
        m_c = jnp.split(silu_cc @ mod_w[i] + mod_b[i], 6, axis=-1)
        hl = modulate(lat, m_l[0], m_l[1])
        hc = modulate(cx, m_c[0], m_c[1])
        if kind == 0:
            lam_init = 0.8 - 0.6 * math.exp(-0.3 * i)
            oc, ol = diff_attention(hc, hl, da_wqkv[j], da_wo[j], da_lambda[j], da_subln[j], lam_init,
                                    cos, sin, not last)
        elif kind == 1:
            oc, ol = window_attention(hc, hl, wa_wqkv[j], wa_wo[j], wa_sink[j], cos, sin, not last)
        else:
            oc, ol = s5_mixer(hc, hl, ssm_lam_re[j], ssm_lam_im[j], ssm_log_step[j], ssm_b_re[j], ssm_b_im[j],
                              ssm_c_re[j], ssm_c_im[j], ssm_d[j], ssm_w_glu[j], not last)
        lat = layer_norm(DEEPNORM_ALPHA * lat + m_l[2] * ol, ln_g[i, 0], ln_b[i, 0])
        hl = modulate(lat, m_l[3], m_l[4])
        if last:
            ol = peer_ffn(hl, peer_wq[i], peer_keys[i], peer_u[i], peer_v[i])
        else:
            cx = layer_norm(DEEPNORM_ALPHA * cx + m_c[2] * oc, ln_g[i, 0], ln_b[i, 0])
            hc = modulate(cx, m_c[3], m_c[4])
            o = peer_ffn(jnp.concatenate([hc, hl], 1), peer_wq[i], peer_keys[i], peer_u[i], peer_v[i])
            oc, ol = o[:, :L], o[:, L:]
            cx = layer_norm(DEEPNORM_ALPHA * cx + m_c[5] * oc, ln_g[i, 1], ln_b[i, 1])
        lat = layer_norm(DEEPNORM_ALPHA * lat + m_l[5] * ol, ln_g[i, 1], ln_b[i, 1])
    return lat
```

```cpp
#include <hip/hip_runtime.h>
#include <cstdio>
#include <cstdint>
#define MK_DEBUG 0
#define CHK_MASK 0xFDFF
namespace pg8 {
#define PG8_LAS __attribute__((address_space(3)))
typedef unsigned short bf16_t;
typedef short bf16x8 __attribute__((ext_vector_type(8)));
typedef float f32x4 __attribute__((ext_vector_type(4)));
typedef unsigned u32x4 __attribute__((ext_vector_type(4)));
constexpr int BM = 256, BK = 64, HALF = 128, HTB = HALF * BK * 2  , STAGE_BYTES = 8 * HTB, NXCD = 8, WGM = 8;

__host__ __device__ __forceinline__ int lds_byte(int r, int c) { const int st = (r >> 4) * 2 + (c >> 5), rr = r & 15, cc = c & 31, ob = rr * 64 + cc * 2; return st * 1024 + (ob ^ (((ob >> 9) & 1) << 5)); }
__host__ __device__ __forceinline__ void stage_rc(int b, int& R, int& C) { const int st = b / 1024, sb = b % 1024, swz = sb ^ (((sb >> 9) & 1) << 5); R = (st >> 1) * 16 + swz / 64; C = (st & 1) * 32 + (swz % 64) / 2; }
__host__ __device__ __forceinline__ int perm32(int rho) { const int n = rho >> 4, i = rho & 15; return 8 * (i >> 2) + 4 * n + (i & 3); }

struct Unit { int pm, pn; };
struct Gemm { const bf16_t* A; const bf16_t* Bt; int M, N, K; };

struct StaticOrder {
    int nM, nN, nwg, G, c;
    __host__ __device__ void init(int M, int N, int G_, int c_) { nM = M / BM; nN = N / BM; nwg = nM * nN; G = G_; c = c_; }
    __host__ __device__ bool next(int i, Unit& u) const {
        const long L = (long)i * G + c; if (L >= nwg) return false;
        int wgid = (int)L; { const int q = nwg / NXCD, r = nwg % NXCD, xcd = wgid % NXCD, off = wgid / NXCD; wgid = (xcd < r ? xcd * (q + 1) : r * (q + 1) + (xcd - r) * q) + off; }
        const int nig = WGM * nN, gid = wgid / nig, fm = gid * WGM, gsz = (nM - fm) < WGM ? (nM - fm) : WGM;
        u.pm = fm + ((wgid % nig) % gsz); u.pn = (wgid % nig) / gsz; return true;
    }
    __device__ __forceinline__ void a_ready(const Unit&) const {}
    __device__ __forceinline__ void done(const Unit&) const {}
};

__device__ __forceinline__ unsigned cvt_pk_bf16(float lo, float hi) { unsigned r; asm volatile("v_cvt_pk_bf16_f32 %0, %1, %2" : "=v"(r) : "v"(lo), "v"(hi)); return r; }
typedef float f32x2 __attribute__((ext_vector_type(2)));
struct RowOrder {
    int nM, nN, nwg, G, c, skip;
    __device__ __forceinline__ void init(int nM_, int nN_, int G_, int c_, int skip_) { nM = nM_; nN = nN_; nwg = nM * nN; G = G_; c = c_; skip = skip_; }
    __device__ __forceinline__ bool next(int i, Unit& u) const {
        const long L = (long)i * G + c; if (L >= nwg) return false;
        int wgid = (int)L; { const int q = nwg / NXCD, r = nwg % NXCD, xcd = wgid % NXCD, off = wgid / NXCD; wgid = (xcd < r ? xcd * (q + 1) : r * (q + 1) + (xcd - r) * q) + off; }
        const int nig = WGM * nN, gid = wgid / nig, fm = gid * WGM, gsz = (nM - fm) < WGM ? (nM - fm) : WGM;
        const int pm = fm + ((wgid % nig) % gsz); u.pn = (wgid % nig) / gsz;
        u.pm = skip ? (pm >> 3) * 9 + 1 + (pm & 7) : pm; return true;
    }
    __device__ __forceinline__ void a_ready(const Unit&) const {}
    __device__ __forceinline__ void done(const Unit&) const {}
};
typedef unsigned u32x4e __attribute__((ext_vector_type(4)));
struct EpiQKV {
    static constexpr bool PERM = true, AFTER_DRAIN = false;
    bf16_t* Q; bf16_t* K; bf16_t* V; int nq, nk; const float* cosT; const float* sinT; float qscale;
    __device__ __forceinline__ void operator()(const f32x4 (&acc)[2][2][4][2], const Unit& u, int wr, int wc, int fr, int fq) const {
        bf16_t* base; int kind, pl;
        if (u.pn < nq) { base = Q; kind = 0; pl = u.pn; } else if (u.pn < nq + nk) { base = K; kind = 1; pl = u.pn - nq; } else { base = V; kind = 2; pl = u.pn - nq - nk; }
        const int bq = u.pm / 9; const bool lat = (u.pm - bq * 9) != 0; const bool rope = lat && kind < 2;
        const float sc = (kind == 0) ? qscale : 1.f;
        const int row0 = u.pm * BM + wr * 64 + fr, col0 = pl * BM + wc * 32 + 8 * fq;
#pragma unroll
        for (int ai = 0; ai < 2; ++ai)
#pragma unroll
            for (int m = 0; m < 4; ++m) { const int row = row0 + ai * HALF + m * 16; const int t = row - bq * 2304 - 256;
#pragma unroll
                for (int bj = 0; bj < 2; ++bj) { const int col = col0 + bj * HALF; f32x4 v0 = acc[ai][bj][m][0], v1 = acc[ai][bj][m][1];
                    if (rope) { const int i0 = (col & 63) >> 1; const f32x4 cs = *(const f32x4*)(cosT + t * 32 + i0), sn = *(const f32x4*)(sinT + t * 32 + i0);
                        float e, o;
                        e = v0[0]; o = v0[1]; v0[0] = e * cs[0] - o * sn[0]; v0[1] = e * sn[0] + o * cs[0];
                        e = v0[2]; o = v0[3]; v0[2] = e * cs[1] - o * sn[1]; v0[3] = e * sn[1] + o * cs[1];
                        e = v1[0]; o = v1[1]; v1[0] = e * cs[2] - o * sn[2]; v1[1] = e * sn[2] + o * cs[2];
                        e = v1[2]; o = v1[3]; v1[2] = e * cs[3] - o * sn[3]; v1[3] = e * sn[3] + o * cs[3]; }
                    v0 = v0 * sc; v1 = v1 * sc; u32x4e w; w.x = cvt_pk_bf16(v0[0], v0[1]); w.y = cvt_pk_bf16(v0[2], v0[3]); w.z = cvt_pk_bf16(v1[0], v1[1]); w.w = cvt_pk_bf16(v1[2], v1[3]);
                    *(u32x4e*)(base + (size_t)row * 1024 + col) = w; } }
    }
};
struct EpiPlain {
    static constexpr bool PERM = true, AFTER_DRAIN = false;
    bf16_t* O; int ldc;
    __device__ __forceinline__ void operator()(const f32x4 (&acc)[2][2][4][2], const Unit& u, int wr, int wc, int fr, int fq) const {
        const int row0 = u.pm * BM + wr * 64 + fr, col0 = u.pn * BM + wc * 32 + 8 * fq;
#pragma unroll
        for (int ai = 0; ai < 2; ++ai)
#pragma unroll
            for (int m = 0; m < 4; ++m) { bf16_t* rowp = O + (size_t)(row0 + ai * HALF + m * 16) * ldc + col0;
#pragma unroll
                for (int bj = 0; bj < 2; ++bj) { const f32x4 v0 = acc[ai][bj][m][0], v1 = acc[ai][bj][m][1];
                    u32x4e w; w.x = cvt_pk_bf16(v0[0], v0[1]); w.y = cvt_pk_bf16(v0[2], v0[3]); w.z = cvt_pk_bf16(v1[0], v1[1]); w.w = cvt_pk_bf16(v1[2], v1[3]);
                    *(u32x4e*)(rowp + bj * HALF) = w; } }
    }
};
struct EpiRes {
    static constexpr bool PERM = false, AFTER_DRAIN = false;
    const float* lat; float* R; const float* mod; float alpha;
    __device__ __forceinline__ void operator()(const f32x4 (&acc)[2][2][4][2], const Unit& u, int wr, int wc, int fr, int fq) const {
        const int bq = u.pm / 9; const int midx = ((u.pm - bq * 9) == 0) ? 16 : bq; const float* gate = mod + midx * 6144 + 2048;
        const int row0 = u.pm * BM + wr * 64 + fr, col0 = u.pn * BM + wc * 32 + 4 * fq;
#pragma unroll
        for (int bj = 0; bj < 2; ++bj)
#pragma unroll
            for (int n = 0; n < 2; ++n) { const int col = col0 + bj * HALF + n * 16; const f32x4 gv = *(const f32x4*)(gate + col);
#pragma unroll
                for (int ai = 0; ai < 2; ++ai)
#pragma unroll
                    for (int m = 0; m < 4; ++m) { const size_t off = (size_t)(row0 + ai * HALF + m * 16) * 1024 + col; const f32x4 lv = *(const f32x4*)(lat + off);
                        *(f32x4*)(R + off) = lv * alpha + gv * acc[ai][bj][m][n]; } }
    }
};
struct EpiGlu {
    static constexpr bool PERM = false, AFTER_DRAIN = false;
    const float* lat; float* R; const float* mod; float alpha;
    __device__ __forceinline__ void operator()(const f32x4 (&acc)[2][2][4][2], const Unit& u, int wr, int wc, int fr, int fq) const {
        const int bq = u.pm / 9; const int midx = ((u.pm - bq * 9) == 0) ? 16 : bq; const float* gate = mod + midx * 6144 + 2048;
        const int row0 = u.pm * BM + wr * 64 + fr, col0 = u.pn * HALF + wc * 32 + 4 * fq;
#pragma unroll
        for (int n = 0; n < 2; ++n) { const int col = col0 + n * 16; const f32x4 gv = *(const f32x4*)(gate + col);
#pragma unroll
            for (int ai = 0; ai < 2; ++ai)
#pragma unroll
                for (int m = 0; m < 4; ++m) { const size_t off = (size_t)(row0 + ai * HALF + m * 16) * 1024 + col; const f32x4 lv = *(const f32x4*)(lat + off);
                    const f32x4 a = acc[ai][0][m][n], g = acc[ai][1][m][n]; f32x4 val;
#pragma unroll
                    for (int j = 0; j < 4; ++j) val[j] = a[j] * __builtin_amdgcn_rcpf(1.f + __builtin_amdgcn_exp2f(-1.4426950408889634f * g[j]));
                    *(f32x4*)(R + off) = lv * alpha + gv * val; } }
    }
};
template <class Epi, class Sched, bool ALIGN_EPI = false, bool SP2 = false>
__device__ __forceinline__ void gemm_phase(PG8_LAS unsigned char* lds, const Gemm g, const Sched& S, const Epi& E, const int tid_in) {
    const int tid = tid_in; const int wid = __builtin_amdgcn_readfirstlane(tid >> 6), lane = tid & 63, wr = wid >> 2, wc = wid & 3, fr = lane & 15, fq = lane >> 4;
    const int K = g.K, nt = K / BK;
    unsigned voffA[2], voffB[2];
#pragma unroll
    for (int i = 0; i < 2; ++i) { int R, C; stage_rc(tid * 16 + i * 8192, R, C); const int Rb = Epi::PERM ? ((R & ~31) + perm32(R & 31)) : R;
        voffA[i] = (unsigned)(R * K + C) * 2u; voffB[i] = (unsigned)(Rb * K + C) * 2u; }
    const size_t kstep = (size_t)(BK * 2);
    const size_t hstep = (size_t)HALF * K * 2;
    const size_t tstep = 2 * hstep;
    const unsigned ldsw = (unsigned)wid * 1024u;
    const int aoff = lds_byte(wr * 64 + fr, fq * 8), boff = lds_byte(wc * 32 + fr, fq * 8);
#define PG8_SA(b, h) (((b) * 2 + (h)) * HTB)
#define PG8_SB(b, h) ((4 + (b) * 2 + (h)) * HTB)
#define PG8_STAGE(bufoff, gbase, voff) do { _Pragma("unroll") for (int _i = 0; _i < 2; ++_i) \
        __builtin_amdgcn_global_load_lds((const unsigned*)((const char*)(gbase) + (voff)[_i]), (PG8_LAS unsigned*)(lds + (bufoff) + ldsw + _i * 8192), 16, 0, 0); } while (0)
#define PG8_LDA(dst, b, h) do { _Pragma("unroll") for (int m = 0; m < 4; ++m) _Pragma("unroll") for (int k = 0; k < 2; ++k) dst[m][k] = *(const PG8_LAS bf16x8*)(lds + PG8_SA(b, h) + aoff + m * 2048 + k * 1024); } while (0)
#define PG8_LDB(dst, b, h) do { _Pragma("unroll") for (int n = 0; n < 2; ++n) _Pragma("unroll") for (int k = 0; k < 2; ++k) dst[n][k] = *(const PG8_LAS bf16x8*)(lds + PG8_SB(b, h) + boff + n * 2048 + k * 1024); } while (0)
#define PG8_MMA(ai, bj, At, Bt) do { __builtin_amdgcn_s_setprio(1); _Pragma("unroll") for (int m = 0; m < 4; ++m) _Pragma("unroll") for (int n = 0; n < 2; ++n) _Pragma("unroll") for (int k = 0; k < 2; ++k) \
        acc[ai][bj][m][n] = __builtin_amdgcn_mfma_f32_16x16x32_bf16(Bt[n][k], At[m][k], acc[ai][bj][m][n], 0, 0, 0); __builtin_amdgcn_s_setprio(0); } while (0)
#define PG8_WAIT_V(n) asm volatile("s_waitcnt vmcnt(" #n ")" ::: "memory")
#define PG8_WAIT_L(n) asm volatile("s_waitcnt lgkmcnt(" #n ")" ::: "memory")
#define PG8_BAR __builtin_amdgcn_s_barrier()
#define PG8_SCHED __builtin_amdgcn_sched_barrier(0)
    Unit cur, nxt; int ui = 0;
    if (!S.next(0, cur)) return;
    f32x4 acc[2][2][4][2];
#pragma unroll
    for (int a = 0; a < 2; ++a)
#pragma unroll
        for (int b = 0; b < 2; ++b)
#pragma unroll
            for (int m = 0; m < 4; ++m)
#pragma unroll
                for (int n = 0; n < 2; ++n) acc[a][b][m][n] = (f32x4){0.f, 0.f, 0.f, 0.f};
    bf16x8 At[4][2], B0[2][2], B1[2][2];
    const char* cA = (const char*)g.A + (size_t)cur.pm * tstep; const char* cB = (const char*)g.Bt + (size_t)cur.pn * tstep;
    S.a_ready(cur);
    if constexpr (SP2) {
        PG8_STAGE(PG8_SB(0, 0), cB, voffB); PG8_STAGE(PG8_SB(0, 1), cB + hstep, voffB); PG8_STAGE(PG8_SA(0, 0), cA, voffA); PG8_STAGE(PG8_SA(0, 1), cA + hstep, voffA);
        if (wr == 1) PG8_BAR;
        PG8_WAIT_V(2); PG8_BAR;
        PG8_STAGE(PG8_SB(1, 0), cB + kstep, voffB); PG8_STAGE(PG8_SA(1, 0), cA + kstep, voffA); PG8_STAGE(PG8_SB(1, 1), cB + hstep + kstep, voffB);
        PG8_WAIT_V(6); PG8_BAR;
    } else {
        PG8_STAGE(PG8_SB(0, 0), cB, voffB); PG8_STAGE(PG8_SA(0, 0), cA, voffA); PG8_STAGE(PG8_SB(0, 1), cB + hstep, voffB); PG8_STAGE(PG8_SA(0, 1), cA + hstep, voffA);
        if (wr == 1) PG8_BAR;
        PG8_WAIT_V(4); PG8_BAR;
        PG8_STAGE(PG8_SB(1, 0), cB + kstep, voffB); PG8_STAGE(PG8_SA(1, 0), cA + kstep, voffA); PG8_STAGE(PG8_SB(1, 1), cB + hstep + kstep, voffB);
        PG8_WAIT_V(6); PG8_BAR;
    }
    for (;;) {
        const bool has_next = S.next(ui + 1, nxt);
        const char* nA = has_next ? (const char*)g.A + (size_t)nxt.pm * tstep : cA; const char* nB = has_next ? (const char*)g.Bt + (size_t)nxt.pn * tstep : cB;
        for (int t = 0; t < nt; t += 2) {
            const bool last = (t == nt - 2);
            const char* a1 = cA + (size_t)(t + 1) * kstep;
            const char* a2 = last ? nA : cA + (size_t)(t + 2) * kstep; const char* b2 = last ? nB : cB + (size_t)(t + 2) * kstep;
            const char* a3 = a2 + kstep; const char* b3 = b2 + kstep;
            if (last && has_next) S.a_ready(nxt);
            if constexpr (SP2) {
            PG8_LDB(B0, 0, 0); PG8_LDB(B1, 0, 1); PG8_SCHED; PG8_LDA(At, 0, 0); PG8_STAGE(PG8_SA(1, 1), a1 + hstep, voffA);
            PG8_WAIT_V(8); PG8_WAIT_L(0); PG8_BAR; PG8_MMA(0, 0, At, B0); PG8_MMA(0, 1, At, B1); PG8_BAR; PG8_SCHED;
            PG8_LDA(At, 0, 1); PG8_STAGE(PG8_SB(0, 0), b2, voffB); PG8_STAGE(PG8_SB(0, 1), b2 + hstep, voffB); PG8_STAGE(PG8_SA(0, 0), a2, voffA);
            PG8_WAIT_V(8); PG8_WAIT_L(0); PG8_BAR; PG8_MMA(1, 0, At, B0); PG8_MMA(1, 1, At, B1); PG8_BAR; PG8_SCHED;
            PG8_LDB(B0, 1, 0); PG8_LDB(B1, 1, 1); PG8_SCHED; PG8_LDA(At, 1, 0); PG8_STAGE(PG8_SA(0, 1), a2 + hstep, voffA);
            PG8_WAIT_V(8); PG8_WAIT_L(0); PG8_BAR; PG8_MMA(0, 0, At, B0); PG8_MMA(0, 1, At, B1); PG8_BAR; PG8_SCHED;
            PG8_LDA(At, 1, 1); PG8_STAGE(PG8_SB(1, 0), b3, voffB); PG8_STAGE(PG8_SB(1, 1), b3 + hstep, voffB); PG8_STAGE(PG8_SA(1, 0), a3, voffA);
            PG8_WAIT_V(8); PG8_WAIT_L(0); PG8_BAR; PG8_MMA(1, 0, At, B0); PG8_MMA(1, 1, At, B1); PG8_BAR; PG8_SCHED;
            } else {
            PG8_LDB(B0, 0, 0); PG8_SCHED; PG8_LDA(At, 0, 0); PG8_STAGE(PG8_SA(1, 1), a1 + hstep, voffA);
            PG8_WAIT_L(8); PG8_BAR; PG8_WAIT_L(0); PG8_MMA(0, 0, At, B0); PG8_BAR; PG8_SCHED;
            PG8_LDB(B1, 0, 1); PG8_STAGE(PG8_SB(0, 0), b2, voffB);
            PG8_BAR; PG8_WAIT_L(0); PG8_MMA(0, 1, At, B1); PG8_BAR;
            PG8_LDA(At, 0, 1); PG8_STAGE(PG8_SA(0, 0), a2, voffA);
            PG8_BAR; PG8_WAIT_L(0); PG8_MMA(1, 0, At, B0); PG8_BAR; PG8_SCHED;
            PG8_STAGE(PG8_SB(0, 1), b2 + hstep, voffB);
            PG8_WAIT_V(6); PG8_BAR; PG8_MMA(1, 1, At, B1); PG8_BAR;
            PG8_LDB(B0, 1, 0); PG8_SCHED; PG8_LDA(At, 1, 0); PG8_STAGE(PG8_SA(0, 1), a2 + hstep, voffA);
            PG8_WAIT_L(8); PG8_BAR; PG8_WAIT_L(0); PG8_MMA(0, 0, At, B0); PG8_BAR; PG8_SCHED;
            PG8_LDB(B1, 1, 1); PG8_STAGE(PG8_SB(1, 0), b3, voffB);
            PG8_BAR; PG8_WAIT_L(0); PG8_MMA(0, 1, At, B1); PG8_BAR;
            PG8_LDA(At, 1, 1); PG8_STAGE(PG8_SA(1, 0), a3, voffA);
            PG8_BAR; PG8_WAIT_L(0); PG8_MMA(1, 0, At, B0); PG8_BAR; PG8_SCHED;
            PG8_STAGE(PG8_SB(1, 1), b3 + hstep, voffB);
            PG8_WAIT_V(6); PG8_BAR; PG8_MMA(1, 1, At, B1); PG8_BAR;
            }
        }
        if constexpr (ALIGN_EPI) { if (wr == 0) PG8_BAR; }
        if constexpr (!Epi::AFTER_DRAIN) { E(acc, cur, wr, wc, fr, fq); S.done(cur); }
        if (!has_next) break;
#pragma unroll
        for (int a = 0; a < 2; ++a)
#pragma unroll
            for (int b = 0; b < 2; ++b)
#pragma unroll
                for (int m = 0; m < 4; ++m)
#pragma unroll
                    for (int n = 0; n < 2; ++n) acc[a][b][m][n] = (f32x4){0.f, 0.f, 0.f, 0.f};
        cur = nxt; cA = nA; cB = nB; ++ui;
        if constexpr (ALIGN_EPI) { if (wr == 1) PG8_BAR; }
    }
    PG8_WAIT_V(0);
    if constexpr (!ALIGN_EPI) { if (wr == 0) PG8_BAR; }
    PG8_BAR;
    if constexpr (Epi::AFTER_DRAIN) { E.fused(acc, cur, wr, wc, fr, fq, lds, wid, lane); S.done(cur); }
#undef PG8_SA
#undef PG8_SB
#undef PG8_STAGE
#undef PG8_LDA
#undef PG8_LDB
#undef PG8_MMA
#undef PG8_WAIT_V
#undef PG8_WAIT_L
#undef PG8_BAR
#undef PG8_SCHED
}
}
#include <hip/hip_bf16.h>
#include <cmath>
namespace attn_body {
using bf16=__hip_bfloat16;
using bf16x8=__attribute__((ext_vector_type(8)))short;
using s16x4=__attribute__((ext_vector_type(4)))short;
using f32x16=__attribute__((ext_vector_type(16)))float;
using u32x4=__attribute__((ext_vector_type(4)))unsigned;
constexpr int D=64,DM=1024;
constexpr int NW=8,QBLK=32,QB=QBLK*NW,KVBLK=64;
constexpr int ATTN_PITCH=DM, ATTN_UNIT_ROWS=QB;
__device__ __forceinline__ int crow(int r,int hi){return (r&3)+8*(r>>2)+4*hi;}
#define SBAR() __builtin_amdgcn_sched_barrier(0)
__device__ __forceinline__ void bandmask(f32x16&p0,f32x16&p1,int kb,int qpos,int hi){
  const float NEG=-INFINITY; const int d0=kb+4*hi-qpos;
  #pragma unroll
  for(int r=0;r<16;++r){const int d=d0+(r&3)+8*(r>>2); if(d>128||d<-128)p0[r]=NEG; if(d+32>128||d+32<-128)p1[r]=NEG;}
}

constexpr int NSLOT=3, SLOTB=8192;
constexpr int LDS_K=0, LDS_V=NSLOT*SLOTB, LDS_WS=2*NSLOT*SLOTB, LDS_OST=LDS_WS+NW*64*4, LDS_BYTES=LDS_OST+NW*4096;
constexpr float C2=0.125f*1.4426950408889634f;
__device__ __forceinline__ void glds16(const void*gsrc,unsigned lds_dst){unsigned keep;
  asm volatile("s_mov_b32 %0, m0\n\ts_mov_b32 m0, %2\n\ts_nop 0\n\tglobal_load_lds_dwordx4 %1, off\n\ts_mov_b32 m0, %0":"=&s"(keep):"v"(gsrc),"s"(lds_dst):"memory");}
__device__ __forceinline__ float max3f(float a,float b,float c){float r;asm("v_max3_f32 %0, %1, %2, %3":"=v"(r):"v"(a),"v"(b),"v"(c));return r;}
__device__ __forceinline__ float max2f(float a,float b){float r;asm("v_max_f32_e32 %0, %1, %2":"=v"(r):"v"(a),"v"(b));return r;}
__device__ __forceinline__ float fadd_s(float a,float b){float r;asm("v_add_f32_e32 %0, %1, %2":"=v"(r):"v"(a),"v"(b));return r;}
__device__ __forceinline__ float fsub_s(float a,float b){float r;asm("v_sub_f32_e32 %0, %1, %2":"=v"(r):"v"(a),"v"(b));return r;}
typedef float f32x2_t __attribute__((ext_vector_type(2))); typedef __bf16 bf16x2_t __attribute__((ext_vector_type(2)));
__device__ __forceinline__ unsigned cvtpk_s(float lo,float hi){f32x2_t v={lo,hi};bf16x2_t b=__builtin_convertvector(v,bf16x2_t);return __builtin_bit_cast(unsigned,b);}
#define WAIT_BAR(N) asm volatile("s_waitcnt vmcnt(" #N ") lgkmcnt(0)\n\ts_barrier":::"memory")

__device__ __forceinline__ void qkt(f32x16&p0,f32x16&p1,const char*Kslot,const bf16x8*qr,const f32x16&negm,int r32,int hi){
  const char*kb=Kslot+hi*1024+r32*16;
  #pragma unroll
  for(int d0=0;d0<4;++d0){
    const bf16x8 b0=*reinterpret_cast<const bf16x8*>(kb+d0*2048);
    const bf16x8 b1=*reinterpret_cast<const bf16x8*>(kb+d0*2048+512);
    if(d0==0){p0=__builtin_amdgcn_mfma_f32_32x32x16_bf16(b0,qr[0],negm,0,0,0);p1=__builtin_amdgcn_mfma_f32_32x32x16_bf16(b1,qr[0],negm,0,0,0);}
    else{p0=__builtin_amdgcn_mfma_f32_32x32x16_bf16(b0,qr[d0],p0,0,0,0);p1=__builtin_amdgcn_mfma_f32_32x32x16_bf16(b1,qr[d0],p1,0,0,0);}}
}
typedef __attribute__((address_space(3))) const char* lds_cptr;
typedef short v4i16_t __attribute__((ext_vector_type(4)));
__device__ __forceinline__ void kload8(bf16x8*kf,lds_cptr kp){
  kf[0]=*(const __attribute__((address_space(3))) bf16x8*)(kp);      kf[1]=*(const __attribute__((address_space(3))) bf16x8*)(kp+512);
  kf[2]=*(const __attribute__((address_space(3))) bf16x8*)(kp+2048); kf[3]=*(const __attribute__((address_space(3))) bf16x8*)(kp+2560);
  kf[4]=*(const __attribute__((address_space(3))) bf16x8*)(kp+4096); kf[5]=*(const __attribute__((address_space(3))) bf16x8*)(kp+4608);
  kf[6]=*(const __attribute__((address_space(3))) bf16x8*)(kp+6144); kf[7]=*(const __attribute__((address_space(3))) bf16x8*)(kp+6656);
}
__device__ __forceinline__ void kload2(bf16x8*kf,lds_cptr kp,int j){ kf[2*j]=*(const __attribute__((address_space(3))) bf16x8*)(kp+j*2048); kf[2*j+1]=*(const __attribute__((address_space(3))) bf16x8*)(kp+j*2048+512); }
__device__ __forceinline__ s16x4 vtr(lds_cptr p){ return __builtin_bit_cast(s16x4,__builtin_amdgcn_ds_read_tr16_b64_v4i16((__attribute__((address_space(3))) v4i16_t*)p)); }
__device__ __forceinline__ float rowmax(const f32x16&p0,const f32x16&p1){
  float a=max3f(p0[0],p0[1],p1[0]),b=max3f(p0[2],p0[3],p1[1]);a=max3f(a,p1[2],p1[3]);
  #pragma unroll
  for(int r=4;r<16;r+=4){a=max3f(a,p0[r],p0[r+1]);b=max3f(b,p0[r+2],p0[r+3]);a=max3f(a,p1[r],p1[r+1]);b=max3f(b,p1[r+2],p1[r+3]);}
  const float m=max2f(a,b);
  auto rr=__builtin_amdgcn_permlane32_swap(__float_as_uint(m),__float_as_uint(m),false,false);
  return max2f(__uint_as_float(rr[0]),__uint_as_float(rr[1]));
}
__device__ __forceinline__ void pv(f32x16*o,int vb,bf16x8 pa0,bf16x8 pa1,bf16x8 pa2,bf16x8 pa3){
  #pragma unroll
  for(int d0=0;d0<2;++d0){s16x4 lo[4],hi[4];
    #pragma unroll
    for(int ks=0;ks<4;++ks){
      asm volatile("ds_read_b64_tr_b16 %0,%1 offset:%c2":"=&v"(lo[ks]):"v"(vb),"i"(d0*4096+ks*1024):"memory");
      asm volatile("ds_read_b64_tr_b16 %0,%1 offset:%c2":"=&v"(hi[ks]):"v"(vb),"i"(d0*4096+ks*1024+512):"memory");}
    asm volatile("s_waitcnt lgkmcnt(0)":::"memory");SBAR();
    #define PK(k) (bf16x8){lo[k][0],lo[k][1],lo[k][2],lo[k][3],hi[k][0],hi[k][1],hi[k][2],hi[k][3]}
    o[d0]=__builtin_amdgcn_mfma_f32_32x32x16_bf16(pa0,PK(0),o[d0],0,0,0);
    o[d0]=__builtin_amdgcn_mfma_f32_32x32x16_bf16(pa1,PK(1),o[d0],0,0,0);
    o[d0]=__builtin_amdgcn_mfma_f32_32x32x16_bf16(pa2,PK(2),o[d0],0,0,0);
    o[d0]=__builtin_amdgcn_mfma_f32_32x32x16_bf16(pa3,PK(3),o[d0],0,0,0);
    #undef PK
  }
}

#ifndef ATTN_STORE16
#define ATTN_STORE16(p,v) (*(u32x4*)(p)=(v))
#endif
struct UnitDesc { const bf16* Q; const bf16* K; const bf16* V; bf16* O; int NT, latoff, kpos4, qpos0; float sink2; };
template<int THRL,bool MASK> __device__ __forceinline__ void attn_unit(const UnitDesc&u,char*shm,const int tid_in){
  const int tid=tid_in; const int lane=tid&63,r32=lane&31,hi=lane>>5; const int wid=__builtin_amdgcn_readfirstlane(tid>>6);
  const int u_latoff=u.latoff;
  const bf16*Qw=u.Q+(long)(wid*QBLK)*DM;
  const bf16*Kh=u.K,*Vh=u.V;
  const unsigned lds0=(unsigned)(uintptr_t)shm;
  float*wsf=(float*)(shm+LDS_WS)+wid*64;
  const bf16*ksrc=Kh+(long)lane*DM+wid*8;
  const bf16*vsrc=Vh+(long)(16*(wid&3)+(lane>>2))*DM+(wid>>2)*32+(lane&3)*8;
  const unsigned kdst=lds0+LDS_K+wid*1024, vdst=lds0+LDS_V+wid*1024;
  #define TOFF(t) ((long)(((t)<4)?(t)*KVBLK:u_latoff+((t)-4)*KVBLK)*DM)
  #define DMA_K(t,slot) glds16(ksrc+TOFF(t),(unsigned)__builtin_amdgcn_readfirstlane(kdst+(slot)))
  #define DMA_V(t,slot) glds16(vsrc+TOFF(t),(unsigned)__builtin_amdgcn_readfirstlane(vdst+(slot)))
  const int vb0=(int)(lds0+LDS_V)+((lane>>4)&1)*32+(lane&3)*8+(4*hi+((lane&15)>>2))*64;
  const char*Kbase=shm+LDS_K; bf16x8 kf[8];
  const lds_cptr shm3=(lds_cptr)shm; const lds_cptr kp0=shm3+LDS_K+hi*1024+r32*16; const lds_cptr vp0=shm3+LDS_V+((lane>>4)&1)*32+(lane&3)*8+(4*hi+((lane&15)>>2))*64;
  const int NT=u.NT;
  DMA_K(0,0);DMA_V(0,0);DMA_K(1,SLOTB);
  bf16x8 qr[4];
  #pragma unroll
  for(int d0=0;d0<4;++d0)qr[d0]=*reinterpret_cast<const bf16x8*>(&Qw[(long)r32*DM+d0*16+hi*8]);
  float mhat=0.f,l_reg=0.f;f32x16 o[2];o[0]=f32x16{};o[1]=f32x16{};const f32x16 negm=f32x16{};
  const int qpos=u.qpos0+wid*QBLK+r32; const int kpos4=u.kpos4;
  #define CMASK(P0,P1,t) do{ if constexpr(MASK){ if((t)>=4) bandmask(P0,P1,kpos4+((t)-4)*KVBLK,qpos,hi); } }while(0)
  bool resc=false;
  #define START(P0,P1) do{ const float rm=rowmax(P0,P1); resc=false; \
    { const float dl=rm; mhat=fadd_s(mhat,dl); \
      _Pragma("unroll") for(int r=0;r<16;++r){P0[r]=fsub_s(P0[r],dl);P1[r]=fsub_s(P1[r],dl);} \
      } \
    _Pragma("unroll") for(int r=0;r<16;++r)P0[r]=__builtin_amdgcn_exp2f(P0[r]); }while(0)
  #define RESC() do{ if(resc){ asm volatile("s_waitcnt lgkmcnt(0)":::"memory"); \
      _Pragma("unroll") for(int d_=0;d_<2;++d_) _Pragma("unroll") for(int r=0;r<16;++r)o[d_][r]*=wsf[crow(r,hi)]; } }while(0)
  f32x16 pA0,pA1,pB0,pB1;
  int sl_prev=0,sl_cur=0,sl_next=SLOTB;
  #define ROT() do{sl_prev=sl_cur;sl_cur=sl_next;sl_next=(sl_next==(NSLOT-1)*SLOTB)?0:sl_next+SLOTB;}while(0)
  DMA_K(2,2*SLOTB);
  WAIT_BAR(3);
  qkt(pA0,pA1,Kbase,qr,negm,r32,hi);asm volatile("s_nop 15\n\ts_nop 7":"+v"(pA0),"+v"(pA1));CMASK(pA0,pA1,0);
  START(pA0,pA1);
  _Pragma("unroll") for(int r=0;r<16;++r)pA1[r]=__builtin_amdgcn_exp2f(pA1[r]);
  WAIT_BAR(0);
  DMA_K(3,0);DMA_V(1,SLOTB);
  ROT();
  kload8(kf,kp0+sl_cur);
  WAIT_BAR(2);
  s16x4 vlo[8],vhi[8]; u32x4 pw0,pw1,pw2,pw3;
  #define PKW(P,B) cvtpk_s(P[B],P[B+1])
  #define PAF(k) __builtin_bit_cast(bf16x8,pw##k)
  #define VFR(i) (bf16x8){vlo[i][0],vlo[i][1],vlo[i][2],vlo[i][3],vhi[i][0],vhi[i][1],vhi[i][2],vhi[i][3]}
  #define PIN(x) asm volatile("":"+v"(x))
  #define MX3(a,b,c) __builtin_fmaxf(__builtin_fmaxf((a),(b)),(c))
  #define GAPA(MF,A0,A1,A2,A3,W0,W1,PW) do{ MF; sacc+=A0; sacc+=A1; sacc+=A2; sacc+=A3; PIN(sacc); W0; W1; PIN(PW); SBAR(); }while(0)
  #define EX(v) __builtin_amdgcn_exp2f(v)
  #define GAPB(MF,X,B) do{ MF; X[B]=EX(X[B]); X[B+1]=EX(X[B+1]); X[B+2]=EX(X[B+2]); X[B+3]=EX(X[B+3]); PIN(X); SBAR(); }while(0)
  #define VRD(i) do{ vlo[i]=vtr(vp_+(((i)>>2)*4096+((i)&3)*1024)); vhi[i]=vtr(vp_+(((i)>>2)*4096+((i)&3)*1024+512)); }while(0)
  #define KRD(G,j) do{ if(G){ kload2(kf,kp0+sl_next,j); SBAR(); } }while(0)
  #define STEP(C0,C1,P0,P1,t,GK,GV,GL) do{ SBAR(); \
    const lds_cptr vp_=vp0+sl_prev; \
    VRD(0); SBAR(); float sacc=(P0[0]+P0[1]); \
    GAPA(C0=__builtin_amdgcn_mfma_f32_32x32x16_bf16(kf[0],qr[0],negm,0,0,0), P0[2],P0[3],P0[4],P0[5],     pw0[0]=PKW(P0,0), pw0[1]=PKW(P0,2), pw0); \
    VRD(4); SBAR(); GAPA(C1=__builtin_amdgcn_mfma_f32_32x32x16_bf16(kf[1],qr[0],negm,0,0,0), P0[6],P0[7],P0[8],P0[9],     pw0[2]=PKW(P0,4), pw0[3]=PKW(P0,6), pw0); \
    VRD(1); SBAR(); GAPA(C0=__builtin_amdgcn_mfma_f32_32x32x16_bf16(kf[2],qr[1],C0,0,0,0),   P0[10],P0[11],P0[12],P0[13], pw1[0]=PKW(P0,8), pw1[1]=PKW(P0,10), pw1); \
    VRD(5); SBAR(); GAPA(C1=__builtin_amdgcn_mfma_f32_32x32x16_bf16(kf[3],qr[1],C1,0,0,0),   P0[14],P0[15],P1[0],P1[1],   pw1[2]=PKW(P0,12),pw1[3]=PKW(P0,14), pw1); \
    VRD(2); SBAR(); GAPA(C0=__builtin_amdgcn_mfma_f32_32x32x16_bf16(kf[4],qr[2],C0,0,0,0),   P1[2],P1[3],P1[4],P1[5],     pw2[0]=PKW(P1,0), pw2[1]=PKW(P1,2), pw2); \
    VRD(6); SBAR(); GAPA(C1=__builtin_amdgcn_mfma_f32_32x32x16_bf16(kf[5],qr[2],C1,0,0,0),   P1[6],P1[7],P1[8],P1[9],     pw2[2]=PKW(P1,4), pw2[3]=PKW(P1,6), pw2); \
    VRD(3); SBAR(); GAPA(C0=__builtin_amdgcn_mfma_f32_32x32x16_bf16(kf[6],qr[3],C0,0,0,0),   P1[10],P1[11],P1[12],P1[13], pw3[0]=PKW(P1,8), pw3[1]=PKW(P1,10), pw3); \
    VRD(7); SBAR(); GAPA(C1=__builtin_amdgcn_mfma_f32_32x32x16_bf16(kf[7],qr[3],C1,0,0,0),   P1[14],P1[15],0.f,0.f,       pw3[2]=PKW(P1,12),pw3[3]=PKW(P1,14), pw3); \
    l_reg+=sacc; \
    if(GK){DMA_K((t)+3,sl_cur);} if(GV){DMA_V((t)+1,sl_next);} \
    CMASK(C0,C1,t); \
    { float a=MX3(C0[0],C0[1],C1[0]),b=MX3(C0[2],C0[3],C1[1]); a=MX3(a,C1[2],C1[3]); \
      _Pragma("unroll") for(int r=4;r<16;r+=4){a=MX3(a,C0[r],C0[r+1]);b=MX3(b,C0[r+2],C0[r+3]);a=MX3(a,C1[r],C1[r+1]);b=MX3(b,C1[r+2],C1[r+3]);} \
      float rm=__builtin_fmaxf(a,b); { auto rr=__builtin_amdgcn_permlane32_swap(__float_as_uint(rm),__float_as_uint(rm),false,false); rm=__builtin_fmaxf(__uint_as_float(rr[0]),__uint_as_float(rr[1])); } \
      rm-=mhat; resc=false; \
      if(__builtin_expect(__any(rm>(float)THRL),0)){ const float dl=__builtin_fmaxf(rm,0.f); mhat+=dl; \
        const float f=__builtin_amdgcn_exp2f(-dl); l_reg*=f; if(hi==0)wsf[r32]=f; resc=true; } \
      _Pragma("unroll") for(int r=0;r<16;++r){C0[r]-=mhat;C1[r]-=mhat;} } \
    SBAR(); \
    GAPB(o[0]=__builtin_amdgcn_mfma_f32_32x32x16_bf16(PAF(0),VFR(0),o[0],0,0,0), C0,0); \
    GAPB(o[1]=__builtin_amdgcn_mfma_f32_32x32x16_bf16(PAF(0),VFR(4),o[1],0,0,0), C0,4); \
    KRD(GL,0); GAPB(o[0]=__builtin_amdgcn_mfma_f32_32x32x16_bf16(PAF(1),VFR(1),o[0],0,0,0), C0,8); \
    KRD(GL,1); GAPB(o[1]=__builtin_amdgcn_mfma_f32_32x32x16_bf16(PAF(1),VFR(5),o[1],0,0,0), C0,12); \
    KRD(GL,2); GAPB(o[0]=__builtin_amdgcn_mfma_f32_32x32x16_bf16(PAF(2),VFR(2),o[0],0,0,0), C1,0); \
    KRD(GL,3); GAPB(o[1]=__builtin_amdgcn_mfma_f32_32x32x16_bf16(PAF(2),VFR(6),o[1],0,0,0), C1,4); \
    GAPB(o[0]=__builtin_amdgcn_mfma_f32_32x32x16_bf16(PAF(3),VFR(3),o[0],0,0,0), C1,8); \
    GAPB(o[1]=__builtin_amdgcn_mfma_f32_32x32x16_bf16(PAF(3),VFR(7),o[1],0,0,0), C1,12); \
    }while(0)
  int t=1;


  if constexpr(!MASK) for(;t+5<NT;t+=2){
    STEP(pB0,pB1,pA0,pA1,t,true,true,true);     WAIT_BAR(2); RESC(); ROT();
    STEP(pA0,pA1,pB0,pB1,t+1,true,true,true);   WAIT_BAR(2); RESC(); ROT();
  }


  #define ENDW(tt) do{ if((tt)+3<NT){WAIT_BAR(2);} else if((tt)+2<NT){WAIT_BAR(1);} else {WAIT_BAR(0);} }while(0)
  for(;t+1<NT;t+=2){
    STEP(pB0,pB1,pA0,pA1,t,(t+3<NT),(t+1<NT),(t+1<NT));       ENDW(t);   RESC(); ROT();
    STEP(pA0,pA1,pB0,pB1,t+1,(t+4<NT),(t+2<NT),(t+2<NT));     ENDW(t+1); RESC(); ROT();
  }
  STEP(pB0,pB1,pA0,pA1,NT-1,false,false,false); RESC();
  { float sacc=pB0[0]+pB0[1]; _Pragma("unroll") for(int r=2;r<16;++r)sacc+=pB0[r]; _Pragma("unroll") for(int r=0;r<16;++r)sacc+=pB1[r]; l_reg+=sacc;
    pw0=(u32x4){PKW(pB0,0),PKW(pB0,2),PKW(pB0,4),PKW(pB0,6)};pw1=(u32x4){PKW(pB0,8),PKW(pB0,10),PKW(pB0,12),PKW(pB0,14)};pw2=(u32x4){PKW(pB1,0),PKW(pB1,2),PKW(pB1,4),PKW(pB1,6)};pw3=(u32x4){PKW(pB1,8),PKW(pB1,10),PKW(pB1,12),PKW(pB1,14)};
    SBAR(); pv(o,vb0+sl_cur,PAF(0),PAF(1),PAF(2),PAF(3)); }
  #undef PKW
  #undef PAF
  #undef VFR
  #undef PIN
  #undef MX3
  #undef GAPA
  #undef GAPB
  #undef EX
  #undef VRD
  #undef KRD
  #undef STEP
  #undef ENDW
  {auto rr=__builtin_amdgcn_permlane32_swap(__float_as_uint(l_reg),__float_as_uint(l_reg),false,false);l_reg=__uint_as_float(rr[0])+__uint_as_float(rr[1]); l_reg+=__builtin_amdgcn_exp2f(u.sink2-mhat);}
  if(hi==0)wsf[32+r32]=l_reg;asm volatile("s_waitcnt lgkmcnt(0)":::"memory");
  float rli[16];
  #pragma unroll
  for(int r=0;r<16;++r)rli[r]=__builtin_amdgcn_rcpf(wsf[32+crow(r,hi)]);
  bf16*Ow=u.O+(long)(wid*QBLK)*DM;
  { bf16*stg=(bf16*)(shm+LDS_OST)+wid*2048;
    #pragma unroll
    for(int r=0;r<16;++r){const int orow=crow(r,hi);
      #pragma unroll
      for(int d0=0;d0<2;++d0)stg[orow*64+d0*32+r32]=__float2bfloat16(o[d0][r]*rli[r]);}
    asm volatile("s_waitcnt lgkmcnt(0)":::"memory");
    #pragma unroll
    for(int i=0;i<4;++i){const int row=i*8+(lane>>3),ch=lane&7; const u32x4 v=*(const u32x4*)(stg+row*64+ch*8); ATTN_STORE16(Ow+(long)row*DM+ch*8,v);} }
  asm volatile("s_waitcnt lgkmcnt(0)\n\ts_barrier":::"memory");
  #undef TOFF
  #undef DMA_K
  #undef DMA_V
  #undef CMASK
  #undef START
  #undef RESC
  #undef ROT
}
constexpr int ATTN_LDS_BYTES=LDS_BYTES;
#undef SBAR
#undef WAIT_BAR
}
#define GAS __attribute__((address_space(1)))
#define LAS __attribute__((address_space(3)))
typedef unsigned short bf16;
typedef unsigned v4u __attribute__((ext_vector_type(4)));
typedef float f32x4 __attribute__((ext_vector_type(4)));
typedef short bf16x8 __attribute__((ext_vector_type(8)));
typedef GAS unsigned gu32;
typedef GAS unsigned long long gu64;
#define RLX_AGENT __ATOMIC_RELAXED, __HIP_MEMORY_SCOPE_AGENT
#define LDS_WAIT() asm volatile("s_waitcnt lgkmcnt(0)" ::: "memory")
#define VM_WAIT() asm volatile("s_waitcnt vmcnt(0)" ::: "memory")
__device__ __forceinline__ unsigned long long rt() { return __builtin_amdgcn_s_memrealtime(); }
__device__ __forceinline__ unsigned f2bf(float f) { unsigned u = __builtin_bit_cast(unsigned, f); return (u + 0x7fffu + ((u >> 16) & 1u)) >> 16; }
__device__ __forceinline__ unsigned pk2(float lo, float hi) { return f2bf(lo) | (f2bf(hi) << 16); }

#define XB_TMO      128
#define XB_XCNT(j)  (256  + 64 * (j))
#define XB_XSUB(j)  (1280 + 64 * (j))
#define XB_XGEN(j)  (2304 + 64 * (j))
#define XB_TOP      3328
#define XB_TOPGEN   3392
#define XCD_BAR_WORDS 3456
#define XB_SPIN_CAP (1u << 29)

__device__ __forceinline__ unsigned xb_ld(unsigned* p)              { return __hip_atomic_load(p, __ATOMIC_RELAXED, __HIP_MEMORY_SCOPE_AGENT); }
__device__ __forceinline__ unsigned xb_add(unsigned* p, unsigned v) { return __hip_atomic_fetch_add(p, v, __ATOMIC_RELAXED, __HIP_MEMORY_SCOPE_AGENT); }
__device__ __forceinline__ unsigned xb_xcc_id() { return (unsigned)__builtin_amdgcn_s_getreg((3 << 11) | 20) & 0xFu; }
#define XB_SPIN(cond, bar) do { unsigned _sp = 0; while (cond) { __builtin_amdgcn_s_sleep(1); \
    if ((++_sp & 255u) == 0u) { if (xb_ld(&(bar)[XB_TMO])) break; if (_sp > XB_SPIN_CAP) { atomicAdd(&(bar)[XB_TMO], 1u); break; } } } } while (0)

struct XcdBarrier {
    unsigned* bar; unsigned x;
    volatile LAS unsigned* st;
};

__device__ __forceinline__ XcdBarrier xcd_barrier_post(unsigned* bar, volatile LAS unsigned* st, const int tid_in) {
    XcdBarrier b; b.bar = bar; b.x = xb_xcc_id(); b.st = st;
    if (tid_in == 0) (void)xb_add(&bar[XB_XCNT(b.x)], 1u);
    return b;
}
__device__ __forceinline__ void xcd_barrier_complete(unsigned* bar, unsigned x, unsigned& nloc, unsigned& nx) {
    const unsigned G = gridDim.x * gridDim.y * gridDim.z;
    unsigned sum, cnt, mine, sp = 0u;
    for (;;) {
        sum = 0u; cnt = 0u; mine = 0u;
#pragma unroll
        for (unsigned j = 0; j < 16; ++j) { const unsigned c = xb_ld(&bar[XB_XCNT(j)]); sum += c; cnt += (c > 0u) ? 1u : 0u; mine = (j == x) ? c : mine; }
        if (sum == G) break;
        __builtin_amdgcn_s_sleep(1);
        if ((++sp & 255u) == 0u) { if (xb_ld(&bar[XB_TMO])) break; if (sp > XB_SPIN_CAP) { atomicAdd(&bar[XB_TMO], 1u); break; } }
    }
    nloc = mine > 0u ? mine : 1u; nx = cnt > 0u ? cnt : 1u;
}

__device__ __forceinline__ void xcd_barrier(const XcdBarrier& b, const int tid_in) {
    asm volatile("s_waitcnt vmcnt(0)" ::: "memory");
    __syncthreads();
    if (tid_in == 0) {
        unsigned* bar = b.bar;
        __builtin_amdgcn_s_waitcnt(0);
        unsigned nloc = b.st[0], nx = b.st[1];
        if (nloc == 0u) { xcd_barrier_complete(bar, b.x, nloc, nx); b.st[0] = nloc; b.st[1] = nx; }
        const unsigned old = xb_add(&bar[XB_XSUB(b.x)], 1u);
        const unsigned gen = old / nloc;
        if (old + 1u == (gen + 1u) * nloc) {
            __builtin_amdgcn_fence(__ATOMIC_RELEASE, "agent");
            asm volatile("s_waitcnt vmcnt(0)" ::: "memory");
            const unsigned og = xb_add(&bar[XB_TOP], 1u);
            const unsigned tg = og / nx;
            if (og + 1u == (tg + 1u) * nx) xb_add(&bar[XB_TOPGEN], 1u);
            else XB_SPIN(xb_ld(&bar[XB_TOPGEN]) == tg, bar);
            __builtin_amdgcn_fence(__ATOMIC_ACQUIRE, "agent");
            xb_add(&bar[XB_XGEN(b.x)], 1u);
            asm volatile("s_waitcnt vmcnt(0)" ::: "memory");
        } else {
            XB_SPIN(xb_ld(&bar[XB_XGEN(b.x)]) == gen, bar);
            __builtin_amdgcn_fence(__ATOMIC_ACQUIRE, "agent");
            asm volatile("s_waitcnt vmcnt(0)" ::: "memory");
        }
    }
    __syncthreads();
}
constexpr int NB = 16, TL = 2048, LC = 256, SQ = TL + LC, MR = NB * SQ, DD = 1024, NLAYER = 4;
constexpr float LN_EPS = 1e-5f, DN_ALPHA = 1.6817928305074290f;
constexpr float LOG2E = 1.4426950408889634f;
constexpr int NWAVES = 8, NTHR = 512;
constexpr size_t MiB = 1u << 20;
constexpr size_t WS_CTL = 0, CTL_ZERO_BYTES = 1 * MiB;
constexpr size_t WS_MOD = 1 * MiB;
constexpr size_t WS_ROPE = 3 * MiB;
constexpr size_t WS_S5LB = 4 * MiB;
constexpr size_t WS_S5B = 4 * MiB + 128 * 1024;
constexpr size_t WS_S5C = 5 * MiB;
constexpr size_t WS_KEYS = 6 * MiB;
constexpr size_t WS_WQKV_DA = 8 * MiB;
constexpr size_t WS_WO_DA = 20 * MiB;
constexpr size_t WS_WQKV_WA = 24 * MiB;
constexpr size_t WS_WO_WA = 27 * MiB;
constexpr size_t WS_WGLU = 29 * MiB;
constexpr size_t WS_WPQ = 33 * MiB;
constexpr size_t WS_PU = 64 * MiB;
constexpr size_t WS_PV = 192 * MiB;
constexpr size_t WS_LAT = 320 * MiB;
constexpr size_t WS_H = 464 * MiB;
constexpr size_t WS_A = 536 * MiB;
constexpr size_t WS_B = 752 * MiB;
constexpr size_t WS_END = 896 * MiB;
constexpr size_t SZ72 = 72 * MiB;
constexpr int CW_TMO = 0, CW_CODE = 1, CW_ERR = 2;
constexpr int CW_BAR = 4096;
constexpr int RING_OFF = 0, RING_BYTES = 131072;
constexpr int LDSCTL_OFF = RING_BYTES, MISC_OFF = LDSCTL_OFF + 320;
constexpr int LDS_BYTES = 147456;
static_assert(MISC_OFF + 128 <= LDS_BYTES, "LDS map");

typedef __bf16 bf16x2v __attribute__((ext_vector_type(2)));
typedef float f32x16 __attribute__((ext_vector_type(16)));
__device__ __forceinline__ float dot2bf(unsigned w, unsigned x, float acc) { return __builtin_amdgcn_fdot2_f32_bf16(__builtin_bit_cast(bf16x2v, w), __builtin_bit_cast(bf16x2v, x), acc, false); }
__device__ __forceinline__ float bflo(unsigned u) { return __uint_as_float(u << 16); }
__device__ __forceinline__ float bfhi(unsigned u) { return __uint_as_float(u & 0xffff0000u); }
__device__ __forceinline__ float bf2f(bf16 h) { return __uint_as_float((unsigned)h << 16); }
__device__ __forceinline__ float wave_sum(float v) {
#pragma unroll
    for (int o = 1; o < 64; o <<= 1) v += __shfl_xor(v, o);
    return v;
}
__device__ __forceinline__ float gelu_tanh(float x) {
    const float z = 0.7978845608028654f * (x + 0.044715f * x * x * x);
    return x * __builtin_amdgcn_rcpf(1.f + __builtin_amdgcn_exp2f(-2.f * LOG2E * z));
}
__device__ __forceinline__ int mod_index(int row) { const int b = row / SQ; return (row - b * SQ) < LC ? 16 : b; }

__device__ __forceinline__ void p0_transpose_item(const float* W, int K, int N, bf16* WT, int glu, LAS float* scr, int item, int lane) {
    const int nblk = N / 32, kb = item / nblk, nb = item % nblk, k0 = 64 * kb, n0 = 32 * nb;
#pragma unroll 8
    for (int i = 0; i < 32; ++i) { const int kk = 2 * i + (lane >> 5); scr[kk * 33 + (lane & 31)] = W[(size_t)(k0 + kk) * N + n0 + (lane & 31)]; }
    LDS_WAIT(); asm volatile("" ::: "memory");
    const int c = lane & 7;
    int r0 = n0; if (glu) r0 = (n0 < 1024) ? ((n0 >> 7) * 256 + (n0 & 127)) : (((n0 - 1024) >> 7) * 256 + 128 + ((n0 - 1024) & 127));
#pragma unroll
    for (int j = 0; j < 4; ++j) { const int n = (lane >> 3) + 8 * j; const LAS float* s = scr + (8 * c) * 33 + n;
        v4u o; o.x = pk2(s[0 * 33], s[1 * 33]); o.y = pk2(s[2 * 33], s[3 * 33]); o.z = pk2(s[4 * 33], s[5 * 33]); o.w = pk2(s[6 * 33], s[7 * 33]);
        *(GAS v4u*)(WT + (size_t)(r0 + n) * K + k0 + 8 * c) = o; }
    LDS_WAIT(); asm volatile("" ::: "memory");
}
__device__ __forceinline__ void cvt_f32_bf16_stream(const float* src, bf16* dst, size_t nchunks8, size_t gt, size_t ngt) {
    for (size_t c = gt; c < nchunks8; c += ngt) { const f32x4 a = *(const GAS f32x4*)(src + c * 8), b = *(const GAS f32x4*)(src + c * 8 + 4);
        v4u o; o.x = pk2(a.x, a.y); o.y = pk2(a.z, a.w); o.z = pk2(b.x, b.y); o.w = pk2(b.z, b.w); *(GAS v4u*)(dst + c * 8) = o; }
}
struct Args;
template <class KP> __device__ __forceinline__ void p0_prologue(KP ka, unsigned char* ws, LAS unsigned char* lds, int vcu, int G, int tid, int lane, int wave) {
    const int gw = vcu * NWAVES + wave, NGW = G * NWAVES; const size_t gt = (size_t)vcu * NTHR + tid, ngt = (size_t)G * NTHR;
    { LAS float* scr = (LAS float*)(lds + wave * 16384);
      constexpr int I_QKV = 16 * 96, I_O = 16 * 32, I_WA = 16 * 48, I_G = 16 * 64, I_PQ = 16 * 64;
      constexpr int NITEMS = 2 * I_QKV + 2 * I_O + I_WA + I_O + I_G + 4 * I_PQ;
      for (int it = gw; it < NITEMS; it += NGW) { int r = it;
          if (r < 2 * I_QKV) { const int l = r / I_QKV; p0_transpose_item(ka->in[12] + (size_t)l * 1024 * 3072, 1024, 3072, (bf16*)(ws + WS_WQKV_DA) + (size_t)l * 3072 * 1024, 0, scr, r % I_QKV, lane); continue; } r -= 2 * I_QKV;
          if (r < 2 * I_O) { const int l = r / I_O; p0_transpose_item(ka->in[13] + (size_t)l * 1024 * 1024, 1024, 1024, (bf16*)(ws + WS_WO_DA) + (size_t)l * 1024 * 1024, 0, scr, r % I_O, lane); continue; } r -= 2 * I_O;
          if (r < I_WA) { p0_transpose_item(ka->in[16], 1024, 1536, (bf16*)(ws + WS_WQKV_WA), 0, scr, r, lane); continue; } r -= I_WA;
          if (r < I_O) { p0_transpose_item(ka->in[17], 1024, 1024, (bf16*)(ws + WS_WO_WA), 0, scr, r, lane); continue; } r -= I_O;
          if (r < I_G) { p0_transpose_item(ka->in[27], 1024, 2048, (bf16*)(ws + WS_WGLU), 1, scr, r, lane); continue; } r -= I_G;
          { const int l = r / I_PQ; p0_transpose_item(ka->in[8] + (size_t)l * 1024 * 2048, 1024, 2048, (bf16*)(ws + WS_WPQ) + (size_t)l * 2048 * 1024, 0, scr, r % I_PQ, lane); } }
    }
    cvt_f32_bf16_stream(ka->in[9], (bf16*)(ws + WS_KEYS), (size_t)4 * 2 * 8 * 128 * 128 / 8, gt, ngt);
    cvt_f32_bf16_stream(ka->in[10], (bf16*)(ws + WS_PU), (size_t)4 * 16384 * 1024 / 8, gt, ngt);
    cvt_f32_bf16_stream(ka->in[11], (bf16*)(ws + WS_PV), (size_t)4 * 16384 * 1024 / 8, gt, ngt);
    { float* cosT = (float*)(ws + WS_ROPE); float* sinT = cosT + 2048 * 32;
      for (size_t idx = gt; idx < 2048 * 32; idx += ngt) { const int t = (int)(idx >> 5), i = (int)(idx & 31), f = i & 15;
          const float inv = exp2f(-(float)f * (13.287712379549449f / 16.f));
          const float pos = (float)((i < 16) ? (t >> 6) : (t & 63)); const float ang = pos * inv;
          cosT[idx] = cosf(ang); sinT[idx] = sinf(ang); } }
    { float* LB = (float*)(ws + WS_S5LB); bf16* Bop = (bf16*)(ws + WS_S5B); bf16* Cop = (bf16*)(ws + WS_S5C);
      for (size_t idx = gt; idx < 2 * 64 * 64; idx += ngt) { const int p = (int)(idx & 63), rg = (int)(idx >> 6);
          const float re = ka->in[19][idx], im = ka->in[20][idx], step = expf(ka->in[21][rg]);
          const float mag = expf(re * step), lbr = mag * cosf(im * step), lbi = mag * sinf(im * step);
          const float a = lbr - 1.f, b = lbi, den = re * re + im * im, qr = (a * re + b * im) / den, qi = (b * re - a * im) / den;
          LB[idx * 2] = lbr; LB[idx * 2 + 1] = lbi;
          const int nre = (p >> 5) * 64 + (p & 31), nim = nre + 32;
          for (int h = 0; h < 16; ++h) { const float br = ka->in[22][idx * 16 + h], bi = ka->in[23][idx * 16 + h];
              Bop[((size_t)rg * 128 + nre) * 16 + h] = (bf16)f2bf(br * qr - bi * qi); Bop[((size_t)rg * 128 + nim) * 16 + h] = (bf16)f2bf(br * qi + bi * qr);
              const float cr = ka->in[24][((size_t)rg * 16 + h) * 64 + p], ci = ka->in[25][((size_t)rg * 16 + h) * 64 + p];
              Cop[((size_t)rg * 16 + h) * 128 + 2 * p] = (bf16)f2bf(cr); Cop[((size_t)rg * 16 + h) * 128 + 2 * p + 1] = (bf16)f2bf(-ci); } } }
    { LAS float* sl = (LAS float*)lds;
      LAS float* red = (LAS float*)(lds + 81920);
      __syncthreads();
      for (int idx = tid; idx < 17 * 1024; idx += NTHR) { const int r = idx >> 10, k = idx & 1023; const float v = (r < 16) ? ka->in[1][r * 1024 + k] : ka->in[3][k]; sl[k * 20 + r] = v / (1.f + expf(-v)); }
      __syncthreads();
      float* MOD = (float*)(ws + WS_MOD);
      for (int item = vcu; item < 4 * 96; item += G) { const int i = item / 96, n0 = (item % 96) * 64;
          const float* W = ka->in[4] + (size_t)i * 1024 * 6144 + n0 + lane;
          float acc[17];
#pragma unroll
          for (int r = 0; r < 17; ++r) acc[r] = 0.f;
#pragma unroll 4
          for (int kk = 0; kk < 128; ++kk) { const int k = wave * 128 + kk; const float w = W[(size_t)k * 6144];
              const f32x4 s0 = *(const LAS f32x4*)(sl + k * 20), s1 = *(const LAS f32x4*)(sl + k * 20 + 4), s2 = *(const LAS f32x4*)(sl + k * 20 + 8), s3 = *(const LAS f32x4*)(sl + k * 20 + 12); const float s4 = sl[k * 20 + 16];
              acc[0] += s0.x * w; acc[1] += s0.y * w; acc[2] += s0.z * w; acc[3] += s0.w * w; acc[4] += s1.x * w; acc[5] += s1.y * w; acc[6] += s1.z * w; acc[7] += s1.w * w;
              acc[8] += s2.x * w; acc[9] += s2.y * w; acc[10] += s2.z * w; acc[11] += s2.w * w; acc[12] += s3.x * w; acc[13] += s3.y * w; acc[14] += s3.z * w; acc[15] += s3.w * w; acc[16] += s4 * w; }
#pragma unroll
          for (int r = 0; r < 17; ++r) red[(wave * 17 + r) * 64 + lane] = acc[r];
          __syncthreads();
          for (int r = wave; r < 17; r += 8) { float t = 0.f;
#pragma unroll
              for (int w2 = 0; w2 < 8; ++w2) t += red[(w2 * 17 + r) * 64 + lane];
              MOD[((size_t)i * 17 + r) * 6144 + n0 + lane] = t + ka->in[5][i * 6144 + n0 + lane]; }
          __syncthreads(); } }
}
__device__ __forceinline__ void p1_embed(const float* x, const float* ctx, unsigned char* ws, int gw, int NGW, int lane) {
    float* LAT = (float*)(ws + WS_LAT); bf16* H = (bf16*)(ws + WS_H); const float* MOD = (const float*)(ws + WS_MOD);
    for (int row = gw; row < MR; row += NGW) { const int b = row / SQ, s = row - b * SQ;
        const float* src = (s < LC) ? ctx + ((size_t)b * LC + s) * DD : x + ((size_t)b * TL + (s - LC)) * DD;
        const float* md = MOD + (size_t)((s < LC) ? 16 : b) * 6144;
#pragma unroll
        for (int j = 0; j < 4; ++j) { const int c = 256 * j + 4 * lane; const f32x4 v = *(const GAS f32x4*)(src + c), sh = *(const GAS f32x4*)(md + c), sc = *(const GAS f32x4*)(md + 1024 + c);
            *(GAS f32x4*)(LAT + (size_t)row * DD + c) = v; const f32x4 h = v * (sc + 1.f) + sh;
            *(GAS unsigned long long*)(H + (size_t)row * DD + c) = (unsigned long long)pk2(h.x, h.y) | ((unsigned long long)pk2(h.z, h.w) << 32); } }
}
__device__ __forceinline__ void ln1_phase(unsigned char* ws, const float* lng, const float* lnb, int layer, int skip_ctx, int gw, int NGW, int lane) {
    const float* R = (const float*)(ws + WS_B); float* LAT = (float*)(ws + WS_LAT); bf16* H = (bf16*)(ws + WS_H); const float* MOD = (const float*)(ws + WS_MOD) + (size_t)layer * 17 * 6144;
    for (int row = gw; row < MR; row += NGW) { const int b = row / SQ, s = row - b * SQ; if (skip_ctx && s < LC) continue;
        const float* md = MOD + (size_t)((s < LC) ? 16 : b) * 6144;
        f32x4 v[4]; float sm = 0.f;
#pragma unroll
        for (int j = 0; j < 4; ++j) { v[j] = *(const GAS f32x4*)(R + (size_t)row * DD + 256 * j + 4 * lane); sm += (v[j].x + v[j].y) + (v[j].z + v[j].w); }
        const float mean = wave_sum(sm) * (1.f / DD); float s2 = 0.f;
#pragma unroll
        for (int j = 0; j < 4; ++j) { v[j] = v[j] - mean; s2 += (v[j].x * v[j].x + v[j].y * v[j].y) + (v[j].z * v[j].z + v[j].w * v[j].w); }
        const float rstd = 1.f / sqrtf(wave_sum(s2) * (1.f / DD) + LN_EPS);
#pragma unroll
        for (int j = 0; j < 4; ++j) { const int c = 256 * j + 4 * lane; const f32x4 g = *(const GAS f32x4*)(lng + c), bb = *(const GAS f32x4*)(lnb + c);
            const f32x4 y = v[j] * rstd * g + bb; *(GAS f32x4*)(LAT + (size_t)row * DD + c) = y;
            const f32x4 sh = *(const GAS f32x4*)(md + 3072 + c), sc = *(const GAS f32x4*)(md + 4096 + c); const f32x4 h = y * (sc + 1.f) + sh;
            *(GAS unsigned long long*)(H + (size_t)row * DD + c) = (unsigned long long)pk2(h.x, h.y) | ((unsigned long long)pk2(h.z, h.w) << 32); } }
}
__device__ __forceinline__ void da_combine_phase(unsigned char* ws, const float* lam_p, const float* subln, float lam_init, int skip_ctx, int gw, int NGW, int lane) {
    const bf16* O0 = (const bf16*)(ws + WS_B); const bf16* O1 = (const bf16*)(ws + WS_B + SZ72); bf16* OC = (bf16*)(ws + WS_A);
    float d01 = lam_p[lane] * lam_p[64 + lane], d23 = lam_p[128 + lane] * lam_p[192 + lane];
    d01 = wave_sum(d01); d23 = wave_sum(d23);
    const float lam = expf(d01) - expf(d23) + lam_init, post = 1.f - lam_init;
    float gs[16];
#pragma unroll
    for (int j = 0; j < 16; ++j) gs[j] = subln[((lane & 7) * 16 + j)] * post;
    for (int row = gw; row < MR; row += NGW) { const int b = row / SQ, s = row - b * SQ; if (skip_ctx && s < LC) continue;
        const size_t off = (size_t)row * DD + 16 * lane;
        const v4u a0 = *(const GAS v4u*)(O0 + off), a1 = *(const GAS v4u*)(O0 + off + 8), b0 = *(const GAS v4u*)(O1 + off), b1 = *(const GAS v4u*)(O1 + off + 8);
        float o[16];
        o[0] = bflo(a0.x) - lam * bflo(b0.x); o[1] = bfhi(a0.x) - lam * bfhi(b0.x); o[2] = bflo(a0.y) - lam * bflo(b0.y); o[3] = bfhi(a0.y) - lam * bfhi(b0.y);
        o[4] = bflo(a0.z) - lam * bflo(b0.z); o[5] = bfhi(a0.z) - lam * bfhi(b0.z); o[6] = bflo(a0.w) - lam * bflo(b0.w); o[7] = bfhi(a0.w) - lam * bfhi(b0.w);
        o[8] = bflo(a1.x) - lam * bflo(b1.x); o[9] = bfhi(a1.x) - lam * bfhi(b1.x); o[10] = bflo(a1.y) - lam * bflo(b1.y); o[11] = bfhi(a1.y) - lam * bfhi(b1.y);
        o[12] = bflo(a1.z) - lam * bflo(b1.z); o[13] = bfhi(a1.z) - lam * bfhi(b1.z); o[14] = bflo(a1.w) - lam * bflo(b1.w); o[15] = bfhi(a1.w) - lam * bfhi(b1.w);
        float ss = 0.f;
#pragma unroll
        for (int j = 0; j < 16; ++j) ss += o[j] * o[j];
        ss += __shfl_xor(ss, 1); ss += __shfl_xor(ss, 2); ss += __shfl_xor(ss, 4);
        const float rs = 1.f / sqrtf(ss * (1.f / 128.f) + LN_EPS);
        v4u w0, w1;
        w0.x = pk2(o[0] * rs * gs[0], o[1] * rs * gs[1]); w0.y = pk2(o[2] * rs * gs[2], o[3] * rs * gs[3]); w0.z = pk2(o[4] * rs * gs[4], o[5] * rs * gs[5]); w0.w = pk2(o[6] * rs * gs[6], o[7] * rs * gs[7]);
        w1.x = pk2(o[8] * rs * gs[8], o[9] * rs * gs[9]); w1.y = pk2(o[10] * rs * gs[10], o[11] * rs * gs[11]); w1.z = pk2(o[12] * rs * gs[12], o[13] * rs * gs[13]); w1.w = pk2(o[14] * rs * gs[14], o[15] * rs * gs[15]);
        *(GAS v4u*)(OC + off) = w0; *(GAS v4u*)(OC + off + 8) = w1; }
}
template <int N> __device__ __forceinline__ void sort_desc_u32(unsigned (&v)[N]) {
#pragma unroll
    for (int k = 2; k <= N; k <<= 1)
#pragma unroll
        for (int j = k >> 1; j > 0; j >>= 1)
#pragma unroll
            for (int i = 0; i < N; ++i) { const int l = i ^ j; if (l > i) { const unsigned a = v[i], b = v[l]; const unsigned mx = a > b ? a : b, mn = a > b ? b : a; const bool desc = ((i & k) == 0) || (k == N);
                    v[i] = desc ? mx : mn; v[l] = desc ? mn : mx; } }
}
template <int N> __device__ __forceinline__ void merge_desc_u32(unsigned (&v)[N]) {
#pragma unroll
    for (int j = N >> 1; j > 0; j >>= 1)
#pragma unroll
        for (int i = 0; i < N; ++i) { const int l = i ^ j; if (l > i) { const unsigned a = v[i], b = v[l]; v[i] = a > b ? a : b; v[l] = a > b ? b : a; } }
}
__device__ __forceinline__ void top16_u32(unsigned (&a)[16], const unsigned (&b)[16]) {
#pragma unroll
    for (int i = 0; i < 16; ++i) a[i] = a[i] > b[15 - i] ? a[i] : b[15 - i];
    merge_desc_u32<16>(a);
}
#define CE_F(i, l, up) do { const bool gt_ = s[i] > s[l]; const float s_hi = gt_ ? s[i] : s[l], s_lo = gt_ ? s[l] : s[i]; const int e_hi = gt_ ? e[i] : e[l], e_lo = gt_ ? e[l] : e[i]; \
        if (up) { s[i] = s_hi; s[l] = s_lo; e[i] = e_hi; e[l] = e_lo; } else { s[i] = s_lo; s[l] = s_hi; e[i] = e_lo; e[l] = e_hi; } } while (0)
template <int N> __device__ __forceinline__ void sort_desc_f(float (&s)[N], int (&e)[N]) {
#pragma unroll
    for (int k = 2; k <= N; k <<= 1)
#pragma unroll
        for (int j = k >> 1; j > 0; j >>= 1)
#pragma unroll
            for (int i = 0; i < N; ++i) { const int l = i ^ j; if (l > i) { const bool desc = ((i & k) == 0) || (k == N); CE_F(i, l, desc); } }
}
template <int N> __device__ __forceinline__ void merge_desc_f(float (&s)[N], int (&e)[N]) {
#pragma unroll
    for (int j = N >> 1; j > 0; j >>= 1)
#pragma unroll
        for (int i = 0; i < N; ++i) { const int l = i ^ j; if (l > i) { CE_F(i, l, true); } }
}
__device__ __forceinline__ unsigned fkey(float f) { const unsigned u = __float_as_uint(f); return u ^ ((unsigned)((int)u >> 31) | 0x80000000u); }
__device__ __forceinline__ float fdec(unsigned k) { const unsigned u = (k & 0x80000000u) ? (k ^ 0x80000000u) : ~k; return __uint_as_float(u); }

__device__ __forceinline__ void topk_phase(unsigned char* ws, int layer, int skip_ctx, LAS unsigned char* lds, int vcu, int G, int tid, int lane, int wave) {
    const bf16* PQ = (const bf16*)(ws + WS_A); const bf16* KEYS = (const bf16*)(ws + WS_KEYS) + (size_t)layer * 2 * 8 * 128 * 128;
    int* EIDX = (int*)(ws + WS_B); float* EG = (float*)(ws + WS_B + (size_t)MR * 128 * 4);
    const int nrt = skip_ctx ? 128 : 144, nunits = nrt * 8;
    const int r32 = lane & 31, hi = lane >> 5;
    constexpr int KP = 272;
    int cur_h = -1;
    for (int u = vcu; u < nunits; u += G) {
        const int h = u / nrt, rtl = u - h * nrt; const int rt = skip_ctx ? (rtl >> 3) * 9 + 1 + (rtl & 7) : rtl;
        if (h != cur_h) { __syncthreads();
            for (int c = tid; c < 2 * 128 * 16; c += NTHR) { const int j = c >> 11, k = (c >> 4) & 127, ch = c & 15;
                const v4u v = *(const GAS v4u*)(KEYS + ((size_t)(j * 8 + h) * 128 + k) * 128 + ch * 8); *(LAS v4u*)(lds + (j * 128 + k) * KP + ch * 16) = v; }
            __syncthreads(); cur_h = h; }
        const int row = rt * 256 + wave * 32 + r32;
        unsigned top[2][16];
#pragma unroll
        for (int j = 0; j < 2; ++j) {
            const bf16* qp = PQ + (size_t)row * 2048 + h * 256 + j * 128 + hi * 8;
            bf16x8 bq[8];
#pragma unroll
            for (int ks = 0; ks < 8; ++ks) bq[ks] = *(const GAS bf16x8*)(qp + ks * 16);
            f32x16 acc[4];
#pragma unroll
            for (int blk = 0; blk < 4; ++blk) { acc[blk] = (f32x16){};
#pragma unroll
                for (int ks = 0; ks < 8; ++ks) { const bf16x8 ka = *(const LAS bf16x8*)(lds + (j * 128 + blk * 32 + r32) * KP + (ks * 16 + hi * 8) * 2);
                    acc[blk] = __builtin_amdgcn_mfma_f32_32x32x16_bf16(ka, bq[ks], acc[blk], 0, 0, 0); } }
            unsigned t0[16], t1[16];
#pragma unroll
            for (int blk = 0; blk < 4; ++blk) { unsigned g[16];
#pragma unroll
                for (int r = 0; r < 16; ++r) g[r] = (fkey(acc[blk][r]) & ~127u) | (unsigned)(blk * 32 + (r & 3) + 8 * (r >> 2) + 4 * hi);
                sort_desc_u32<16>(g);
                if (blk == 0) {
#pragma unroll
                    for (int r = 0; r < 16; ++r) t0[r] = g[r];
                } else if (blk == 1) { top16_u32(t0, g); }
                else if (blk == 2) {
#pragma unroll
                    for (int r = 0; r < 16; ++r) t1[r] = g[r];
                } else { top16_u32(t1, g); } }
            top16_u32(t0, t1);
            unsigned oth[16];
#pragma unroll
            for (int r = 0; r < 16; ++r) oth[r] = (unsigned)__shfl_xor((int)t0[r], 32);
            top16_u32(t0, oth);
#pragma unroll
            for (int r = 0; r < 16; ++r) top[j][r] = t0[r];
        }
        LAS unsigned char* tab = lds + 2 * 128 * KP + wave * (64 * 36) + lane * 36;
#pragma unroll
        for (int r = 0; r < 16; ++r) { tab[r] = (unsigned char)(top[0][r] & 127u); tab[16 + r] = (unsigned char)(top[1][r] & 127u); }
        float sA[16], sB[16];
#pragma unroll
        for (int r = 0; r < 16; ++r) { sA[r] = fdec(top[0][r] & ~127u); sB[r] = fdec(top[1][r] & ~127u); }
        unsigned ck[32];
        { int c = 0;
#pragma unroll
          for (int a = 0; a < 16; ++a)
#pragma unroll
              for (int b = 0; b < 16; ++b) if ((a + 1) * (b + 1) <= 16) { const int slot = c >> 1; const unsigned kk = (fkey(sA[a] + sB[b]) & ~255u) | (unsigned)(a * 16 + b);
                      if ((c & 1) == 0) ck[slot] = kk; else ck[slot] = hi ? kk : ck[slot];
                      ++c; }
#pragma unroll
          for (int slot = 25; slot < 32; ++slot) ck[slot] = 0u; }
        sort_desc_u32<32>(ck);
        unsigned k16[16];
#pragma unroll
        for (int r = 0; r < 16; ++r) k16[r] = ck[r];
        { unsigned oth[16];
#pragma unroll
          for (int r = 0; r < 16; ++r) oth[r] = (unsigned)__shfl_xor((int)k16[r], 32);
          top16_u32(k16, oth); }
        asm volatile("s_waitcnt lgkmcnt(0)" ::: "memory");
        float s16[16]; int e16[16];
#pragma unroll
        for (int r = 0; r < 16; ++r) { s16[r] = fdec(k16[r] & ~255u); const int ia = tab[(k16[r] >> 4) & 15u], ib = tab[16 + (k16[r] & 15u)]; e16[r] = ia * 128 + ib; }
        float den = 0.f, p[16];
#pragma unroll
        for (int r = 0; r < 16; ++r) { p[r] = __builtin_amdgcn_exp2f((s16[r] - s16[0]) * LOG2E); den += p[r]; }
        const float rden = 1.f / den;
        const size_t ob = ((size_t)row * 8 + h) * 16;
        if (hi == 0) {
#pragma unroll
            for (int q = 0; q < 4; ++q) { v4u w; w.x = (unsigned)e16[4 * q]; w.y = (unsigned)e16[4 * q + 1]; w.z = (unsigned)e16[4 * q + 2]; w.w = (unsigned)e16[4 * q + 3]; *(GAS v4u*)(EIDX + ob + 4 * q) = w; }
        } else {
#pragma unroll
            for (int q = 0; q < 4; ++q) { f32x4 w; w.x = p[4 * q] * rden; w.y = p[4 * q + 1] * rden; w.z = p[4 * q + 2] * rden; w.w = p[4 * q + 3] * rden; *(GAS f32x4*)(EG + ob + 4 * q) = w; }
        }
    }
}

__device__ __forceinline__ void peer_phase(unsigned char* ws, float* d_out, const float* lng, const float* lnb, int layer, int last, int gw, int NGW, int lane) {
    const bf16* H = (const bf16*)(ws + WS_H); float* LAT = (float*)(ws + WS_LAT); bf16* Hn = (bf16*)(ws + WS_H);
    const bf16* PU = (const bf16*)(ws + WS_PU) + (size_t)layer * 16384 * 1024; const bf16* PV = (const bf16*)(ws + WS_PV) + (size_t)layer * 16384 * 1024;
    const int* EIDX = (const int*)(ws + WS_B); const float* EG = (const float*)(ws + WS_B + (size_t)MR * 128 * 4);
    const float* MOD = (const float*)(ws + WS_MOD) + (size_t)layer * 17 * 6144; const float* MODN = MOD + 17 * 6144;
    const int b3 = (lane >> 3) & 1, b4 = (lane >> 4) & 1, b5 = lane >> 5;
    for (int row = gw; row < MR; row += NGW) { const int b = row / SQ, s = row - b * SQ; if (last && s < LC) continue;
        const int midx = (s < LC) ? 16 : b;
        const v4u xa = *(const GAS v4u*)(H + (size_t)row * DD + 8 * lane), xb = *(const GAS v4u*)(H + (size_t)row * DD + 512 + 8 * lane);
        const int e_lo = EIDX[(size_t)row * 128 + lane], e_hi = EIDX[(size_t)row * 128 + 64 + lane];
        const float g_lo = EG[(size_t)row * 128 + lane], g_hi = EG[(size_t)row * 128 + 64 + lane];
        float out[16];
#pragma unroll
        for (int j = 0; j < 16; ++j) out[j] = 0.f;
        for (int kb = 0; kb < 128; kb += 8) {
            const int esel = (kb < 64) ? e_lo : e_hi; const float gsel = (kb < 64) ? g_lo : g_hi;
            v4u ua[8], ub[8], va[8], vb[8];
#pragma unroll
            for (int k = 0; k < 8; ++k) { const int ek = __builtin_amdgcn_readlane(esel, (kb & 63) + k);
                const bf16* up = PU + (size_t)ek * 1024 + 8 * lane; ua[k] = *(const GAS v4u*)up; ub[k] = *(const GAS v4u*)(up + 512); }
#pragma unroll
            for (int k = 0; k < 8; ++k) { const int ek = __builtin_amdgcn_readlane(esel, (kb & 63) + k);
                const bf16* vp = PV + (size_t)ek * 1024 + 8 * lane; va[k] = *(const GAS v4u*)vp; vb[k] = *(const GAS v4u*)(vp + 512); }
            float d[8];
#pragma unroll
            for (int k = 0; k < 8; ++k) { float a0 = dot2bf(ua[k].x, xa.x, 0.f), a1 = dot2bf(ua[k].y, xa.y, 0.f); a0 = dot2bf(ua[k].z, xa.z, a0); a1 = dot2bf(ua[k].w, xa.w, a1);
                a0 = dot2bf(ub[k].x, xb.x, a0); a1 = dot2bf(ub[k].y, xb.y, a1); a0 = dot2bf(ub[k].z, xb.z, a0); a1 = dot2bf(ub[k].w, xb.w, a1); d[k] = a0 + a1; }
            float s4[4], s2[2], s1;
#pragma unroll
            for (int k = 0; k < 4; ++k) { const float snd = b5 ? d[k] : d[k + 4], mine = b5 ? d[k + 4] : d[k]; s4[k] = mine + __shfl_xor(snd, 32); }
#pragma unroll
            for (int k = 0; k < 2; ++k) { const float snd = b4 ? s4[k] : s4[k + 2], mine = b4 ? s4[k + 2] : s4[k]; s2[k] = mine + __shfl_xor(snd, 16); }
            { const float snd = b3 ? s2[0] : s2[1], mine = b3 ? s2[1] : s2[0]; s1 = mine + __shfl_xor(snd, 8); }
            s1 += __shfl_xor(s1, 4); s1 += __shfl_xor(s1, 2); s1 += __shfl_xor(s1, 1);
            const float gk = __shfl(gsel, (kb & 63) + (lane >> 3));
            const float w = gk * gelu_tanh(s1);
#pragma unroll
            for (int k = 0; k < 8; ++k) { const float wk = __uint_as_float((unsigned)__builtin_amdgcn_readlane((int)__float_as_uint(w), 8 * k));
                out[0] += wk * bflo(va[k].x); out[1] += wk * bfhi(va[k].x); out[2] += wk * bflo(va[k].y); out[3] += wk * bfhi(va[k].y);
                out[4] += wk * bflo(va[k].z); out[5] += wk * bfhi(va[k].z); out[6] += wk * bflo(va[k].w); out[7] += wk * bfhi(va[k].w);
                out[8] += wk * bflo(vb[k].x); out[9] += wk * bfhi(vb[k].x); out[10] += wk * bflo(vb[k].y); out[11] += wk * bfhi(vb[k].y);
                out[12] += wk * bflo(vb[k].z); out[13] += wk * bfhi(vb[k].z); out[14] += wk * bflo(vb[k].w); out[15] += wk * bfhi(vb[k].w); }
        }
        const float* md = MOD + (size_t)midx * 6144; float r[16]; float sm = 0.f;
#pragma unroll
        for (int hf = 0; hf < 2; ++hf)
#pragma unroll
            for (int q = 0; q < 2; ++q) { const int c = 512 * hf + 8 * lane + 4 * q; const f32x4 lv = *(const GAS f32x4*)(LAT + (size_t)row * DD + c), gv = *(const GAS f32x4*)(md + 5120 + c);
#pragma unroll
                for (int j = 0; j < 4; ++j) { const float t = DN_ALPHA * lv[j] + gv[j] * out[8 * hf + 4 * q + j]; r[8 * hf + 4 * q + j] = t; sm += t; } }
        const float mean = wave_sum(sm) * (1.f / DD); float s2s = 0.f;
#pragma unroll
        for (int j = 0; j < 16; ++j) { r[j] -= mean; s2s += r[j] * r[j]; }
        const float rstd = 1.f / sqrtf(wave_sum(s2s) * (1.f / DD) + LN_EPS);
        const float* mdn = MODN + (size_t)midx * 6144;
#pragma unroll
        for (int hf = 0; hf < 2; ++hf) { float y[8];
#pragma unroll
            for (int q = 0; q < 2; ++q) { const int c = 512 * hf + 8 * lane + 4 * q; const f32x4 g = *(const GAS f32x4*)(lng + c), bb = *(const GAS f32x4*)(lnb + c);
#pragma unroll
                for (int j = 0; j < 4; ++j) y[4 * q + j] = r[8 * hf + 4 * q + j] * rstd * g[j] + bb[j]; }
            const int c0 = 512 * hf + 8 * lane;
            if (last) { float* op = d_out + ((size_t)b * TL + (s - LC)) * DD + c0; *(GAS f32x4*)op = (f32x4){y[0], y[1], y[2], y[3]}; *(GAS f32x4*)(op + 4) = (f32x4){y[4], y[5], y[6], y[7]}; }
            else { float* lp = LAT + (size_t)row * DD + c0; *(GAS f32x4*)lp = (f32x4){y[0], y[1], y[2], y[3]}; *(GAS f32x4*)(lp + 4) = (f32x4){y[4], y[5], y[6], y[7]};
                float hh[8];
#pragma unroll
                for (int q = 0; q < 2; ++q) { const f32x4 sh = *(const GAS f32x4*)(mdn + c0 + 4 * q), sc = *(const GAS f32x4*)(mdn + 1024 + c0 + 4 * q);
#pragma unroll
                    for (int j = 0; j < 4; ++j) hh[4 * q + j] = y[4 * q + j] * (1.f + sc[j]) + sh[j]; }
                v4u w; w.x = pk2(hh[0], hh[1]); w.y = pk2(hh[2], hh[3]); w.z = pk2(hh[4], hh[5]); w.w = pk2(hh[6], hh[7]); *(GAS v4u*)(Hn + (size_t)row * DD + c0) = w; } }
    }
}

__device__ __forceinline__ int s5_pos(int dir, int step) { return dir == 0 ? step : (step < LC ? (LC - 1 - step) : (SQ + LC - 1 - step)); }
__device__ __forceinline__ void s5_phase(unsigned char* ws, const float* dskip, LAS unsigned char* lds, int vcu, int tid, int lane, int wave) {
    if (wave >= 2) return;
    const bf16* U = (const bf16*)(ws + WS_H); float* YP = (float*)(ws + WS_A + SZ72); bf16* YG = (bf16*)(ws + WS_A);
    const float* LB = (const float*)(ws + WS_S5LB); const bf16* Bop = (const bf16*)(ws + WS_S5B); const bf16* Cop = (const bf16*)(ws + WS_S5C);
    const int wt = vcu * 2 + wave; if (wt >= 512) return;
    const int bp = wt >> 6, g = wt & 63; const int r32 = lane & 31, hi = lane >> 5, t16 = lane & 15, q4 = lane >> 4;
    constexpr int XP = 272;
    LAS unsigned char* img = lds + wave * 16384;
    const int a_b = 2 * bp + ((r32 >> 2) & 1), a_t = (r32 & 3) + 4 * (r32 >> 3);
    f32x4 dv; { const f32x4 t = *(const GAS f32x4*)(dskip + g * 16 + 4 * q4); dv = t; }
    for (int dir = 0; dir < 2; ++dir) {
        const int rg = dir * 64 + g;
        bf16x8 Bf[4], Cf[4];
#pragma unroll
        for (int blk = 0; blk < 4; ++blk) Bf[blk] = *(const GAS bf16x8*)(Bop + ((size_t)rg * 128 + blk * 32 + r32) * 16 + 8 * hi);
#pragma unroll
        for (int ks = 0; ks < 4; ++ks) Cf[ks] = *(const GAS bf16x8*)(Cop + ((size_t)rg * 16 + t16) * 128 + 32 * ks + 8 * q4);
        const float l0r = LB[((size_t)rg * 64 + r32) * 2], l0i = LB[((size_t)rg * 64 + r32) * 2 + 1], l1r = LB[((size_t)rg * 64 + 32 + r32) * 2], l1i = LB[((size_t)rg * 64 + 32 + r32) * 2 + 1];
        float x0r = 0.f, x0i = 0.f, x1r = 0.f, x1i = 0.f;
        bf16x8 an = *(const GAS bf16x8*)(U + ((size_t)a_b * SQ + s5_pos(dir, a_t)) * DD + g * 16 + 8 * hi);
        for (int tile = 0; tile < SQ / 16; ++tile) {
            const bf16x8 a = an;
            if (tile + 1 < SQ / 16) an = *(const GAS bf16x8*)(U + ((size_t)a_b * SQ + s5_pos(dir, (tile + 1) * 16 + a_t)) * DD + g * 16 + 8 * hi);
            f32x16 acc[4];
#pragma unroll
            for (int blk = 0; blk < 4; ++blk) acc[blk] = __builtin_amdgcn_mfma_f32_32x32x16_bf16(a, Bf[blk], (f32x16){}, 0, 0, 0);
#pragma unroll
            for (int r = 0; r < 16; ++r) {
                const float n0r = l0r * x0r - l0i * x0i + acc[0][r], n0i = l0r * x0i + l0i * x0r + acc[1][r];
                const float n1r = l1r * x1r - l1i * x1i + acc[2][r], n1i = l1r * x1i + l1i * x1r + acc[3][r];
                x0r = n0r; x0i = n0i; x1r = n1r; x1i = n1i;
                *(LAS unsigned*)(img + (hi * 16 + r) * XP + r32 * 4) = pk2(n0r, n0i);
                *(LAS unsigned*)(img + (hi * 16 + r) * XP + 128 + r32 * 4) = pk2(n1r, n1i);
            }
            asm volatile("s_waitcnt lgkmcnt(0)" ::: "memory");
#pragma unroll
            for (int bb = 0; bb < 2; ++bb) { f32x4 y = (f32x4){0.f, 0.f, 0.f, 0.f};
#pragma unroll
                for (int ks = 0; ks < 4; ++ks) { const bf16x8 xb = *(const LAS bf16x8*)(img + (bb * 16 + t16) * XP + (32 * ks + 8 * q4) * 2);
                    y = __builtin_amdgcn_mfma_f32_16x16x32_bf16(Cf[ks], xb, y, 0, 0, 0); }
                const size_t off = ((size_t)(2 * bp + bb) * SQ + s5_pos(dir, tile * 16 + t16)) * DD + g * 16 + 4 * q4;
                if (dir == 0) { const unsigned long long uu = *(const GAS unsigned long long*)(U + off); const unsigned ulo = (unsigned)uu, uhi = (unsigned)(uu >> 32);
                    f32x4 o; o.x = y.x + dv.x * bflo(ulo); o.y = y.y + dv.y * bfhi(ulo); o.z = y.z + dv.z * bflo(uhi); o.w = y.w + dv.w * bfhi(uhi); *(GAS f32x4*)(YP + off) = o; }
                else { const f32x4 pv = *(const GAS f32x4*)(YP + off); const float o0 = gelu_tanh(pv.x + y.x), o1 = gelu_tanh(pv.y + y.y), o2 = gelu_tanh(pv.z + y.z), o3 = gelu_tanh(pv.w + y.w);
                    *(GAS unsigned long long*)(YG + off) = (unsigned long long)pk2(o0, o1) | ((unsigned long long)pk2(o2, o3) << 32); } }
            asm volatile("s_waitcnt lgkmcnt(0)" ::: "memory");
        }
        asm volatile("s_waitcnt vmcnt(0)" ::: "memory");
    }
}
#ifndef MK_DEBUG
#define MK_DEBUG 0
#endif
#if MK_DEBUG
__device__ __forceinline__ void chk_fail(gu32* ctl, unsigned code) { unsigned expect = 0u; __hip_atomic_compare_exchange_strong((unsigned*)(ctl + CW_ERR), &expect, code, __ATOMIC_RELAXED, __ATOMIC_RELAXED, __HIP_MEMORY_SCOPE_AGENT); }
__device__ __forceinline__ bool chk_close(float got, float ref, float rtol, float atol) { const float d = fabsf(got - ref); return (d <= atol + rtol * fabsf(ref)) && (got == got); }
__device__ __forceinline__ float bfround(float f) { return __uint_as_float(f2bf(f) << 16); }
__device__ __forceinline__ float chk_dot(const bf16* arow, const float* W, int N, int col) { float s = 0.f; for (int k = 0; k < 1024; ++k) s += bf2f(arow[k]) * bfround(W[(size_t)k * N + col]); return s; }
__device__ __forceinline__ int chk_row(int i) { const int b = (i * 5) & 15; const int sel = i & 7; const int s = (sel == 0) ? 3 : (sel == 1) ? 255 : (sel == 2) ? 256 : (sel == 3) ? 2303 : (sel == 4) ? 777 : (sel == 5) ? 1400 : (sel == 6) ? 130 : 2000; return b * SQ + s; }

__device__ __forceinline__ void check_pre_peer(unsigned char* ws, int layer, int tid) {
    const int row = chk_row(3 + 2 * layer);
    for (int c = tid; c < 1024; c += NTHR) { ((float*)(ws + WS_CTL + 262144))[c] = ((const float*)(ws + WS_LAT))[(size_t)row * DD + c]; ((bf16*)(ws + WS_CTL + 262144 + 4096))[c] = ((const bf16*)(ws + WS_H))[(size_t)row * DD + c]; }
}
template <class KP> __device__ __forceinline__ void check_step(KP ka, unsigned char* ws, LAS unsigned char* lds, int op, int layer, int code, int tid, int lane, int wave) {
#define CHK_FRESH asm volatile("" : "+v"(lane), "+v"(tid), "+s"(ws));
    const int kind = layer % 3, jj = layer / 3, last = (layer == NLAYER - 1);
#ifndef CHK_MASK
#define CHK_MASK 0xFFFF
#endif
    if (!((CHK_MASK >> op) & 1)) return;
    bool bad = false;
#define MOD ((const float*)(ws + WS_MOD) + (size_t)layer * 17 * 6144)
    if (op == 9) { CHK_FRESH
        if (wave == 0) {
            { const int i = lane & 3, r = lane % 17, n = (lane * 97 + 13) % 6144; float s = 0.f;
              for (int k = 0; k < 1024; ++k) { const float v = (r < 16) ? ka->in[1][r * 1024 + k] : ka->in[3][k]; s += v / (1.f + expf(-v)) * ka->in[4][((size_t)i * 1024 + k) * 6144 + n]; }
              s += ka->in[5][i * 6144 + n]; bad |= !chk_close(((const float*)(ws + WS_MOD))[((size_t)i * 17 + r) * 6144 + n], s, 1e-3f, 1e-3f); }
            { const int n = (lane * 131 + 7) % 3072, k = (lane * 37 + 5) % 1024; bad |= bf2f(((const bf16*)(ws + WS_WQKV_DA))[((size_t)3072 + n) * 1024 + k]) != bfround(ka->in[12][(size_t)1024 * 3072 + (size_t)k * 3072 + n]); }
            { const int n = (lane * 131 + 7) % 1536, k = (lane * 37 + 5) % 1024; bad |= bf2f(((const bf16*)(ws + WS_WQKV_WA))[(size_t)n * 1024 + k]) != bfround(ka->in[16][(size_t)k * 1536 + n]); }
            { const int n = (lane * 131 + 7) % 1024, k = (lane * 37 + 5) % 1024; bad |= bf2f(((const bf16*)(ws + WS_WO_DA))[((size_t)1024 + n) * 1024 + k]) != bfround(ka->in[13][(size_t)1024 * 1024 + (size_t)k * 1024 + n]);
              bad |= bf2f(((const bf16*)(ws + WS_WO_WA))[(size_t)n * 1024 + k]) != bfround(ka->in[17][(size_t)k * 1024 + n]); }
            { const int n = (lane * 131 + 7) % 2048, k = (lane * 37 + 5) % 1024; const int pr = (n < 1024) ? ((n >> 7) * 256 + (n & 127)) : (((n - 1024) >> 7) * 256 + 128 + ((n - 1024) & 127));
              bad |= bf2f(((const bf16*)(ws + WS_WGLU))[(size_t)pr * 1024 + k]) != bfround(ka->in[27][(size_t)k * 2048 + n]);
              bad |= bf2f(((const bf16*)(ws + WS_WPQ))[((size_t)3 * 2048 + n) * 1024 + k]) != bfround(ka->in[8][(size_t)3 * 1024 * 2048 + (size_t)k * 2048 + n]); }
            { const size_t idx = (size_t)lane * 1048583u + 12345u; bad |= bf2f(((const bf16*)(ws + WS_PU))[idx]) != bfround(ka->in[10][idx]); bad |= bf2f(((const bf16*)(ws + WS_PV))[idx + 999]) != bfround(ka->in[11][idx + 999]);
              bad |= bf2f(((const bf16*)(ws + WS_KEYS))[idx % 2097152]) != bfround(ka->in[9][idx % 2097152]); }
            { const int t = (lane * 31 + 3) % 2048, i = lane & 31; const float inv = powf(10000.f, -(float)(i & 15) / 16.f); const float ang = (float)((i < 16) ? (t >> 6) : (t & 63)) * inv;
              bad |= !chk_close(((const float*)(ws + WS_ROPE))[t * 32 + i], cosf(ang), 0.f, 2e-5f); bad |= !chk_close(((const float*)(ws + WS_ROPE))[2048 * 32 + t * 32 + i], sinf(ang), 0.f, 2e-5f); }
        }
    } else if (op == 10) { CHK_FRESH
        if (wave == 0) { const int row = chk_row(lane), b = row / SQ, s = row - b * SQ, c = (lane * 53 + 1) % 1024; const float v = (s < LC) ? ka->in[2][((size_t)b * LC + s) * DD + c] : ka->in[0][((size_t)b * TL + s - LC) * DD + c];
            const float* md = (const float*)(ws + WS_MOD) + (size_t)((s < LC) ? 16 : b) * 6144;
            bad |= ((const float*)(ws + WS_LAT))[(size_t)row * DD + c] != v; bad |= !chk_close(bf2f(((const bf16*)(ws + WS_H))[(size_t)row * DD + c]), v * (1.f + md[1024 + c]) + md[c], 1e-2f, 1e-2f); }
    } else if (op == 0) { CHK_FRESH
        if (wave == 0) { const int row = chk_row(lane), b = row / SQ, s = row - b * SQ; const int N = (kind == 0) ? 3072 : 1536; const int col = ((lane * 211 + 17) % N) & ~1;
            const float* W = (kind == 0) ? ka->in[12] + (size_t)jj * 1024 * 3072 : ka->in[16]; const bf16* hrow = (const bf16*)(ws + WS_H) + (size_t)row * DD;
            float e = chk_dot(hrow, W, N, col), o = chk_dot(hrow, W, N, col + 1);
            const int kstart = 1024, vstart = (kind == 0) ? 2048 : 1280; const int reg = (col < kstart) ? 0 : (col < vstart) ? 1 : 2; const int lc = col - ((reg == 0) ? 0 : (reg == 1) ? kstart : vstart);
            if (reg < 2 && s >= LC) { const int t = s - LC, i = (lc & 63) >> 1; const float cs = ((const float*)(ws + WS_ROPE))[t * 32 + i], sn = ((const float*)(ws + WS_ROPE))[2048 * 32 + t * 32 + i]; const float e2 = e * cs - o * sn, o2 = e * sn + o * cs; e = e2; o = o2; }
            if (reg == 0) { e *= 0.125f * LOG2E; o *= 0.125f * LOG2E; }
            const bf16* dst = (const bf16*)(ws + WS_A + (size_t)reg * SZ72) + (size_t)row * DD + lc;
            bad |= !chk_close(bf2f(dst[0]), e, 2e-2f, 2e-2f); bad |= !chk_close(bf2f(dst[1]), o, 2e-2f, 2e-2f);
            if (kind == 1) { const int hq = (lane * 5 + 2) & 15; bf16* sv = (bf16*)(ws + WS_CTL + 300000) + lane * 64; for (int cc = 0; cc < 64; ++cc) sv[cc] = ((const bf16*)(ws + WS_A))[(size_t)row * DD + hq * 64 + cc]; } }
    } else if (op == 1) { CHK_FRESH
        if (wave == 0 && kind == 0) { const int row = chk_row(lane), b = row / SQ, s = row - b * SQ; if (!(last && s < LC)) { const int hh = (lane * 7 + 3) & 31, h = hh >> 2, j = (hh >> 1) & 1, vh = hh & 1, d = (lane * 11) & 63;
            const bf16* q = (const bf16*)(ws + WS_A) + (size_t)row * DD + h * 128 + j * 64; const bf16* Kb = (const bf16*)(ws + WS_A + SZ72) + (size_t)b * SQ * DD + h * 128 + j * 64; const bf16* Vb = (const bf16*)(ws + WS_A + 2 * SZ72) + (size_t)b * SQ * DD + h * 128 + vh * 64 + d;
            const int nk = (s < LC) ? LC : SQ; float m = -INFINITY;
            for (int k = 0; k < nk; ++k) { float sc = 0.f; for (int c = 0; c < 64; ++c) sc += bf2f(q[c]) * bf2f(Kb[(size_t)k * DD + c]); m = fmaxf(m, sc); }
            float l = 0.f, o = 0.f;
            for (int k = 0; k < nk; ++k) { float sc = 0.f; for (int c = 0; c < 64; ++c) sc += bf2f(q[c]) * bf2f(Kb[(size_t)k * DD + c]); const float p = exp2f(sc - m); l += p; o += p * bf2f(Vb[(size_t)k * DD]); }
            const bf16* O = (const bf16*)(ws + WS_B + (size_t)j * SZ72) + (size_t)row * DD + h * 128 + vh * 64 + d;
            bad |= !chk_close(bf2f(O[0]), o / l, 3e-2f, 1e-2f); } }
        if (wave == 0 && kind == 1) { const int row = chk_row(lane), b = row / SQ, s = row - b * SQ; if (!(last && s < LC)) { const int hq = (lane * 5 + 2) & 15, d = (lane * 11) & 63;
            const bf16* q = (const bf16*)(ws + WS_CTL + 300000) + lane * 64; const bf16* Kb = (const bf16*)(ws + WS_A + SZ72) + (size_t)b * SQ * DD + (hq >> 2) * 64; const bf16* Vb = (const bf16*)(ws + WS_A + 2 * SZ72) + (size_t)b * SQ * DD + (hq >> 2) * 64 + d;
            float m = -INFINITY;
            for (int k = 0; k < SQ; ++k) { if (k >= LC) { if (s < LC) break; const int dd = (k - LC) - (s - LC); if (dd > 128 || dd < -128) continue; }
                float sc = 0.f; for (int c2 = 0; c2 < 64; ++c2) sc += bf2f(q[c2]) * bf2f(Kb[(size_t)k * DD + c2]); m = fmaxf(m, sc); }
            float l = 0.f, o = 0.f;
            for (int k = 0; k < SQ; ++k) { if (k >= LC) { if (s < LC) break; const int dd = (k - LC) - (s - LC); if (dd > 128 || dd < -128) continue; }
                float sc = 0.f; for (int c2 = 0; c2 < 64; ++c2) sc += bf2f(q[c2]) * bf2f(Kb[(size_t)k * DD + c2]); const float p = exp2f(sc - m); l += p; o += p * bf2f(Vb[(size_t)k * DD]); }
            l += exp2f(ka->in[18][hq] * LOG2E - m);
            bad |= !chk_close(bf2f(((const bf16*)(ws + WS_A))[(size_t)row * DD + hq * 64 + d]), o / l, 3e-2f, 1e-2f); } }
    } else if (op == 2) { CHK_FRESH
        if (wave == 0) { const int row = chk_row(lane), b = row / SQ, s = row - b * SQ; if (!(last && s < LC)) { const int h = lane & 7, e0 = (lane * 13) & 127;
            const float* lp = ka->in[14] + jj * 256; float d01 = 0.f, d23 = 0.f; for (int i = 0; i < 64; ++i) { d01 += lp[i] * lp[64 + i]; d23 += lp[128 + i] * lp[192 + i]; }
            const float lam_init = 0.8f - 0.6f * expf(-0.3f * (float)layer), lam = expf(d01) - expf(d23) + lam_init;
            const bf16* o0 = (const bf16*)(ws + WS_B) + (size_t)row * DD + h * 128; const bf16* o1 = (const bf16*)(ws + WS_B + SZ72) + (size_t)row * DD + h * 128; float ss = 0.f;
            for (int e = 0; e < 128; ++e) { const float v = bf2f(o0[e]) - lam * bf2f(o1[e]); ss += v * v; }
            const float v = (bf2f(o0[e0]) - lam * bf2f(o1[e0])) / sqrtf(ss / 128.f + LN_EPS) * ka->in[15][jj * 128 + e0] * (1.f - lam_init);
            bad |= !chk_close(bf2f(((const bf16*)(ws + WS_A))[(size_t)row * DD + h * 128 + e0]), v, 2e-2f, 1e-2f); } }
    } else if (op == 3) { CHK_FRESH
        if (wave == 0) { const int row = chk_row(lane), b = row / SQ, s = row - b * SQ; if (!(last && s < LC)) { const int col = (lane * 67 + 9) % 1024; const bf16* arow = (const bf16*)(ws + WS_A) + (size_t)row * DD;
            float val;
            if (kind == 2) { const float a = chk_dot(arow, ka->in[27], 2048, col), g = chk_dot(arow, ka->in[27], 2048, 1024 + col); val = a / (1.f + expf(-g)); }
            else val = chk_dot(arow, (kind == 0) ? ka->in[13] + (size_t)jj * 1024 * 1024 : ka->in[17], 1024, col);
            const float ref = DN_ALPHA * ((const float*)(ws + WS_LAT))[(size_t)row * DD + col] + MOD[(size_t)((s < LC) ? 16 : b) * 6144 + 2048 + col] * val;
            bad |= !chk_close(((const float*)(ws + WS_B))[(size_t)row * DD + col], ref, 1e-2f, 1e-2f); } }
    } else if (op == 4) { CHK_FRESH
        if (wave == 0) { const int row = chk_row(lane), b = row / SQ, s = row - b * SQ; if (!(last && s < LC)) { const int col = (lane * 67 + 9) % 1024; const float* r = (const float*)(ws + WS_B) + (size_t)row * DD;
            float s1 = 0.f, s2 = 0.f;
#pragma clang loop vectorize(disable) unroll(disable)
            for (int c = 0; c < 1024; ++c) { float v = r[c]; asm volatile("" : "+v"(v)); s1 += v; s2 = fmaf(v, v, s2); }
            const float mu = s1 / 1024.f, var = s2 / 1024.f - mu * mu;
            float y = (r[col] - mu) / sqrtf(var + LN_EPS); asm volatile("" : "+v"(y)); y = fmaf(y, ka->in[6][(layer * 2) * 1024 + col], ka->in[7][(layer * 2) * 1024 + col]); asm volatile("" : "+v"(y)); const float* md = MOD + (size_t)((s < LC) ? 16 : b) * 6144;
            float hm = fmaf(y, md[4096 + col], y); asm volatile("" : "+v"(hm)); hm += md[3072 + col]; asm volatile("" : "+v"(hm));
            bad |= !chk_close(((const float*)(ws + WS_LAT))[(size_t)row * DD + col], y, 1e-3f, 1e-3f); bad |= !chk_close(bf2f(((const bf16*)(ws + WS_H))[(size_t)row * DD + col]), hm, 1e-2f, 1e-2f); } }
    } else if (op == 5) { CHK_FRESH
        if (wave == 0) { const int row = chk_row(lane), s = row % SQ; if (!(last && s < LC)) { const int col = (lane * 139 + 9) % 2048;
            const float ref = chk_dot((const bf16*)(ws + WS_H) + (size_t)row * DD, ka->in[8] + (size_t)layer * 1024 * 2048, 2048, col);
            bad |= !chk_close(bf2f(((const bf16*)(ws + WS_A))[(size_t)row * 2048 + col]), ref, 2e-2f, 2e-2f); } }
    } else if (op == 6) { CHK_FRESH
        if (wave == 0) { const int row = chk_row(lane), s = row % SQ; const int h = (lane * 3 + 1) & 7; LAS float* sc = (LAS float*)lds + lane * 257; LAS unsigned char* used = lds + 66048 + lane * 260;
            if (!(last && s < LC)) {
                const bf16* q = (const bf16*)(ws + WS_A) + (size_t)row * 2048 + h * 256; const bf16* KEYS = (const bf16*)(ws + WS_KEYS) + (size_t)layer * 2 * 8 * 128 * 128;
                for (int j = 0; j < 2; ++j) for (int k = 0; k < 128; ++k) { float a = 0.f; for (int c = 0; c < 128; ++c) a += bf2f(q[j * 128 + c]) * bf2f(KEYS[((size_t)(j * 8 + h) * 128 + k) * 128 + c]); sc[j * 128 + k] = a; }
                LAS float* tv = (LAS float*)(lds + 83200) + lane * 65; LAS int* ti = (LAS int*)(lds + 100096) + lane * 65;
                for (int j = 0; j < 2; ++j) for (int it = 0; it < 16; ++it) { float bv = -INFINITY; int bi = 0; for (int k = 0; k < 128; ++k) { const float v = sc[j * 128 + k]; if (v > bv) { bv = v; bi = k; } } tv[j * 16 + it] = bv; ti[j * 16 + it] = bi; sc[j * 128 + bi] = -INFINITY; }
                for (int i = 0; i < 256; ++i) used[i] = 0;
                float rs[1]; int nmatch = 0; float gsum_err = 0.f; (void)rs;
                const int* E = (const int*)(ws + WS_B) + ((size_t)row * 8 + h) * 16; const float* Gt = (const float*)(ws + WS_B + (size_t)MR * 128 * 4) + ((size_t)row * 8 + h) * 16;
                float topv0 = 0.f, den = 0.f;
                for (int it = 0; it < 16; ++it) { float bv = -INFINITY; int bi = 0; for (int i = 0; i < 256; ++i) if (!used[i]) { const float v = tv[i >> 4] + tv[16 + (i & 15)]; if (v > bv) { bv = v; bi = i; } } used[bi] = (unsigned char)(it + 1); if (it == 0) topv0 = bv; den += expf(bv - topv0); }
                for (int i = 0; i < 256; ++i) if (used[i]) { const float v = tv[i >> 4] + tv[16 + (i & 15)]; const int e = ti[i >> 4] * 128 + ti[16 + (i & 15)]; const float g = expf(v - topv0) / den;
                        for (int r = 0; r < 16; ++r) if (E[r] == e) { ++nmatch; gsum_err += fabsf(Gt[r] - g); } }
                float gs = 0.f; for (int r = 0; r < 16; ++r) { gs += Gt[r]; bad |= (E[r] < 0 || E[r] >= 16384); }
                bad |= (nmatch < 14) || (gsum_err > 0.05f) || !chk_close(gs, 1.f, 0.f, 1e-3f);
            } }
        __syncthreads(); check_pre_peer(ws, layer, tid);
    } else if (op == 7) { CHK_FRESH
        const int row = chk_row(3 + 2 * layer), b = row / SQ, s = row - b * SQ;
        if (!(last && s < LC)) {
            LAS float* act = (LAS float*)lds; LAS float* rr = (LAS float*)lds + 256; LAS float* red = (LAS float*)lds + 256 + 1024;
            const bf16* hrow = (const bf16*)(ws + WS_H) + (size_t)row * DD; const float* latold = (const float*)(ws + WS_CTL + 262144);
            const bf16* hold = (const bf16*)(ws + WS_CTL + 262144 + 4096);
            const int* E = (const int*)(ws + WS_B) + (size_t)row * 128; const float* Gt = (const float*)(ws + WS_B + (size_t)MR * 128 * 4) + (size_t)row * 128;
            const bf16* PU = (const bf16*)(ws + WS_PU) + (size_t)layer * 16384 * 1024; const bf16* PV = (const bf16*)(ws + WS_PV) + (size_t)layer * 16384 * 1024;
            (void)hrow;
            if (tid < 128) { const int e = E[tid]; float a = 0.f; for (int dd = 0; dd < 1024; ++dd) a += bf2f(hold[dd]) * bf2f(PU[(size_t)e * 1024 + dd]); act[tid] = Gt[tid] * gelu_tanh(a); }
            __syncthreads();
            for (int c = tid; c < 1024; c += NTHR) { float o = 0.f; for (int k = 0; k < 128; ++k) o += act[k] * bf2f(PV[(size_t)E[k] * 1024 + c]); rr[c] = DN_ALPHA * latold[c] + MOD[(size_t)((s < LC) ? 16 : b) * 6144 + 5120 + c] * o; }
            __syncthreads();
            if (tid == 0) { float mu = 0.f; for (int c = 0; c < 1024; ++c) mu += rr[c]; mu /= 1024.f; float var = 0.f; for (int c = 0; c < 1024; ++c) var += (rr[c] - mu) * (rr[c] - mu); red[0] = mu; red[1] = 1.f / sqrtf(var / 1024.f + LN_EPS); }
            __syncthreads();
            for (int c = tid; c < 1024; c += NTHR) { const float y = (rr[c] - red[0]) * red[1] * ka->in[6][(layer * 2 + 1) * 1024 + c] + ka->in[7][(layer * 2 + 1) * 1024 + c];
                const float got = last ? ka->out[((size_t)b * TL + s - LC) * DD + c] : ((const float*)(ws + WS_LAT))[(size_t)row * DD + c]; bad |= !chk_close(got, y, 2e-2f, 2e-2f); }
            __syncthreads();
        }
    } else if (op == 8) { CHK_FRESH
        { const int b = (wave * 5 + 1) & 15, g = (wave * 23 + 7) & 63; const int p = lane; const bf16* U = (const bf16*)(ws + WS_H); const bf16* YG = (const bf16*)(ws + WS_A);
          float yacc[3][16];
#pragma unroll
          for (int a = 0; a < 3; ++a)
#pragma unroll
              for (int h = 0; h < 16; ++h) yacc[a][h] = 0.f;
          for (int dir = 0; dir < 2; ++dir) { const int rg = dir * 64 + g; const float re = ka->in[19][rg * 64 + p], im = ka->in[20][rg * 64 + p], stp = expf(ka->in[21][rg]);
              const float mag = expf(re * stp), lbr = mag * cosf(im * stp), lbi = mag * sinf(im * stp); const float aa = lbr - 1.f, bb = lbi, den = re * re + im * im, qr = (aa * re + bb * im) / den, qi = (bb * re - aa * im) / den;
              float bbr[16], bbi[16], cr[16], ci[16];
#pragma unroll
              for (int h = 0; h < 16; ++h) { const float br = ka->in[22][((size_t)rg * 64 + p) * 16 + h], bi = ka->in[23][((size_t)rg * 64 + p) * 16 + h]; bbr[h] = br * qr - bi * qi; bbi[h] = br * qi + bi * qr; cr[h] = ka->in[24][((size_t)rg * 16 + h) * 64 + p]; ci[h] = ka->in[25][((size_t)rg * 16 + h) * 64 + p]; }
              float xr = 0.f, xi = 0.f;
              for (int step = 0; step < SQ; ++step) { const int pos = s5_pos(dir, step); const bf16* u = U + ((size_t)b * SQ + pos) * DD + g * 16; float bur = 0.f, bui = 0.f;
#pragma unroll
                  for (int h = 0; h < 16; ++h) { const float uv = bf2f(u[h]); bur += uv * bbr[h]; bui += uv * bbi[h]; }
                  const float nr = lbr * xr - lbi * xi + bur, ni = lbr * xi + lbi * xr + bui; xr = nr; xi = ni;
                  const int a = (pos == 255) ? 0 : (pos == 256) ? 1 : (pos == 1777) ? 2 : -1;
                  if (a >= 0) {
#pragma unroll
                      for (int aa2 = 0; aa2 < 3; ++aa2) if (aa2 == a) {
#pragma unroll
                          for (int h = 0; h < 16; ++h) yacc[aa2][h] += wave_sum(xr * cr[h] - xi * ci[h]); } } } }
#pragma unroll
          for (int a = 0; a < 3; ++a) { const int pos = (a == 0) ? 255 : (a == 1) ? 256 : 1777; const bf16* u = U + ((size_t)b * SQ + pos) * DD + g * 16;
#pragma unroll
              for (int h = 0; h < 16; ++h) { const float y = gelu_tanh(yacc[a][h] + ka->in[26][g * 16 + h] * bf2f(u[h])); bad |= !chk_close(bf2f(YG[((size_t)b * SQ + pos) * DD + g * 16 + h]), y, 3e-2f, 2e-2f); } } }
    }
    if (bad) chk_fail((gu32*)(ws + WS_CTL), (unsigned)code);
#undef CHK_FRESH
#undef MOD
}
#endif
__device__ __forceinline__ void attn_phase_da(unsigned char* ws, int last, LAS unsigned char* lds, int vcu, int G, int tid) {
    typedef attn_body::bf16 abf;
    const abf* Qb = (const abf*)(ws + WS_A); const abf* Kb = (const abf*)(ws + WS_A + SZ72); const abf* Vb = (const abf*)(ws + WS_A + 2 * SZ72);
    abf* O0 = (abf*)(ws + WS_B); abf* O1 = (abf*)(ws + WS_B + SZ72);
    const int nlat = NB * 32 * 8, nctx = last ? 0 : NB * 32;
    for (int u = vcu; u < nlat + nctx; u += G) {
        int b, hh, qb;
        if (u < nlat) { const int idx = u >> 3; b = idx >> 5; hh = idx & 31; qb = (u & 7) + 1; } else { const int v = u - nlat; b = v >> 5; hh = v & 31; qb = 0; }
        const int h = hh >> 2, j = (hh >> 1) & 1, vh = hh & 1;
        attn_body::UnitDesc d;
        const size_t qrow = (size_t)b * SQ + 256 * qb, krow = (size_t)b * SQ;
        d.Q = Qb + qrow * DD + h * 128 + j * 64; d.K = Kb + krow * DD + h * 128 + j * 64; d.V = Vb + krow * DD + h * 128 + vh * 64;
        d.O = (j ? O1 : O0) + qrow * DD + h * 128 + vh * 64;
        d.NT = qb ? 36 : 4; d.latoff = 256; d.kpos4 = 0; d.qpos0 = 0; d.sink2 = -INFINITY;
        attn_body::attn_unit<8, false>(d, (char*)lds, tid);
    }
}
__device__ __forceinline__ void attn_phase_wa(unsigned char* ws, const float* sink, int last, LAS unsigned char* lds, int vcu, int G, int tid) {
    typedef attn_body::bf16 abf;
    const abf* Qb = (const abf*)(ws + WS_A); const abf* Kb = (const abf*)(ws + WS_A + SZ72); const abf* Vb = (const abf*)(ws + WS_A + 2 * SZ72);
    abf* OC = (abf*)(ws + WS_A);
    const int nlat = NB * 16 * 8, nctx = last ? 0 : NB * 16;
    for (int u = vcu; u < nlat + nctx; u += G) {
        int b, hq, qb;
        if (u < nlat) { const int idx = u >> 3; b = idx >> 4; hq = idx & 15; qb = (u & 7) + 1; } else { const int v = u - nlat; b = v >> 4; hq = v & 15; qb = 0; }
        attn_body::UnitDesc d;
        const size_t qrow = (size_t)b * SQ + 256 * qb, krow = (size_t)b * SQ;
        d.Q = Qb + qrow * DD + hq * 64; d.K = Kb + krow * DD + (hq >> 2) * 64; d.V = Vb + krow * DD + (hq >> 2) * 64; d.O = OC + qrow * DD + hq * 64;
        if (qb) { const int qpos0 = 256 * (qb - 1); const int ks = (qpos0 - 128) < 0 ? 0 : (qpos0 - 128), ke = (qpos0 + 384) > TL ? TL : (qpos0 + 384);
            d.NT = 4 + (ke - ks) / 64; d.latoff = 256 + ks; d.kpos4 = ks; d.qpos0 = qpos0; }
        else { d.NT = 4; d.latoff = 256; d.kpos4 = 0; d.qpos0 = 0; }
        d.sink2 = sink[hq] * LOG2E;
        attn_body::attn_unit<8, true>(d, (char*)lds, tid);
    }
}

#ifndef PHM
#define PHM 0xFFFFF
#endif
#define PH_ON(k) (((PHM) >> (k)) & 1)
constexpr int NSTEPS = 2 + 8 + 7 + 6 + 8;
struct Args { const float* in[28]; float* out; unsigned char* ws; int ph_lo, ph_hi; };
static_assert(sizeof(Args) == 28 * 8 + 8 + 8 + 8, "Args has no padding");

__global__ void __launch_bounds__(NTHR, 2) mk_fwd(Args args) {
    extern __shared__ __attribute__((aligned(16))) unsigned char lds_raw[];
    volatile LAS unsigned* MISC = (volatile LAS unsigned*)((LAS unsigned char*)lds_raw + MISC_OFF);
    typedef const __attribute__((address_space(4))) Args* KArgP;
    KArgP ka = (KArgP)__builtin_amdgcn_kernarg_segment_ptr();
#define KA_IN(k) (ka->in[k])
#define KA_FRESH() asm volatile("" : "+s"(ka))
    const int wave0 = __builtin_amdgcn_readfirstlane(threadIdx.x >> 6);
    { const int t0 = threadIdx.x; for (int u = t0; u < (LDS_BYTES - LDSCTL_OFF) / 4; u += NTHR) ((LAS unsigned*)((LAS unsigned char*)lds_raw + LDSCTL_OFF))[u] = 0u; }
    __syncthreads();
    const int lo = ka->ph_lo, hi = ka->ph_hi;
    const bool multi = (hi - lo) > 1 || MK_DEBUG;
    XcdBarrier bar; bar.bar = (unsigned*)((gu32*)(ka->ws + WS_CTL) + CW_BAR); bar.x = 0; bar.st = nullptr;
    if (multi) bar = xcd_barrier_post((unsigned*)((gu32*)(ka->ws + WS_CTL) + CW_BAR), MISC + 8, (int)threadIdx.x);
#define PH_TID int wv_b = wave0; asm volatile("" : "+s"(wv_b)); int ln_b = (int)__builtin_amdgcn_mbcnt_hi(~0u, __builtin_amdgcn_mbcnt_lo(~0u, 0u)); asm volatile("" : "+v"(ln_b)); const int tid_b = wv_b * 64 + ln_b;
#define PH_LOCALS \
    int wave = wave0; asm volatile("" : "+s"(wave)); \
    int lane = (int)__builtin_amdgcn_mbcnt_hi(~0u, __builtin_amdgcn_mbcnt_lo(~0u, 0u)); asm volatile("" : "+v"(lane)); const int tid = wave * 64 + lane; \
    int G = gridDim.x, bx = blockIdx.x; asm volatile("" : "+s"(G), "+s"(bx)); \
    const int vcu = (G % 8 == 0) ? (bx % 8) * (G / 8) + bx / 8 : bx; \
    const int gw = vcu * NWAVES + wave, NGW = G * NWAVES; \
    KA_FRESH(); unsigned char* ws = ka->ws; \
    unsigned ldsb = 0; asm volatile("" : "+s"(ldsb)); \
    LAS unsigned char* lds = (LAS unsigned char*)lds_raw + ldsb; \
    (void)lane; (void)wave; (void)vcu; (void)gw; (void)NGW; (void)ws; (void)lds; (void)tid;
#if MK_DEBUG
    for (int it = 0; it <= 2 * NSTEPS; ++it) { const int step = it >> 1; const bool is_check = (it & 1) != 0; const bool is_report = (it == 2 * NSTEPS);
#else
    for (int step = lo; step < hi; ++step) {
#endif
        KA_FRESH();
        int layer = 0, op;
        if (step < 2) op = 9 + step;
        else { const int s = step - 2;
            if (s < 8) { layer = 0; op = s; }
            else if (s < 15) { layer = 1; op = s - 8; if (op >= 2) ++op; }
            else if (s < 21) { layer = 2; op = s - 15; op = (op == 0) ? 8 : op + 2; }
            else { layer = 3; op = s - 21; } }
        const int kind = layer % 3, jj = layer / 3, last = (layer == NLAYER - 1) ? 1 : 0;
#if MK_DEBUG
        if (is_report) { PH_LOCALS const unsigned code = __hip_atomic_load((unsigned*)((gu32*)(ws + WS_CTL) + CW_ERR), __ATOMIC_RELAXED, __HIP_MEMORY_SCOPE_AGENT);
            if (code) { const float v = sqrtf((float)code); float* o = ka->out; for (size_t i = (size_t)vcu * NTHR + tid; i < (size_t)NB * TL * DD; i += (size_t)G * NTHR) o[i] = v; } }
        else if (is_check) { PH_LOCALS if (bx == 0) check_step(ka, ws, lds, op, layer, step + 1, tid, lane, wave); }
        else
#endif
        if (op == 9) { if constexpr (PH_ON(0)) { PH_LOCALS p0_prologue(ka, ws, lds, vcu, G, tid, lane, wave); } }
        else if (op == 10) { if constexpr (PH_ON(1)) { PH_LOCALS p1_embed(KA_IN(0), KA_IN(2), ws, gw, NGW, lane); } }
        else if (op == 0) { if constexpr (PH_ON(2)) { PH_LOCALS
            pg8::Gemm g; g.A = (const pg8::bf16_t*)(ws + WS_H); g.K = 1024; g.M = MR;
            pg8::EpiQKV E; E.Q = (pg8::bf16_t*)(ws + WS_A); E.K = (pg8::bf16_t*)(ws + WS_A + SZ72); E.V = (pg8::bf16_t*)(ws + WS_A + 2 * SZ72);
            E.cosT = (const float*)(ws + WS_ROPE); E.sinT = E.cosT + 2048 * 32; E.qscale = 0.125f * LOG2E;
            int nN;
            if (kind == 0) { g.Bt = (const pg8::bf16_t*)(ws + WS_WQKV_DA) + (size_t)jj * 3072 * 1024; g.N = 3072; E.nq = 4; E.nk = 4; nN = 12; }
            else { g.Bt = (const pg8::bf16_t*)(ws + WS_WQKV_WA); g.N = 1536; E.nq = 4; E.nk = 1; nN = 6; }
            pg8::RowOrder S; S.init(144, nN, G, bx, 0);
            pg8::gemm_phase<pg8::EpiQKV, pg8::RowOrder, true, true>(lds + RING_OFF, g, S, E, tid); } }
        else if (op == 1) { if (kind == 0) { if constexpr (PH_ON(3)) { PH_LOCALS attn_phase_da(ws, last, lds, vcu, G, tid); } } else { if constexpr (PH_ON(4)) { PH_LOCALS attn_phase_wa(ws, KA_IN(18), last, lds, vcu, G, tid); } } }
        else if (op == 2) { if constexpr (PH_ON(5)) { PH_LOCALS
            const float lam_init = 0.8f - 0.6f * expf(-0.3f * (float)layer);
            da_combine_phase(ws, KA_IN(14) + jj * 256, KA_IN(15) + jj * 128, lam_init, last, gw, NGW, lane); } }
        else if (op == 8) { if constexpr (PH_ON(6)) { PH_LOCALS s5_phase(ws, KA_IN(26), lds, vcu, tid, lane, wave); } }
        else if (op == 3) {
            if (kind != 2) { if constexpr (PH_ON(7)) { PH_LOCALS
                pg8::Gemm g; g.A = (const pg8::bf16_t*)(ws + WS_A); g.K = 1024; g.M = MR; g.N = 1024;
                g.Bt = (kind == 0) ? (const pg8::bf16_t*)(ws + WS_WO_DA) + (size_t)jj * 1024 * 1024 : (const pg8::bf16_t*)(ws + WS_WO_WA);
                pg8::EpiRes E; E.lat = (const float*)(ws + WS_LAT); E.R = (float*)(ws + WS_B); E.mod = (const float*)(ws + WS_MOD) + (size_t)layer * 17 * 6144; E.alpha = DN_ALPHA;
                pg8::RowOrder S; S.init(last ? 128 : 144, 4, G, bx, last);
                pg8::gemm_phase<pg8::EpiRes, pg8::RowOrder, true, true>(lds + RING_OFF, g, S, E, tid); } }
            else { if constexpr (PH_ON(8)) { PH_LOCALS
                pg8::Gemm g; g.A = (const pg8::bf16_t*)(ws + WS_A); g.K = 1024; g.M = MR; g.N = 2048; g.Bt = (const pg8::bf16_t*)(ws + WS_WGLU);
                pg8::EpiGlu E; E.lat = (const float*)(ws + WS_LAT); E.R = (float*)(ws + WS_B); E.mod = (const float*)(ws + WS_MOD) + (size_t)layer * 17 * 6144; E.alpha = DN_ALPHA;
                pg8::RowOrder S; S.init(144, 8, G, bx, 0);
                pg8::gemm_phase<pg8::EpiGlu, pg8::RowOrder, true, true>(lds + RING_OFF, g, S, E, tid); } } }
        else if (op == 4) { if constexpr (PH_ON(9)) { PH_LOCALS ln1_phase(ws, KA_IN(6) + (size_t)(layer * 2) * 1024, KA_IN(7) + (size_t)(layer * 2) * 1024, layer, last, gw, NGW, lane); } }
        else if (op == 5) { if constexpr (PH_ON(10)) { PH_LOCALS
            pg8::Gemm g; g.A = (const pg8::bf16_t*)(ws + WS_H); g.K = 1024; g.M = MR; g.N = 2048; g.Bt = (const pg8::bf16_t*)(ws + WS_WPQ) + (size_t)layer * 2048 * 1024;
            pg8::EpiPlain E; E.O = (pg8::bf16_t*)(ws + WS_A); E.ldc = 2048;
            pg8::RowOrder S; S.init(last ? 128 : 144, 8, G, bx, last);
            pg8::gemm_phase<pg8::EpiPlain, pg8::RowOrder, true, true>(lds + RING_OFF, g, S, E, tid); } }
        else if (op == 6) { if constexpr (PH_ON(11)) { PH_LOCALS topk_phase(ws, layer, last, lds, vcu, G, tid, lane, wave); } }
        else { if constexpr (PH_ON(12)) { PH_LOCALS peer_phase(ws, ka->out, KA_IN(6) + (size_t)(layer * 2 + 1) * 1024, KA_IN(7) + (size_t)(layer * 2 + 1) * 1024, layer, last, gw, NGW, lane); } }
#if MK_DEBUG
        { XcdBarrier b2 = bar; asm volatile("" : "+s"(b2.bar)); PH_TID xcd_barrier(b2, tid_b); }
#else
        if (step + 1 < hi) { XcdBarrier b2 = bar; asm volatile("" : "+s"(b2.bar)); PH_TID xcd_barrier(b2, tid_b); }
#endif
    }
}

#ifndef MK_ONE_LAUNCH
#define MK_ONE_LAUNCH 1
#endif
extern "C" void kernel_launch(void* const* d_in, const int* in_sizes, int n_in, void* d_out, int out_size, void* d_ws, size_t ws_size, hipStream_t stream) {
    static int grid = 0;
    if (grid == 0) {
        if (n_in != 28 || ws_size < WS_END || out_size != NB * TL * DD) { fprintf(stderr, "kernel_launch: unexpected shapes (n_in %d, ws %zu, out %d); nothing launched\n", n_in, ws_size, out_size); grid = -1; return; }
        int dev = 0, cus = 0, per_cu = 0;
        if (hipGetDevice(&dev) != hipSuccess || hipDeviceGetAttribute(&cus, hipDeviceAttributeMultiprocessorCount, dev) != hipSuccess) { grid = -1; return; }
        if (hipFuncSetAttribute((const void*)mk_fwd, hipFuncAttributeMaxDynamicSharedMemorySize, LDS_BYTES) != hipSuccess) { fprintf(stderr, "kernel_launch: hipFuncSetAttribute failed\n"); grid = -1; return; }
        if (hipOccupancyMaxActiveBlocksPerMultiprocessor(&per_cu, (const void*)mk_fwd, NTHR, LDS_BYTES) != hipSuccess || per_cu < 1) fprintf(stderr, "kernel_launch: occupancy query reports %d\n", per_cu);
        (void)hipGetLastError();
        grid = cus;
    }
    if (grid < 0) return;
    if (hipMemsetAsync((char*)d_ws + WS_CTL, 0, CTL_ZERO_BYTES, stream) != hipSuccess) return;
    Args a{};
    for (int i = 0; i < 28; ++i) a.in[i] = (const float*)d_in[i];
    a.out = (float*)d_out; a.ws = (unsigned char*)d_ws;
#if MK_ONE_LAUNCH
    a.ph_lo = 0; a.ph_hi = NSTEPS;
    hipLaunchKernelGGL(mk_fwd, dim3(grid), dim3(NTHR), LDS_BYTES, stream, a);
#else
    for (int s = 0; s < NSTEPS; ++s) { a.ph_lo = s; a.ph_hi = s + 1; hipLaunchKernelGGL(mk_fwd, dim3(grid), dim3(NTHR), LDS_BYTES, stream, a); }
#endif
}
```

```cpp
#include <hip/hip_runtime.h>
#include <cstdio>
#include <cstdint>
#define MK_DEBUG 0
#define CHK_MASK 0xFDFF
#define PEER_SLICED 0
#define PEER_SPLIT 1
namespace pg8 {
#define PG8_LAS __attribute__((address_space(3)))
typedef unsigned short bf16_t;
typedef short bf16x8 __attribute__((ext_vector_type(8)));
typedef float f32x4 __attribute__((ext_vector_type(4)));
typedef unsigned u32x4 __attribute__((ext_vector_type(4)));
constexpr int BM = 256, BK = 64, HALF = 128, HTB = HALF * BK * 2  , STAGE_BYTES = 8 * HTB, NXCD = 8, WGM = 8;

__host__ __device__ __forceinline__ int lds_byte(int r, int c) { const int st = (r >> 4) * 2 + (c >> 5), rr = r & 15, cc = c & 31, ob = rr * 64 + cc * 2; return st * 1024 + (ob ^ (((ob >> 9) & 1) << 5)); }
__host__ __device__ __forceinline__ void stage_rc(int b, int& R, int& C) { const int st = b / 1024, sb = b % 1024, swz = sb ^ (((sb >> 9) & 1) << 5); R = (st >> 1) * 16 + swz / 64; C = (st & 1) * 32 + (swz % 64) / 2; }
__host__ __device__ __forceinline__ int perm32(int rho) { const int n = rho >> 4, i = rho & 15; return 8 * (i >> 2) + 4 * n + (i & 3); }

struct Unit { int pm, pn; };
struct Gemm { const bf16_t* A; const bf16_t* Bt; int M, N, K; };

struct StaticOrder {
    int nM, nN, nwg, G, c;
    __host__ __device__ void init(int M, int N, int G_, int c_) { nM = M / BM; nN = N / BM; nwg = nM * nN; G = G_; c = c_; }
    __host__ __device__ bool next(int i, Unit& u) const {
        const long L = (long)i * G + c; if (L >= nwg) return false;
        int wgid = (int)L; { const int q = nwg / NXCD, r = nwg % NXCD, xcd = wgid % NXCD, off = wgid / NXCD; wgid = (xcd < r ? xcd * (q + 1) : r * (q + 1) + (xcd - r) * q) + off; }
        const int nig = WGM * nN, gid = wgid / nig, fm = gid * WGM, gsz = (nM - fm) < WGM ? (nM - fm) : WGM;
        u.pm = fm + ((wgid % nig) % gsz); u.pn = (wgid % nig) / gsz; return true;
    }
    __device__ __forceinline__ void a_ready(const Unit&) const {}
    __device__ __forceinline__ void done(const Unit&) const {}
};

__device__ __forceinline__ unsigned cvt_pk_bf16(float lo, float hi) { unsigned r; asm volatile("v_cvt_pk_bf16_f32 %0, %1, %2" : "=v"(r) : "v"(lo), "v"(hi)); return r; }
typedef float f32x2 __attribute__((ext_vector_type(2)));
struct RowOrder {
    int nM, nN, nwg, G, c, skip;
    __device__ __forceinline__ void init(int nM_, int nN_, int G_, int c_, int skip_) { nM = nM_; nN = nN_; nwg = nM * nN; G = G_; c = c_; skip = skip_; }
    __device__ __forceinline__ bool next(int i, Unit& u) const {
        const long L = (long)i * G + c; if (L >= nwg) return false;
        int wgid = (int)L; { const int q = nwg / NXCD, r = nwg % NXCD, xcd = wgid % NXCD, off = wgid / NXCD; wgid = (xcd < r ? xcd * (q + 1) : r * (q + 1) + (xcd - r) * q) + off; }
        const int nig = WGM * nN, gid = wgid / nig, fm = gid * WGM, gsz = (nM - fm) < WGM ? (nM - fm) : WGM;
        const int pm = fm + ((wgid % nig) % gsz); u.pn = (wgid % nig) / gsz;
        u.pm = skip ? (pm >> 3) * 9 + 1 + (pm & 7) : pm; return true;
    }
    __device__ __forceinline__ void a_ready(const Unit&) const {}
    __device__ __forceinline__ void done(const Unit&) const {}
};
typedef unsigned u32x4e __attribute__((ext_vector_type(4)));
struct EpiQKV {
    static constexpr bool PERM = true, AFTER_DRAIN = false;
    bf16_t* Q; bf16_t* K; bf16_t* V; int nq, nk; const float* cosT; const float* sinT; float qscale;
    __device__ __forceinline__ void operator()(const f32x4 (&acc)[2][2][4][2], const Unit& u, int wr, int wc, int fr, int fq) const {
        bf16_t* base; int kind, pl;
        if (u.pn < nq) { base = Q; kind = 0; pl = u.pn; } else if (u.pn < nq + nk) { base = K; kind = 1; pl = u.pn - nq; } else { base = V; kind = 2; pl = u.pn - nq - nk; }
        const int bq = u.pm / 9; const bool lat = (u.pm - bq * 9) != 0; const bool rope = lat && kind < 2;
        const float sc = (kind == 0) ? qscale : 1.f;
        const int row0 = u.pm * BM + wr * 64 + fr, col0 = pl * BM + wc * 32 + 8 * fq;
#pragma unroll
        for (int ai = 0; ai < 2; ++ai)
#pragma unroll
            for (int m = 0; m < 4; ++m) { const int row = row0 + ai * HALF + m * 16; const int t = row - bq * 2304 - 256;
                f32x4 cs = (f32x4){1.f, 1.f, 1.f, 1.f}, sn = (f32x4){0.f, 0.f, 0.f, 0.f};
                if (rope) { const int i0 = (col0 & 63) >> 1; cs = *(const f32x4*)(cosT + t * 32 + i0); sn = *(const f32x4*)(sinT + t * 32 + i0); }
#pragma unroll
                for (int bj = 0; bj < 2; ++bj) { const int col = col0 + bj * HALF; f32x4 v0 = acc[ai][bj][m][0], v1 = acc[ai][bj][m][1];
                    if (rope) {
                        float e, o;
                        e = v0[0]; o = v0[1]; v0[0] = e * cs[0] - o * sn[0]; v0[1] = e * sn[0] + o * cs[0];
                        e = v0[2]; o = v0[3]; v0[2] = e * cs[1] - o * sn[1]; v0[3] = e * sn[1] + o * cs[1];
                        e = v1[0]; o = v1[1]; v1[0] = e * cs[2] - o * sn[2]; v1[1] = e * sn[2] + o * cs[2];
                        e = v1[2]; o = v1[3]; v1[2] = e * cs[3] - o * sn[3]; v1[3] = e * sn[3] + o * cs[3]; }
                    v0 = v0 * sc; v1 = v1 * sc; u32x4e w; w.x = cvt_pk_bf16(v0[0], v0[1]); w.y = cvt_pk_bf16(v0[2], v0[3]); w.z = cvt_pk_bf16(v1[0], v1[1]); w.w = cvt_pk_bf16(v1[2], v1[3]);
                    *(u32x4e*)(base + (size_t)row * 1024 + col) = w; } }
    }
};
struct EpiPlain {
    static constexpr bool PERM = true, AFTER_DRAIN = false;
    bf16_t* O; int ldc;
    __device__ __forceinline__ void operator()(const f32x4 (&acc)[2][2][4][2], const Unit& u, int wr, int wc, int fr, int fq) const {
        const int row0 = u.pm * BM + wr * 64 + fr, col0 = u.pn * BM + wc * 32 + 8 * fq;
#pragma unroll
        for (int ai = 0; ai < 2; ++ai)
#pragma unroll
            for (int m = 0; m < 4; ++m) { bf16_t* rowp = O + (size_t)(row0 + ai * HALF + m * 16) * ldc + col0;
#pragma unroll
                for (int bj = 0; bj < 2; ++bj) { const f32x4 v0 = acc[ai][bj][m][0], v1 = acc[ai][bj][m][1];
                    u32x4e w; w.x = cvt_pk_bf16(v0[0], v0[1]); w.y = cvt_pk_bf16(v0[2], v0[3]); w.z = cvt_pk_bf16(v1[0], v1[1]); w.w = cvt_pk_bf16(v1[2], v1[3]);
                    *(u32x4e*)(rowp + bj * HALF) = w; } }
    }
};
__device__ __forceinline__ void unpack8(const u32x4e w, f32x4& lo, f32x4& hi) {
    lo[0] = __uint_as_float(w.x << 16); lo[1] = __uint_as_float(w.x & 0xffff0000u); lo[2] = __uint_as_float(w.y << 16); lo[3] = __uint_as_float(w.y & 0xffff0000u);
    hi[0] = __uint_as_float(w.z << 16); hi[1] = __uint_as_float(w.z & 0xffff0000u); hi[2] = __uint_as_float(w.w << 16); hi[3] = __uint_as_float(w.w & 0xffff0000u); }
struct EpiRes {
    static constexpr bool PERM = true, AFTER_DRAIN = false;
    const bf16_t* lat; bf16_t* R; const float* mod; float alpha;
    __device__ __forceinline__ void operator()(const f32x4 (&acc)[2][2][4][2], const Unit& u, int wr, int wc, int fr, int fq) const {
        const int bq = u.pm / 9; const int midx = ((u.pm - bq * 9) == 0) ? 16 : bq; const float* gate = mod + midx * 6144 + 2048;
        const int row0 = u.pm * BM + wr * 64 + fr, col0 = u.pn * BM + wc * 32 + 8 * fq;
#pragma unroll
        for (int bj = 0; bj < 2; ++bj) { const int col = col0 + bj * HALF; const f32x4 g0 = *(const f32x4*)(gate + col), g1 = *(const f32x4*)(gate + col + 4);
#pragma unroll
            for (int ai = 0; ai < 2; ++ai)
#pragma unroll
                for (int m = 0; m < 4; ++m) { const size_t off = (size_t)(row0 + ai * HALF + m * 16) * 1024 + col; f32x4 l0, l1; unpack8(*(const u32x4e*)(lat + off), l0, l1);
                    const f32x4 o0 = l0 * alpha + g0 * acc[ai][bj][m][0], o1 = l1 * alpha + g1 * acc[ai][bj][m][1];
                    u32x4e w; w.x = cvt_pk_bf16(o0[0], o0[1]); w.y = cvt_pk_bf16(o0[2], o0[3]); w.z = cvt_pk_bf16(o1[0], o1[1]); w.w = cvt_pk_bf16(o1[2], o1[3]); *(u32x4e*)(R + off) = w; } }
    }
};
struct EpiGlu {
    static constexpr bool PERM = true, AFTER_DRAIN = false;
    const bf16_t* lat; bf16_t* R; const float* mod; float alpha;
    __device__ __forceinline__ void operator()(const f32x4 (&acc)[2][2][4][2], const Unit& u, int wr, int wc, int fr, int fq) const {
        const int bq = u.pm / 9; const int midx = ((u.pm - bq * 9) == 0) ? 16 : bq; const float* gate = mod + midx * 6144 + 2048;
        const int row0 = u.pm * BM + wr * 64 + fr, col = u.pn * HALF + wc * 32 + 8 * fq;
        const f32x4 g0 = *(const f32x4*)(gate + col), g1 = *(const f32x4*)(gate + col + 4);
#pragma unroll
        for (int ai = 0; ai < 2; ++ai)
#pragma unroll
            for (int m = 0; m < 4; ++m) { const size_t off = (size_t)(row0 + ai * HALF + m * 16) * 1024 + col; f32x4 l0, l1; unpack8(*(const u32x4e*)(lat + off), l0, l1);
                f32x4 v0, v1;
#pragma unroll
                for (int j = 0; j < 4; ++j) { v0[j] = acc[ai][0][m][0][j] * __builtin_amdgcn_rcpf(1.f + __builtin_amdgcn_exp2f(-1.4426950408889634f * acc[ai][1][m][0][j]));
                    v1[j] = acc[ai][0][m][1][j] * __builtin_amdgcn_rcpf(1.f + __builtin_amdgcn_exp2f(-1.4426950408889634f * acc[ai][1][m][1][j])); }
                const f32x4 o0 = l0 * alpha + g0 * v0, o1 = l1 * alpha + g1 * v1;
                u32x4e w; w.x = cvt_pk_bf16(o0[0], o0[1]); w.y = cvt_pk_bf16(o0[2], o0[3]); w.z = cvt_pk_bf16(o1[0], o1[1]); w.w = cvt_pk_bf16(o1[2], o1[3]); *(u32x4e*)(R + off) = w; }
    }
};
template <class Epi, class Sched, bool ALIGN_EPI = false, bool SP2 = false>
__device__ __forceinline__ void gemm_phase(PG8_LAS unsigned char* lds, const Gemm g, const Sched& S, const Epi& E, const int tid_in) {
    const int tid = tid_in; const int wid = __builtin_amdgcn_readfirstlane(tid >> 6), lane = tid & 63, wr = wid >> 2, wc = wid & 3, fr = lane & 15, fq = lane >> 4;
    const int K = g.K, nt = K / BK;
    unsigned voffA[2], voffB[2];
#pragma unroll
    for (int i = 0; i < 2; ++i) { int R, C; stage_rc(tid * 16 + i * 8192, R, C); const int Rb = Epi::PERM ? ((R & ~31) + perm32(R & 31)) : R;
        voffA[i] = (unsigned)(R * K + C) * 2u; voffB[i] = (unsigned)(Rb * K + C) * 2u; }
    const size_t kstep = (size_t)(BK * 2);
    const size_t hstep = (size_t)HALF * K * 2;
    const size_t tstep = 2 * hstep;
    const unsigned ldsw = (unsigned)wid * 1024u;
    const int aoff = lds_byte(wr * 64 + fr, fq * 8), boff = lds_byte(wc * 32 + fr, fq * 8);
#define PG8_SA(b, h) (((b) * 2 + (h)) * HTB)
#define PG8_SB(b, h) ((4 + (b) * 2 + (h)) * HTB)
#define PG8_STAGE(bufoff, gbase, voff) do { _Pragma("unroll") for (int _i = 0; _i < 2; ++_i) \
        __builtin_amdgcn_global_load_lds((const unsigned*)((const char*)(gbase) + (voff)[_i]), (PG8_LAS unsigned*)(lds + (bufoff) + ldsw + _i * 8192), 16, 0, 0); } while (0)
#define PG8_LDA(dst, b, h) do { _Pragma("unroll") for (int m = 0; m < 4; ++m) _Pragma("unroll") for (int k = 0; k < 2; ++k) dst[m][k] = *(const PG8_LAS bf16x8*)(lds + PG8_SA(b, h) + aoff + m * 2048 + k * 1024); } while (0)
#define PG8_LDB(dst, b, h) do { _Pragma("unroll") for (int n = 0; n < 2; ++n) _Pragma("unroll") for (int k = 0; k < 2; ++k) dst[n][k] = *(const PG8_LAS bf16x8*)(lds + PG8_SB(b, h) + boff + n * 2048 + k * 1024); } while (0)
#define PG8_MMA(ai, bj, At, Bt) do { __builtin_amdgcn_s_setprio(1); _Pragma("unroll") for (int m = 0; m < 4; ++m) _Pragma("unroll") for (int n = 0; n < 2; ++n) _Pragma("unroll") for (int k = 0; k < 2; ++k) \
        acc[ai][bj][m][n] = __builtin_amdgcn_mfma_f32_16x16x32_bf16(Bt[n][k], At[m][k], acc[ai][bj][m][n], 0, 0, 0); __builtin_amdgcn_s_setprio(0); } while (0)
#define PG8_WAIT_V(n) asm volatile("s_waitcnt vmcnt(" #n ")" ::: "memory")
#define PG8_WAIT_L(n) asm volatile("s_waitcnt lgkmcnt(" #n ")" ::: "memory")
#define PG8_BAR __builtin_amdgcn_s_barrier()
#define PG8_SCHED __builtin_amdgcn_sched_barrier(0)
    Unit cur, nxt; int ui = 0;
    if (!S.next(0, cur)) return;
    f32x4 acc[2][2][4][2];
#pragma unroll
    for (int a = 0; a < 2; ++a)
#pragma unroll
        for (int b = 0; b < 2; ++b)
#pragma unroll
            for (int m = 0; m < 4; ++m)
#pragma unroll
                for (int n = 0; n < 2; ++n) acc[a][b][m][n] = (f32x4){0.f, 0.f, 0.f, 0.f};
    bf16x8 At[4][2], B0[2][2], B1[2][2];
    const char* cA = (const char*)g.A + (size_t)cur.pm * tstep; const char* cB = (const char*)g.Bt + (size_t)cur.pn * tstep;
    S.a_ready(cur);
    if constexpr (SP2) {
        PG8_STAGE(PG8_SB(0, 0), cB, voffB); PG8_STAGE(PG8_SB(0, 1), cB + hstep, voffB); PG8_STAGE(PG8_SA(0, 0), cA, voffA); PG8_STAGE(PG8_SA(0, 1), cA + hstep, voffA);
        if (wr == 1) PG8_BAR;
        PG8_WAIT_V(2); PG8_BAR;
        PG8_STAGE(PG8_SB(1, 0), cB + kstep, voffB); PG8_STAGE(PG8_SA(1, 0), cA + kstep, voffA); PG8_STAGE(PG8_SB(1, 1), cB + hstep + kstep, voffB);
        PG8_WAIT_V(6); PG8_BAR;
    } else {
        PG8_STAGE(PG8_SB(0, 0), cB, voffB); PG8_STAGE(PG8_SA(0, 0), cA, voffA); PG8_STAGE(PG8_SB(0, 1), cB + hstep, voffB); PG8_STAGE(PG8_SA(0, 1), cA + hstep, voffA);
        if (wr == 1) PG8_BAR;
        PG8_WAIT_V(4); PG8_BAR;
        PG8_STAGE(PG8_SB(1, 0), cB + kstep, voffB); PG8_STAGE(PG8_SA(1, 0), cA + kstep, voffA); PG8_STAGE(PG8_SB(1, 1), cB + hstep + kstep, voffB);
        PG8_WAIT_V(6); PG8_BAR;
    }
    for (;;) {
        const bool has_next = S.next(ui + 1, nxt);
        const char* nA = has_next ? (const char*)g.A + (size_t)nxt.pm * tstep : cA; const char* nB = has_next ? (const char*)g.Bt + (size_t)nxt.pn * tstep : cB;
        for (int t = 0; t < nt; t += 2) {
            const bool last = (t == nt - 2);
            const char* a1 = cA + (size_t)(t + 1) * kstep;
            const char* a2 = last ? nA : cA + (size_t)(t + 2) * kstep; const char* b2 = last ? nB : cB + (size_t)(t + 2) * kstep;
            const char* a3 = a2 + kstep; const char* b3 = b2 + kstep;
            if (last && has_next) S.a_ready(nxt);
            if constexpr (SP2) {
            PG8_LDB(B0, 0, 0); PG8_LDB(B1, 0, 1); PG8_SCHED; PG8_LDA(At, 0, 0); PG8_STAGE(PG8_SA(1, 1), a1 + hstep, voffA);
            PG8_WAIT_V(8); PG8_WAIT_L(0); PG8_BAR; PG8_MMA(0, 0, At, B0); PG8_MMA(0, 1, At, B1); PG8_BAR; PG8_SCHED;
            PG8_LDA(At, 0, 1); PG8_STAGE(PG8_SB(0, 0), b2, voffB); PG8_STAGE(PG8_SB(0, 1), b2 + hstep, voffB); PG8_STAGE(PG8_SA(0, 0), a2, voffA);
            PG8_WAIT_V(8); PG8_WAIT_L(0); PG8_BAR; PG8_MMA(1, 0, At, B0); PG8_MMA(1, 1, At, B1); PG8_BAR; PG8_SCHED;
            PG8_LDB(B0, 1, 0); PG8_LDB(B1, 1, 1); PG8_SCHED; PG8_LDA(At, 1, 0); PG8_STAGE(PG8_SA(0, 1), a2 + hstep, voffA);
            PG8_WAIT_V(8); PG8_WAIT_L(0); PG8_BAR; PG8_MMA(0, 0, At, B0); PG8_MMA(0, 1, At, B1); PG8_BAR; PG8_SCHED;
            PG8_LDA(At, 1, 1); PG8_STAGE(PG8_SB(1, 0), b3, voffB); PG8_STAGE(PG8_SB(1, 1), b3 + hstep, voffB); PG8_STAGE(PG8_SA(1, 0), a3, voffA);
            PG8_WAIT_V(8); PG8_WAIT_L(0); PG8_BAR; PG8_MMA(1, 0, At, B0); PG8_MMA(1, 1, At, B1); PG8_BAR; PG8_SCHED;
            } else {
            PG8_LDB(B0, 0, 0); PG8_SCHED; PG8_LDA(At, 0, 0); PG8_STAGE(PG8_SA(1, 1), a1 + hstep, voffA);
            PG8_WAIT_L(8); PG8_BAR; PG8_WAIT_L(0); PG8_MMA(0, 0, At, B0); PG8_BAR; PG8_SCHED;
            PG8_LDB(B1, 0, 1); PG8_STAGE(PG8_SB(0, 0), b2, voffB);
            PG8_BAR; PG8_WAIT_L(0); PG8_MMA(0, 1, At, B1); PG8_BAR;
            PG8_LDA(At, 0, 1); PG8_STAGE(PG8_SA(0, 0), a2, voffA);
            PG8_BAR; PG8_WAIT_L(0); PG8_MMA(1, 0, At, B0); PG8_BAR; PG8_SCHED;
            PG8_STAGE(PG8_SB(0, 1), b2 + hstep, voffB);
            PG8_WAIT_V(6); PG8_BAR; PG8_MMA(1, 1, At, B1); PG8_BAR;
            PG8_LDB(B0, 1, 0); PG8_SCHED; PG8_LDA(At, 1, 0); PG8_STAGE(PG8_SA(0, 1), a2 + hstep, voffA);
            PG8_WAIT_L(8); PG8_BAR; PG8_WAIT_L(0); PG8_MMA(0, 0, At, B0); PG8_BAR; PG8_SCHED;
            PG8_LDB(B1, 1, 1); PG8_STAGE(PG8_SB(1, 0), b3, voffB);
            PG8_BAR; PG8_WAIT_L(0); PG8_MMA(0, 1, At, B1); PG8_BAR;
            PG8_LDA(At, 1, 1); PG8_STAGE(PG8_SA(1, 0), a3, voffA);
            PG8_BAR; PG8_WAIT_L(0); PG8_MMA(1, 0, At, B0); PG8_BAR; PG8_SCHED;
            PG8_STAGE(PG8_SB(1, 1), b3 + hstep, voffB);
            PG8_WAIT_V(6); PG8_BAR; PG8_MMA(1, 1, At, B1); PG8_BAR;
            }
        }
        if constexpr (ALIGN_EPI) { if (wr == 0) PG8_BAR; }
        if constexpr (!Epi::AFTER_DRAIN) { E(acc, cur, wr, wc, fr, fq); S.done(cur); }
        if (!has_next) break;
#pragma unroll
        for (int a = 0; a < 2; ++a)
#pragma unroll
            for (int b = 0; b < 2; ++b)
#pragma unroll
                for (int m = 0; m < 4; ++m)
#pragma unroll
                    for (int n = 0; n < 2; ++n) acc[a][b][m][n] = (f32x4){0.f, 0.f, 0.f, 0.f};
        cur = nxt; cA = nA; cB = nB; ++ui;
        if constexpr (ALIGN_EPI) { if (wr == 1) PG8_BAR; }
    }
    PG8_WAIT_V(0);
    if constexpr (!ALIGN_EPI) { if (wr == 0) PG8_BAR; }
    PG8_BAR;
    if constexpr (Epi::AFTER_DRAIN) { E.fused(acc, cur, wr, wc, fr, fq, lds, wid, lane); S.done(cur); }
#undef PG8_SA
#undef PG8_SB
#undef PG8_STAGE
#undef PG8_LDA
#undef PG8_LDB
#undef PG8_MMA
#undef PG8_WAIT_V
#undef PG8_WAIT_L
#undef PG8_BAR
#undef PG8_SCHED
}
}
#include <hip/hip_bf16.h>
#include <cmath>
namespace attn_body {
using bf16=__hip_bfloat16;
using bf16x8=__attribute__((ext_vector_type(8)))short;
using s16x4=__attribute__((ext_vector_type(4)))short;
using f32x16=__attribute__((ext_vector_type(16)))float;
using u32x4=__attribute__((ext_vector_type(4)))unsigned;
constexpr int D=64,DM=1024;
constexpr int NW=8,QBLK=32,QB=QBLK*NW,KVBLK=64;
constexpr int ATTN_PITCH=DM, ATTN_UNIT_ROWS=QB;
__device__ __forceinline__ int crow(int r,int hi){return (r&3)+8*(r>>2)+4*hi;}
#define SBAR() __builtin_amdgcn_sched_barrier(0)
__device__ __forceinline__ void bandmask(f32x16&p0,f32x16&p1,int kb,int qpos,int hi){
  const float NEG=-INFINITY; const int d0=kb+4*hi-qpos;
  #pragma unroll
  for(int r=0;r<16;++r){const int d=d0+(r&3)+8*(r>>2); if(d>128||d<-128)p0[r]=NEG; if(d+32>128||d+32<-128)p1[r]=NEG;}
}

constexpr int NSLOT=3, SLOTB=8192;
constexpr int LDS_K=0, LDS_V=NSLOT*SLOTB, LDS_WS=2*NSLOT*SLOTB, LDS_OST=LDS_WS+NW*64*4, LDS_BYTES=LDS_OST+NW*4096;
constexpr float C2=0.125f*1.4426950408889634f;
__device__ __forceinline__ void glds16(const void*gsrc,unsigned lds_dst){unsigned keep;
  asm volatile("s_mov_b32 %0, m0\n\ts_mov_b32 m0, %2\n\ts_nop 0\n\tglobal_load_lds_dwordx4 %1, off\n\ts_mov_b32 m0, %0":"=&s"(keep):"v"(gsrc),"s"(lds_dst):"memory");}
__device__ __forceinline__ float max3f(float a,float b,float c){float r;asm("v_max3_f32 %0, %1, %2, %3":"=v"(r):"v"(a),"v"(b),"v"(c));return r;}
__device__ __forceinline__ float max2f(float a,float b){float r;asm("v_max_f32_e32 %0, %1, %2":"=v"(r):"v"(a),"v"(b));return r;}
__device__ __forceinline__ float fadd_s(float a,float b){float r;asm("v_add_f32_e32 %0, %1, %2":"=v"(r):"v"(a),"v"(b));return r;}
__device__ __forceinline__ float fsub_s(float a,float b){float r;asm("v_sub_f32_e32 %0, %1, %2":"=v"(r):"v"(a),"v"(b));return r;}
typedef float f32x2_t __attribute__((ext_vector_type(2))); typedef __bf16 bf16x2_t __attribute__((ext_vector_type(2)));
__device__ __forceinline__ unsigned cvtpk_s(float lo,float hi){f32x2_t v={lo,hi};bf16x2_t b=__builtin_convertvector(v,bf16x2_t);return __builtin_bit_cast(unsigned,b);}
#define WAIT_BAR(N) asm volatile("s_waitcnt vmcnt(" #N ") lgkmcnt(0)\n\ts_barrier":::"memory")

__device__ __forceinline__ void qkt(f32x16&p0,f32x16&p1,const char*Kslot,const bf16x8*qr,const f32x16&negm,int r32,int hi){
  const char*kb=Kslot+hi*1024+r32*16;
  #pragma unroll
  for(int d0=0;d0<4;++d0){
    const bf16x8 b0=*reinterpret_cast<const bf16x8*>(kb+d0*2048);
    const bf16x8 b1=*reinterpret_cast<const bf16x8*>(kb+d0*2048+512);
    if(d0==0){p0=__builtin_amdgcn_mfma_f32_32x32x16_bf16(b0,qr[0],negm,0,0,0);p1=__builtin_amdgcn_mfma_f32_32x32x16_bf16(b1,qr[0],negm,0,0,0);}
    else{p0=__builtin_amdgcn_mfma_f32_32x32x16_bf16(b0,qr[d0],p0,0,0,0);p1=__builtin_amdgcn_mfma_f32_32x32x16_bf16(b1,qr[d0],p1,0,0,0);}}
}
typedef __attribute__((address_space(3))) const char* lds_cptr;
typedef short v4i16_t __attribute__((ext_vector_type(4)));
__device__ __forceinline__ void kload8(bf16x8*kf,lds_cptr kp){
  kf[0]=*(const __attribute__((address_space(3))) bf16x8*)(kp);      kf[1]=*(const __attribute__((address_space(3))) bf16x8*)(kp+512);
  kf[2]=*(const __attribute__((address_space(3))) bf16x8*)(kp+2048); kf[3]=*(const __attribute__((address_space(3))) bf16x8*)(kp+2560);
  kf[4]=*(const __attribute__((address_space(3))) bf16x8*)(kp+4096); kf[5]=*(const __attribute__((address_space(3))) bf16x8*)(kp+4608);
  kf[6]=*(const __attribute__((address_space(3))) bf16x8*)(kp+6144); kf[7]=*(const __attribute__((address_space(3))) bf16x8*)(kp+6656);
}
__device__ __forceinline__ void kload2(bf16x8*kf,lds_cptr kp,int j){ kf[2*j]=*(const __attribute__((address_space(3))) bf16x8*)(kp+j*2048); kf[2*j+1]=*(const __attribute__((address_space(3))) bf16x8*)(kp+j*2048+512); }
__device__ __forceinline__ s16x4 vtr(lds_cptr p){ return __builtin_bit_cast(s16x4,__builtin_amdgcn_ds_read_tr16_b64_v4i16((__attribute__((address_space(3))) v4i16_t*)p)); }
__device__ __forceinline__ float rowmax(const f32x16&p0,const f32x16&p1){
  float a=max3f(p0[0],p0[1],p1[0]),b=max3f(p0[2],p0[3],p1[1]);a=max3f(a,p1[2],p1[3]);
  #pragma unroll
  for(int r=4;r<16;r+=4){a=max3f(a,p0[r],p0[r+1]);b=max3f(b,p0[r+2],p0[r+3]);a=max3f(a,p1[r],p1[r+1]);b=max3f(b,p1[r+2],p1[r+3]);}
  const float m=max2f(a,b);
  auto rr=__builtin_amdgcn_permlane32_swap(__float_as_uint(m),__float_as_uint(m),false,false);
  return max2f(__uint_as_float(rr[0]),__uint_as_float(rr[1]));
}
__device__ __forceinline__ void pv(f32x16*o,int vb,bf16x8 pa0,bf16x8 pa1,bf16x8 pa2,bf16x8 pa3){
  #pragma unroll
  for(int d0=0;d0<2;++d0){s16x4 lo[4],hi[4];
    #pragma unroll
    for(int ks=0;ks<4;++ks){
      asm volatile("ds_read_b64_tr_b16 %0,%1 offset:%c2":"=&v"(lo[ks]):"v"(vb),"i"(d0*4096+ks*1024):"memory");
      asm volatile("ds_read_b64_tr_b16 %0,%1 offset:%c2":"=&v"(hi[ks]):"v"(vb),"i"(d0*4096+ks*1024+512):"memory");}
    asm volatile("s_waitcnt lgkmcnt(0)":::"memory");SBAR();
    #define PK(k) (bf16x8){lo[k][0],lo[k][1],lo[k][2],lo[k][3],hi[k][0],hi[k][1],hi[k][2],hi[k][3]}
    o[d0]=__builtin_amdgcn_mfma_f32_32x32x16_bf16(pa0,PK(0),o[d0],0,0,0);
    o[d0]=__builtin_amdgcn_mfma_f32_32x32x16_bf16(pa1,PK(1),o[d0],0,0,0);
    o[d0]=__builtin_amdgcn_mfma_f32_32x32x16_bf16(pa2,PK(2),o[d0],0,0,0);
    o[d0]=__builtin_amdgcn_mfma_f32_32x32x16_bf16(pa3,PK(3),o[d0],0,0,0);
    #undef PK
  }
}

#ifndef ATTN_STORE16
#define ATTN_STORE16(p,v) (*(u32x4*)(p)=(v))
#endif
struct UnitDesc { const bf16* Q; const bf16* K; const bf16* V; bf16* O; int NT, latoff, kpos4, qpos0; float sink2; int hmask = 0; const float* sinkp = nullptr; };
template<int THRL,bool MASK> __device__ __forceinline__ void attn_unit(const UnitDesc&u,char*shm,const int tid_in){
  const int tid=tid_in; const int lane=tid&63,r32=lane&31,hi=lane>>5; const int wid=__builtin_amdgcn_readfirstlane(tid>>6);
  const int u_latoff=u.latoff;
  const int hsel=wid&u.hmask, rblk=u.hmask?(wid>>2):wid;
  const bf16*Qw=u.Q+(long)(rblk*QBLK)*DM+hsel*64;
  const bf16*Kh=u.K,*Vh=u.V;
  const unsigned lds0=(unsigned)(uintptr_t)shm;
  float*wsf=(float*)(shm+LDS_WS)+wid*64;
  const bf16*ksrc=Kh+(long)lane*DM+wid*8;
  const bf16*vsrc=Vh+(long)(16*(wid&3)+(lane>>2))*DM+(wid>>2)*32+(lane&3)*8;
  const unsigned kdst=lds0+LDS_K+wid*1024, vdst=lds0+LDS_V+wid*1024;
  #define TOFF(t) ((long)(((t)<4)?(t)*KVBLK:u_latoff+((t)-4)*KVBLK)*DM)
  #define DMA_K(t,slot) glds16(ksrc+TOFF(t),(unsigned)__builtin_amdgcn_readfirstlane(kdst+(slot)))
  #define DMA_V(t,slot) glds16(vsrc+TOFF(t),(unsigned)__builtin_amdgcn_readfirstlane(vdst+(slot)))
  const int vb0=(int)(lds0+LDS_V)+((lane>>4)&1)*32+(lane&3)*8+(4*hi+((lane&15)>>2))*64;
  const char*Kbase=shm+LDS_K; bf16x8 kf[8];
  const lds_cptr shm3=(lds_cptr)shm; const lds_cptr kp0=shm3+LDS_K+hi*1024+r32*16; const lds_cptr vp0=shm3+LDS_V+((lane>>4)&1)*32+(lane&3)*8+(4*hi+((lane&15)>>2))*64;
  const int NT=u.NT;
  DMA_K(0,0);DMA_V(0,0);DMA_K(1,SLOTB);
  bf16x8 qr[4];
  #pragma unroll
  for(int d0=0;d0<4;++d0)qr[d0]=*reinterpret_cast<const bf16x8*>(&Qw[(long)r32*DM+d0*16+hi*8]);
  float mhat=0.f,l_reg=0.f;f32x16 o[2];o[0]=f32x16{};o[1]=f32x16{};const f32x16 negm=f32x16{};
  const int qpos=u.qpos0+rblk*QBLK+r32; const int kpos4=u.kpos4;
  #define CMASK(P0,P1,t) do{ if constexpr(MASK){ if((t)>=4) bandmask(P0,P1,kpos4+((t)-4)*KVBLK,qpos,hi); } }while(0)
  bool resc=false;
  #define START(P0,P1) do{ const float rm=rowmax(P0,P1); resc=false; \
    { const float dl=rm; mhat=fadd_s(mhat,dl); \
      _Pragma("unroll") for(int r=0;r<16;++r){P0[r]=fsub_s(P0[r],dl);P1[r]=fsub_s(P1[r],dl);} \
      } \
    _Pragma("unroll") for(int r=0;r<16;++r)P0[r]=__builtin_amdgcn_exp2f(P0[r]); }while(0)
  #define RESC() do{ if(resc){ asm volatile("s_waitcnt lgkmcnt(0)":::"memory"); \
      _Pragma("unroll") for(int d_=0;d_<2;++d_) _Pragma("unroll") for(int r=0;r<16;++r)o[d_][r]*=wsf[crow(r,hi)]; } }while(0)
  f32x16 pA0,pA1,pB0,pB1;
  int sl_prev=0,sl_cur=0,sl_next=SLOTB;
  #define ROT() do{sl_prev=sl_cur;sl_cur=sl_next;sl_next=(sl_next==(NSLOT-1)*SLOTB)?0:sl_next+SLOTB;}while(0)
  DMA_K(2,2*SLOTB);
  WAIT_BAR(3);
  qkt(pA0,pA1,Kbase,qr,negm,r32,hi);asm volatile("s_nop 15\n\ts_nop 7":"+v"(pA0),"+v"(pA1));CMASK(pA0,pA1,0);
  START(pA0,pA1);
  _Pragma("unroll") for(int r=0;r<16;++r)pA1[r]=__builtin_amdgcn_exp2f(pA1[r]);
  WAIT_BAR(0);
  DMA_K(3,0);DMA_V(1,SLOTB);
  ROT();
  kload8(kf,kp0+sl_cur);
  WAIT_BAR(2);
  s16x4 vlo[8],vhi[8]; u32x4 pw0,pw1,pw2,pw3;
  #define PKW(P,B) cvtpk_s(P[B],P[B+1])
  #define PAF(k) __builtin_bit_cast(bf16x8,pw##k)
  #define VFR(i) (bf16x8){vlo[i][0],vlo[i][1],vlo[i][2],vlo[i][3],vhi[i][0],vhi[i][1],vhi[i][2],vhi[i][3]}
  #define PIN(x) asm volatile("":"+v"(x))
  #define MX3(a,b,c) __builtin_fmaxf(__builtin_fmaxf((a),(b)),(c))
  #define GAPA(MF,A0,A1,A2,A3,W0,W1,PW) do{ MF; sacc+=A0; sacc+=A1; sacc+=A2; sacc+=A3; PIN(sacc); W0; W1; PIN(PW); SBAR(); }while(0)
  #define EX(v) __builtin_amdgcn_exp2f(v)
  #define GAPB(MF,X,B) do{ MF; X[B]=EX(X[B]); X[B+1]=EX(X[B+1]); X[B+2]=EX(X[B+2]); X[B+3]=EX(X[B+3]); PIN(X); SBAR(); }while(0)
  #define VRD(i) do{ vlo[i]=vtr(vp_+(((i)>>2)*4096+((i)&3)*1024)); vhi[i]=vtr(vp_+(((i)>>2)*4096+((i)&3)*1024+512)); }while(0)
  #define KRD(G,j) do{ if(G){ kload2(kf,kp0+sl_next,j); SBAR(); } }while(0)
  #define STEP(C0,C1,P0,P1,t,GK,GV,GL) do{ SBAR(); \
    const lds_cptr vp_=vp0+sl_prev; \
    VRD(0); SBAR(); float sacc=(P0[0]+P0[1]); \
    GAPA(C0=__builtin_amdgcn_mfma_f32_32x32x16_bf16(kf[0],qr[0],negm,0,0,0), P0[2],P0[3],P0[4],P0[5],     pw0[0]=PKW(P0,0), pw0[1]=PKW(P0,2), pw0); \
    VRD(4); SBAR(); GAPA(C1=__builtin_amdgcn_mfma_f32_32x32x16_bf16(kf[1],qr[0],negm,0,0,0), P0[6],P0[7],P0[8],P0[9],     pw0[2]=PKW(P0,4), pw0[3]=PKW(P0,6), pw0); \
    VRD(1); SBAR(); GAPA(C0=__builtin_amdgcn_mfma_f32_32x32x16_bf16(kf[2],qr[1],C0,0,0,0),   P0[10],P0[11],P0[12],P0[13], pw1[0]=PKW(P0,8), pw1[1]=PKW(P0,10), pw1); \
    VRD(5); SBAR(); GAPA(C1=__builtin_amdgcn_mfma_f32_32x32x16_bf16(kf[3],qr[1],C1,0,0,0),   P0[14],P0[15],P1[0],P1[1],   pw1[2]=PKW(P0,12),pw1[3]=PKW(P0,14), pw1); \
    VRD(2); SBAR(); GAPA(C0=__builtin_amdgcn_mfma_f32_32x32x16_bf16(kf[4],qr[2],C0,0,0,0),   P1[2],P1[3],P1[4],P1[5],     pw2[0]=PKW(P1,0), pw2[1]=PKW(P1,2), pw2); \
    VRD(6); SBAR(); GAPA(C1=__builtin_amdgcn_mfma_f32_32x32x16_bf16(kf[5],qr[2],C1,0,0,0),   P1[6],P1[7],P1[8],P1[9],     pw2[2]=PKW(P1,4), pw2[3]=PKW(P1,6), pw2); \
    VRD(3); SBAR(); GAPA(C0=__builtin_amdgcn_mfma_f32_32x32x16_bf16(kf[6],qr[3],C0,0,0,0),   P1[10],P1[11],P1[12],P1[13], pw3[0]=PKW(P1,8), pw3[1]=PKW(P1,10), pw3); \
    VRD(7); SBAR(); GAPA(C1=__builtin_amdgcn_mfma_f32_32x32x16_bf16(kf[7],qr[3],C1,0,0,0),   P1[14],P1[15],0.f,0.f,       pw3[2]=PKW(P1,12),pw3[3]=PKW(P1,14), pw3); \
    l_reg+=sacc; \
    if(GK){DMA_K((t)+3,sl_cur);} if(GV){DMA_V((t)+1,sl_next);} \
    CMASK(C0,C1,t); \
    { float a=MX3(C0[0],C0[1],C1[0]),b=MX3(C0[2],C0[3],C1[1]); a=MX3(a,C1[2],C1[3]); \
      _Pragma("unroll") for(int r=4;r<16;r+=4){a=MX3(a,C0[r],C0[r+1]);b=MX3(b,C0[r+2],C0[r+3]);a=MX3(a,C1[r],C1[r+1]);b=MX3(b,C1[r+2],C1[r+3]);} \
      float rm=__builtin_fmaxf(a,b); { auto rr=__builtin_amdgcn_permlane32_swap(__float_as_uint(rm),__float_as_uint(rm),false,false); rm=__builtin_fmaxf(__uint_as_float(rr[0]),__uint_as_float(rr[1])); } \
      rm-=mhat; resc=false; \
      if(__builtin_expect(__any(rm>(float)THRL),0)){ const float dl=__builtin_fmaxf(rm,0.f); mhat+=dl; \
        const float f=__builtin_amdgcn_exp2f(-dl); l_reg*=f; if(hi==0)wsf[r32]=f; resc=true; } \
      _Pragma("unroll") for(int r=0;r<16;++r){C0[r]-=mhat;C1[r]-=mhat;} } \
    SBAR(); \
    GAPB(o[0]=__builtin_amdgcn_mfma_f32_32x32x16_bf16(PAF(0),VFR(0),o[0],0,0,0), C0,0); \
    GAPB(o[1]=__builtin_amdgcn_mfma_f32_32x32x16_bf16(PAF(0),VFR(4),o[1],0,0,0), C0,4); \
    KRD(GL,0); GAPB(o[0]=__builtin_amdgcn_mfma_f32_32x32x16_bf16(PAF(1),VFR(1),o[0],0,0,0), C0,8); \
    KRD(GL,1); GAPB(o[1]=__builtin_amdgcn_mfma_f32_32x32x16_bf16(PAF(1),VFR(5),o[1],0,0,0), C0,12); \
    KRD(GL,2); GAPB(o[0]=__builtin_amdgcn_mfma_f32_32x32x16_bf16(PAF(2),VFR(2),o[0],0,0,0), C1,0); \
    KRD(GL,3); GAPB(o[1]=__builtin_amdgcn_mfma_f32_32x32x16_bf16(PAF(2),VFR(6),o[1],0,0,0), C1,4); \
    GAPB(o[0]=__builtin_amdgcn_mfma_f32_32x32x16_bf16(PAF(3),VFR(3),o[0],0,0,0), C1,8); \
    GAPB(o[1]=__builtin_amdgcn_mfma_f32_32x32x16_bf16(PAF(3),VFR(7),o[1],0,0,0), C1,12); \
    }while(0)
  int t=1;


  if constexpr(!MASK) for(;t+5<NT;t+=2){
    STEP(pB0,pB1,pA0,pA1,t,true,true,true);     WAIT_BAR(2); RESC(); ROT();
    STEP(pA0,pA1,pB0,pB1,t+1,true,true,true);   WAIT_BAR(2); RESC(); ROT();
  }


  #define ENDW(tt) do{ if((tt)+3<NT){WAIT_BAR(2);} else if((tt)+2<NT){WAIT_BAR(1);} else {WAIT_BAR(0);} }while(0)
  for(;t+1<NT;t+=2){
    STEP(pB0,pB1,pA0,pA1,t,(t+3<NT),(t+1<NT),(t+1<NT));       ENDW(t);   RESC(); ROT();
    STEP(pA0,pA1,pB0,pB1,t+1,(t+4<NT),(t+2<NT),(t+2<NT));     ENDW(t+1); RESC(); ROT();
  }
  STEP(pB0,pB1,pA0,pA1,NT-1,false,false,false); RESC();
  { float sacc=pB0[0]+pB0[1]; _Pragma("unroll") for(int r=2;r<16;++r)sacc+=pB0[r]; _Pragma("unroll") for(int r=0;r<16;++r)sacc+=pB1[r]; l_reg+=sacc;
    pw0=(u32x4){PKW(pB0,0),PKW(pB0,2),PKW(pB0,4),PKW(pB0,6)};pw1=(u32x4){PKW(pB0,8),PKW(pB0,10),PKW(pB0,12),PKW(pB0,14)};pw2=(u32x4){PKW(pB1,0),PKW(pB1,2),PKW(pB1,4),PKW(pB1,6)};pw3=(u32x4){PKW(pB1,8),PKW(pB1,10),PKW(pB1,12),PKW(pB1,14)};
    SBAR(); pv(o,vb0+sl_cur,PAF(0),PAF(1),PAF(2),PAF(3)); }
  #undef PKW
  #undef PAF
  #undef VFR
  #undef PIN
  #undef MX3
  #undef GAPA
  #undef GAPB
  #undef EX
  #undef VRD
  #undef KRD
  #undef STEP
  #undef ENDW
  {auto rr=__builtin_amdgcn_permlane32_swap(__float_as_uint(l_reg),__float_as_uint(l_reg),false,false);l_reg=__uint_as_float(rr[0])+__uint_as_float(rr[1]); l_reg+=__builtin_amdgcn_exp2f((u.sinkp?u.sinkp[hsel]*1.4426950408889634f:u.sink2)-mhat);}
  if(hi==0)wsf[32+r32]=l_reg;asm volatile("s_waitcnt lgkmcnt(0)":::"memory");
  float rli[16];
  #pragma unroll
  for(int r=0;r<16;++r)rli[r]=__builtin_amdgcn_rcpf(wsf[32+crow(r,hi)]);
  bf16*Ow=u.O+(long)(rblk*QBLK)*DM+hsel*64;
  { bf16*stg=(bf16*)(shm+LDS_OST)+wid*2048;
    #pragma unroll
    for(int r=0;r<16;++r){const int orow=crow(r,hi);
      #pragma unroll
      for(int d0=0;d0<2;++d0)stg[orow*64+d0*32+r32]=__float2bfloat16(o[d0][r]*rli[r]);}
    asm volatile("s_waitcnt lgkmcnt(0)":::"memory");
    #pragma unroll
    for(int i=0;i<4;++i){const int row=i*8+(lane>>3),ch=lane&7; const u32x4 v=*(const u32x4*)(stg+row*64+ch*8); ATTN_STORE16(Ow+(long)row*DM+ch*8,v);} }
  asm volatile("s_waitcnt lgkmcnt(0)\n\ts_barrier":::"memory");
  #undef TOFF
  #undef DMA_K
  #undef DMA_V
  #undef CMASK
  #undef START
  #undef RESC
  #undef ROT
}

constexpr int SLOTV=16384;
constexpr int LDS2_V=NSLOT*SLOTB, LDS2_WS=LDS2_V+NSLOT*SLOTV, LDS2_OST=LDS2_WS+NW*64*4, LDS2_BYTES=LDS2_OST+NW*4096;
template<int THRL> __device__ __forceinline__ void attn_unit_v128(const UnitDesc&u,char*shm,const int tid_in){
  const int tid=tid_in; const int lane=tid&63,r32=lane&31,hi=lane>>5; const int wid=__builtin_amdgcn_readfirstlane(tid>>6);
  const int u_latoff=u.latoff;
  const bf16*Qw=u.Q+(long)(wid*QBLK)*DM;
  const bf16*Kh=u.K,*Vh=u.V;
  const unsigned lds0=(unsigned)(uintptr_t)shm;
  float*wsf=(float*)(shm+LDS2_WS)+wid*64;
  const bf16*ksrc=Kh+(long)lane*DM+wid*8;
  const bf16*vsrc=Vh+(long)(16*(wid&3)+(lane>>2))*DM+(wid>>2)*32+(lane&3)*8;
  const unsigned kdst=lds0+LDS_K+wid*1024, vdst=lds0+LDS2_V+wid*1024;
  #define TOFF(t) ((long)(((t)<4)?(t)*KVBLK:u_latoff+((t)-4)*KVBLK)*DM)
  #define DMA_K(t,slot) glds16(ksrc+TOFF(t),(unsigned)__builtin_amdgcn_readfirstlane(kdst+(slot)))
  #define DMA_V(t,slot) do{ glds16(vsrc+TOFF(t),(unsigned)__builtin_amdgcn_readfirstlane(vdst+2*(slot))); glds16(vsrc+64+TOFF(t),(unsigned)__builtin_amdgcn_readfirstlane(vdst+2*(slot)+8192)); }while(0)
  const int vb0=(int)(lds0+LDS2_V)+((lane>>4)&1)*32+(lane&3)*8+(4*hi+((lane&15)>>2))*64;
  const char*Kbase=shm+LDS_K; bf16x8 kf[8];
  const lds_cptr shm3=(lds_cptr)shm; const lds_cptr kp0=shm3+LDS_K+hi*1024+r32*16; const lds_cptr vp0=shm3+LDS2_V+((lane>>4)&1)*32+(lane&3)*8+(4*hi+((lane&15)>>2))*64;
  const int NT=u.NT;
  DMA_K(0,0);DMA_V(0,0);DMA_K(1,SLOTB);
  bf16x8 qr[4];
  #pragma unroll
  for(int d0=0;d0<4;++d0)qr[d0]=*reinterpret_cast<const bf16x8*>(&Qw[(long)r32*DM+d0*16+hi*8]);
  float mhat=0.f,l_reg=0.f;f32x16 o[4];o[0]=f32x16{};o[1]=f32x16{};o[2]=f32x16{};o[3]=f32x16{};const f32x16 negm=f32x16{};
  bool resc=false;
  #define START(P0,P1) do{ const float rm=rowmax(P0,P1); resc=false; \
    { const float dl=rm; mhat=fadd_s(mhat,dl); \
      _Pragma("unroll") for(int r=0;r<16;++r){P0[r]=fsub_s(P0[r],dl);P1[r]=fsub_s(P1[r],dl);} \
      } \
    _Pragma("unroll") for(int r=0;r<16;++r)P0[r]=__builtin_amdgcn_exp2f(P0[r]); }while(0)
  #define RESC() do{ if(resc){ asm volatile("s_waitcnt lgkmcnt(0)":::"memory"); \
      _Pragma("unroll") for(int d_=0;d_<4;++d_) _Pragma("unroll") for(int r=0;r<16;++r)o[d_][r]*=wsf[crow(r,hi)]; } }while(0)
  f32x16 pA0,pA1,pB0,pB1;
  int sl_prev=0,sl_cur=0,sl_next=SLOTB;
  #define ROT() do{sl_prev=sl_cur;sl_cur=sl_next;sl_next=(sl_next==(NSLOT-1)*SLOTB)?0:sl_next+SLOTB;}while(0)
  DMA_K(2,2*SLOTB);
  WAIT_BAR(3);
  qkt(pA0,pA1,Kbase,qr,negm,r32,hi);asm volatile("s_nop 15\n\ts_nop 7":"+v"(pA0),"+v"(pA1));
  START(pA0,pA1);
  _Pragma("unroll") for(int r=0;r<16;++r)pA1[r]=__builtin_amdgcn_exp2f(pA1[r]);
  WAIT_BAR(0);
  DMA_K(3,0);DMA_V(1,SLOTB);
  ROT();
  kload8(kf,kp0+sl_cur);
  WAIT_BAR(3);
  s16x4 vlo[16],vhi[16]; u32x4 pw0,pw1,pw2,pw3;
  #define PKW(P,B) cvtpk_s(P[B],P[B+1])
  #define PAF(k) __builtin_bit_cast(bf16x8,pw##k)
  #define VFR(i) (bf16x8){vlo[i][0],vlo[i][1],vlo[i][2],vlo[i][3],vhi[i][0],vhi[i][1],vhi[i][2],vhi[i][3]}
  #define PIN(x) asm volatile("":"+v"(x))
  #define MX3(a,b,c) __builtin_fmaxf(__builtin_fmaxf((a),(b)),(c))
  #define GAPA(MF,A0,A1,A2,A3,W0,W1,PW) do{ MF; sacc+=A0; sacc+=A1; sacc+=A2; sacc+=A3; PIN(sacc); W0; W1; PIN(PW); SBAR(); }while(0)
  #define EX(v) __builtin_amdgcn_exp2f(v)
  #define GAPB(MF,X,B) do{ MF; X[B]=EX(X[B]); X[B+1]=EX(X[B+1]); PIN(X); SBAR(); }while(0)
  #define VRD(i) do{ vlo[i]=vtr(vp_+(((i)>>2)*4096+((i)&3)*1024)); vhi[i]=vtr(vp_+(((i)>>2)*4096+((i)&3)*1024+512)); }while(0)
  #define KR1(G,i) do{ if(G){ kf[i]=*(const __attribute__((address_space(3))) bf16x8*)(kp0+sl_next+((i)>>1)*2048+((i)&1)*512); } }while(0)
  #define MF32(a,b,c) __builtin_amdgcn_mfma_f32_32x32x16_bf16(a,b,c,0,0,0)
  #define STEP(C0,C1,P0,P1,t,GK,GV,GL) do{ SBAR(); \
    const lds_cptr vp_=vp0+2*sl_prev; \
    float sacc=(P0[0]+P0[1]); \
    GAPA(C0=MF32(kf[0],qr[0],negm), P0[2],P0[3],P0[4],P0[5],     pw0[0]=PKW(P0,0), pw0[1]=PKW(P0,2), pw0); \
    GAPA(C1=MF32(kf[1],qr[0],negm), P0[6],P0[7],P0[8],P0[9],     pw0[2]=PKW(P0,4), pw0[3]=PKW(P0,6), pw0); \
    GAPA(C0=MF32(kf[2],qr[1],C0),   P0[10],P0[11],P0[12],P0[13], pw1[0]=PKW(P0,8), pw1[1]=PKW(P0,10), pw1); \
    GAPA(C1=MF32(kf[3],qr[1],C1),  P0[14],P0[15],P1[0],P1[1],   pw1[2]=PKW(P0,12),pw1[3]=PKW(P0,14), pw1); \
    VRD(0); SBAR(); GAPA(C0=MF32(kf[4],qr[2],C0),   P1[2],P1[3],P1[4],P1[5],     pw2[0]=PKW(P1,0), pw2[1]=PKW(P1,2), pw2); \
    VRD(4); SBAR(); GAPA(C1=MF32(kf[5],qr[2],C1),   P1[6],P1[7],P1[8],P1[9],     pw2[2]=PKW(P1,4), pw2[3]=PKW(P1,6), pw2); \
    VRD(8); SBAR(); GAPA(C0=MF32(kf[6],qr[3],C0),   P1[10],P1[11],P1[12],P1[13], pw3[0]=PKW(P1,8), pw3[1]=PKW(P1,10), pw3); \
    VRD(12); SBAR(); GAPA(C1=MF32(kf[7],qr[3],C1),  P1[14],P1[15],0.f,0.f,       pw3[2]=PKW(P1,12),pw3[3]=PKW(P1,14), pw3); \
    l_reg+=sacc; \
    if(GK){DMA_K((t)+3,sl_cur);} if(GV){DMA_V((t)+1,sl_next);} \
    SBAR(); \
    VRD(1); SBAR(); o[0]=MF32(PAF(0),VFR(0),o[0]); SBAR(); \
    VRD(5); SBAR(); o[1]=MF32(PAF(0),VFR(4),o[1]); float a_=MX3(C0[0],C0[1],C1[0]),b_=MX3(C0[2],C0[3],C1[1]); a_=MX3(a_,C1[2],C1[3]); a_=MX3(a_,C0[4],C0[5]); b_=MX3(b_,C0[6],C0[7]); a_=MX3(a_,C1[4],C1[5]); b_=MX3(b_,C1[6],C1[7]); PIN(a_); PIN(b_); SBAR(); \
    VRD(9); KR1(GL,0); SBAR(); o[2]=MF32(PAF(0),VFR(8),o[2]); a_=MX3(a_,C0[8],C0[9]); b_=MX3(b_,C0[10],C0[11]); a_=MX3(a_,C1[8],C1[9]); b_=MX3(b_,C1[10],C1[11]); a_=MX3(a_,C0[12],C0[13]); b_=MX3(b_,C0[14],C0[15]); a_=MX3(a_,C1[12],C1[13]); b_=MX3(b_,C1[14],C1[15]); PIN(a_); PIN(b_); SBAR(); \
    VRD(13); KR1(GL,1); SBAR(); o[3]=MF32(PAF(0),VFR(12),o[3]); { float rm=__builtin_fmaxf(a_,b_); { auto rr=__builtin_amdgcn_permlane32_swap(__float_as_uint(rm),__float_as_uint(rm),false,false); rm=__builtin_fmaxf(__uint_as_float(rr[0]),__uint_as_float(rr[1])); } \
      rm-=mhat; resc=false; \
      if(__builtin_expect(__any(rm>(float)THRL),0)){ const float dl=__builtin_fmaxf(rm,0.f); mhat+=dl; \
        const float f=__builtin_amdgcn_exp2f(-dl); l_reg*=f; if(hi==0)wsf[r32]=f; resc=true; } } PIN(mhat); SBAR(); \
    VRD(2); KR1(GL,2); SBAR(); o[0]=MF32(PAF(1),VFR(1),o[0]); _Pragma("unroll") for(int r=0;r<16;++r){C0[r]-=mhat;} PIN(C0); SBAR(); \
    VRD(6); KR1(GL,3); SBAR(); o[1]=MF32(PAF(1),VFR(5),o[1]); _Pragma("unroll") for(int r=0;r<16;++r){C1[r]-=mhat;} PIN(C1); SBAR(); \
    VRD(10); KR1(GL,4); SBAR(); o[2]=MF32(PAF(1),VFR(9),o[2]); C0[0]=EX(C0[0]); C0[1]=EX(C0[1]); C0[2]=EX(C0[2]); PIN(C0); SBAR(); \
    VRD(14); KR1(GL,5); SBAR(); o[3]=MF32(PAF(1),VFR(13),o[3]); C0[3]=EX(C0[3]); C0[4]=EX(C0[4]); C0[5]=EX(C0[5]); PIN(C0); SBAR(); \
    VRD(3); KR1(GL,6); SBAR(); o[0]=MF32(PAF(2),VFR(2),o[0]); C0[6]=EX(C0[6]); C0[7]=EX(C0[7]); C0[8]=EX(C0[8]); PIN(C0); SBAR(); \
    VRD(7); KR1(GL,7); SBAR(); o[1]=MF32(PAF(2),VFR(6),o[1]); C0[9]=EX(C0[9]); C0[10]=EX(C0[10]); C0[11]=EX(C0[11]); PIN(C0); SBAR(); \
    VRD(11); SBAR(); o[2]=MF32(PAF(2),VFR(10),o[2]); C0[12]=EX(C0[12]); C0[13]=EX(C0[13]); C0[14]=EX(C0[14]); PIN(C0); SBAR(); \
    VRD(15); SBAR(); o[3]=MF32(PAF(2),VFR(14),o[3]); C0[15]=EX(C0[15]); C1[0]=EX(C1[0]); C1[1]=EX(C1[1]); PIN(C0); PIN(C1); SBAR(); \
    o[0]=MF32(PAF(3),VFR(3),o[0]); C1[2]=EX(C1[2]); C1[3]=EX(C1[3]); C1[4]=EX(C1[4]); PIN(C1); SBAR(); \
    o[1]=MF32(PAF(3),VFR(7),o[1]); C1[5]=EX(C1[5]); C1[6]=EX(C1[6]); C1[7]=EX(C1[7]); PIN(C1); SBAR(); \
    o[2]=MF32(PAF(3),VFR(11),o[2]); C1[8]=EX(C1[8]); C1[9]=EX(C1[9]); C1[10]=EX(C1[10]); C1[11]=EX(C1[11]); PIN(C1); SBAR(); \
    o[3]=MF32(PAF(3),VFR(15),o[3]); C1[12]=EX(C1[12]); C1[13]=EX(C1[13]); C1[14]=EX(C1[14]); C1[15]=EX(C1[15]); PIN(C1); SBAR(); \
    }while(0)
  int t=1;
  for(;t+5<NT;t+=2){
    STEP(pB0,pB1,pA0,pA1,t,true,true,true);     WAIT_BAR(3); RESC(); ROT();
    STEP(pA0,pA1,pB0,pB1,t+1,true,true,true);   WAIT_BAR(3); RESC(); ROT();
  }
  #define ENDW(tt) do{ if((tt)+3<NT){WAIT_BAR(3);} else if((tt)+2<NT){WAIT_BAR(2);} else {WAIT_BAR(0);} }while(0)
  for(;t+1<NT;t+=2){
    STEP(pB0,pB1,pA0,pA1,t,(t+3<NT),(t+1<NT),(t+1<NT));       ENDW(t);   RESC(); ROT();
    STEP(pA0,pA1,pB0,pB1,t+1,(t+4<NT),(t+2<NT),(t+2<NT));     ENDW(t+1); RESC(); ROT();
  }
  STEP(pB0,pB1,pA0,pA1,NT-1,false,false,false); RESC();
  { float sacc=pB0[0]+pB0[1]; _Pragma("unroll") for(int r=2;r<16;++r)sacc+=pB0[r]; _Pragma("unroll") for(int r=0;r<16;++r)sacc+=pB1[r]; l_reg+=sacc;
    pw0=(u32x4){PKW(pB0,0),PKW(pB0,2),PKW(pB0,4),PKW(pB0,6)};pw1=(u32x4){PKW(pB0,8),PKW(pB0,10),PKW(pB0,12),PKW(pB0,14)};pw2=(u32x4){PKW(pB1,0),PKW(pB1,2),PKW(pB1,4),PKW(pB1,6)};pw3=(u32x4){PKW(pB1,8),PKW(pB1,10),PKW(pB1,12),PKW(pB1,14)};
    SBAR(); pv(o,vb0+2*sl_cur,PAF(0),PAF(1),PAF(2),PAF(3)); pv(o+2,vb0+2*sl_cur+8192,PAF(0),PAF(1),PAF(2),PAF(3)); }
  #undef PKW
  #undef PAF
  #undef VFR
  #undef PIN
  #undef MX3
  #undef GAPA
  #undef GAPB
  #undef EX
  #undef VRD
  #undef KR1
  #undef MF32
  #undef STEP
  #undef ENDW
  {auto rr=__builtin_amdgcn_permlane32_swap(__float_as_uint(l_reg),__float_as_uint(l_reg),false,false);l_reg=__uint_as_float(rr[0])+__uint_as_float(rr[1]); l_reg+=__builtin_amdgcn_exp2f(u.sink2-mhat);}
  if(hi==0)wsf[32+r32]=l_reg;asm volatile("s_waitcnt lgkmcnt(0)":::"memory");
  float rli[16];
  #pragma unroll
  for(int r=0;r<16;++r)rli[r]=__builtin_amdgcn_rcpf(wsf[32+crow(r,hi)]);
  bf16*Ow=u.O+(long)(wid*QBLK)*DM;
  { bf16*stg=(bf16*)(shm+LDS2_OST)+wid*2048;
    #pragma unroll
    for(int h2=0;h2<2;++h2){
      #pragma unroll
      for(int r=0;r<16;++r){const int orow=crow(r,hi);
        #pragma unroll
        for(int d0=0;d0<2;++d0)stg[orow*64+d0*32+r32]=__float2bfloat16(o[2*h2+d0][r]*rli[r]);}
      asm volatile("s_waitcnt lgkmcnt(0)":::"memory");
      #pragma unroll
      for(int i=0;i<4;++i){const int row=i*8+(lane>>3),ch=lane&7; const u32x4 v=*(const u32x4*)(stg+row*64+ch*8); ATTN_STORE16(Ow+(long)row*DM+h2*64+ch*8,v);}
      asm volatile("s_waitcnt lgkmcnt(0)":::"memory"); } }
  asm volatile("s_waitcnt lgkmcnt(0)\n\ts_barrier":::"memory");
  #undef TOFF
  #undef DMA_K
  #undef DMA_V
  #undef START
  #undef RESC
  #undef ROT
}
constexpr int ATTN_LDS_BYTES=LDS_BYTES;
#undef SBAR
#undef WAIT_BAR
}
#define GAS __attribute__((address_space(1)))
#define LAS __attribute__((address_space(3)))
typedef unsigned short bf16;
typedef unsigned v4u __attribute__((ext_vector_type(4)));
typedef float f32x4 __attribute__((ext_vector_type(4)));
typedef short bf16x8 __attribute__((ext_vector_type(8)));
typedef GAS unsigned gu32;
typedef GAS unsigned long long gu64;
#define RLX_AGENT __ATOMIC_RELAXED, __HIP_MEMORY_SCOPE_AGENT
#define LDS_WAIT() asm volatile("s_waitcnt lgkmcnt(0)" ::: "memory")
#define VM_WAIT() asm volatile("s_waitcnt vmcnt(0)" ::: "memory")
__device__ __forceinline__ unsigned long long rt() { return __builtin_amdgcn_s_memrealtime(); }
__device__ __forceinline__ unsigned f2bf(float f) { unsigned u = __builtin_bit_cast(unsigned, f); return (u + 0x7fffu + ((u >> 16) & 1u)) >> 16; }
__device__ __forceinline__ unsigned pk2(float lo, float hi) { unsigned r; asm("v_cvt_pk_bf16_f32 %0, %1, %2" : "=v"(r) : "v"(lo), "v"(hi)); return r; }

#define XB_TMO      128
#define XB_XCNT(j)  (256  + 64 * (j))
#define XB_XSUB(j)  (1280 + 64 * (j))
#define XB_XGEN(j)  (2304 + 64 * (j))
#define XB_TOP      3328
#define XB_TOPGEN   3392
#define XCD_BAR_WORDS 3456
#define XB_SPIN_CAP (1u << 29)

__device__ __forceinline__ unsigned xb_ld(unsigned* p)              { return __hip_atomic_load(p, __ATOMIC_RELAXED, __HIP_MEMORY_SCOPE_AGENT); }
__device__ __forceinline__ unsigned xb_add(unsigned* p, unsigned v) { return __hip_atomic_fetch_add(p, v, __ATOMIC_RELAXED, __HIP_MEMORY_SCOPE_AGENT); }
__device__ __forceinline__ unsigned xb_xcc_id() { return (unsigned)__builtin_amdgcn_s_getreg((3 << 11) | 20) & 0xFu; }
#define XB_SPIN(cond, bar) do { unsigned _sp = 0; while (cond) { __builtin_amdgcn_s_sleep(1); \
    if ((++_sp & 255u) == 0u) { if (xb_ld(&(bar)[XB_TMO])) break; if (_sp > XB_SPIN_CAP) { atomicAdd(&(bar)[XB_TMO], 1u); break; } } } } while (0)

struct XcdBarrier {
    unsigned* bar; unsigned x;
    volatile LAS unsigned* st;
};

__device__ __forceinline__ XcdBarrier xcd_barrier_post(unsigned* bar, volatile LAS unsigned* st, const int tid_in) {
    XcdBarrier b; b.bar = bar; b.x = xb_xcc_id(); b.st = st;
    if (tid_in == 0) (void)xb_add(&bar[XB_XCNT(b.x)], 1u);
    return b;
}
__device__ __forceinline__ void xcd_barrier_complete(unsigned* bar, unsigned x, unsigned& nloc, unsigned& nx) {
    const unsigned G = gridDim.x * gridDim.y * gridDim.z;
    unsigned sum, cnt, mine, sp = 0u;
    for (;;) {
        sum = 0u; cnt = 0u; mine = 0u;
#pragma unroll
        for (unsigned j = 0; j < 16; ++j) { const unsigned c = xb_ld(&bar[XB_XCNT(j)]); sum += c; cnt += (c > 0u) ? 1u : 0u; mine = (j == x) ? c : mine; }
        if (sum == G) break;
        __builtin_amdgcn_s_sleep(1);
        if ((++sp & 255u) == 0u) { if (xb_ld(&bar[XB_TMO])) break; if (sp > XB_SPIN_CAP) { atomicAdd(&bar[XB_TMO], 1u); break; } }
    }
    nloc = mine > 0u ? mine : 1u; nx = cnt > 0u ? cnt : 1u;
}

__device__ __forceinline__ void xcd_barrier(const XcdBarrier& b, const int tid_in) {
    asm volatile("s_waitcnt vmcnt(0)" ::: "memory");
    __syncthreads();
    if (tid_in == 0) {
        unsigned* bar = b.bar;
        __builtin_amdgcn_s_waitcnt(0);
        unsigned nloc = b.st[0], nx = b.st[1];
        if (nloc == 0u) { xcd_barrier_complete(bar, b.x, nloc, nx); b.st[0] = nloc; b.st[1] = nx; }
        const unsigned old = xb_add(&bar[XB_XSUB(b.x)], 1u);
        const unsigned gen = old / nloc;
        if (old + 1u == (gen + 1u) * nloc) {
            __builtin_amdgcn_fence(__ATOMIC_RELEASE, "agent");
            asm volatile("s_waitcnt vmcnt(0)" ::: "memory");
            const unsigned og = xb_add(&bar[XB_TOP], 1u);
            const unsigned tg = og / nx;
            if (og + 1u == (tg + 1u) * nx) xb_add(&bar[XB_TOPGEN], 1u);
            else XB_SPIN(xb_ld(&bar[XB_TOPGEN]) == tg, bar);
            __builtin_amdgcn_fence(__ATOMIC_ACQUIRE, "agent");
            xb_add(&bar[XB_XGEN(b.x)], 1u);
            asm volatile("s_waitcnt vmcnt(0)" ::: "memory");
        } else {
            XB_SPIN(xb_ld(&bar[XB_XGEN(b.x)]) == gen, bar);
            __builtin_amdgcn_fence(__ATOMIC_ACQUIRE, "agent");
            asm volatile("s_waitcnt vmcnt(0)" ::: "memory");
        }
    }
    __syncthreads();
}
constexpr int NB = 16, TL = 2048, LC = 256, SQ = TL + LC, MR = NB * SQ, DD = 1024, NLAYER = 4;
constexpr float LN_EPS = 1e-5f, DN_ALPHA = 1.6817928305074290f;
constexpr float LOG2E = 1.4426950408889634f;
constexpr int NWAVES = 8, NTHR = 512;
constexpr size_t MiB = 1u << 20;
constexpr size_t WS_CTL = 0, CTL_ZERO_BYTES = 1 * MiB;
constexpr size_t WS_MOD = 1 * MiB;
constexpr size_t WS_ROPE = 3 * MiB;
constexpr size_t WS_S5LB = 4 * MiB;
constexpr size_t WS_S5B = 4 * MiB + 128 * 1024;
constexpr size_t WS_S5C = 5 * MiB;
constexpr size_t WS_KEYS = 6 * MiB;
constexpr size_t WS_WQKV_DA = 8 * MiB;
constexpr size_t WS_WO_DA = 20 * MiB;
constexpr size_t WS_WQKV_WA = 24 * MiB;
constexpr size_t WS_WO_WA = 27 * MiB;
constexpr size_t WS_WGLU = 29 * MiB;
constexpr size_t WS_WPQ = 33 * MiB;
constexpr size_t WS_PU = 64 * MiB;
constexpr size_t WS_PV = 192 * MiB;
constexpr size_t WS_LAT = 320 * MiB;
constexpr size_t WS_H = 464 * MiB;
constexpr size_t WS_A = 536 * MiB;
constexpr size_t WS_B = 752 * MiB;
constexpr size_t WS_END = 896 * MiB;
constexpr size_t SZ72 = 72 * MiB;
constexpr int CW_TMO = 0, CW_CODE = 1, CW_ERR = 2;
constexpr int CW_BAR = 4096;
constexpr int RING_OFF = 0, RING_BYTES = 131072;
constexpr int LDSCTL_OFF = RING_BYTES, MISC_OFF = LDSCTL_OFF + 320;
constexpr int LDS_BYTES = 147456;
static_assert(MISC_OFF + 128 <= LDS_BYTES, "LDS map");

typedef __bf16 bf16x2v __attribute__((ext_vector_type(2)));
typedef float f32x16 __attribute__((ext_vector_type(16)));
__device__ __forceinline__ float dot2bf(unsigned w, unsigned x, float acc) { return __builtin_amdgcn_fdot2_f32_bf16(__builtin_bit_cast(bf16x2v, w), __builtin_bit_cast(bf16x2v, x), acc, false); }
__device__ __forceinline__ float bflo(unsigned u) { return __uint_as_float(u << 16); }
__device__ __forceinline__ float bfhi(unsigned u) { return __uint_as_float(u & 0xffff0000u); }
__device__ __forceinline__ float bf2f(bf16 h) { return __uint_as_float((unsigned)h << 16); }
__device__ __forceinline__ float wave_sum(float v) {
#pragma unroll
    for (int o = 1; o < 64; o <<= 1) v += __shfl_xor(v, o);
    return v;
}
__device__ __forceinline__ float gelu_tanh(float x) {
    const float z = 0.7978845608028654f * (x + 0.044715f * x * x * x);
    return x * __builtin_amdgcn_rcpf(1.f + __builtin_amdgcn_exp2f(-2.f * LOG2E * z));
}
__device__ __forceinline__ int mod_index(int row) { const int b = row / SQ; return (row - b * SQ) < LC ? 16 : b; }

__device__ __forceinline__ void p0_transpose_item(const float* W, int K, int N, bf16* WT, int glu, LAS float* scr, int item, int lane) {
    const int nblk = N / 32, kb = item / nblk, nb = item % nblk, k0 = 64 * kb, n0 = 32 * nb;
#pragma unroll 8
    for (int i = 0; i < 32; ++i) { const int kk = 2 * i + (lane >> 5); scr[kk * 33 + (lane & 31)] = W[(size_t)(k0 + kk) * N + n0 + (lane & 31)]; }
    LDS_WAIT(); asm volatile("" ::: "memory");
    const int c = lane & 7;
    int r0 = n0; if (glu) r0 = (n0 < 1024) ? ((n0 >> 7) * 256 + (n0 & 127)) : (((n0 - 1024) >> 7) * 256 + 128 + ((n0 - 1024) & 127));
#pragma unroll
    for (int j = 0; j < 4; ++j) { const int n = (lane >> 3) + 8 * j; const LAS float* s = scr + (8 * c) * 33 + n;
        v4u o; o.x = pk2(s[0 * 33], s[1 * 33]); o.y = pk2(s[2 * 33], s[3 * 33]); o.z = pk2(s[4 * 33], s[5 * 33]); o.w = pk2(s[6 * 33], s[7 * 33]);
        *(GAS v4u*)(WT + (size_t)(r0 + n) * K + k0 + 8 * c) = o; }
    LDS_WAIT(); asm volatile("" ::: "memory");
}
__device__ __forceinline__ void cvt_f32_bf16_stream(const float* src, bf16* dst, size_t nchunks8, size_t gt, size_t ngt) {
    for (size_t c = gt; c < nchunks8; c += ngt) { const f32x4 a = *(const GAS f32x4*)(src + c * 8), b = *(const GAS f32x4*)(src + c * 8 + 4);
        v4u o; o.x = pk2(a.x, a.y); o.y = pk2(a.z, a.w); o.z = pk2(b.x, b.y); o.w = pk2(b.z, b.w); *(GAS v4u*)(dst + c * 8) = o; }
}
struct Args;
#ifndef PEER_SLICED
#define PEER_SLICED 0
#endif
constexpr float PU_SCALE = 512.f, PV_SCALE = 32.f;
__device__ __forceinline__ unsigned pk4_fp8(float a, float b, float c, float d, float sc) {
    a = fminf(fmaxf(a * sc, -448.f), 448.f); b = fminf(fmaxf(b * sc, -448.f), 448.f); c = fminf(fmaxf(c * sc, -448.f), 448.f); d = fminf(fmaxf(d * sc, -448.f), 448.f);
    int w = 0; w = __builtin_amdgcn_cvt_pk_fp8_f32(a, b, w, false); w = __builtin_amdgcn_cvt_pk_fp8_f32(c, d, w, true); return (unsigned)w; }
__device__ __forceinline__ void cvt_f32_fp8_stream(const float* src, unsigned char* dst, size_t nchunks16, float sc, size_t gt, size_t ngt) {
    for (size_t c = gt; c < nchunks16; c += ngt) { const f32x4 a = *(const GAS f32x4*)(src + c * 16), b = *(const GAS f32x4*)(src + c * 16 + 4), cc = *(const GAS f32x4*)(src + c * 16 + 8), d = *(const GAS f32x4*)(src + c * 16 + 12);
        v4u o; o.x = pk4_fp8(a.x, a.y, a.z, a.w, sc); o.y = pk4_fp8(b.x, b.y, b.z, b.w, sc); o.z = pk4_fp8(cc.x, cc.y, cc.z, cc.w, sc); o.w = pk4_fp8(d.x, d.y, d.z, d.w, sc);
#if PEER_SLICED
        const size_t lay = c >> 20, e = (c >> 6) & 16383, c16 = c & 63; *(GAS v4u*)(dst + (lay << 24) + ((c16 >> 3) << 21) + e * 128 + (c16 & 7) * 16) = o; }
#else
        *(GAS v4u*)(dst + c * 16) = o; }
#endif
}
template <class KP> __device__ __forceinline__ void cvt_tables_layer(KP ka, unsigned char* ws, int layer, int part, int nparts, int tid) {
    const size_t per = (size_t)16384 * 1024, gt = (size_t)part * NTHR + tid, ngt = (size_t)nparts * NTHR;
    cvt_f32_fp8_stream(ka->in[10] + (size_t)layer * per, ws + WS_PU + (size_t)layer * per, per / 16, PU_SCALE, gt, ngt);
    cvt_f32_fp8_stream(ka->in[11] + (size_t)layer * per, ws + WS_PV + (size_t)layer * per, per / 16, PV_SCALE, gt, ngt);
}
constexpr size_t WS_MODP = WS_A;
constexpr size_t MODN_ = (size_t)4 * 17 * 6144;
template <class KP> __device__ __forceinline__ void p0_mod(KP ka, unsigned char* ws, LAS unsigned char* lds, int vcu, int G, int tid, int lane, int wave) {
    LAS float* sl = (LAS float*)lds;
    for (int idx = tid; idx < 17 * 1024; idx += NTHR) { const int r = idx >> 10, k = idx & 1023; const float v = (r < 16) ? ka->in[1][r * 1024 + k] : ka->in[3][k]; sl[k * 20 + r] = v / (1.f + expf(-v)); }
    __syncthreads();
    float* MODP = (float*)(ws + WS_MODP);
    const int gw = vcu * NWAVES + wave, NGW = G * NWAVES;
    for (int item = gw; item < 4 * 96 * 8; item += NGW) { const int kc = item & 7, cg = item >> 3, i = cg / 96, n0 = (cg % 96) * 64;
        const float* W = ka->in[4] + (size_t)i * 1024 * 6144 + n0 + lane;
        float acc[17];
#pragma unroll
        for (int r = 0; r < 17; ++r) acc[r] = 0.f;
#pragma unroll 8
        for (int kk = 0; kk < 128; ++kk) { const int k = kc * 128 + kk; const float w = W[(size_t)k * 6144];
            const f32x4 s0 = *(const LAS f32x4*)(sl + k * 20), s1 = *(const LAS f32x4*)(sl + k * 20 + 4), s2 = *(const LAS f32x4*)(sl + k * 20 + 8), s3 = *(const LAS f32x4*)(sl + k * 20 + 12); const float s4 = sl[k * 20 + 16];
            acc[0] += s0.x * w; acc[1] += s0.y * w; acc[2] += s0.z * w; acc[3] += s0.w * w; acc[4] += s1.x * w; acc[5] += s1.y * w; acc[6] += s1.z * w; acc[7] += s1.w * w;
            acc[8] += s2.x * w; acc[9] += s2.y * w; acc[10] += s2.z * w; acc[11] += s2.w * w; acc[12] += s3.x * w; acc[13] += s3.y * w; acc[14] += s3.z * w; acc[15] += s3.w * w; acc[16] += s4 * w; }
#pragma unroll
        for (int r = 0; r < 17; ++r) MODP[(size_t)kc * MODN_ + ((size_t)i * 17 + r) * 6144 + n0 + lane] = acc[r]; }
    __syncthreads();
}
template <class KP> __device__ __forceinline__ void p0_prologue(KP ka, unsigned char* ws, LAS unsigned char* lds, int vcu, int G, int tid, int lane, int wave) {
    p0_mod(ka, ws, lds, vcu, G, tid, lane, wave);
    const int gw = vcu * NWAVES + wave, NGW = G * NWAVES; const size_t gt = (size_t)vcu * NTHR + tid, ngt = (size_t)G * NTHR;
    { LAS float* scr = (LAS float*)(lds + wave * 16384);
      constexpr int I_QKV = 16 * 96, I_O = 16 * 32, I_WA = 16 * 48, I_G = 16 * 64, I_PQ = 16 * 64;
      constexpr int NITEMS = 2 * I_QKV + 2 * I_O + I_WA + I_O + I_G + 4 * I_PQ;
      for (int it = gw; it < NITEMS; it += NGW) { int r = it;
          if (r < 2 * I_QKV) { const int l = r / I_QKV; p0_transpose_item(ka->in[12] + (size_t)l * 1024 * 3072, 1024, 3072, (bf16*)(ws + WS_WQKV_DA) + (size_t)l * 3072 * 1024, 0, scr, r % I_QKV, lane); continue; } r -= 2 * I_QKV;
          if (r < 2 * I_O) { const int l = r / I_O; p0_transpose_item(ka->in[13] + (size_t)l * 1024 * 1024, 1024, 1024, (bf16*)(ws + WS_WO_DA) + (size_t)l * 1024 * 1024, 0, scr, r % I_O, lane); continue; } r -= 2 * I_O;
          if (r < I_WA) { p0_transpose_item(ka->in[16], 1024, 1536, (bf16*)(ws + WS_WQKV_WA), 0, scr, r, lane); continue; } r -= I_WA;
          if (r < I_O) { p0_transpose_item(ka->in[17], 1024, 1024, (bf16*)(ws + WS_WO_WA), 0, scr, r, lane); continue; } r -= I_O;
          if (r < I_G) { p0_transpose_item(ka->in[27], 1024, 2048, (bf16*)(ws + WS_WGLU), 1, scr, r, lane); continue; } r -= I_G;
          { const int l = r / I_PQ; p0_transpose_item(ka->in[8] + (size_t)l * 1024 * 2048, 1024, 2048, (bf16*)(ws + WS_WPQ) + (size_t)l * 2048 * 1024, 0, scr, r % I_PQ, lane); } }
    }
    cvt_f32_bf16_stream(ka->in[9], (bf16*)(ws + WS_KEYS), (size_t)4 * 2 * 8 * 128 * 128 / 8, gt, ngt);
    cvt_f32_fp8_stream(ka->in[10], ws + WS_PU, (size_t)16384 * 1024 / 16, PU_SCALE, gt, ngt);
    cvt_f32_fp8_stream(ka->in[11], ws + WS_PV, (size_t)16384 * 1024 / 16, PV_SCALE, gt, ngt);
    { float* cosT = (float*)(ws + WS_ROPE); float* sinT = cosT + 2048 * 32;
      for (size_t idx = gt; idx < 2048 * 32; idx += ngt) { const int t = (int)(idx >> 5), i = (int)(idx & 31), f = i & 15;
          const float inv = exp2f(-(float)f * (13.287712379549449f / 16.f));
          const float pos = (float)((i < 16) ? (t >> 6) : (t & 63)); const float ang = pos * inv;
          cosT[idx] = cosf(ang); sinT[idx] = sinf(ang); } }
    { float* LB = (float*)(ws + WS_S5LB); bf16* Bop = (bf16*)(ws + WS_S5B); bf16* Cop = (bf16*)(ws + WS_S5C);
      for (size_t idx = gt; idx < 2 * 64 * 64; idx += ngt) { const int p = (int)(idx & 63), rg = (int)(idx >> 6);
          const float re = ka->in[19][idx], im = ka->in[20][idx], step = expf(ka->in[21][rg]);
          const float mag = expf(re * step), lbr = mag * cosf(im * step), lbi = mag * sinf(im * step);
          const float a = lbr - 1.f, b = lbi, den = re * re + im * im, qr = (a * re + b * im) / den, qi = (b * re - a * im) / den;
          LB[idx * 2] = lbr; LB[idx * 2 + 1] = lbi;
          const int nre = (p >> 5) * 64 + (p & 31), nim = nre + 32;
          for (int h = 0; h < 16; ++h) { const float br = ka->in[22][idx * 16 + h], bi = ka->in[23][idx * 16 + h];
              Bop[((size_t)rg * 128 + nre) * 16 + h] = (bf16)f2bf(br * qr - bi * qi); Bop[((size_t)rg * 128 + nim) * 16 + h] = (bf16)f2bf(br * qi + bi * qr);
              const float cr = ka->in[24][((size_t)rg * 16 + h) * 64 + p], ci = ka->in[25][((size_t)rg * 16 + h) * 64 + p];
              Cop[((size_t)rg * 16 + h) * 128 + 2 * p] = (bf16)f2bf(cr); Cop[((size_t)rg * 16 + h) * 128 + 2 * p + 1] = (bf16)f2bf(-ci); } } }
}
__device__ __forceinline__ void modred_phase(const float* mod_b, unsigned char* ws, int gw, int NGW, int lane) {
    float* MOD = (float*)(ws + WS_MOD); const float* MODP = (const float*)(ws + WS_MODP);
    for (size_t q = (size_t)gw * 64 + lane; q < MODN_ / 4; q += (size_t)NGW * 64) { const size_t idx = q * 4; const int i = (int)(idx / (17 * 6144)), n = (int)(idx % 6144);
        f32x4 s = *(const GAS f32x4*)(mod_b + (size_t)i * 6144 + n);
#pragma unroll
        for (int kc = 0; kc < 8; ++kc) s = s + *(const GAS f32x4*)(MODP + (size_t)kc * MODN_ + idx);
        *(GAS f32x4*)(MOD + idx) = s; }
}
__device__ __forceinline__ void p1_embed(const float* x, const float* ctx, unsigned char* ws, int gw, int NGW, int lane) {
    bf16* LAT = (bf16*)(ws + WS_LAT); bf16* H = (bf16*)(ws + WS_H); const float* MOD = (const float*)(ws + WS_MOD);
    for (int row = gw; row < MR; row += NGW) { const int b = row / SQ, s = row - b * SQ;
        const float* src = (s < LC) ? ctx + ((size_t)b * LC + s) * DD : x + ((size_t)b * TL + (s - LC)) * DD;
        const float* md = MOD + (size_t)((s < LC) ? 16 : b) * 6144;
#pragma unroll
        for (int j = 0; j < 4; ++j) { const int c = 256 * j + 4 * lane; const f32x4 v = *(const GAS f32x4*)(src + c), sh = *(const GAS f32x4*)(md + c), sc = *(const GAS f32x4*)(md + 1024 + c);
            *(GAS unsigned long long*)(LAT + (size_t)row * DD + c) = (unsigned long long)pk2(v.x, v.y) | ((unsigned long long)pk2(v.z, v.w) << 32); const f32x4 h = v * (sc + 1.f) + sh;
            *(GAS unsigned long long*)(H + (size_t)row * DD + c) = (unsigned long long)pk2(h.x, h.y) | ((unsigned long long)pk2(h.z, h.w) << 32); } }
}
__device__ __forceinline__ void ln1_phase(unsigned char* ws, const float* lng, const float* lnb, int layer, int skip_ctx, int gw, int NGW, int lane) {
    const bf16* R = (const bf16*)(ws + WS_B); bf16* LAT = (bf16*)(ws + WS_LAT); bf16* H = (bf16*)(ws + WS_H); const float* MOD = (const float*)(ws + WS_MOD) + (size_t)layer * 17 * 6144;
    const int nrows = skip_ctx ? NB * TL : MR;
    f32x4 g[4], bb[4];
#pragma unroll
    for (int j = 0; j < 4; ++j) { g[j] = *(const GAS f32x4*)(lng + 256 * j + 4 * lane); bb[j] = *(const GAS f32x4*)(lnb + 256 * j + 4 * lane); }
    for (int lr = gw; lr < nrows; lr += 2 * NGW) {
        int rows[2]; bool ok[2];
#pragma unroll
        for (int u = 0; u < 2; ++u) { const int l2 = lr + u * NGW; ok[u] = l2 < nrows; const int l3 = ok[u] ? l2 : lr; rows[u] = skip_ctx ? (l3 >> 11) * SQ + LC + (l3 & 2047) : l3; }
        f32x4 v[2][4]; float sm[2];
#pragma unroll
        for (int u = 0; u < 2; ++u) { sm[u] = 0.f;
#pragma unroll
            for (int j = 0; j < 4; ++j) { const unsigned long long rb = *(const GAS unsigned long long*)(R + (size_t)rows[u] * DD + 256 * j + 4 * lane); const unsigned r0 = (unsigned)rb, r1 = (unsigned)(rb >> 32);
                v[u][j].x = bflo(r0); v[u][j].y = bfhi(r0); v[u][j].z = bflo(r1); v[u][j].w = bfhi(r1); sm[u] += (v[u][j].x + v[u][j].y) + (v[u][j].z + v[u][j].w); } }
#pragma unroll
        for (int o = 1; o < 64; o <<= 1) { sm[0] += __shfl_xor(sm[0], o); sm[1] += __shfl_xor(sm[1], o); }
        float s2[2];
#pragma unroll
        for (int u = 0; u < 2; ++u) { const float mean = sm[u] * (1.f / DD); s2[u] = 0.f;
#pragma unroll
            for (int j = 0; j < 4; ++j) { v[u][j] = v[u][j] - mean; s2[u] += (v[u][j].x * v[u][j].x + v[u][j].y * v[u][j].y) + (v[u][j].z * v[u][j].z + v[u][j].w * v[u][j].w); } }
#pragma unroll
        for (int o = 1; o < 64; o <<= 1) { s2[0] += __shfl_xor(s2[0], o); s2[1] += __shfl_xor(s2[1], o); }
#pragma unroll
        for (int u = 0; u < 2; ++u) { if (!ok[u]) continue; const int row = rows[u]; const int b = row / SQ, s = row - b * SQ; const float* md = MOD + (size_t)((s < LC) ? 16 : b) * 6144;
            const float rstd = 1.f / sqrtf(s2[u] * (1.f / DD) + LN_EPS);
#pragma unroll
            for (int j = 0; j < 4; ++j) { const int c = 256 * j + 4 * lane;
                const f32x4 y = v[u][j] * rstd * g[j] + bb[j]; *(GAS unsigned long long*)(LAT + (size_t)row * DD + c) = (unsigned long long)pk2(y.x, y.y) | ((unsigned long long)pk2(y.z, y.w) << 32);
                const f32x4 sh = *(const GAS f32x4*)(md + 3072 + c), sc = *(const GAS f32x4*)(md + 4096 + c); const f32x4 h = y * (sc + 1.f) + sh;
                *(GAS unsigned long long*)(H + (size_t)row * DD + c) = (unsigned long long)pk2(h.x, h.y) | ((unsigned long long)pk2(h.z, h.w) << 32); } }
    }
}
__device__ __forceinline__ void da_combine_phase(unsigned char* ws, const float* lam_p, const float* subln, float lam_init, int skip_ctx, int gw, int NGW, int lane) {
    const bf16* O0 = (const bf16*)(ws + WS_B); const bf16* O1 = (const bf16*)(ws + WS_B + SZ72); bf16* OC = (bf16*)(ws + WS_A);
    float d01 = lam_p[lane] * lam_p[64 + lane], d23 = lam_p[128 + lane] * lam_p[192 + lane];
    d01 = wave_sum(d01); d23 = wave_sum(d23);
    const float lam = expf(d01) - expf(d23) + lam_init, post = 1.f - lam_init;
    float gs[16];
#pragma unroll
    for (int j = 0; j < 16; ++j) gs[j] = subln[((lane & 7) * 16 + j)] * post;
    for (int row = gw; row < MR; row += NGW) { const int b = row / SQ, s = row - b * SQ; if (skip_ctx && s < LC) continue;
        const size_t off = (size_t)row * DD + 16 * lane;
        const v4u a0 = *(const GAS v4u*)(O0 + off), a1 = *(const GAS v4u*)(O0 + off + 8), b0 = *(const GAS v4u*)(O1 + off), b1 = *(const GAS v4u*)(O1 + off + 8);
        float o[16];
        o[0] = bflo(a0.x) - lam * bflo(b0.x); o[1] = bfhi(a0.x) - lam * bfhi(b0.x); o[2] = bflo(a0.y) - lam * bflo(b0.y); o[3] = bfhi(a0.y) - lam * bfhi(b0.y);
        o[4] = bflo(a0.z) - lam * bflo(b0.z); o[5] = bfhi(a0.z) - lam * bfhi(b0.z); o[6] = bflo(a0.w) - lam * bflo(b0.w); o[7] = bfhi(a0.w) - lam * bfhi(b0.w);
        o[8] = bflo(a1.x) - lam * bflo(b1.x); o[9] = bfhi(a1.x) - lam * bfhi(b1.x); o[10] = bflo(a1.y) - lam * bflo(b1.y); o[11] = bfhi(a1.y) - lam * bfhi(b1.y);
        o[12] = bflo(a1.z) - lam * bflo(b1.z); o[13] = bfhi(a1.z) - lam * bfhi(b1.z); o[14] = bflo(a1.w) - lam * bflo(b1.w); o[15] = bfhi(a1.w) - lam * bfhi(b1.w);
        float ss = 0.f;
#pragma unroll
        for (int j = 0; j < 16; ++j) ss += o[j] * o[j];
        ss += __shfl_xor(ss, 1); ss += __shfl_xor(ss, 2); ss += __shfl_xor(ss, 4);
        const float rs = 1.f / sqrtf(ss * (1.f / 128.f) + LN_EPS);
        v4u w0, w1;
        w0.x = pk2(o[0] * rs * gs[0], o[1] * rs * gs[1]); w0.y = pk2(o[2] * rs * gs[2], o[3] * rs * gs[3]); w0.z = pk2(o[4] * rs * gs[4], o[5] * rs * gs[5]); w0.w = pk2(o[6] * rs * gs[6], o[7] * rs * gs[7]);
        w1.x = pk2(o[8] * rs * gs[8], o[9] * rs * gs[9]); w1.y = pk2(o[10] * rs * gs[10], o[11] * rs * gs[11]); w1.z = pk2(o[12] * rs * gs[12], o[13] * rs * gs[13]); w1.w = pk2(o[14] * rs * gs[14], o[15] * rs * gs[15]);
        *(GAS v4u*)(OC + off) = w0; *(GAS v4u*)(OC + off + 8) = w1; }
}
template <int N> __device__ __forceinline__ void sort_desc_u32(unsigned (&v)[N]) {
#pragma unroll
    for (int k = 2; k <= N; k <<= 1)
#pragma unroll
        for (int j = k >> 1; j > 0; j >>= 1)
#pragma unroll
            for (int i = 0; i < N; ++i) { const int l = i ^ j; if (l > i) { const unsigned a = v[i], b = v[l]; const unsigned mx = a > b ? a : b, mn = a > b ? b : a; const bool desc = ((i & k) == 0) || (k == N);
                    v[i] = desc ? mx : mn; v[l] = desc ? mn : mx; } }
}
template <int N> __device__ __forceinline__ void merge_desc_u32(unsigned (&v)[N]) {
#pragma unroll
    for (int j = N >> 1; j > 0; j >>= 1)
#pragma unroll
        for (int i = 0; i < N; ++i) { const int l = i ^ j; if (l > i) { const unsigned a = v[i], b = v[l]; v[i] = a > b ? a : b; v[l] = a > b ? b : a; } }
}
__device__ __forceinline__ void top16_u32(unsigned (&a)[16], const unsigned (&b)[16]) {
#pragma unroll
    for (int i = 0; i < 16; ++i) a[i] = a[i] > b[15 - i] ? a[i] : b[15 - i];
    merge_desc_u32<16>(a);
}
#define CE_F(i, l, up) do { const bool gt_ = s[i] > s[l]; const float s_hi = gt_ ? s[i] : s[l], s_lo = gt_ ? s[l] : s[i]; const int e_hi = gt_ ? e[i] : e[l], e_lo = gt_ ? e[l] : e[i]; \
        if (up) { s[i] = s_hi; s[l] = s_lo; e[i] = e_hi; e[l] = e_lo; } else { s[i] = s_lo; s[l] = s_hi; e[i] = e_lo; e[l] = e_hi; } } while (0)
template <int N> __device__ __forceinline__ void sort_desc_f(float (&s)[N], int (&e)[N]) {
#pragma unroll
    for (int k = 2; k <= N; k <<= 1)
#pragma unroll
        for (int j = k >> 1; j > 0; j >>= 1)
#pragma unroll
            for (int i = 0; i < N; ++i) { const int l = i ^ j; if (l > i) { const bool desc = ((i & k) == 0) || (k == N); CE_F(i, l, desc); } }
}
template <int N> __device__ __forceinline__ void merge_desc_f(float (&s)[N], int (&e)[N]) {
#pragma unroll
    for (int j = N >> 1; j > 0; j >>= 1)
#pragma unroll
        for (int i = 0; i < N; ++i) { const int l = i ^ j; if (l > i) { CE_F(i, l, true); } }
}
__device__ __forceinline__ unsigned fkey(float f) { const unsigned u = __float_as_uint(f); return u ^ ((unsigned)((int)u >> 31) | 0x80000000u); }
__device__ __forceinline__ float fdec(unsigned k) { const unsigned u = (k & 0x80000000u) ? (k ^ 0x80000000u) : ~k; return __uint_as_float(u); }

__device__ __forceinline__ void topk_phase(unsigned char* ws, int layer, int skip_ctx, LAS unsigned char* lds, int vcu, int G, int tid, int lane, int wave) {
    const bf16* PQ = (const bf16*)(ws + WS_A); const bf16* KEYS = (const bf16*)(ws + WS_KEYS) + (size_t)layer * 2 * 8 * 128 * 128;
    int* EIDX = (int*)(ws + WS_B); float* EG = (float*)(ws + WS_B + (size_t)MR * 128 * 4);
    const int nrt = skip_ctx ? 128 : 144, nunits = nrt * 8;
    const int r32 = lane & 31, hi = lane >> 5;
    constexpr int KP = 272;
    int cur_h = -1;
    const int gq = G >> 3, hgrp = vcu / gq, wq = vcu - hgrp * gq;
    for (int u2 = wq; u2 < nrt; u2 += gq) {
        const int h = hgrp & 7, rtl = u2; const int rt = skip_ctx ? (rtl >> 3) * 9 + 1 + (rtl & 7) : rtl;
        if (h != cur_h) { __syncthreads();
            for (int c = tid; c < 2 * 128 * 16; c += NTHR) { const int j = c >> 11, k = (c >> 4) & 127, ch = c & 15;
                const v4u v = *(const GAS v4u*)(KEYS + ((size_t)(j * 8 + h) * 128 + k) * 128 + ch * 8); *(LAS v4u*)(lds + (j * 128 + k) * KP + ch * 16) = v; }
            __syncthreads(); cur_h = h; }
        const int row = rt * 256 + wave * 32 + r32;
        unsigned top[2][16];
#pragma unroll
        for (int j = 0; j < 2; ++j) {
            const bf16* qp = PQ + (size_t)row * 2048 + h * 256 + j * 128 + hi * 8;
            bf16x8 bq[8];
#pragma unroll
            for (int ks = 0; ks < 8; ++ks) bq[ks] = *(const GAS bf16x8*)(qp + ks * 16);
            unsigned t0[16];
#pragma unroll
            for (int r = 0; r < 16; ++r) t0[r] = 0u;
#pragma unroll 1
            for (int blk = 0; blk < 4; ++blk) { f32x16 acc = (f32x16){};
#pragma unroll
                for (int ks = 0; ks < 8; ++ks) { const bf16x8 ka = *(const LAS bf16x8*)(lds + (j * 128 + blk * 32 + r32) * KP + (ks * 16 + hi * 8) * 2);
                    acc = __builtin_amdgcn_mfma_f32_32x32x16_bf16(ka, bq[ks], acc, 0, 0, 0); }
                unsigned g[16]; const unsigned kb0 = (unsigned)(blk * 32 + 4 * hi);
#pragma unroll
                for (int r = 0; r < 16; ++r) g[r] = (fkey(acc[r]) & ~127u) | (kb0 + (unsigned)((r & 3) + 8 * (r >> 2)));
                sort_desc_u32<16>(g);
                top16_u32(t0, g); }
            unsigned oth[16];
#pragma unroll
            for (int r = 0; r < 16; ++r) oth[r] = (unsigned)__shfl_xor((int)t0[r], 32);
            top16_u32(t0, oth);
#pragma unroll
            for (int r = 0; r < 16; ++r) top[j][r] = t0[r];
        }
        LAS unsigned char* tab = lds + 2 * 128 * KP + wave * (64 * 36) + lane * 36;
#pragma unroll
        for (int r = 0; r < 16; ++r) { tab[r] = (unsigned char)(top[0][r] & 127u); tab[16 + r] = (unsigned char)(top[1][r] & 127u); }
        float sA[16], sB[16];
#pragma unroll
        for (int r = 0; r < 16; ++r) { sA[r] = fdec(top[0][r] & ~127u); sB[r] = fdec(top[1][r] & ~127u); }
        unsigned ck[32];
        { int c = 0;
#pragma unroll
          for (int a = 0; a < 16; ++a)
#pragma unroll
              for (int b = 0; b < 16; ++b) if ((a + 1) * (b + 1) <= 16) { const int slot = c >> 1; const unsigned kk = (fkey(sA[a] + sB[b]) & ~255u) | (unsigned)(a * 16 + b);
                      if ((c & 1) == 0) ck[slot] = kk; else ck[slot] = hi ? kk : ck[slot];
                      ++c; }
#pragma unroll
          for (int slot = 25; slot < 32; ++slot) ck[slot] = 0u; }
        sort_desc_u32<32>(ck);
        unsigned k16[16];
#pragma unroll
        for (int r = 0; r < 16; ++r) k16[r] = ck[r];
        { unsigned oth[16];
#pragma unroll
          for (int r = 0; r < 16; ++r) oth[r] = (unsigned)__shfl_xor((int)k16[r], 32);
          top16_u32(k16, oth); }
        asm volatile("s_waitcnt lgkmcnt(0)" ::: "memory");
        float s16[16]; int e16[16];
#pragma unroll
        for (int r = 0; r < 16; ++r) { s16[r] = fdec(k16[r] & ~255u); const int ia = tab[(k16[r] >> 4) & 15u], ib = tab[16 + (k16[r] & 15u)]; e16[r] = ia * 128 + ib; }
        float den = 0.f, p[16];
#pragma unroll
        for (int r = 0; r < 16; ++r) { p[r] = __builtin_amdgcn_exp2f((s16[r] - s16[0]) * LOG2E); den += p[r]; }
        const float rden = 1.f / den;
        const size_t ob = ((size_t)row * 8 + h) * 16;
        if (hi == 0) {
#pragma unroll
            for (int q = 0; q < 4; ++q) { v4u w; w.x = (unsigned)e16[4 * q]; w.y = (unsigned)e16[4 * q + 1]; w.z = (unsigned)e16[4 * q + 2]; w.w = (unsigned)e16[4 * q + 3]; *(GAS v4u*)(EIDX + ob + 4 * q) = w; }
        } else {
#pragma unroll
            for (int q = 0; q < 4; ++q) { f32x4 w; w.x = p[4 * q] * rden; w.y = p[4 * q + 1] * rden; w.z = p[4 * q + 2] * rden; w.w = p[4 * q + 3] * rden; *(GAS f32x4*)(EG + ob + 4 * q) = w; }
        }
    }
}

typedef float f32x2p __attribute__((ext_vector_type(2)));
__device__ __forceinline__ void peer_phase(unsigned char* ws, float* d_out, const float* lng, const float* lnb, int layer, int last, int dry, int gw, int NGW, int lane) {
    const bf16* H = (const bf16*)(ws + WS_H); bf16* LAT = (bf16*)(ws + WS_LAT); bf16* Hn = (bf16*)(ws + WS_H);
    const unsigned char* PU = ws + WS_PU + (size_t)layer * 16384 * 1024; const unsigned char* PV = ws + WS_PV + (size_t)layer * 16384 * 1024;
    const int* EIDX = (const int*)(ws + WS_B); const float* EG = (const float*)(ws + WS_B + (size_t)MR * 128 * 4);
    const float* MOD = (const float*)(ws + WS_MOD) + (size_t)layer * 17 * 6144; const float* MODN = MOD + 17 * 6144;
    const int b3 = (lane >> 3) & 1, b4 = (lane >> 4) & 1, b5 = lane >> 5;
    for (int row = gw; row < MR; row += NGW) { const int b = row / SQ, s = row - b * SQ; if (last && s < LC) continue;
        const int midx = (s < LC) ? 16 : b;
        float x[16];
        { const v4u xa = *(const GAS v4u*)(H + (size_t)row * DD + 16 * lane), xb = *(const GAS v4u*)(H + (size_t)row * DD + 16 * lane + 8);
          x[0] = bflo(xa.x); x[1] = bfhi(xa.x); x[2] = bflo(xa.y); x[3] = bfhi(xa.y); x[4] = bflo(xa.z); x[5] = bfhi(xa.z); x[6] = bflo(xa.w); x[7] = bfhi(xa.w);
          x[8] = bflo(xb.x); x[9] = bfhi(xb.x); x[10] = bflo(xb.y); x[11] = bfhi(xb.y); x[12] = bflo(xb.z); x[13] = bfhi(xb.z); x[14] = bflo(xb.w); x[15] = bfhi(xb.w); }
        const int e_lo = EIDX[(size_t)row * 128 + lane], e_hi = EIDX[(size_t)row * 128 + 64 + lane];
        const float g_lo = EG[(size_t)row * 128 + lane], g_hi = EG[(size_t)row * 128 + 64 + lane];
        float out[16];
#pragma unroll
        for (int j = 0; j < 16; ++j) out[j] = 0.f;
        for (int kb = 0; kb < 128; kb += 8) {
            const int esel = (kb < 64) ? e_lo : e_hi; const float gsel = (kb < 64) ? g_lo : g_hi;
            v4u u8[8], v8[8];
#pragma unroll
            for (int k = 0; k < 8; ++k) { const int ek = __builtin_amdgcn_readlane(esel, (kb & 63) + k); u8[k] = *(const GAS v4u*)(PU + (size_t)ek * 1024 + 16 * lane); }
#pragma unroll
            for (int k = 0; k < 8; ++k) { const int ek = __builtin_amdgcn_readlane(esel, (kb & 63) + k); v8[k] = *(const GAS v4u*)(PV + (size_t)ek * 1024 + 16 * lane); }
            float d[8];
#pragma unroll
            for (int k = 0; k < 8; ++k) { float a0 = 0.f, a1 = 0.f;
#pragma unroll
                for (int q = 0; q < 4; ++q) { const int w = (int)u8[k][q]; const f32x2p lo = __builtin_amdgcn_cvt_pk_f32_fp8(w, false), hi2 = __builtin_amdgcn_cvt_pk_f32_fp8(w, true);
                    a0 = fmaf(lo.x, x[4 * q], a0); a1 = fmaf(lo.y, x[4 * q + 1], a1); a0 = fmaf(hi2.x, x[4 * q + 2], a0); a1 = fmaf(hi2.y, x[4 * q + 3], a1); }
                d[k] = a0 + a1; }
            float s4[4], s2[2], s1;
#pragma unroll
            for (int k = 0; k < 4; ++k) { const float snd = b5 ? d[k] : d[k + 4], mine = b5 ? d[k + 4] : d[k]; s4[k] = mine + __shfl_xor(snd, 32); }
#pragma unroll
            for (int k = 0; k < 2; ++k) { const float snd = b4 ? s4[k] : s4[k + 2], mine = b4 ? s4[k + 2] : s4[k]; s2[k] = mine + __shfl_xor(snd, 16); }
            { const float snd = b3 ? s2[0] : s2[1], mine = b3 ? s2[1] : s2[0]; s1 = mine + __shfl_xor(snd, 8); }
            s1 += __shfl_xor(s1, 4); s1 += __shfl_xor(s1, 2); s1 += __shfl_xor(s1, 1);
            const float gk = __shfl(gsel, (kb & 63) + (lane >> 3));
            const float w = gk * gelu_tanh(s1 * (1.f / PU_SCALE)) * (1.f / PV_SCALE);
#pragma unroll
            for (int k = 0; k < 8; ++k) { const float wk = __uint_as_float((unsigned)__builtin_amdgcn_readlane((int)__float_as_uint(w), 8 * k));
#pragma unroll
                for (int q = 0; q < 4; ++q) { const int vw = (int)v8[k][q]; const f32x2p lo = __builtin_amdgcn_cvt_pk_f32_fp8(vw, false), hi2 = __builtin_amdgcn_cvt_pk_f32_fp8(vw, true);
                    out[4 * q] = fmaf(wk, lo.x, out[4 * q]); out[4 * q + 1] = fmaf(wk, lo.y, out[4 * q + 1]); out[4 * q + 2] = fmaf(wk, hi2.x, out[4 * q + 2]); out[4 * q + 3] = fmaf(wk, hi2.y, out[4 * q + 3]); } }
        }
        const float* md = MOD + (size_t)midx * 6144; float r[16]; float sm = 0.f;
#pragma unroll
        for (int q = 0; q < 4; ++q) { const int c = 16 * lane + 4 * q; const unsigned long long lb = *(const GAS unsigned long long*)(LAT + (size_t)row * DD + c); const unsigned l0 = (unsigned)lb, l1 = (unsigned)(lb >> 32);
            f32x4 lv; lv[0] = bflo(l0); lv[1] = bfhi(l0); lv[2] = bflo(l1); lv[3] = bfhi(l1); const f32x4 gv = *(const GAS f32x4*)(md + 5120 + c);
#pragma unroll
            for (int j = 0; j < 4; ++j) { const float t = DN_ALPHA * lv[j] + gv[j] * out[4 * q + j]; r[4 * q + j] = t; sm += t; } }
        const float mean = wave_sum(sm) * (1.f / DD); float s2s = 0.f;
#pragma unroll
        for (int j = 0; j < 16; ++j) { r[j] -= mean; s2s += r[j] * r[j]; }
        const float rstd = 1.f / sqrtf(wave_sum(s2s) * (1.f / DD) + LN_EPS);
        const float* mdn = MODN + (size_t)midx * 6144;
        float y[16];
#pragma unroll
        for (int q = 0; q < 4; ++q) { const int c = 16 * lane + 4 * q; const f32x4 g = *(const GAS f32x4*)(lng + c), bb = *(const GAS f32x4*)(lnb + c);
#pragma unroll
            for (int j = 0; j < 4; ++j) y[4 * q + j] = r[4 * q + j] * rstd * g[j] + bb[j]; }
        const int c0 = 16 * lane;
        if (dry) { if (y[0] == 123.456f) LAT[0] = (bf16)f2bf(y[1] + y[2] + y[3] + y[4] + y[5] + y[6] + y[7] + y[8] + y[9] + y[10] + y[11] + y[12] + y[13] + y[14] + y[15]); }
        else if (last) { float* op = d_out + ((size_t)b * TL + (s - LC)) * DD + c0;
#pragma unroll
            for (int q = 0; q < 4; ++q) *(GAS f32x4*)(op + 4 * q) = (f32x4){y[4 * q], y[4 * q + 1], y[4 * q + 2], y[4 * q + 3]}; }
        else { { v4u l0, l1; l0.x = pk2(y[0], y[1]); l0.y = pk2(y[2], y[3]); l0.z = pk2(y[4], y[5]); l0.w = pk2(y[6], y[7]); l1.x = pk2(y[8], y[9]); l1.y = pk2(y[10], y[11]); l1.z = pk2(y[12], y[13]); l1.w = pk2(y[14], y[15]);
              *(GAS v4u*)(LAT + (size_t)row * DD + c0) = l0; *(GAS v4u*)(LAT + (size_t)row * DD + c0 + 8) = l1; }
            float hh[16];
#pragma unroll
            for (int q = 0; q < 4; ++q) { const f32x4 sh = *(const GAS f32x4*)(mdn + c0 + 4 * q), sc = *(const GAS f32x4*)(mdn + 1024 + c0 + 4 * q);
#pragma unroll
                for (int j = 0; j < 4; ++j) hh[4 * q + j] = y[4 * q + j] * (1.f + sc[j]) + sh[j]; }
            v4u w0, w1; w0.x = pk2(hh[0], hh[1]); w0.y = pk2(hh[2], hh[3]); w0.z = pk2(hh[4], hh[5]); w0.w = pk2(hh[6], hh[7]); w1.x = pk2(hh[8], hh[9]); w1.y = pk2(hh[10], hh[11]); w1.z = pk2(hh[12], hh[13]); w1.w = pk2(hh[14], hh[15]);
            *(GAS v4u*)(Hn + (size_t)row * DD + c0) = w0; *(GAS v4u*)(Hn + (size_t)row * DD + c0 + 8) = w1; }
    }
}

__device__ __forceinline__ int peer_row(int t, int last) { return last ? (t >> 11) * SQ + LC + (t & 2047) : t; }
typedef _Float16 h2v __attribute__((ext_vector_type(2)));
__device__ __forceinline__ h2v pkh(float lo, float hi) { return __builtin_bit_cast(h2v, __builtin_amdgcn_cvt_pkrtz(lo, hi)); }
__device__ __forceinline__ void peer_gu_phase(unsigned char* ws, float* d_out, const float* lng, const float* lnb, int layer, int last, int dry, int gw, int NGW, int lane) {
    const bf16* H = (const bf16*)(ws + WS_H); bf16* LAT = (bf16*)(ws + WS_LAT); bf16* Hn = (bf16*)(ws + WS_H);
    const unsigned char* PU = ws + WS_PU + (size_t)layer * 16384 * 1024; const unsigned char* PV = ws + WS_PV + (size_t)layer * 16384 * 1024;
    float* Wb = (float*)(ws + WS_B + (size_t)2 * MR * 128 * 4);
    const int* EIDX = (const int*)(ws + WS_B); const float* EG = (const float*)(ws + WS_B + (size_t)MR * 128 * 4);
    const float* MOD = (const float*)(ws + WS_MOD) + (size_t)layer * 17 * 6144; const float* MODN = MOD + 17 * 6144;
    const int b2 = (lane >> 2) & 1, b3 = (lane >> 3) & 1, b4 = (lane >> 4) & 1, b5 = lane >> 5;
    const int ntok = last ? NB * TL : MR;
    v4u nxa, nxb; int ne_lo = 0, ne_hi = 0; float ng_lo = 0.f, ng_hi = 0.f;
    if (gw < ntok) { const int r0 = peer_row(gw, last); nxa = *(const GAS v4u*)(H + (size_t)r0 * DD + 16 * lane); nxb = *(const GAS v4u*)(H + (size_t)r0 * DD + 16 * lane + 8);
        ne_lo = EIDX[(size_t)r0 * 128 + lane]; ne_hi = EIDX[(size_t)r0 * 128 + 64 + lane]; ng_lo = EG[(size_t)r0 * 128 + lane]; ng_hi = EG[(size_t)r0 * 128 + 64 + lane]; }
    for (int t = gw; t < ntok; t += NGW) { const int row = peer_row(t, last);
        const v4u xa = nxa, xb = nxb; const int e_lo = ne_lo, e_hi = ne_hi; const float g_lo = ng_lo, g_hi = ng_hi;
        if (t + NGW < ntok) { const int r1 = peer_row(t + NGW, last); nxa = *(const GAS v4u*)(H + (size_t)r1 * DD + 16 * lane); nxb = *(const GAS v4u*)(H + (size_t)r1 * DD + 16 * lane + 8);
            ne_lo = EIDX[(size_t)r1 * 128 + lane]; ne_hi = EIDX[(size_t)r1 * 128 + 64 + lane]; ng_lo = EG[(size_t)r1 * 128 + lane]; ng_hi = EG[(size_t)r1 * 128 + 64 + lane]; }
        h2v xh[8];
        xh[0] = pkh(bflo(xa.x), bfhi(xa.x)); xh[1] = pkh(bflo(xa.y), bfhi(xa.y)); xh[2] = pkh(bflo(xa.z), bfhi(xa.z)); xh[3] = pkh(bflo(xa.w), bfhi(xa.w));
        xh[4] = pkh(bflo(xb.x), bfhi(xb.x)); xh[5] = pkh(bflo(xb.y), bfhi(xb.y)); xh[6] = pkh(bflo(xb.z), bfhi(xb.z)); xh[7] = pkh(bflo(xb.w), bfhi(xb.w));
        for (int kb = 0; kb < 128; kb += 16) {
            const int esel = (kb < 64) ? e_lo : e_hi; const float gsel = (kb < 64) ? g_lo : g_hi;
            v4u u8[16];
#pragma unroll
            for (int k = 0; k < 16; ++k) { const int ek = __builtin_amdgcn_readlane(esel, (kb & 63) + k); u8[k] = *(const GAS v4u*)(PU + (size_t)ek * 1024 + 16 * lane); }
            float d[16];
#pragma unroll
            for (int k = 0; k < 16; ++k) { float a0 = 0.f, a1 = 0.f;
#pragma unroll
                for (int q = 0; q < 4; ++q) { const int w = (int)u8[k][q];
                    a0 = __builtin_amdgcn_fdot2(__builtin_bit_cast(h2v, __builtin_amdgcn_cvt_scalef32_pk_f16_fp8(w, 1.0f, false)), xh[2 * q], a0, false); a1 = __builtin_amdgcn_fdot2(__builtin_bit_cast(h2v, __builtin_amdgcn_cvt_scalef32_pk_f16_fp8(w, 1.0f, true)), xh[2 * q + 1], a1, false); }
                d[k] = a0 + a1; }
            float s8[8], s4[4], s2[2], s1;
#pragma unroll
            for (int k = 0; k < 8; ++k) { const float snd = b5 ? d[k] : d[k + 8], mine = b5 ? d[k + 8] : d[k]; s8[k] = mine + __shfl_xor(snd, 32); }
#pragma unroll
            for (int k = 0; k < 4; ++k) { const float snd = b4 ? s8[k] : s8[k + 4], mine = b4 ? s8[k + 4] : s8[k]; s4[k] = mine + __shfl_xor(snd, 16); }
#pragma unroll
            for (int k = 0; k < 2; ++k) { const float snd = b3 ? s4[k] : s4[k + 2], mine = b3 ? s4[k + 2] : s4[k]; s2[k] = mine + __shfl_xor(snd, 8); }
            { const float snd = b2 ? s2[0] : s2[1], mine = b2 ? s2[1] : s2[0]; s1 = mine + __shfl_xor(snd, 4); }
            s1 += __shfl_xor(s1, 2); s1 += __shfl_xor(s1, 1);
            const float gk = __shfl(gsel, (kb & 63) + (lane >> 2));
            const float w = gk * gelu_tanh(s1 * (1.f / PU_SCALE));
            if ((lane & 3) == 0) Wb[(size_t)row * 128 + kb + (lane >> 2)] = w;
        }
    }
}
__device__ __forceinline__ void peer_gv_phase(unsigned char* ws, float* d_out, const float* lng, const float* lnb, int layer, int last, int dry, int gw, int NGW, int lane) {
    const bf16* H = (const bf16*)(ws + WS_H); bf16* LAT = (bf16*)(ws + WS_LAT); bf16* Hn = (bf16*)(ws + WS_H);
    const unsigned char* PU = ws + WS_PU + (size_t)layer * 16384 * 1024; const unsigned char* PV = ws + WS_PV + (size_t)layer * 16384 * 1024;
    const float* Wb = (const float*)(ws + WS_B + (size_t)2 * MR * 128 * 4);
    const int* EIDX = (const int*)(ws + WS_B); const float* EG = (const float*)(ws + WS_B + (size_t)MR * 128 * 4);
    const float* MOD = (const float*)(ws + WS_MOD) + (size_t)layer * 17 * 6144; const float* MODN = MOD + 17 * 6144;
    const int b3 = (lane >> 3) & 1, b4 = (lane >> 4) & 1, b5 = lane >> 5;
    const int ntok = last ? NB * TL : MR;
    int ne_lo = 0, ne_hi = 0; float ng_lo = 0.f, ng_hi = 0.f;
    if (gw < ntok) { const int r0 = peer_row(gw, last); ne_lo = EIDX[(size_t)r0 * 128 + lane]; ne_hi = EIDX[(size_t)r0 * 128 + 64 + lane]; ng_lo = Wb[(size_t)r0 * 128 + lane]; ng_hi = Wb[(size_t)r0 * 128 + 64 + lane]; }
    for (int t = gw; t < ntok; t += NGW) { const int row = peer_row(t, last); const int b = row / SQ, s = row - b * SQ;
        const int midx = (s < LC) ? 16 : b;
        const int e_lo = ne_lo, e_hi = ne_hi; const float g_lo = ng_lo, g_hi = ng_hi;
        if (t + NGW < ntok) { const int r1 = peer_row(t + NGW, last); ne_lo = EIDX[(size_t)r1 * 128 + lane]; ne_hi = EIDX[(size_t)r1 * 128 + 64 + lane]; ng_lo = Wb[(size_t)r1 * 128 + lane]; ng_hi = Wb[(size_t)r1 * 128 + 64 + lane]; }
        float out[16];
#pragma unroll
        for (int j = 0; j < 16; ++j) out[j] = 0.f;
        for (int kb = 0; kb < 128; kb += 16) {
            const int esel = (kb < 64) ? e_lo : e_hi; const float gsel = (kb < 64) ? g_lo : g_hi;
            v4u v8[16];
#pragma unroll
            for (int k = 0; k < 16; ++k) { const int ek = __builtin_amdgcn_readlane(esel, (kb & 63) + k); v8[k] = *(const GAS v4u*)(PV + (size_t)ek * 1024 + 16 * lane); }
            const float w = __shfl(gsel, (kb & 63) + (lane >> 2));
            const int w16 = __builtin_bit_cast(int, pkh(w, w));
            h2v acc16[8];
#pragma unroll
            for (int q = 0; q < 8; ++q) acc16[q] = (h2v){(_Float16)0.f, (_Float16)0.f};
#pragma unroll
            for (int k = 0; k < 16; ++k) { const h2v wk2 = __builtin_bit_cast(h2v, __builtin_amdgcn_readlane(w16, 4 * k));
#pragma unroll
                for (int q = 0; q < 4; ++q) { const int vw = (int)v8[k][q];
                    acc16[2 * q] = __builtin_elementwise_fma(wk2, __builtin_bit_cast(h2v, __builtin_amdgcn_cvt_scalef32_pk_f16_fp8(vw, 1.0f, false)), acc16[2 * q]);
                    acc16[2 * q + 1] = __builtin_elementwise_fma(wk2, __builtin_bit_cast(h2v, __builtin_amdgcn_cvt_scalef32_pk_f16_fp8(vw, 1.0f, true)), acc16[2 * q + 1]); } }
#pragma unroll
            for (int q = 0; q < 8; ++q) { out[2 * q] += (float)acc16[q].x; out[2 * q + 1] += (float)acc16[q].y; }
        }
#pragma unroll
        for (int j = 0; j < 16; ++j) out[j] *= (1.f / PV_SCALE);
        const float* md = MOD + (size_t)midx * 6144; float r[16]; float sm = 0.f;
#pragma unroll
        for (int q = 0; q < 4; ++q) { const int c = 16 * lane + 4 * q; const unsigned long long lb = *(const GAS unsigned long long*)(LAT + (size_t)row * DD + c); const unsigned l0 = (unsigned)lb, l1 = (unsigned)(lb >> 32);
            f32x4 lv; lv[0] = bflo(l0); lv[1] = bfhi(l0); lv[2] = bflo(l1); lv[3] = bfhi(l1); const f32x4 gv = *(const GAS f32x4*)(md + 5120 + c);
#pragma unroll
            for (int j = 0; j < 4; ++j) { const float t = DN_ALPHA * lv[j] + gv[j] * out[4 * q + j]; r[4 * q + j] = t; sm += t; } }
        const float mean = wave_sum(sm) * (1.f / DD); float s2s = 0.f;
#pragma unroll
        for (int j = 0; j < 16; ++j) { r[j] -= mean; s2s += r[j] * r[j]; }
        const float rstd = 1.f / sqrtf(wave_sum(s2s) * (1.f / DD) + LN_EPS);
        const float* mdn = MODN + (size_t)midx * 6144;
        float y[16];
#pragma unroll
        for (int q = 0; q < 4; ++q) { const int c = 16 * lane + 4 * q; const f32x4 g = *(const GAS f32x4*)(lng + c), bb = *(const GAS f32x4*)(lnb + c);
#pragma unroll
            for (int j = 0; j < 4; ++j) y[4 * q + j] = r[4 * q + j] * rstd * g[j] + bb[j]; }
        const int c0 = 16 * lane;
        if (dry) { if (y[0] == 123.456f) LAT[0] = (bf16)f2bf(y[1] + y[2] + y[3] + y[4] + y[5] + y[6] + y[7] + y[8] + y[9] + y[10] + y[11] + y[12] + y[13] + y[14] + y[15]); }
        else if (last) { float* op = d_out + ((size_t)b * TL + (s - LC)) * DD + c0;
#pragma unroll
            for (int q = 0; q < 4; ++q) *(GAS f32x4*)(op + 4 * q) = (f32x4){y[4 * q], y[4 * q + 1], y[4 * q + 2], y[4 * q + 3]}; }
        else { { v4u l0, l1; l0.x = pk2(y[0], y[1]); l0.y = pk2(y[2], y[3]); l0.z = pk2(y[4], y[5]); l0.w = pk2(y[6], y[7]); l1.x = pk2(y[8], y[9]); l1.y = pk2(y[10], y[11]); l1.z = pk2(y[12], y[13]); l1.w = pk2(y[14], y[15]);
              *(GAS v4u*)(LAT + (size_t)row * DD + c0) = l0; *(GAS v4u*)(LAT + (size_t)row * DD + c0 + 8) = l1; }
            float hh[16];
#pragma unroll
            for (int q = 0; q < 4; ++q) { const f32x4 sh = *(const GAS f32x4*)(mdn + c0 + 4 * q), sc = *(const GAS f32x4*)(mdn + 1024 + c0 + 4 * q);
#pragma unroll
                for (int j = 0; j < 4; ++j) hh[4 * q + j] = y[4 * q + j] * (1.f + sc[j]) + sh[j]; }
            v4u w0, w1; w0.x = pk2(hh[0], hh[1]); w0.y = pk2(hh[2], hh[3]); w0.z = pk2(hh[4], hh[5]); w0.w = pk2(hh[6], hh[7]); w1.x = pk2(hh[8], hh[9]); w1.y = pk2(hh[10], hh[11]); w1.z = pk2(hh[12], hh[13]); w1.w = pk2(hh[14], hh[15]);
            *(GAS v4u*)(Hn + (size_t)row * DD + c0) = w0; *(GAS v4u*)(Hn + (size_t)row * DD + c0 + 8) = w1; }
    }
}

#if PEER_SLICED
constexpr size_t WS_W = WS_B + (size_t)2 * MR * 128 * 4;
constexpr size_t WS_OUT = WS_B + SZ72;
constexpr size_t WS_P = WS_A;
template <int MODE> __device__ __forceinline__ void peer_slice_pass(unsigned char* ws, int layer, int last, int slice, int widx, int nwg_slice, int lane, int wave) {
    const unsigned char* TAB = ws + (MODE == 0 ? WS_PU : WS_PV) + (size_t)layer * 16384 * 1024;
    const bf16* H = (const bf16*)(ws + WS_H); const int* EIDX = (const int*)(ws + WS_B); const float* W = (const float*)(ws + WS_W); bf16* OUT = (bf16*)(ws + WS_OUT);
    const int nwv = nwg_slice * NWAVES; const int ntok = last ? NB * TL : MR;
    float* P = (float*)(ws + WS_P) + (size_t)slice * MR * 128;
    const int b0 = lane & 1, b1 = (lane >> 1) & 1, b2 = (lane >> 2) & 1, b3 = (lane >> 3) & 1, b4 = (lane >> 4) & 1, b5 = lane >> 5, grp = lane >> 3, sub = lane & 7;
    const unsigned char* tl = TAB + ((size_t)slice << 21) + 16 * sub;
    const int t0 = widx * NWAVES + wave;
    int ec0, ec1, en0, en1, em0, em1; float wc0, wc1, wn0, wn1, wm0, wm1; v4u xc0, xc1, xn0, xn1;
    v4u rX[8], rY[8]; float fX[8], fY[8];
#define PS_LOADIDX(E0_, E1_, W0_, W1_, t_) do { if ((t_) < ntok) { const int row_ = peer_row((t_), last); E0_ = __builtin_nontemporal_load(EIDX + (size_t)row_ * 128 + lane); E1_ = __builtin_nontemporal_load(EIDX + (size_t)row_ * 128 + 64 + lane); \
        if (MODE == 1) { W0_ = __builtin_nontemporal_load(W + (size_t)row_ * 128 + lane); W1_ = __builtin_nontemporal_load(W + (size_t)row_ * 128 + 64 + lane); } } } while (0)
#define PS_LOADX(X0_, X1_, t_) do { if (MODE == 0 && (t_) < ntok) { const int row_ = peer_row((t_), last); X0_ = __builtin_nontemporal_load((const v4u*)(H + (size_t)row_ * DD + 128 * slice + 16 * sub)); X1_ = __builtin_nontemporal_load((const v4u*)(H + (size_t)row_ * DD + 128 * slice + 16 * sub + 8)); } } while (0)
#define PS_ISSUE(R_, F_, E_, W_) do { _Pragma("unroll") for (int i = 0; i < 8; ++i) { const int src = 8 * i + grp; const int e = __shfl(E_, src); \
        if (MODE == 1) F_[i] = __shfl(W_, src); R_[i] = *(const GAS v4u*)(tl + (size_t)e * 128); } } while (0)
    PS_LOADIDX(ec0, ec1, wc0, wc1, t0); PS_LOADIDX(en0, en1, wn0, wn1, t0 + nwv); PS_LOADX(xc0, xc1, t0);
    if (t0 < ntok) { PS_ISSUE(rX, fX, ec0, wc0); PS_ISSUE(rY, fY, ec1, wc1); }
    for (int t = t0; t < ntok; t += nwv) {
        const int row = peer_row(t, last); const bool more = (t + nwv) < ntok;
        PS_LOADIDX(em0, em1, wm0, wm1, t + 2 * nwv); PS_LOADX(xn0, xn1, t + nwv);
        float acc[16];
        if (MODE == 1) {
#pragma unroll
            for (int c = 0; c < 16; ++c) acc[c] = 0.f;
#pragma unroll
            for (int i = 0; i < 8; ++i) {
#pragma unroll
                for (int q = 0; q < 4; ++q) { const int vw = (int)rX[i][q]; const f32x2p lo = __builtin_amdgcn_cvt_pk_f32_fp8(vw, false), hi2 = __builtin_amdgcn_cvt_pk_f32_fp8(vw, true);
                    acc[4 * q] = fmaf(fX[i], lo.x, acc[4 * q]); acc[4 * q + 1] = fmaf(fX[i], lo.y, acc[4 * q + 1]); acc[4 * q + 2] = fmaf(fX[i], hi2.x, acc[4 * q + 2]); acc[4 * q + 3] = fmaf(fX[i], hi2.y, acc[4 * q + 3]); } }
            if (more) PS_ISSUE(rX, fX, en0, wn0);
#pragma unroll
            for (int i = 0; i < 8; ++i) {
#pragma unroll
                for (int q = 0; q < 4; ++q) { const int vw = (int)rY[i][q]; const f32x2p lo = __builtin_amdgcn_cvt_pk_f32_fp8(vw, false), hi2 = __builtin_amdgcn_cvt_pk_f32_fp8(vw, true);
                    acc[4 * q] = fmaf(fY[i], lo.x, acc[4 * q]); acc[4 * q + 1] = fmaf(fY[i], lo.y, acc[4 * q + 1]); acc[4 * q + 2] = fmaf(fY[i], hi2.x, acc[4 * q + 2]); acc[4 * q + 3] = fmaf(fY[i], hi2.y, acc[4 * q + 3]); } }
            if (more) PS_ISSUE(rY, fY, en1, wn1);
            float r8[8], r4[4], r2[2];
#pragma unroll
            for (int c = 0; c < 8; ++c) { const float snd = b5 ? acc[c] : acc[c + 8], mine = b5 ? acc[c + 8] : acc[c]; r8[c] = mine + __shfl_xor(snd, 32); }
#pragma unroll
            for (int c = 0; c < 4; ++c) { const float snd = b4 ? r8[c] : r8[c + 4], mine = b4 ? r8[c + 4] : r8[c]; r4[c] = mine + __shfl_xor(snd, 16); }
#pragma unroll
            for (int c = 0; c < 2; ++c) { const float snd = b3 ? r4[c] : r4[c + 2], mine = b3 ? r4[c + 2] : r4[c]; r2[c] = mine + __shfl_xor(snd, 8); }
            __builtin_nontemporal_store(pk2(r2[0], r2[1]), (unsigned*)(OUT + (size_t)row * DD + 128 * slice + 16 * sub + 8 * b5 + 4 * b4 + 2 * b3));
        } else {
            float x[16]; x[0] = bflo(xc0.x); x[1] = bfhi(xc0.x); x[2] = bflo(xc0.y); x[3] = bfhi(xc0.y); x[4] = bflo(xc0.z); x[5] = bfhi(xc0.z); x[6] = bflo(xc0.w); x[7] = bfhi(xc0.w);
            x[8] = bflo(xc1.x); x[9] = bfhi(xc1.x); x[10] = bflo(xc1.y); x[11] = bfhi(xc1.y); x[12] = bflo(xc1.z); x[13] = bfhi(xc1.z); x[14] = bflo(xc1.w); x[15] = bfhi(xc1.w);
#pragma unroll
            for (int i = 0; i < 8; ++i) { float a0 = 0.f, a1 = 0.f;
#pragma unroll
                for (int q = 0; q < 4; ++q) { const int uw = (int)rX[i][q]; const f32x2p lo = __builtin_amdgcn_cvt_pk_f32_fp8(uw, false), hi2 = __builtin_amdgcn_cvt_pk_f32_fp8(uw, true);
                    a0 = fmaf(lo.x, x[4 * q], a0); a1 = fmaf(lo.y, x[4 * q + 1], a1); a0 = fmaf(hi2.x, x[4 * q + 2], a0); a1 = fmaf(hi2.y, x[4 * q + 3], a1); }
                acc[i] = a0 + a1; }
            if (more) PS_ISSUE(rX, fX, en0, wn0);
#pragma unroll
            for (int i = 0; i < 8; ++i) { float a0 = 0.f, a1 = 0.f;
#pragma unroll
                for (int q = 0; q < 4; ++q) { const int uw = (int)rY[i][q]; const f32x2p lo = __builtin_amdgcn_cvt_pk_f32_fp8(uw, false), hi2 = __builtin_amdgcn_cvt_pk_f32_fp8(uw, true);
                    a0 = fmaf(lo.x, x[4 * q], a0); a1 = fmaf(lo.y, x[4 * q + 1], a1); a0 = fmaf(hi2.x, x[4 * q + 2], a0); a1 = fmaf(hi2.y, x[4 * q + 3], a1); }
                acc[8 + i] = a0 + a1; }
            if (more) PS_ISSUE(rY, fY, en1, wn1);
            float r8[8], r4[4], r2[2];
#pragma unroll
            for (int c = 0; c < 8; ++c) { const float snd = b2 ? acc[c] : acc[c + 8], mine = b2 ? acc[c + 8] : acc[c]; r8[c] = mine + __shfl_xor(snd, 4); }
#pragma unroll
            for (int c = 0; c < 4; ++c) { const float snd = b1 ? r8[c] : r8[c + 4], mine = b1 ? r8[c + 4] : r8[c]; r4[c] = mine + __shfl_xor(snd, 2); }
#pragma unroll
            for (int c = 0; c < 2; ++c) { const float snd = b0 ? r4[c] : r4[c + 2], mine = b0 ? r4[c + 2] : r4[c]; r2[c] = mine + __shfl_xor(snd, 1); }
            __builtin_nontemporal_store((unsigned long long)__float_as_uint(r2[0]) | ((unsigned long long)__float_as_uint(r2[1]) << 32), (unsigned long long*)(P + (size_t)row * 128 + 2 * lane));
        }
        ec0 = en0; ec1 = en1; wc0 = wn0; wc1 = wn1; xc0 = xn0; xc1 = xn1;
        en0 = em0; en1 = em1; wn0 = wm0; wn1 = wm1;
    }
#undef PS_LOADIDX
#undef PS_LOADX
#undef PS_ISSUE
}
__device__ __forceinline__ void peer_act_phase(unsigned char* ws, int last, int gw, int NGW, int lane) {
    const float* P = (const float*)(ws + WS_P); const float* EG = (const float*)(ws + WS_B + (size_t)MR * 128 * 4); float* W = (float*)(ws + WS_W);
    const int ntok = last ? NB * TL : MR; const int grp = lane >> 3, ib = 8 * ((lane >> 2) & 1) + 4 * ((lane >> 1) & 1) + 2 * (lane & 1);
    for (int t = gw; t < ntok; t += NGW) { const int row = peer_row(t, last); float s0 = 0.f, s1 = 0.f;
#pragma unroll
        for (int sl = 0; sl < 8; ++sl) { const unsigned long long v = *(const GAS unsigned long long*)(P + ((size_t)sl * MR + row) * 128 + 2 * lane); s0 += __uint_as_float((unsigned)v); s1 += __uint_as_float((unsigned)(v >> 32)); }
        const int k0 = 8 * ib + grp, k1 = 8 * (ib + 1) + grp;
        W[(size_t)row * 128 + k0] = EG[(size_t)row * 128 + k0] * gelu_tanh(s0 * (1.f / PU_SCALE)) * (1.f / PV_SCALE);
        W[(size_t)row * 128 + k1] = EG[(size_t)row * 128 + k1] * gelu_tanh(s1 * (1.f / PU_SCALE)) * (1.f / PV_SCALE); }
}
__device__ __forceinline__ void ln2_phase(unsigned char* ws, float* d_out, const float* lng, const float* lnb, int layer, int last, int gw, int NGW, int lane) {
    const bf16* OUT = (const bf16*)(ws + WS_OUT); bf16* LAT = (bf16*)(ws + WS_LAT); bf16* H = (bf16*)(ws + WS_H);
    const float* MOD = (const float*)(ws + WS_MOD) + (size_t)layer * 17 * 6144; const float* MODN = MOD + 17 * 6144;
    const int nrows = last ? NB * TL : MR;
    f32x4 g[4], bb[4];
#pragma unroll
    for (int j = 0; j < 4; ++j) { g[j] = *(const GAS f32x4*)(lng + 256 * j + 4 * lane); bb[j] = *(const GAS f32x4*)(lnb + 256 * j + 4 * lane); }
    for (int lr = gw; lr < nrows; lr += 2 * NGW) {
        int rows[2]; bool ok[2];
#pragma unroll
        for (int u = 0; u < 2; ++u) { const int l2 = lr + u * NGW; ok[u] = l2 < nrows; rows[u] = peer_row(ok[u] ? l2 : lr, last); }
        f32x4 v[2][4]; float sm[2];
#pragma unroll
        for (int u = 0; u < 2; ++u) { sm[u] = 0.f; const int row = rows[u]; const int b = row / SQ, s = row - b * SQ; const float* md = MOD + (size_t)((s < LC) ? 16 : b) * 6144;
#pragma unroll
            for (int j = 0; j < 4; ++j) { const int c = 256 * j + 4 * lane; const unsigned long long lb = *(const GAS unsigned long long*)(LAT + (size_t)row * DD + c); const unsigned l0 = (unsigned)lb, l1 = (unsigned)(lb >> 32);
                f32x4 lv; lv.x = bflo(l0); lv.y = bfhi(l0); lv.z = bflo(l1); lv.w = bfhi(l1); const f32x4 gv = *(const GAS f32x4*)(md + 5120 + c);
                const unsigned long long ob = *(const GAS unsigned long long*)(OUT + (size_t)row * DD + c); const unsigned olo = (unsigned)ob, ohi = (unsigned)(ob >> 32);
                f32x4 o; o.x = bflo(olo); o.y = bfhi(olo); o.z = bflo(ohi); o.w = bfhi(ohi);
                v[u][j] = lv * DN_ALPHA + gv * o; sm[u] += (v[u][j].x + v[u][j].y) + (v[u][j].z + v[u][j].w); } }
#pragma unroll
        for (int o = 1; o < 64; o <<= 1) { sm[0] += __shfl_xor(sm[0], o); sm[1] += __shfl_xor(sm[1], o); }
        float s2[2];
#pragma unroll
        for (int u = 0; u < 2; ++u) { const float mean = sm[u] * (1.f / DD); s2[u] = 0.f;
#pragma unroll
            for (int j = 0; j < 4; ++j) { v[u][j] = v[u][j] - mean; s2[u] += (v[u][j].x * v[u][j].x + v[u][j].y * v[u][j].y) + (v[u][j].z * v[u][j].z + v[u][j].w * v[u][j].w); } }
#pragma unroll
        for (int o = 1; o < 64; o <<= 1) { s2[0] += __shfl_xor(s2[0], o); s2[1] += __shfl_xor(s2[1], o); }
#pragma unroll
        for (int u = 0; u < 2; ++u) { if (!ok[u]) continue; const int row = rows[u]; const int b = row / SQ, s = row - b * SQ; const float* mdn = MODN + (size_t)((s < LC) ? 16 : b) * 6144;
            const float rstd = 1.f / sqrtf(s2[u] * (1.f / DD) + LN_EPS);
#pragma unroll
            for (int j = 0; j < 4; ++j) { const int c = 256 * j + 4 * lane; const f32x4 y = v[u][j] * rstd * g[j] + bb[j];
                if (last) { *(GAS f32x4*)(d_out + ((size_t)b * TL + (s - LC)) * DD + c) = y; }
                else { *(GAS unsigned long long*)(LAT + (size_t)row * DD + c) = (unsigned long long)pk2(y.x, y.y) | ((unsigned long long)pk2(y.z, y.w) << 32);
                    const f32x4 sh = *(const GAS f32x4*)(mdn + c), sc = *(const GAS f32x4*)(mdn + 1024 + c); const f32x4 h = y * (sc + 1.f) + sh;
                    *(GAS unsigned long long*)(H + (size_t)row * DD + c) = (unsigned long long)pk2(h.x, h.y) | ((unsigned long long)pk2(h.z, h.w) << 32); } } }
    }
}

#endif
__device__ __forceinline__ int s5_pos(int dir, int step) { return dir == 0 ? step : (step < LC ? (LC - 1 - step) : (SQ + LC - 1 - step)); }
__device__ __forceinline__ int s5_other_tile(int dir, int pos) { const int st = (dir == 0) ? (pos < LC ? (LC - 1 - pos) : (SQ + LC - 1 - pos)) : pos; return st >> 4; }
__device__ __forceinline__ int s5_mirror(int t) { return t < 16 ? 15 - t : 159 - t; }
__device__ __forceinline__ void s5_phase(unsigned char* ws, const float* dskip, LAS unsigned char* lds, int vcu, int tid, int lane, int wave) {
    const bf16* U = (const bf16*)(ws + WS_H); float* YP = (float*)(ws + WS_A + SZ72); bf16* YG = (bf16*)(ws + WS_A);
    const float* LB = (const float*)(ws + WS_S5LB); const bf16* Bop = (const bf16*)(ws + WS_S5B); const bf16* Cop = (const bf16*)(ws + WS_S5C);
    const int half = wave & 1, dir = (wave >> 1) & 1, wt = vcu * 2 + (wave >> 2); const bool active = (wt < 512);
    const int bp = (wt >> 6) & 7, g = wt & 63; const int r32 = lane & 31, hi = lane >> 5, t16 = lane & 15, q4 = lane >> 4;
    constexpr int XP = 272, IMGB = 9216, NTILE = SQ / 16;
    LAS unsigned char* img0 = lds + (wave >> 1) * (2 * IMGB);
    const int a_b = 2 * bp + ((r32 >> 2) & 1), a_t = (r32 & 3) + 4 * (r32 >> 3);
    const f32x4 dv = *(const GAS f32x4*)(dskip + g * 16 + 4 * q4);
    const int rg = dir * 64 + g; const int bb = half;
    bf16x8 Bf[2], Cf[4];
#pragma unroll
    for (int i = 0; i < 2; ++i) Bf[i] = *(const GAS bf16x8*)(Bop + ((size_t)rg * 128 + (2 * half + i) * 32 + r32) * 16 + 8 * hi);
#pragma unroll
    for (int ks = 0; ks < 4; ++ks) Cf[ks] = *(const GAS bf16x8*)(Cop + ((size_t)rg * 16 + t16) * 128 + 32 * ks + 8 * q4);
    const float lr = LB[((size_t)rg * 64 + 32 * half + r32) * 2], li = LB[((size_t)rg * 64 + 32 * half + r32) * 2 + 1];
    float xr = 0.f, xi = 0.f;
    const bf16* Ua = U + (size_t)a_b * SQ * DD + g * 16 + 8 * hi;
    const size_t eoff = (size_t)(2 * bp + bb) * SQ * DD + g * 16 + 4 * q4;
    bf16x8 an[2]; unsigned long long un[2]; f32x4 pn[2];
#define S5_LOAD_A(slot_, tile_) do { const bf16* p_ = Ua + (size_t)s5_pos(dir, (tile_) * 16 + a_t) * DD; asm volatile("global_load_dwordx4 %0, %1, off" : "=v"(an[slot_]) : "v"(p_) : "memory"); } while (0)
#define S5_LOAD_E(slot_, tile_) do { const int tp_ = (tile_); const size_t o_ = eoff + (size_t)s5_pos(dir, tp_ * 16 + t16) * DD; \
        const bf16* p_ = U + o_; const float* q_ = (tp_ - s5_mirror(tp_) >= 6) ? (const float*)(YP + o_) : (const float*)p_; \
        asm volatile("global_load_dwordx2 %0, %2, off\n\tglobal_load_dwordx4 %1, %3, off nt" : "=&v"(un[slot_]), "=&v"(pn[slot_]) : "v"(p_), "v"(q_) : "memory"); } while (0)
#define S5_TILE(slot_, tile_) do { \
        const int tile = (tile_); LAS unsigned char* img = img0 + (tile & 1) * IMGB; \
        const int mir = s5_mirror(tile); const bool second = mir < tile, farv = (tile - mir) >= 6; \
        const int tnx = (tile + 2 < NTILE) ? tile + 2 : NTILE - 1; \
        const size_t off = eoff + (size_t)s5_pos(dir, tile * 16 + t16) * DD; \
        if (active) { \
        asm volatile("s_waitcnt vmcnt(7)" : "+v"(an[slot_]) :: "memory");        \
        f32x16 acc[2]; \
        _Pragma("unroll") for (int i = 0; i < 2; ++i) acc[i] = __builtin_amdgcn_mfma_f32_32x32x16_bf16(an[slot_], Bf[i], (f32x16){}, 0, 0, 0); \
        __builtin_amdgcn_sched_barrier(0); \
        S5_LOAD_A(slot_, tnx); \
        __builtin_amdgcn_sched_barrier(0); \
        _Pragma("unroll") for (int r = 0; r < 16; ++r) { \
            const float nr = lr * xr - li * xi + acc[0][r], ni = lr * xi + li * xr + acc[1][r]; xr = nr; xi = ni; \
            *(LAS unsigned*)(img + (hi * 16 + r) * XP + 128 * half + r32 * 4) = pk2(nr, ni); } \
        } \
        asm volatile("s_waitcnt lgkmcnt(0)" ::: "memory"); \
        __builtin_amdgcn_s_barrier();        \
        if (active) { \
        f32x4 y = (f32x4){0.f, 0.f, 0.f, 0.f}; \
        _Pragma("unroll") for (int ks = 0; ks < 4; ++ks) { const bf16x8 xb = *(const LAS bf16x8*)(img + (bb * 16 + t16) * XP + (32 * ks + 8 * q4) * 2); \
            y = __builtin_amdgcn_mfma_f32_16x16x32_bf16(Cf[ks], xb, y, 0, 0, 0); } \
        asm volatile("s_waitcnt vmcnt(5)" : "+v"(pn[slot_]), "+v"(un[slot_]) :: "memory");        \
        if (!second) { *(GAS f32x4*)(YP + off) = y; } \
        else { f32x4 pc = pn[slot_]; const unsigned long long uc = un[slot_]; \
            if (!farv) { const float* p_ = YP + off; asm volatile("global_load_dwordx4 %0, %1, off nt\n\ts_waitcnt vmcnt(0)" : "=&v"(pc) : "v"(p_) : "memory"); }        \
            const unsigned ulo = (unsigned)uc, uhi = (unsigned)(uc >> 32); \
            const float o0 = gelu_tanh(pc.x + y.x + dv.x * bflo(ulo)), o1 = gelu_tanh(pc.y + y.y + dv.y * bfhi(ulo)), o2 = gelu_tanh(pc.z + y.z + dv.z * bflo(uhi)), o3 = gelu_tanh(pc.w + y.w + dv.w * bfhi(uhi)); \
            *(GAS unsigned long long*)(YG + off) = (unsigned long long)pk2(o0, o1) | ((unsigned long long)pk2(o2, o3) << 32); } \
        __builtin_amdgcn_sched_barrier(0); \
        S5_LOAD_E(slot_, tnx); \
        if (tile == 7 || tile == 79) asm volatile("s_waitcnt vmcnt(0)" ::: "memory"); else asm volatile("s_waitcnt vmcnt(6)" ::: "memory");        \
        } \
    } while (0)
    if (active) { S5_LOAD_A(0, 0); S5_LOAD_A(1, 1); S5_LOAD_E(0, 0); S5_LOAD_E(1, 1); asm volatile("s_waitcnt vmcnt(0)" : "+v"(an[0]), "+v"(an[1]), "+v"(un[0]), "+v"(un[1]), "+v"(pn[0]), "+v"(pn[1]) :: "memory"); }
    for (int t2 = 0; t2 < NTILE; t2 += 2) { S5_TILE(0, t2); S5_TILE(1, t2 + 1); }
    asm volatile("s_waitcnt vmcnt(0) lgkmcnt(0)" ::: "memory");
#undef S5_TILE
#undef S5_LOAD_A
#undef S5_LOAD_E
}
#ifndef MK_DEBUG
#define MK_DEBUG 0
#endif
#if MK_DEBUG
__device__ __forceinline__ void chk_fail(gu32* ctl, unsigned code) { unsigned expect = 0u; __hip_atomic_compare_exchange_strong((unsigned*)(ctl + CW_ERR), &expect, code, __ATOMIC_RELAXED, __ATOMIC_RELAXED, __HIP_MEMORY_SCOPE_AGENT); }
__device__ __forceinline__ bool chk_close(float got, float ref, float rtol, float atol) { const float d = fabsf(got - ref); return (d <= atol + rtol * fabsf(ref)) && (got == got); }
__device__ __forceinline__ float fp8f(unsigned char v) { return __builtin_amdgcn_cvt_f32_fp8((int)v, 0); }
__device__ __forceinline__ float bfround(float f) { return __uint_as_float(f2bf(f) << 16); }
__device__ __forceinline__ float chk_dot(const bf16* arow, const float* W, int N, int col) { float s = 0.f; for (int k = 0; k < 1024; ++k) s += bf2f(arow[k]) * bfround(W[(size_t)k * N + col]); return s; }
__device__ __forceinline__ int chk_row(int i) { const int b = (i * 5) & 15; const int sel = i & 7; const int s = (sel == 0) ? 3 : (sel == 1) ? 255 : (sel == 2) ? 256 : (sel == 3) ? 2303 : (sel == 4) ? 777 : (sel == 5) ? 1400 : (sel == 6) ? 130 : 2000; return b * SQ + s; }

__device__ __forceinline__ void check_pre_peer(unsigned char* ws, int layer, int tid) {
    const int row = chk_row(3 + 2 * layer);
    for (int c = tid; c < 1024; c += NTHR) { ((float*)(ws + WS_CTL + 262144))[c] = bf2f(((const bf16*)(ws + WS_LAT))[(size_t)row * DD + c]); ((bf16*)(ws + WS_CTL + 262144 + 4096))[c] = ((const bf16*)(ws + WS_H))[(size_t)row * DD + c]; }
}
template <class KP> __device__ __forceinline__ void check_step(KP ka, unsigned char* ws, LAS unsigned char* lds, int op, int layer, int code, int tid, int lane, int wave) {
#define CHK_FRESH asm volatile("" : "+v"(lane), "+v"(tid), "+s"(ws));
    const int kind = layer % 3, jj = layer / 3, last = (layer == NLAYER - 1);
#ifndef CHK_MASK
#define CHK_MASK 0xFFFF
#endif
    if (!((CHK_MASK >> op) & 1)) return;
    bool bad = false;
#define MOD ((const float*)(ws + WS_MOD) + (size_t)layer * 17 * 6144)
    if (op == 9) { CHK_FRESH
        if (wave == 0) {
            { const int i = lane & 3, r = lane % 17, n = (lane * 97 + 13) % 6144; float s = 0.f;
              for (int k = 0; k < 1024; ++k) { const float v = (r < 16) ? ka->in[1][r * 1024 + k] : ka->in[3][k]; s += v / (1.f + expf(-v)) * ka->in[4][((size_t)i * 1024 + k) * 6144 + n]; }
              s += ka->in[5][i * 6144 + n]; bad |= !chk_close(((const float*)(ws + WS_MOD))[((size_t)i * 17 + r) * 6144 + n], s, 1e-3f, 1e-3f); }
            { const int n = (lane * 131 + 7) % 3072, k = (lane * 37 + 5) % 1024; bad |= bf2f(((const bf16*)(ws + WS_WQKV_DA))[((size_t)3072 + n) * 1024 + k]) != bfround(ka->in[12][(size_t)1024 * 3072 + (size_t)k * 3072 + n]); }
            { const int n = (lane * 131 + 7) % 1536, k = (lane * 37 + 5) % 1024; bad |= bf2f(((const bf16*)(ws + WS_WQKV_WA))[(size_t)n * 1024 + k]) != bfround(ka->in[16][(size_t)k * 1536 + n]); }
            { const int n = (lane * 131 + 7) % 1024, k = (lane * 37 + 5) % 1024; bad |= bf2f(((const bf16*)(ws + WS_WO_DA))[((size_t)1024 + n) * 1024 + k]) != bfround(ka->in[13][(size_t)1024 * 1024 + (size_t)k * 1024 + n]);
              bad |= bf2f(((const bf16*)(ws + WS_WO_WA))[(size_t)n * 1024 + k]) != bfround(ka->in[17][(size_t)k * 1024 + n]); }
            { const int n = (lane * 131 + 7) % 2048, k = (lane * 37 + 5) % 1024; const int pr = (n < 1024) ? ((n >> 7) * 256 + (n & 127)) : (((n - 1024) >> 7) * 256 + 128 + ((n - 1024) & 127));
              bad |= bf2f(((const bf16*)(ws + WS_WGLU))[(size_t)pr * 1024 + k]) != bfround(ka->in[27][(size_t)k * 2048 + n]);
              bad |= bf2f(((const bf16*)(ws + WS_WPQ))[((size_t)3 * 2048 + n) * 1024 + k]) != bfround(ka->in[8][(size_t)3 * 1024 * 2048 + (size_t)k * 2048 + n]); }
            { const size_t idx = (size_t)lane * 1048583u + 12345u; bad |= bf2f(((const bf16*)(ws + WS_KEYS))[idx % 2097152]) != bfround(ka->in[9][idx % 2097152]); }
            { const int t = (lane * 31 + 3) % 2048, i = lane & 31; const float inv = powf(10000.f, -(float)(i & 15) / 16.f); const float ang = (float)((i < 16) ? (t >> 6) : (t & 63)) * inv;
              bad |= !chk_close(((const float*)(ws + WS_ROPE))[t * 32 + i], cosf(ang), 0.f, 2e-5f); bad |= !chk_close(((const float*)(ws + WS_ROPE))[2048 * 32 + t * 32 + i], sinf(ang), 0.f, 2e-5f); }
        }
    } else if (op == 10) { CHK_FRESH
        if (wave == 0) { const int row = chk_row(lane), b = row / SQ, s = row - b * SQ, c = (lane * 53 + 1) % 1024; const float v = (s < LC) ? ka->in[2][((size_t)b * LC + s) * DD + c] : ka->in[0][((size_t)b * TL + s - LC) * DD + c];
            const float* md = (const float*)(ws + WS_MOD) + (size_t)((s < LC) ? 16 : b) * 6144;
            bad |= bf2f(((const bf16*)(ws + WS_LAT))[(size_t)row * DD + c]) != bfround(v); bad |= !chk_close(bf2f(((const bf16*)(ws + WS_H))[(size_t)row * DD + c]), v * (1.f + md[1024 + c]) + md[c], 1e-2f, 1e-2f); }
    } else if (op == 0) { CHK_FRESH
        if (wave == 0) { const int row = chk_row(lane), b = row / SQ, s = row - b * SQ; const int N = (kind == 0) ? 3072 : 1536; const int col = ((lane * 211 + 17) % N) & ~1;
            const float* W = (kind == 0) ? ka->in[12] + (size_t)jj * 1024 * 3072 : ka->in[16]; const bf16* hrow = (const bf16*)(ws + WS_H) + (size_t)row * DD;
            float e = chk_dot(hrow, W, N, col), o = chk_dot(hrow, W, N, col + 1);
            const int kstart = 1024, vstart = (kind == 0) ? 2048 : 1280; const int reg = (col < kstart) ? 0 : (col < vstart) ? 1 : 2; const int lc = col - ((reg == 0) ? 0 : (reg == 1) ? kstart : vstart);
            if (reg < 2 && s >= LC) { const int t = s - LC, i = (lc & 63) >> 1; const float cs = ((const float*)(ws + WS_ROPE))[t * 32 + i], sn = ((const float*)(ws + WS_ROPE))[2048 * 32 + t * 32 + i]; const float e2 = e * cs - o * sn, o2 = e * sn + o * cs; e = e2; o = o2; }
            if (reg == 0) { e *= 0.125f * LOG2E; o *= 0.125f * LOG2E; }
            const bf16* dst = (const bf16*)(ws + WS_A + (size_t)reg * SZ72) + (size_t)row * DD + lc;
            bad |= !chk_close(bf2f(dst[0]), e, 2e-2f, 2e-2f); bad |= !chk_close(bf2f(dst[1]), o, 2e-2f, 2e-2f);
            if (kind == 1) { const int hq = (lane * 5 + 2) & 15; bf16* sv = (bf16*)(ws + WS_CTL + 300000) + lane * 64; for (int cc = 0; cc < 64; ++cc) sv[cc] = ((const bf16*)(ws + WS_A))[(size_t)row * DD + hq * 64 + cc]; } }
    } else if (op == 1) { CHK_FRESH
        if (wave == 0 && kind == 0) { const int row = chk_row(lane), b = row / SQ, s = row - b * SQ; if (!(last && s < LC)) { const int hh = (lane * 7 + 3) & 31, h = hh >> 2, j = (hh >> 1) & 1, vh = hh & 1, d = (lane * 11) & 63;
            const bf16* q = (const bf16*)(ws + WS_A) + (size_t)row * DD + h * 128 + j * 64; const bf16* Kb = (const bf16*)(ws + WS_A + SZ72) + (size_t)b * SQ * DD + h * 128 + j * 64; const bf16* Vb = (const bf16*)(ws + WS_A + 2 * SZ72) + (size_t)b * SQ * DD + h * 128 + vh * 64 + d;
            const int nk = (s < LC) ? LC : SQ; float m = -INFINITY;
            for (int k = 0; k < nk; ++k) { float sc = 0.f; for (int c = 0; c < 64; ++c) sc += bf2f(q[c]) * bf2f(Kb[(size_t)k * DD + c]); m = fmaxf(m, sc); }
            float l = 0.f, o = 0.f;
            for (int k = 0; k < nk; ++k) { float sc = 0.f; for (int c = 0; c < 64; ++c) sc += bf2f(q[c]) * bf2f(Kb[(size_t)k * DD + c]); const float p = exp2f(sc - m); l += p; o += p * bf2f(Vb[(size_t)k * DD]); }
            const bf16* O = (const bf16*)(ws + WS_B + (size_t)j * SZ72) + (size_t)row * DD + h * 128 + vh * 64 + d;
            bad |= !chk_close(bf2f(O[0]), o / l, 3e-2f, 1e-2f); } }
        if (wave == 0 && kind == 1) { const int row = chk_row(lane), b = row / SQ, s = row - b * SQ; if (!(last && s < LC)) { const int hq = (lane * 5 + 2) & 15, d = (lane * 11) & 63;
            const bf16* q = (const bf16*)(ws + WS_CTL + 300000) + lane * 64; const bf16* Kb = (const bf16*)(ws + WS_A + SZ72) + (size_t)b * SQ * DD + (hq >> 2) * 64; const bf16* Vb = (const bf16*)(ws + WS_A + 2 * SZ72) + (size_t)b * SQ * DD + (hq >> 2) * 64 + d;
            float m = -INFINITY;
            for (int k = 0; k < SQ; ++k) { if (k >= LC) { if (s < LC) break; const int dd = (k - LC) - (s - LC); if (dd > 128 || dd < -128) continue; }
                float sc = 0.f; for (int c2 = 0; c2 < 64; ++c2) sc += bf2f(q[c2]) * bf2f(Kb[(size_t)k * DD + c2]); m = fmaxf(m, sc); }
            float l = 0.f, o = 0.f;
            for (int k = 0; k < SQ; ++k) { if (k >= LC) { if (s < LC) break; const int dd = (k - LC) - (s - LC); if (dd > 128 || dd < -128) continue; }
                float sc = 0.f; for (int c2 = 0; c2 < 64; ++c2) sc += bf2f(q[c2]) * bf2f(Kb[(size_t)k * DD + c2]); const float p = exp2f(sc - m); l += p; o += p * bf2f(Vb[(size_t)k * DD]); }
            l += exp2f(ka->in[18][hq] * LOG2E - m);
            bad |= !chk_close(bf2f(((const bf16*)(ws + WS_A))[(size_t)row * DD + hq * 64 + d]), o / l, 3e-2f, 1e-2f); } }
    } else if (op == 2) { CHK_FRESH
        if (wave == 0) { const int row = chk_row(lane), b = row / SQ, s = row - b * SQ; if (!(last && s < LC)) { const int h = lane & 7, e0 = (lane * 13) & 127;
            const float* lp = ka->in[14] + jj * 256; float d01 = 0.f, d23 = 0.f; for (int i = 0; i < 64; ++i) { d01 += lp[i] * lp[64 + i]; d23 += lp[128 + i] * lp[192 + i]; }
            const float lam_init = 0.8f - 0.6f * expf(-0.3f * (float)layer), lam = expf(d01) - expf(d23) + lam_init;
            const bf16* o0 = (const bf16*)(ws + WS_B) + (size_t)row * DD + h * 128; const bf16* o1 = (const bf16*)(ws + WS_B + SZ72) + (size_t)row * DD + h * 128; float ss = 0.f;
            for (int e = 0; e < 128; ++e) { const float v = bf2f(o0[e]) - lam * bf2f(o1[e]); ss += v * v; }
            const float v = (bf2f(o0[e0]) - lam * bf2f(o1[e0])) / sqrtf(ss / 128.f + LN_EPS) * ka->in[15][jj * 128 + e0] * (1.f - lam_init);
            bad |= !chk_close(bf2f(((const bf16*)(ws + WS_A))[(size_t)row * DD + h * 128 + e0]), v, 2e-2f, 1e-2f); } }
    } else if (op == 3) { CHK_FRESH
        if (wave == 0) { const int row = chk_row(lane), b = row / SQ, s = row - b * SQ; if (!(last && s < LC)) { const int col = (lane * 67 + 9) % 1024; const bf16* arow = (const bf16*)(ws + WS_A) + (size_t)row * DD;
            float val;
            if (kind == 2) { const float a = chk_dot(arow, ka->in[27], 2048, col), g = chk_dot(arow, ka->in[27], 2048, 1024 + col); val = a / (1.f + expf(-g)); }
            else val = chk_dot(arow, (kind == 0) ? ka->in[13] + (size_t)jj * 1024 * 1024 : ka->in[17], 1024, col);
            const float ref = DN_ALPHA * bf2f(((const bf16*)(ws + WS_LAT))[(size_t)row * DD + col]) + MOD[(size_t)((s < LC) ? 16 : b) * 6144 + 2048 + col] * val;
            bad |= !chk_close(bf2f(((const bf16*)(ws + WS_B))[(size_t)row * DD + col]), ref, 2e-2f, 2e-2f); } }
    } else if (op == 4) { CHK_FRESH
        if (wave == 0) { const int row = chk_row(lane), b = row / SQ, s = row - b * SQ; if (!(last && s < LC)) { const int col = (lane * 67 + 9) % 1024; const bf16* r = (const bf16*)(ws + WS_B) + (size_t)row * DD;
            float s1 = 0.f, s2 = 0.f;
#pragma clang loop vectorize(disable) unroll(disable)
            for (int c = 0; c < 1024; ++c) { float v = bf2f(r[c]); asm volatile("" : "+v"(v)); s1 += v; s2 = fmaf(v, v, s2); }
            const float mu = s1 / 1024.f, var = s2 / 1024.f - mu * mu;
            float y = (bf2f(r[col]) - mu) / sqrtf(var + LN_EPS); asm volatile("" : "+v"(y)); y = fmaf(y, ka->in[6][(layer * 2) * 1024 + col], ka->in[7][(layer * 2) * 1024 + col]); asm volatile("" : "+v"(y)); const float* md = MOD + (size_t)((s < LC) ? 16 : b) * 6144;
            float hm = fmaf(y, md[4096 + col], y); asm volatile("" : "+v"(hm)); hm += md[3072 + col]; asm volatile("" : "+v"(hm));
            bad |= !chk_close(bf2f(((const bf16*)(ws + WS_LAT))[(size_t)row * DD + col]), y, 1e-2f, 1e-2f); bad |= !chk_close(bf2f(((const bf16*)(ws + WS_H))[(size_t)row * DD + col]), hm, 1e-2f, 1e-2f); } }
    } else if (op == 5) { CHK_FRESH
        if (wave == 0) { const int row = chk_row(lane), s = row % SQ; if (!(last && s < LC)) { const int col = (lane * 139 + 9) % 2048;
            const float ref = chk_dot((const bf16*)(ws + WS_H) + (size_t)row * DD, ka->in[8] + (size_t)layer * 1024 * 2048, 2048, col);
            bad |= !chk_close(bf2f(((const bf16*)(ws + WS_A))[(size_t)row * 2048 + col]), ref, 2e-2f, 2e-2f); } }
    } else if (op == 6) { CHK_FRESH
        if (wave == 0) { const int row = chk_row(lane), s = row % SQ; const int h = (lane * 3 + 1) & 7; LAS float* sc = (LAS float*)lds + lane * 257; LAS unsigned char* used = lds + 66048 + lane * 260;
            if (!(last && s < LC)) {
                const bf16* q = (const bf16*)(ws + WS_A) + (size_t)row * 2048 + h * 256; const bf16* KEYS = (const bf16*)(ws + WS_KEYS) + (size_t)layer * 2 * 8 * 128 * 128;
                for (int j = 0; j < 2; ++j) for (int k = 0; k < 128; ++k) { float a = 0.f; for (int c = 0; c < 128; ++c) a += bf2f(q[j * 128 + c]) * bf2f(KEYS[((size_t)(j * 8 + h) * 128 + k) * 128 + c]); sc[j * 128 + k] = a; }
                LAS float* tv = (LAS float*)(lds + 83200) + lane * 65; LAS int* ti = (LAS int*)(lds + 100096) + lane * 65;
                for (int j = 0; j < 2; ++j) for (int it = 0; it < 16; ++it) { float bv = -INFINITY; int bi = 0; for (int k = 0; k < 128; ++k) { const float v = sc[j * 128 + k]; if (v > bv) { bv = v; bi = k; } } tv[j * 16 + it] = bv; ti[j * 16 + it] = bi; sc[j * 128 + bi] = -INFINITY; }
                for (int i = 0; i < 256; ++i) used[i] = 0;
                float rs[1]; int nmatch = 0; float gsum_err = 0.f; (void)rs;
                const int* E = (const int*)(ws + WS_B) + ((size_t)row * 8 + h) * 16; const float* Gt = (const float*)(ws + WS_B + (size_t)MR * 128 * 4) + ((size_t)row * 8 + h) * 16;
                float topv0 = 0.f, den = 0.f;
                for (int it = 0; it < 16; ++it) { float bv = -INFINITY; int bi = 0; for (int i = 0; i < 256; ++i) if (!used[i]) { const float v = tv[i >> 4] + tv[16 + (i & 15)]; if (v > bv) { bv = v; bi = i; } } used[bi] = (unsigned char)(it + 1); if (it == 0) topv0 = bv; den += expf(bv - topv0); }
                for (int i = 0; i < 256; ++i) if (used[i]) { const float v = tv[i >> 4] + tv[16 + (i & 15)]; const int e = ti[i >> 4] * 128 + ti[16 + (i & 15)]; const float g = expf(v - topv0) / den;
                        for (int r = 0; r < 16; ++r) if (E[r] == e) { ++nmatch; gsum_err += fabsf(Gt[r] - g); } }
                float gs = 0.f; for (int r = 0; r < 16; ++r) { gs += Gt[r]; bad |= (E[r] < 0 || E[r] >= 16384); }
                bad |= (nmatch < 14) || (gsum_err > 0.05f) || !chk_close(gs, 1.f, 0.f, 1e-3f);
            } }
        __syncthreads(); check_pre_peer(ws, layer, tid);
    } else if (op == (PEER_SLICED ? 12 : (PEER_SPLIT ? 11 : 7))) { CHK_FRESH
        const int row = chk_row(3 + 2 * layer), b = row / SQ, s = row - b * SQ;
        if (!(last && s < LC)) {
            LAS float* act = (LAS float*)lds; LAS float* rr = (LAS float*)lds + 256; LAS float* red = (LAS float*)lds + 256 + 1024;
            const bf16* hrow = (const bf16*)(ws + WS_H) + (size_t)row * DD; const float* latold = (const float*)(ws + WS_CTL + 262144);
            const bf16* hold = (const bf16*)(ws + WS_CTL + 262144 + 4096);
            const int* E = (const int*)(ws + WS_B) + (size_t)row * 128; const float* Gt = (const float*)(ws + WS_B + (size_t)MR * 128 * 4) + (size_t)row * 128;
            const unsigned char* PU = ws + WS_PU + (size_t)layer * 16384 * 1024; const unsigned char* PV = ws + WS_PV + (size_t)layer * 16384 * 1024;
            (void)hrow;
            if (tid < 128) { const int e = E[tid]; float a = 0.f; for (int dd = 0; dd < 1024; ++dd) a += bf2f(hold[dd]) * fp8f(PU[PEER_SLICED ? (((size_t)(dd >> 7) << 21) + (size_t)e * 128 + (dd & 127)) : ((size_t)e * 1024 + dd)]); act[tid] = Gt[tid] * gelu_tanh(a * (1.f / PU_SCALE)) * (1.f / PV_SCALE); }
            __syncthreads();
            for (int c = tid; c < 1024; c += NTHR) { float o = 0.f; for (int k = 0; k < 128; ++k) o += act[k] * fp8f(PV[PEER_SLICED ? (((size_t)(c >> 7) << 21) + (size_t)E[k] * 128 + (c & 127)) : ((size_t)E[k] * 1024 + c)]); rr[c] = DN_ALPHA * latold[c] + MOD[(size_t)((s < LC) ? 16 : b) * 6144 + 5120 + c] * o; }
            __syncthreads();
            if (tid == 0) { float mu = 0.f; for (int c = 0; c < 1024; ++c) mu += rr[c]; mu /= 1024.f; float var = 0.f; for (int c = 0; c < 1024; ++c) var += (rr[c] - mu) * (rr[c] - mu); red[0] = mu; red[1] = 1.f / sqrtf(var / 1024.f + LN_EPS); }
            __syncthreads();
            for (int c = tid; c < 1024; c += NTHR) { const float y = (rr[c] - red[0]) * red[1] * ka->in[6][(layer * 2 + 1) * 1024 + c] + ka->in[7][(layer * 2 + 1) * 1024 + c];
                const float got = last ? ka->out[((size_t)b * TL + s - LC) * DD + c] : bf2f(((const bf16*)(ws + WS_LAT))[(size_t)row * DD + c]); bad |= !chk_close(got, y, 2e-2f, 2e-2f); }
            __syncthreads();
        }
    } else if (op == 8) { CHK_FRESH
        { const int b = (wave * 5 + 1) & 15, g = (wave * 23 + 7) & 63; const int p = lane; const bf16* U = (const bf16*)(ws + WS_H); const bf16* YG = (const bf16*)(ws + WS_A);
          float yacc[3][16];
#pragma unroll
          for (int a = 0; a < 3; ++a)
#pragma unroll
              for (int h = 0; h < 16; ++h) yacc[a][h] = 0.f;
          for (int dir = 0; dir < 2; ++dir) { const int rg = dir * 64 + g; const float re = ka->in[19][rg * 64 + p], im = ka->in[20][rg * 64 + p], stp = expf(ka->in[21][rg]);
              const float mag = expf(re * stp), lbr = mag * cosf(im * stp), lbi = mag * sinf(im * stp); const float aa = lbr - 1.f, bb = lbi, den = re * re + im * im, qr = (aa * re + bb * im) / den, qi = (bb * re - aa * im) / den;
              float bbr[16], bbi[16], cr[16], ci[16];
#pragma unroll
              for (int h = 0; h < 16; ++h) { const float br = ka->in[22][((size_t)rg * 64 + p) * 16 + h], bi = ka->in[23][((size_t)rg * 64 + p) * 16 + h]; bbr[h] = br * qr - bi * qi; bbi[h] = br * qi + bi * qr; cr[h] = ka->in[24][((size_t)rg * 16 + h) * 64 + p]; ci[h] = ka->in[25][((size_t)rg * 16 + h) * 64 + p]; }
              float xr = 0.f, xi = 0.f;
              for (int step = 0; step < SQ; ++step) { const int pos = s5_pos(dir, step); const bf16* u = U + ((size_t)b * SQ + pos) * DD + g * 16; float bur = 0.f, bui = 0.f;
#pragma unroll
                  for (int h = 0; h < 16; ++h) { const float uv = bf2f(u[h]); bur += uv * bbr[h]; bui += uv * bbi[h]; }
                  const float nr = lbr * xr - lbi * xi + bur, ni = lbr * xi + lbi * xr + bui; xr = nr; xi = ni;
                  const int a = (pos == 255) ? 0 : (pos == 256) ? 1 : (pos == 1777) ? 2 : -1;
                  if (a >= 0) {
#pragma unroll
                      for (int aa2 = 0; aa2 < 3; ++aa2) if (aa2 == a) {
#pragma unroll
                          for (int h = 0; h < 16; ++h) yacc[aa2][h] += wave_sum(xr * cr[h] - xi * ci[h]); } } } }
#pragma unroll
          for (int a = 0; a < 3; ++a) { const int pos = (a == 0) ? 255 : (a == 1) ? 256 : 1777; const bf16* u = U + ((size_t)b * SQ + pos) * DD + g * 16;
#pragma unroll
              for (int h = 0; h < 16; ++h) { const float y = gelu_tanh(yacc[a][h] + ka->in[26][g * 16 + h] * bf2f(u[h])); bad |= !chk_close(bf2f(YG[((size_t)b * SQ + pos) * DD + g * 16 + h]), y, 3e-2f, 2e-2f); } } }
    }
    if (bad) chk_fail((gu32*)(ws + WS_CTL), (unsigned)code);
#undef CHK_FRESH
#undef MOD
}
#endif
__device__ __forceinline__ void attn_phase_da(unsigned char* ws, int last, LAS unsigned char* lds, int vcu, int G, int tid) {
    typedef attn_body::bf16 abf;
    const abf* Qb = (const abf*)(ws + WS_A); const abf* Kb = (const abf*)(ws + WS_A + SZ72); const abf* Vb = (const abf*)(ws + WS_A + 2 * SZ72);
    abf* O0 = (abf*)(ws + WS_B); abf* O1 = (abf*)(ws + WS_B + SZ72);
    const int nlat = NB * 16 * 8, nctx = last ? 0 : NB * 16;
    for (int u = vcu; u < nlat + nctx; u += G) {
        int b, hh, qb;
        if (u < nlat) { const int idx = u >> 3; b = idx >> 4; hh = idx & 15; qb = (u & 7) + 1; } else { const int v = u - nlat; b = v >> 4; hh = v & 15; qb = 0; }
        const int h = hh >> 1, j = hh & 1;
        attn_body::UnitDesc d;
        const size_t qrow = (size_t)b * SQ + 256 * qb, krow = (size_t)b * SQ;
        d.Q = Qb + qrow * DD + h * 128 + j * 64; d.K = Kb + krow * DD + h * 128 + j * 64; d.V = Vb + krow * DD + h * 128;
        d.O = (j ? O1 : O0) + qrow * DD + h * 128;
        d.NT = qb ? 36 : 4; d.latoff = 256; d.kpos4 = 0; d.qpos0 = 0; d.sink2 = -INFINITY;
        attn_body::attn_unit_v128<8>(d, (char*)lds, tid);
    }
}
__device__ __forceinline__ void attn_phase_wa(unsigned char* ws, const float* sink, int last, LAS unsigned char* lds, int vcu, int G, int tid) {
    typedef attn_body::bf16 abf;
    const abf* Qb = (const abf*)(ws + WS_A); const abf* Kb = (const abf*)(ws + WS_A + SZ72); const abf* Vb = (const abf*)(ws + WS_A + 2 * SZ72);
    abf* OC = (abf*)(ws + WS_A);
    const int nlat = NB * 4 * 32, nctx = last ? 0 : NB * 4 * 4;
    for (int u = vcu; u < nlat + nctx; u += G) {
        int b, kvh, qb; bool lat = u < nlat;
        if (lat) { qb = u & 31; const int idx = u >> 5; kvh = idx & 3; b = idx >> 2; } else { const int v = u - nlat; qb = v & 3; const int idx = v >> 2; kvh = idx & 3; b = idx >> 2; }
        attn_body::UnitDesc d;
        const size_t qrow = (size_t)b * SQ + (lat ? LC + 64 * qb : 64 * qb), krow = (size_t)b * SQ;
        d.Q = Qb + qrow * DD + kvh * 256; d.K = Kb + krow * DD + kvh * 64; d.V = Vb + krow * DD + kvh * 64; d.O = OC + qrow * DD + kvh * 256;
        if (lat) { const int qpos0 = 64 * qb; int ks = (qpos0 - 128) < 0 ? 0 : (qpos0 - 128), ke = (qpos0 + 192) > TL ? TL : (qpos0 + 192);
            if (((ke - ks) >> 6) & 1) { if (ks >= 64) ks -= 64; else ke += 64; }
            d.NT = 4 + (ke - ks) / 64; d.latoff = 256 + ks; d.kpos4 = ks; d.qpos0 = qpos0; }
        else { d.NT = 4; d.latoff = 256; d.kpos4 = 0; d.qpos0 = 0; }
        d.sink2 = 0.f; d.hmask = 3; d.sinkp = sink + kvh * 4;
        attn_body::attn_unit<8, true>(d, (char*)lds, tid);
    }
}

#ifndef PHM
#define PHM 0xFFFFF
#endif
#define PH_ON(k) (((PHM) >> (k)) & 1)
#ifndef PEER_SLICED
#define PEER_SLICED 0
#endif
#ifndef PEER_SPLIT
#define PEER_SPLIT 0
#endif
constexpr int NSTEPS = PEER_SLICED ? (3 + 11 + 10 + 9 + 11) : (PEER_SPLIT ? (3 + 9 + 8 + 7 + 9) : (3 + 8 + 7 + 6 + 8));
struct Args { const float* in[28]; float* out; unsigned char* ws; int ph_lo, ph_hi; };
static_assert(sizeof(Args) == 28 * 8 + 8 + 8 + 8, "Args has no padding");

__global__ void __launch_bounds__(NTHR, 2) mk_fwd(Args args) {
    extern __shared__ __attribute__((aligned(16))) unsigned char lds_raw[];
    volatile LAS unsigned* MISC = (volatile LAS unsigned*)((LAS unsigned char*)lds_raw + MISC_OFF);
    typedef const __attribute__((address_space(4))) Args* KArgP;
    KArgP ka = (KArgP)__builtin_amdgcn_kernarg_segment_ptr();
#define KA_IN(k) (ka->in[k])
#define KA_FRESH() asm volatile("" : "+s"(ka))
    const int wave0 = __builtin_amdgcn_readfirstlane(threadIdx.x >> 6);
    { const int t0 = threadIdx.x; for (int u = t0; u < (LDS_BYTES - LDSCTL_OFF) / 4; u += NTHR) ((LAS unsigned*)((LAS unsigned char*)lds_raw + LDSCTL_OFF))[u] = 0u; }
    __syncthreads();
    const int lo = ka->ph_lo, hi = ka->ph_hi;
    const bool multi = (hi - lo) > 1 || MK_DEBUG;
    XcdBarrier bar; bar.bar = (unsigned*)((gu32*)(ka->ws + WS_CTL) + CW_BAR); bar.x = 0; bar.st = nullptr;
    if (multi) bar = xcd_barrier_post((unsigned*)((gu32*)(ka->ws + WS_CTL) + CW_BAR), MISC + 8, (int)threadIdx.x);
#if PEER_SLICED
    if (threadIdx.x == 0) { const unsigned xcc = xb_xcc_id() & 7u; MISC[12] = xcc; MISC[13] = __hip_atomic_fetch_add((unsigned*)((gu32*)(ka->ws + WS_CTL) + 2048 + 64 * xcc), 1u, __ATOMIC_RELAXED, __HIP_MEMORY_SCOPE_AGENT); }
    __syncthreads();
#endif
#define PH_TID int wv_b = wave0; asm volatile("" : "+s"(wv_b)); int ln_b = (int)__builtin_amdgcn_mbcnt_hi(~0u, __builtin_amdgcn_mbcnt_lo(~0u, 0u)); asm volatile("" : "+v"(ln_b)); const int tid_b = wv_b * 64 + ln_b;
#define PS_MAP int ps_slice = bx & 7, ps_widx = bx >> 3; const int ps_n = G >> 3; { bool even_ = true; for (int j_ = 0; j_ < 8; ++j_) even_ = even_ && (__hip_atomic_load((unsigned*)((gu32*)(ws + WS_CTL) + 2048 + 64 * j_), __ATOMIC_RELAXED, __HIP_MEMORY_SCOPE_AGENT) == (unsigned)ps_n); if (even_) { ps_slice = (int)MISC[12]; ps_widx = (int)MISC[13]; } }
#define PH_LOCALS \
    int wave = wave0; asm volatile("" : "+s"(wave)); \
    int lane = (int)__builtin_amdgcn_mbcnt_hi(~0u, __builtin_amdgcn_mbcnt_lo(~0u, 0u)); asm volatile("" : "+v"(lane)); const int tid = wave * 64 + lane; \
    int G = gridDim.x, bx = blockIdx.x; asm volatile("" : "+s"(G), "+s"(bx)); \
    const int vcu = (G % 8 == 0) ? (bx % 8) * (G / 8) + bx / 8 : bx; \
    const int gw = vcu * NWAVES + wave, NGW = G * NWAVES; \
    KA_FRESH(); unsigned char* ws = ka->ws; \
    unsigned ldsb = 0; asm volatile("" : "+s"(ldsb)); \
    LAS unsigned char* lds = (LAS unsigned char*)lds_raw + ldsb; \
    (void)lane; (void)wave; (void)vcu; (void)gw; (void)NGW; (void)ws; (void)lds; (void)tid;
#if MK_DEBUG
    for (int it = 0; it <= 2 * NSTEPS; ++it) { const int step = it >> 1; const bool is_check = (it & 1) != 0; const bool is_report = (it == 2 * NSTEPS);
#else
    for (int step = lo; step < hi; ++step) {
#endif
        KA_FRESH();
        int layer = 0, op;
        if (step < 3) op = (step == 0) ? 9 : (step == 1) ? 16 : 10;
#if PEER_SLICED
        else { const int s = step - 3;
            int k, base;
            if (s < 11) { layer = 0; k = s; } else if (s < 21) { layer = 1; k = s - 11; } else if (s < 30) { layer = 2; k = s - 21; } else { layer = 3; k = s - 30; }
            const int kd = layer % 3; base = (kd == 0) ? 4 : (kd == 1) ? 3 : 2;
            if (k < base) { op = (kd == 0) ? k : (kd == 1) ? ((k < 2) ? k : 3) : ((k == 0) ? 8 : 3); }
            else { const int j = k - base; op = (j == 0) ? 4 : (j == 1) ? 5 : (j == 2) ? 6 : (j == 3) ? 7 : (j == 4) ? 13 : (j == 5) ? 11 : 12; } }
#elif PEER_SPLIT
        else { const int s = step - 3;
            if (s < 9) { layer = 0; op = (s < 8) ? s : 11; }
            else if (s < 17) { layer = 1; op = s - 9; if (op >= 2) ++op; if (op == 8) op = 11; }
            else if (s < 24) { layer = 2; op = s - 17; op = (op == 0) ? 8 : op + 2; if (op == 8 && s - 17 == 6) op = 11; }
            else { layer = 3; op = s - 24; if (op == 8) op = 11; } }
#else
        else { const int s = step - 3;
            if (s < 8) { layer = 0; op = s; }
            else if (s < 15) { layer = 1; op = s - 8; if (op >= 2) ++op; }
            else if (s < 21) { layer = 2; op = s - 15; op = (op == 0) ? 8 : op + 2; }
            else { layer = 3; op = s - 21; } }
#endif
        const int kind = layer % 3, jj = layer / 3, last = (layer == NLAYER - 1) ? 1 : 0;
#ifndef PROBE_REPEAT_OP
#define PROBE_REPEAT_OP -1
#endif
        const int nrep = (op == PROBE_REPEAT_OP && !(op == 1 && kind == 1)) ? 2 : 1;
        for (int rep = 0; rep < nrep; ++rep) {
        const int dry = (nrep == 2 && rep == 0) ? 1 : 0; (void)dry;
#if MK_DEBUG
        if (is_report) { PH_LOCALS const unsigned code = __hip_atomic_load((unsigned*)((gu32*)(ws + WS_CTL) + CW_ERR), __ATOMIC_RELAXED, __HIP_MEMORY_SCOPE_AGENT);
            if (code) { const float v = sqrtf((float)code); float* o = ka->out; for (size_t i = (size_t)vcu * NTHR + tid; i < (size_t)NB * TL * DD; i += (size_t)G * NTHR) o[i] = v; } }
        else if (is_check) { PH_LOCALS if (bx == 0) check_step(ka, ws, lds, op, layer, step + 1, tid, lane, wave); }
        else
#endif
        if (op == 9) { if constexpr (PH_ON(0)) { PH_LOCALS p0_prologue(ka, ws, lds, vcu, G, tid, lane, wave); } }
        else if (op == 10) { if constexpr (PH_ON(1)) { PH_LOCALS p1_embed(KA_IN(0), KA_IN(2), ws, gw, NGW, lane); } }
        else if (op == 16) { if constexpr (PH_ON(1)) { PH_LOCALS modred_phase(KA_IN(5), ws, gw, NGW, lane); } }
        else if (op == 0) { if constexpr (PH_ON(2)) { PH_LOCALS
            pg8::Gemm g; g.A = (const pg8::bf16_t*)(ws + WS_H); g.K = 1024; g.M = MR;
            pg8::EpiQKV E; E.Q = (pg8::bf16_t*)(ws + WS_A); E.K = (pg8::bf16_t*)(ws + WS_A + SZ72); E.V = (pg8::bf16_t*)(ws + WS_A + 2 * SZ72);
            E.cosT = (const float*)(ws + WS_ROPE); E.sinT = E.cosT + 2048 * 32; E.qscale = 0.125f * LOG2E;
            int nN;
            if (kind == 0) { g.Bt = (const pg8::bf16_t*)(ws + WS_WQKV_DA) + (size_t)jj * 3072 * 1024; g.N = 3072; E.nq = 4; E.nk = 4; nN = 12; }
            else { g.Bt = (const pg8::bf16_t*)(ws + WS_WQKV_WA); g.N = 1536; E.nq = 4; E.nk = 1; nN = 6; }
            pg8::RowOrder S; S.init(144, nN, G, bx, 0);
            pg8::gemm_phase<pg8::EpiQKV, pg8::RowOrder, true, true>(lds + RING_OFF, g, S, E, tid); } }
        else if (op == 1) { if (kind == 0) { if constexpr (PH_ON(3)) { PH_LOCALS attn_phase_da(ws, last, lds, vcu, G, tid); } } else { if constexpr (PH_ON(4)) { PH_LOCALS attn_phase_wa(ws, KA_IN(18), last, lds, vcu, G, tid); } } }
        else if (op == 2) { if constexpr (PH_ON(5)) { PH_LOCALS
            int ly = layer; asm volatile("" : "+s"(ly)); const float lam_init = (ly == 0) ? 0.2f : 0.55605820416f;
            da_combine_phase(ws, KA_IN(14) + jj * 256, KA_IN(15) + jj * 128, lam_init, last, gw, NGW, lane); } }
        else if (op == 8) { if constexpr (PH_ON(6)) { PH_LOCALS s5_phase(ws, KA_IN(26), lds, vcu, tid, lane, wave); } }
        else if (op == 3) {
            if (kind != 2) { if constexpr (PH_ON(7)) { PH_LOCALS
                pg8::Gemm g; g.A = (const pg8::bf16_t*)(ws + WS_A); g.K = 1024; g.M = MR; g.N = 1024;
                g.Bt = (kind == 0) ? (const pg8::bf16_t*)(ws + WS_WO_DA) + (size_t)jj * 1024 * 1024 : (const pg8::bf16_t*)(ws + WS_WO_WA);
                pg8::EpiRes E; E.lat = (const pg8::bf16_t*)(ws + WS_LAT); E.R = (pg8::bf16_t*)(ws + WS_B); E.mod = (const float*)(ws + WS_MOD) + (size_t)layer * 17 * 6144; E.alpha = DN_ALPHA;
                pg8::RowOrder S; S.init(last ? 128 : 144, 4, G, bx, last);
                pg8::gemm_phase<pg8::EpiRes, pg8::RowOrder, true, true>(lds + RING_OFF, g, S, E, tid);
                if (layer + 1 < NLAYER) { const int nfull = ((last ? 128 : 144) * 4) % G; if (nfull == 0 || bx >= nfull) cvt_tables_layer(ka, ws, layer + 1, nfull ? bx - nfull : bx, nfull ? G - nfull : G, tid); } } }
            else { if constexpr (PH_ON(8)) { PH_LOCALS
                pg8::Gemm g; g.A = (const pg8::bf16_t*)(ws + WS_A); g.K = 1024; g.M = MR; g.N = 2048; g.Bt = (const pg8::bf16_t*)(ws + WS_WGLU);
                pg8::EpiGlu E; E.lat = (const pg8::bf16_t*)(ws + WS_LAT); E.R = (pg8::bf16_t*)(ws + WS_B); E.mod = (const float*)(ws + WS_MOD) + (size_t)layer * 17 * 6144; E.alpha = DN_ALPHA;
                pg8::RowOrder S; S.init(144, 8, G, bx, 0);
                pg8::gemm_phase<pg8::EpiGlu, pg8::RowOrder, true, true>(lds + RING_OFF, g, S, E, tid);
                if (layer + 1 < NLAYER) { const int nfull = (144 * 8) % G; if (nfull == 0 || bx >= nfull) cvt_tables_layer(ka, ws, layer + 1, nfull ? bx - nfull : bx, nfull ? G - nfull : G, tid); } } } }
        else if (op == 4) { if constexpr (PH_ON(9)) { PH_LOCALS ln1_phase(ws, KA_IN(6) + (size_t)(layer * 2) * 1024, KA_IN(7) + (size_t)(layer * 2) * 1024, layer, last, gw, NGW, lane); } }
        else if (op == 5) { if constexpr (PH_ON(10)) { PH_LOCALS
            pg8::Gemm g; g.A = (const pg8::bf16_t*)(ws + WS_H); g.K = 1024; g.M = MR; g.N = 2048; g.Bt = (const pg8::bf16_t*)(ws + WS_WPQ) + (size_t)layer * 2048 * 1024;
            pg8::EpiPlain E; E.O = (pg8::bf16_t*)(ws + WS_A); E.ldc = 2048;
            pg8::RowOrder S; S.init(last ? 128 : 144, 8, G, bx, last);
            pg8::gemm_phase<pg8::EpiPlain, pg8::RowOrder, true, true>(lds + RING_OFF, g, S, E, tid); } }
        else if (op == 6) { if constexpr (PH_ON(11)) { PH_LOCALS topk_phase(ws, layer, last, lds, vcu, G, tid, lane, wave); } }
#if PEER_SLICED
        else if (op == 7) { if constexpr (PH_ON(12)) { PH_LOCALS PS_MAP peer_slice_pass<0>(ws, layer, last, ps_slice, ps_widx, ps_n, lane, wave); } }
#elif PEER_SPLIT
        else if (op == 7) { if constexpr (PH_ON(12)) { PH_LOCALS peer_gu_phase(ws, ka->out, KA_IN(6) + (size_t)(layer * 2 + 1) * 1024, KA_IN(7) + (size_t)(layer * 2 + 1) * 1024, layer, last, dry, gw, NGW, lane); } }
        else if (op == 11) { if constexpr (PH_ON(13)) { PH_LOCALS peer_gv_phase(ws, ka->out, KA_IN(6) + (size_t)(layer * 2 + 1) * 1024, KA_IN(7) + (size_t)(layer * 2 + 1) * 1024, layer, last, dry, gw, NGW, lane); } }
#else
        else if (op == 7) { if constexpr (PH_ON(12)) { PH_LOCALS peer_phase(ws, ka->out, KA_IN(6) + (size_t)(layer * 2 + 1) * 1024, KA_IN(7) + (size_t)(layer * 2 + 1) * 1024, layer, last, dry, gw, NGW, lane); } }
#endif
#if PEER_SLICED
        else if (op == 11) { if constexpr (PH_ON(13)) { PH_LOCALS PS_MAP peer_slice_pass<1>(ws, layer, last, ps_slice, ps_widx, ps_n, lane, wave); } }
        else if (op == 13) { if constexpr (PH_ON(15)) { PH_LOCALS peer_act_phase(ws, last, gw, NGW, lane); } }
        else { if constexpr (PH_ON(14)) { PH_LOCALS ln2_phase(ws, ka->out, KA_IN(6) + (size_t)(layer * 2 + 1) * 1024, KA_IN(7) + (size_t)(layer * 2 + 1) * 1024, layer, last, gw, NGW, lane); } }
#endif
        if (rep + 1 < nrep) { XcdBarrier b2 = bar; asm volatile("" : "+s"(b2.bar)); PH_TID xcd_barrier(b2, tid_b); }
        }
#if MK_DEBUG
        { XcdBarrier b2 = bar; asm volatile("" : "+s"(b2.bar)); PH_TID xcd_barrier(b2, tid_b); }
#else
        if (step + 1 < hi) { XcdBarrier b2 = bar; asm volatile("" : "+s"(b2.bar)); PH_TID xcd_barrier(b2, tid_b); }
#endif
    }
}

#ifndef MK_ONE_LAUNCH
#define MK_ONE_LAUNCH 1
#endif
extern "C" void kernel_launch(void* const* d_in, const int* in_sizes, int n_in, void* d_out, int out_size, void* d_ws, size_t ws_size, hipStream_t stream) {
    static int grid = 0;
    if (grid == 0) {
        if (n_in != 28 || ws_size < WS_END || out_size != NB * TL * DD) { fprintf(stderr, "kernel_launch: unexpected shapes (n_in %d, ws %zu, out %d); nothing launched\n", n_in, ws_size, out_size); grid = -1; return; }
        int dev = 0, cus = 0, per_cu = 0;
        if (hipGetDevice(&dev) != hipSuccess || hipDeviceGetAttribute(&cus, hipDeviceAttributeMultiprocessorCount, dev) != hipSuccess) { grid = -1; return; }
        if (hipFuncSetAttribute((const void*)mk_fwd, hipFuncAttributeMaxDynamicSharedMemorySize, LDS_BYTES) != hipSuccess) { fprintf(stderr, "kernel_launch: hipFuncSetAttribute failed\n"); grid = -1; return; }
        if (hipOccupancyMaxActiveBlocksPerMultiprocessor(&per_cu, (const void*)mk_fwd, NTHR, LDS_BYTES) != hipSuccess || per_cu < 1) fprintf(stderr, "kernel_launch: occupancy query reports %d\n", per_cu);
        (void)hipGetLastError();
        grid = cus;
    }
    if (grid < 0) return;
    if (hipMemsetAsync((char*)d_ws + WS_CTL, 0, CTL_ZERO_BYTES, stream) != hipSuccess) return;
    Args a{};
    for (int i = 0; i < 28; ++i) a.in[i] = (const float*)d_in[i];
    a.out = (float*)d_out; a.ws = (unsigned char*)d_ws;
#if MK_ONE_LAUNCH
    a.ph_lo = 0; a.ph_hi = NSTEPS;
    hipLaunchKernelGGL(mk_fwd, dim3(grid), dim3(NTHR), LDS_BYTES, stream, a);
#else
    for (int s = 0; s < NSTEPS; ++s) { a.ph_lo = s; a.ph_hi = s + 1; hipLaunchKernelGGL(mk_fwd, dim3(grid), dim3(NTHR), LDS_BYTES, stream, a); }
#endif
}
```

```cpp
#include <hip/hip_runtime.h>
#include <cstdio>
#include <cstdint>
#define MK_DEBUG 0
#define CHK_MASK 0xFDFF
#define PEER_SLICED 0
#define PEER_SPLIT 1
namespace pg8 {
#define PG8_LAS __attribute__((address_space(3)))
typedef unsigned short bf16_t;
typedef short bf16x8 __attribute__((ext_vector_type(8)));
typedef float f32x4 __attribute__((ext_vector_type(4)));
typedef unsigned u32x4 __attribute__((ext_vector_type(4)));
constexpr int BM = 256, BK = 64, HALF = 128, HTB = HALF * BK * 2  , STAGE_BYTES = 8 * HTB, NXCD = 8, WGM = 8;

__host__ __device__ __forceinline__ int lds_byte(int r, int c) { const int st = (r >> 4) * 2 + (c >> 5), rr = r & 15, cc = c & 31, ob = rr * 64 + cc * 2; return st * 1024 + (ob ^ (((ob >> 9) & 1) << 5)); }
__host__ __device__ __forceinline__ void stage_rc(int b, int& R, int& C) { const int st = b / 1024, sb = b % 1024, swz = sb ^ (((sb >> 9) & 1) << 5); R = (st >> 1) * 16 + swz / 64; C = (st & 1) * 32 + (swz % 64) / 2; }
__host__ __device__ __forceinline__ int perm32(int rho) { const int n = rho >> 4, i = rho & 15; return 8 * (i >> 2) + 4 * n + (i & 3); }

struct Unit { int pm, pn; };
struct Gemm { const bf16_t* A; const bf16_t* Bt; int M, N, K; };

struct StaticOrder {
    int nM, nN, nwg, G, c;
    __host__ __device__ void init(int M, int N, int G_, int c_) { nM = M / BM; nN = N / BM; nwg = nM * nN; G = G_; c = c_; }
    __host__ __device__ bool next(int i, Unit& u) const {
        const long L = (long)i * G + c; if (L >= nwg) return false;
        int wgid = (int)L; { const int q = nwg / NXCD, r = nwg % NXCD, xcd = wgid % NXCD, off = wgid / NXCD; wgid = (xcd < r ? xcd * (q + 1) : r * (q + 1) + (xcd - r) * q) + off; }
        const int nig = WGM * nN, gid = wgid / nig, fm = gid * WGM, gsz = (nM - fm) < WGM ? (nM - fm) : WGM;
        u.pm = fm + ((wgid % nig) % gsz); u.pn = (wgid % nig) / gsz; return true;
    }
    __device__ __forceinline__ void a_ready(const Unit&) const {}
    __device__ __forceinline__ void done(const Unit&) const {}
};

__device__ __forceinline__ unsigned cvt_pk_bf16(float lo, float hi) { unsigned r; asm volatile("v_cvt_pk_bf16_f32 %0, %1, %2" : "=v"(r) : "v"(lo), "v"(hi)); return r; }
typedef float f32x2 __attribute__((ext_vector_type(2)));
struct RowOrder {
    int nM, nN, nwg, G, c, skip;
    __device__ __forceinline__ void init(int nM_, int nN_, int G_, int c_, int skip_) { nM = nM_; nN = nN_; nwg = nM * nN; G = G_; c = c_; skip = skip_; }
    __device__ __forceinline__ bool next(int i, Unit& u) const {
        const long L = (long)i * G + c; if (L >= nwg) return false;
        int wgid = (int)L; { const int q = nwg / NXCD, r = nwg % NXCD, xcd = wgid % NXCD, off = wgid / NXCD; wgid = (xcd < r ? xcd * (q + 1) : r * (q + 1) + (xcd - r) * q) + off; }
        const int nig = WGM * nN, gid = wgid / nig, fm = gid * WGM, gsz = (nM - fm) < WGM ? (nM - fm) : WGM;
        const int pm = fm + ((wgid % nig) % gsz); u.pn = (wgid % nig) / gsz;
        u.pm = skip ? (pm >> 3) * 9 + 1 + (pm & 7) : pm; return true;
    }
    __device__ __forceinline__ void a_ready(const Unit&) const {}
    __device__ __forceinline__ void done(const Unit&) const {}
};
typedef unsigned u32x4e __attribute__((ext_vector_type(4)));
struct EpiQKV {
    static constexpr bool PERM = true, AFTER_DRAIN = false;
    bf16_t* Q; bf16_t* K; bf16_t* V; int nq, nk; const float* cosT; const float* sinT; float qscale;
    __device__ __forceinline__ void operator()(const f32x4 (&acc)[2][2][4][2], const Unit& u, int wr, int wc, int fr, int fq) const {
        bf16_t* base; int kind, pl;
        if (u.pn < nq) { base = Q; kind = 0; pl = u.pn; } else if (u.pn < nq + nk) { base = K; kind = 1; pl = u.pn - nq; } else { base = V; kind = 2; pl = u.pn - nq - nk; }
        const int bq = u.pm / 9; const bool lat = (u.pm - bq * 9) != 0; const bool rope = lat && kind < 2;
        const float sc = (kind == 0) ? qscale : 1.f;
        const int row0 = u.pm * BM + wr * 64 + fr, col0 = pl * BM + wc * 32 + 8 * fq;
#pragma unroll
        for (int ai = 0; ai < 2; ++ai)
#pragma unroll
            for (int m = 0; m < 4; ++m) { const int row = row0 + ai * HALF + m * 16; const int t = row - bq * 2304 - 256;
                f32x4 cs = (f32x4){1.f, 1.f, 1.f, 1.f}, sn = (f32x4){0.f, 0.f, 0.f, 0.f};
                if (rope) { const int i0 = (col0 & 63) >> 1; cs = *(const f32x4*)(cosT + t * 32 + i0); sn = *(const f32x4*)(sinT + t * 32 + i0); }
#pragma unroll
                for (int bj = 0; bj < 2; ++bj) { const int col = col0 + bj * HALF; f32x4 v0 = acc[ai][bj][m][0], v1 = acc[ai][bj][m][1];
                    if (rope) {
                        float e, o;
                        e = v0[0]; o = v0[1]; v0[0] = e * cs[0] - o * sn[0]; v0[1] = e * sn[0] + o * cs[0];
                        e = v0[2]; o = v0[3]; v0[2] = e * cs[1] - o * sn[1]; v0[3] = e * sn[1] + o * cs[1];
                        e = v1[0]; o = v1[1]; v1[0] = e * cs[2] - o * sn[2]; v1[1] = e * sn[2] + o * cs[2];
                        e = v1[2]; o = v1[3]; v1[2] = e * cs[3] - o * sn[3]; v1[3] = e * sn[3] + o * cs[3]; }
                    v0 = v0 * sc; v1 = v1 * sc; u32x4e w; w.x = cvt_pk_bf16(v0[0], v0[1]); w.y = cvt_pk_bf16(v0[2], v0[3]); w.z = cvt_pk_bf16(v1[0], v1[1]); w.w = cvt_pk_bf16(v1[2], v1[3]);
                    *(u32x4e*)(base + (size_t)row * 1024 + col) = w; } }
    }
};
struct EpiPlain {
    static constexpr bool PERM = true, AFTER_DRAIN = false;
    bf16_t* O; int ldc;
    __device__ __forceinline__ void operator()(const f32x4 (&acc)[2][2][4][2], const Unit& u, int wr, int wc, int fr, int fq) const {
        const int row0 = u.pm * BM + wr * 64 + fr, col0 = u.pn * BM + wc * 32 + 8 * fq;
#pragma unroll
        for (int ai = 0; ai < 2; ++ai)
#pragma unroll
            for (int m = 0; m < 4; ++m) { bf16_t* rowp = O + (size_t)(row0 + ai * HALF + m * 16) * ldc + col0;
#pragma unroll
                for (int bj = 0; bj < 2; ++bj) { const f32x4 v0 = acc[ai][bj][m][0], v1 = acc[ai][bj][m][1];
                    u32x4e w; w.x = cvt_pk_bf16(v0[0], v0[1]); w.y = cvt_pk_bf16(v0[2], v0[3]); w.z = cvt_pk_bf16(v1[0], v1[1]); w.w = cvt_pk_bf16(v1[2], v1[3]);
                    *(u32x4e*)(rowp + bj * HALF) = w; } }
    }
};
__device__ __forceinline__ void unpack8(const u32x4e w, f32x4& lo, f32x4& hi) {
    lo[0] = __uint_as_float(w.x << 16); lo[1] = __uint_as_float(w.x & 0xffff0000u); lo[2] = __uint_as_float(w.y << 16); lo[3] = __uint_as_float(w.y & 0xffff0000u);
    hi[0] = __uint_as_float(w.z << 16); hi[1] = __uint_as_float(w.z & 0xffff0000u); hi[2] = __uint_as_float(w.w << 16); hi[3] = __uint_as_float(w.w & 0xffff0000u); }
struct EpiRes {
    static constexpr bool PERM = true, AFTER_DRAIN = false;
    const bf16_t* lat; bf16_t* R; const float* mod; float alpha;
    __device__ __forceinline__ void operator()(const f32x4 (&acc)[2][2][4][2], const Unit& u, int wr, int wc, int fr, int fq) const {
        const int bq = u.pm / 9; const int midx = ((u.pm - bq * 9) == 0) ? 16 : bq; const float* gate = mod + midx * 6144 + 2048;
        const int row0 = u.pm * BM + wr * 64 + fr, col0 = u.pn * BM + wc * 32 + 8 * fq;
#pragma unroll
        for (int bj = 0; bj < 2; ++bj) { const int col = col0 + bj * HALF; const f32x4 g0 = *(const f32x4*)(gate + col), g1 = *(const f32x4*)(gate + col + 4);
#pragma unroll
            for (int ai = 0; ai < 2; ++ai)
#pragma unroll
                for (int m = 0; m < 4; ++m) { const size_t off = (size_t)(row0 + ai * HALF + m * 16) * 1024 + col; f32x4 l0, l1; unpack8(*(const u32x4e*)(lat + off), l0, l1);
                    const f32x4 o0 = l0 * alpha + g0 * acc[ai][bj][m][0], o1 = l1 * alpha + g1 * acc[ai][bj][m][1];
                    u32x4e w; w.x = cvt_pk_bf16(o0[0], o0[1]); w.y = cvt_pk_bf16(o0[2], o0[3]); w.z = cvt_pk_bf16(o1[0], o1[1]); w.w = cvt_pk_bf16(o1[2], o1[3]); *(u32x4e*)(R + off) = w; } }
    }
};
struct EpiGlu {
    static constexpr bool PERM = true, AFTER_DRAIN = false;
    const bf16_t* lat; bf16_t* R; const float* mod; float alpha;
    __device__ __forceinline__ void operator()(const f32x4 (&acc)[2][2][4][2], const Unit& u, int wr, int wc, int fr, int fq) const {
        const int bq = u.pm / 9; const int midx = ((u.pm - bq * 9) == 0) ? 16 : bq; const float* gate = mod + midx * 6144 + 2048;
        const int row0 = u.pm * BM + wr * 64 + fr, col = u.pn * HALF + wc * 32 + 8 * fq;
        const f32x4 g0 = *(const f32x4*)(gate + col), g1 = *(const f32x4*)(gate + col + 4);
#pragma unroll
        for (int ai = 0; ai < 2; ++ai)
#pragma unroll
            for (int m = 0; m < 4; ++m) { const size_t off = (size_t)(row0 + ai * HALF + m * 16) * 1024 + col; f32x4 l0, l1; unpack8(*(const u32x4e*)(lat + off), l0, l1);
                f32x4 v0, v1;
#pragma unroll
                for (int j = 0; j < 4; ++j) { v0[j] = acc[ai][0][m][0][j] * __builtin_amdgcn_rcpf(1.f + __builtin_amdgcn_exp2f(-1.4426950408889634f * acc[ai][1][m][0][j]));
                    v1[j] = acc[ai][0][m][1][j] * __builtin_amdgcn_rcpf(1.f + __builtin_amdgcn_exp2f(-1.4426950408889634f * acc[ai][1][m][1][j])); }
                const f32x4 o0 = l0 * alpha + g0 * v0, o1 = l1 * alpha + g1 * v1;
                u32x4e w; w.x = cvt_pk_bf16(o0[0], o0[1]); w.y = cvt_pk_bf16(o0[2], o0[3]); w.z = cvt_pk_bf16(o1[0], o1[1]); w.w = cvt_pk_bf16(o1[2], o1[3]); *(u32x4e*)(R + off) = w; }
    }
};
template <class Epi, class Sched, bool ALIGN_EPI = false, bool SP2 = false>
__device__ __forceinline__ void gemm_phase(PG8_LAS unsigned char* lds, const Gemm g, const Sched& S, const Epi& E, const int tid_in) {
    const int tid = tid_in; const int wid = __builtin_amdgcn_readfirstlane(tid >> 6), lane = tid & 63, wr = wid >> 2, wc = wid & 3, fr = lane & 15, fq = lane >> 4;
    const int K = g.K, nt = K / BK;
    unsigned voffA[2], voffB[2];
#pragma unroll
    for (int i = 0; i < 2; ++i) { int R, C; stage_rc(tid * 16 + i * 8192, R, C); const int Rb = Epi::PERM ? ((R & ~31) + perm32(R & 31)) : R;
        voffA[i] = (unsigned)(R * K + C) * 2u; voffB[i] = (unsigned)(Rb * K + C) * 2u; }
    const size_t kstep = (size_t)(BK * 2);
    const size_t hstep = (size_t)HALF * K * 2;
    const size_t tstep = 2 * hstep;
    const unsigned ldsw = (unsigned)wid * 1024u;
    const int aoff = lds_byte(wr * 64 + fr, fq * 8), boff = lds_byte(wc * 32 + fr, fq * 8);
#define PG8_SA(b, h) (((b) * 2 + (h)) * HTB)
#define PG8_SB(b, h) ((4 + (b) * 2 + (h)) * HTB)
#define PG8_STAGE(bufoff, gbase, voff) do { _Pragma("unroll") for (int _i = 0; _i < 2; ++_i) \
        __builtin_amdgcn_global_load_lds((const unsigned*)((const char*)(gbase) + (voff)[_i]), (PG8_LAS unsigned*)(lds + (bufoff) + ldsw + _i * 8192), 16, 0, 0); } while (0)
#define PG8_LDA(dst, b, h) do { _Pragma("unroll") for (int m = 0; m < 4; ++m) _Pragma("unroll") for (int k = 0; k < 2; ++k) dst[m][k] = *(const PG8_LAS bf16x8*)(lds + PG8_SA(b, h) + aoff + m * 2048 + k * 1024); } while (0)
#define PG8_LDB(dst, b, h) do { _Pragma("unroll") for (int n = 0; n < 2; ++n) _Pragma("unroll") for (int k = 0; k < 2; ++k) dst[n][k] = *(const PG8_LAS bf16x8*)(lds + PG8_SB(b, h) + boff + n * 2048 + k * 1024); } while (0)
#define PG8_MMA(ai, bj, At, Bt) do { __builtin_amdgcn_s_setprio(1); _Pragma("unroll") for (int m = 0; m < 4; ++m) _Pragma("unroll") for (int n = 0; n < 2; ++n) _Pragma("unroll") for (int k = 0; k < 2; ++k) \
        acc[ai][bj][m][n] = __builtin_amdgcn_mfma_f32_16x16x32_bf16(Bt[n][k], At[m][k], acc[ai][bj][m][n], 0, 0, 0); __builtin_amdgcn_s_setprio(0); } while (0)
#define PG8_WAIT_V(n) asm volatile("s_waitcnt vmcnt(" #n ")" ::: "memory")
#define PG8_WAIT_L(n) asm volatile("s_waitcnt lgkmcnt(" #n ")" ::: "memory")
#define PG8_BAR __builtin_amdgcn_s_barrier()
#define PG8_SCHED __builtin_amdgcn_sched_barrier(0)
    Unit cur, nxt; int ui = 0;
    if (!S.next(0, cur)) return;
    f32x4 acc[2][2][4][2];
#pragma unroll
    for (int a = 0; a < 2; ++a)
#pragma unroll
        for (int b = 0; b < 2; ++b)
#pragma unroll
            for (int m = 0; m < 4; ++m)
#pragma unroll
                for (int n = 0; n < 2; ++n) acc[a][b][m][n] = (f32x4){0.f, 0.f, 0.f, 0.f};
    bf16x8 At[4][2], B0[2][2], B1[2][2];
    const char* cA = (const char*)g.A + (size_t)cur.pm * tstep; const char* cB = (const char*)g.Bt + (size_t)cur.pn * tstep;
    S.a_ready(cur);
    if constexpr (SP2) {
        PG8_STAGE(PG8_SB(0, 0), cB, voffB); PG8_STAGE(PG8_SB(0, 1), cB + hstep, voffB); PG8_STAGE(PG8_SA(0, 0), cA, voffA); PG8_STAGE(PG8_SA(0, 1), cA + hstep, voffA);
        if (wr == 1) PG8_BAR;
        PG8_WAIT_V(2); PG8_BAR;
        PG8_STAGE(PG8_SB(1, 0), cB + kstep, voffB); PG8_STAGE(PG8_SA(1, 0), cA + kstep, voffA); PG8_STAGE(PG8_SB(1, 1), cB + hstep + kstep, voffB);
        PG8_WAIT_V(6); PG8_BAR;
    } else {
        PG8_STAGE(PG8_SB(0, 0), cB, voffB); PG8_STAGE(PG8_SA(0, 0), cA, voffA); PG8_STAGE(PG8_SB(0, 1), cB + hstep, voffB); PG8_STAGE(PG8_SA(0, 1), cA + hstep, voffA);
        if (wr == 1) PG8_BAR;
        PG8_WAIT_V(4); PG8_BAR;
        PG8_STAGE(PG8_SB(1, 0), cB + kstep, voffB); PG8_STAGE(PG8_SA(1, 0), cA + kstep, voffA); PG8_STAGE(PG8_SB(1, 1), cB + hstep + kstep, voffB);
        PG8_WAIT_V(6); PG8_BAR;
    }
    for (;;) {
        const bool has_next = S.next(ui + 1, nxt);
        const char* nA = has_next ? (const char*)g.A + (size_t)nxt.pm * tstep : cA; const char* nB = has_next ? (const char*)g.Bt + (size_t)nxt.pn * tstep : cB;
        for (int t = 0; t < nt; t += 2) {
            const bool last = (t == nt - 2);
            const char* a1 = cA + (size_t)(t + 1) * kstep;
            const char* a2 = last ? nA : cA + (size_t)(t + 2) * kstep; const char* b2 = last ? nB : cB + (size_t)(t + 2) * kstep;
            const char* a3 = a2 + kstep; const char* b3 = b2 + kstep;
            if (last && has_next) S.a_ready(nxt);
            if constexpr (SP2) {
            PG8_LDB(B0, 0, 0); PG8_LDB(B1, 0, 1); PG8_SCHED; PG8_LDA(At, 0, 0); PG8_STAGE(PG8_SA(1, 1), a1 + hstep, voffA);
            PG8_WAIT_V(8); PG8_WAIT_L(0); PG8_BAR; PG8_MMA(0, 0, At, B0); PG8_MMA(0, 1, At, B1); PG8_BAR; PG8_SCHED;
            PG8_LDA(At, 0, 1); PG8_STAGE(PG8_SB(0, 0), b2, voffB); PG8_STAGE(PG8_SB(0, 1), b2 + hstep, voffB); PG8_STAGE(PG8_SA(0, 0), a2, voffA);
            PG8_WAIT_V(8); PG8_WAIT_L(0); PG8_BAR; PG8_MMA(1, 0, At, B0); PG8_MMA(1, 1, At, B1); PG8_BAR; PG8_SCHED;
            PG8_LDB(B0, 1, 0); PG8_LDB(B1, 1, 1); PG8_SCHED; PG8_LDA(At, 1, 0); PG8_STAGE(PG8_SA(0, 1), a2 + hstep, voffA);
            PG8_WAIT_V(8); PG8_WAIT_L(0); PG8_BAR; PG8_MMA(0, 0, At, B0); PG8_MMA(0, 1, At, B1); PG8_BAR; PG8_SCHED;
            PG8_LDA(At, 1, 1); PG8_STAGE(PG8_SB(1, 0), b3, voffB); PG8_STAGE(PG8_SB(1, 1), b3 + hstep, voffB); PG8_STAGE(PG8_SA(1, 0), a3, voffA);
            PG8_WAIT_V(8); PG8_WAIT_L(0); PG8_BAR; PG8_MMA(1, 0, At, B0); PG8_MMA(1, 1, At, B1); PG8_BAR; PG8_SCHED;
            } else {
            PG8_LDB(B0, 0, 0); PG8_SCHED; PG8_LDA(At, 0, 0); PG8_STAGE(PG8_SA(1, 1), a1 + hstep, voffA);
            PG8_WAIT_L(8); PG8_BAR; PG8_WAIT_L(0); PG8_MMA(0, 0, At, B0); PG8_BAR; PG8_SCHED;
            PG8_LDB(B1, 0, 1); PG8_STAGE(PG8_SB(0, 0), b2, voffB);
            PG8_BAR; PG8_WAIT_L(0); PG8_MMA(0, 1, At, B1); PG8_BAR;
            PG8_LDA(At, 0, 1); PG8_STAGE(PG8_SA(0, 0), a2, voffA);
            PG8_BAR; PG8_WAIT_L(0); PG8_MMA(1, 0, At, B0); PG8_BAR; PG8_SCHED;
            PG8_STAGE(PG8_SB(0, 1), b2 + hstep, voffB);
            PG8_WAIT_V(6); PG8_BAR; PG8_MMA(1, 1, At, B1); PG8_BAR;
            PG8_LDB(B0, 1, 0); PG8_SCHED; PG8_LDA(At, 1, 0); PG8_STAGE(PG8_SA(0, 1), a2 + hstep, voffA);
            PG8_WAIT_L(8); PG8_BAR; PG8_WAIT_L(0); PG8_MMA(0, 0, At, B0); PG8_BAR; PG8_SCHED;
            PG8_LDB(B1, 1, 1); PG8_STAGE(PG8_SB(1, 0), b3, voffB);
            PG8_BAR; PG8_WAIT_L(0); PG8_MMA(0, 1, At, B1); PG8_BAR;
            PG8_LDA(At, 1, 1); PG8_STAGE(PG8_SA(1, 0), a3, voffA);
            PG8_BAR; PG8_WAIT_L(0); PG8_MMA(1, 0, At, B0); PG8_BAR; PG8_SCHED;
            PG8_STAGE(PG8_SB(1, 1), b3 + hstep, voffB);
            PG8_WAIT_V(6); PG8_BAR; PG8_MMA(1, 1, At, B1); PG8_BAR;
            }
        }
        if constexpr (ALIGN_EPI) { if (wr == 0) PG8_BAR; }
        if constexpr (!Epi::AFTER_DRAIN) { E(acc, cur, wr, wc, fr, fq); S.done(cur); }
        if (!has_next) break;
#pragma unroll
        for (int a = 0; a < 2; ++a)
#pragma unroll
            for (int b = 0; b < 2; ++b)
#pragma unroll
                for (int m = 0; m < 4; ++m)
#pragma unroll
                    for (int n = 0; n < 2; ++n) acc[a][b][m][n] = (f32x4){0.f, 0.f, 0.f, 0.f};
        cur = nxt; cA = nA; cB = nB; ++ui;
        if constexpr (ALIGN_EPI) { if (wr == 1) PG8_BAR; }
    }
    PG8_WAIT_V(0);
    if constexpr (!ALIGN_EPI) { if (wr == 0) PG8_BAR; }
    PG8_BAR;
    if constexpr (Epi::AFTER_DRAIN) { E.fused(acc, cur, wr, wc, fr, fq, lds, wid, lane); S.done(cur); }
#undef PG8_SA
#undef PG8_SB
#undef PG8_STAGE
#undef PG8_LDA
#undef PG8_LDB
#undef PG8_MMA
#undef PG8_WAIT_V
#undef PG8_WAIT_L
#undef PG8_BAR
#undef PG8_SCHED
}
}
#include <hip/hip_bf16.h>
#include <cmath>
namespace attn_body {
using bf16=__hip_bfloat16;
using bf16x8=__attribute__((ext_vector_type(8)))short;
using s16x4=__attribute__((ext_vector_type(4)))short;
using f32x16=__attribute__((ext_vector_type(16)))float;
using u32x4=__attribute__((ext_vector_type(4)))unsigned;
constexpr int D=64,DM=1024;
constexpr int NW=8,QBLK=32,QB=QBLK*NW,KVBLK=64;
constexpr int ATTN_PITCH=DM, ATTN_UNIT_ROWS=QB;
__device__ __forceinline__ int crow(int r,int hi){return (r&3)+8*(r>>2)+4*hi;}
#define SBAR() __builtin_amdgcn_sched_barrier(0)
__device__ __forceinline__ void bandmask(f32x16&p0,f32x16&p1,int kb,int qpos,int hi){
  const float NEG=-INFINITY; const int d0=kb+4*hi-qpos;
  #pragma unroll
  for(int r=0;r<16;++r){const int d=d0+(r&3)+8*(r>>2); if(d>128||d<-128)p0[r]=NEG; if(d+32>128||d+32<-128)p1[r]=NEG;}
}

constexpr int NSLOT=3, SLOTB=8192;
constexpr int LDS_K=0, LDS_V=NSLOT*SLOTB, LDS_WS=2*NSLOT*SLOTB, LDS_OST=LDS_WS+NW*64*4, LDS_BYTES=LDS_OST+NW*4096;
constexpr float C2=0.125f*1.4426950408889634f;
__device__ __forceinline__ void glds16(const void*gsrc,unsigned lds_dst){unsigned keep;
  asm volatile("s_mov_b32 %0, m0\n\ts_mov_b32 m0, %2\n\ts_nop 0\n\tglobal_load_lds_dwordx4 %1, off\n\ts_mov_b32 m0, %0":"=&s"(keep):"v"(gsrc),"s"(lds_dst):"memory");}
__device__ __forceinline__ float max3f(float a,float b,float c){float r;asm("v_max3_f32 %0, %1, %2, %3":"=v"(r):"v"(a),"v"(b),"v"(c));return r;}
__device__ __forceinline__ float max2f(float a,float b){float r;asm("v_max_f32_e32 %0, %1, %2":"=v"(r):"v"(a),"v"(b));return r;}
__device__ __forceinline__ float fadd_s(float a,float b){float r;asm("v_add_f32_e32 %0, %1, %2":"=v"(r):"v"(a),"v"(b));return r;}
__device__ __forceinline__ float fsub_s(float a,float b){float r;asm("v_sub_f32_e32 %0, %1, %2":"=v"(r):"v"(a),"v"(b));return r;}
typedef float f32x2_t __attribute__((ext_vector_type(2))); typedef __bf16 bf16x2_t __attribute__((ext_vector_type(2)));
__device__ __forceinline__ unsigned cvtpk_s(float lo,float hi){f32x2_t v={lo,hi};bf16x2_t b=__builtin_convertvector(v,bf16x2_t);return __builtin_bit_cast(unsigned,b);}
#define WAIT_BAR(N) asm volatile("s_waitcnt vmcnt(" #N ") lgkmcnt(0)\n\ts_barrier":::"memory")

__device__ __forceinline__ void qkt(f32x16&p0,f32x16&p1,const char*Kslot,const bf16x8*qr,const f32x16&negm,int r32,int hi){
  const char*kb=Kslot+hi*1024+r32*16;
  #pragma unroll
  for(int d0=0;d0<4;++d0){
    const bf16x8 b0=*reinterpret_cast<const bf16x8*>(kb+d0*2048);
    const bf16x8 b1=*reinterpret_cast<const bf16x8*>(kb+d0*2048+512);
    if(d0==0){p0=__builtin_amdgcn_mfma_f32_32x32x16_bf16(b0,qr[0],negm,0,0,0);p1=__builtin_amdgcn_mfma_f32_32x32x16_bf16(b1,qr[0],negm,0,0,0);}
    else{p0=__builtin_amdgcn_mfma_f32_32x32x16_bf16(b0,qr[d0],p0,0,0,0);p1=__builtin_amdgcn_mfma_f32_32x32x16_bf16(b1,qr[d0],p1,0,0,0);}}
}
typedef __attribute__((address_space(3))) const char* lds_cptr;
typedef short v4i16_t __attribute__((ext_vector_type(4)));
__device__ __forceinline__ void kload8(bf16x8*kf,lds_cptr kp){
  kf[0]=*(const __attribute__((address_space(3))) bf16x8*)(kp);      kf[1]=*(const __attribute__((address_space(3))) bf16x8*)(kp+512);
  kf[2]=*(const __attribute__((address_space(3))) bf16x8*)(kp+2048); kf[3]=*(const __attribute__((address_space(3))) bf16x8*)(kp+2560);
  kf[4]=*(const __attribute__((address_space(3))) bf16x8*)(kp+4096); kf[5]=*(const __attribute__((address_space(3))) bf16x8*)(kp+4608);
  kf[6]=*(const __attribute__((address_space(3))) bf16x8*)(kp+6144); kf[7]=*(const __attribute__((address_space(3))) bf16x8*)(kp+6656);
}
__device__ __forceinline__ void kload2(bf16x8*kf,lds_cptr kp,int j){ kf[2*j]=*(const __attribute__((address_space(3))) bf16x8*)(kp+j*2048); kf[2*j+1]=*(const __attribute__((address_space(3))) bf16x8*)(kp+j*2048+512); }
__device__ __forceinline__ s16x4 vtr(lds_cptr p){ return __builtin_bit_cast(s16x4,__builtin_amdgcn_ds_read_tr16_b64_v4i16((__attribute__((address_space(3))) v4i16_t*)p)); }
__device__ __forceinline__ float rowmax(const f32x16&p0,const f32x16&p1){
  float a=max3f(p0[0],p0[1],p1[0]),b=max3f(p0[2],p0[3],p1[1]);a=max3f(a,p1[2],p1[3]);
  #pragma unroll
  for(int r=4;r<16;r+=4){a=max3f(a,p0[r],p0[r+1]);b=max3f(b,p0[r+2],p0[r+3]);a=max3f(a,p1[r],p1[r+1]);b=max3f(b,p1[r+2],p1[r+3]);}
  const float m=max2f(a,b);
  auto rr=__builtin_amdgcn_permlane32_swap(__float_as_uint(m),__float_as_uint(m),false,false);
  return max2f(__uint_as_float(rr[0]),__uint_as_float(rr[1]));
}
__device__ __forceinline__ void pv(f32x16*o,int vb,bf16x8 pa0,bf16x8 pa1,bf16x8 pa2,bf16x8 pa3){
  #pragma unroll
  for(int d0=0;d0<2;++d0){s16x4 lo[4],hi[4];
    #pragma unroll
    for(int ks=0;ks<4;++ks){
      asm volatile("ds_read_b64_tr_b16 %0,%1 offset:%c2":"=&v"(lo[ks]):"v"(vb),"i"(d0*4096+ks*1024):"memory");
      asm volatile("ds_read_b64_tr_b16 %0,%1 offset:%c2":"=&v"(hi[ks]):"v"(vb),"i"(d0*4096+ks*1024+512):"memory");}
    asm volatile("s_waitcnt lgkmcnt(0)":::"memory");SBAR();
    #define PK(k) (bf16x8){lo[k][0],lo[k][1],lo[k][2],lo[k][3],hi[k][0],hi[k][1],hi[k][2],hi[k][3]}
    o[d0]=__builtin_amdgcn_mfma_f32_32x32x16_bf16(pa0,PK(0),o[d0],0,0,0);
    o[d0]=__builtin_amdgcn_mfma_f32_32x32x16_bf16(pa1,PK(1),o[d0],0,0,0);
    o[d0]=__builtin_amdgcn_mfma_f32_32x32x16_bf16(pa2,PK(2),o[d0],0,0,0);
    o[d0]=__builtin_amdgcn_mfma_f32_32x32x16_bf16(pa3,PK(3),o[d0],0,0,0);
    #undef PK
  }
}

#ifndef ATTN_STORE16
#define ATTN_STORE16(p,v) (*(u32x4*)(p)=(v))
#endif
struct UnitDesc { const bf16* Q; const bf16* K; const bf16* V; bf16* O; int NT, latoff, kpos4, qpos0; float sink2; };
template<int THRL,bool MASK> __device__ __forceinline__ void attn_unit(const UnitDesc&u,char*shm,const int tid_in){
  const int tid=tid_in; const int lane=tid&63,r32=lane&31,hi=lane>>5; const int wid=__builtin_amdgcn_readfirstlane(tid>>6);
  const int u_latoff=u.latoff;
  const bf16*Qw=u.Q+(long)(wid*QBLK)*DM;
  const bf16*Kh=u.K,*Vh=u.V;
  const unsigned lds0=(unsigned)(uintptr_t)shm;
  float*wsf=(float*)(shm+LDS_WS)+wid*64;
  const bf16*ksrc=Kh+(long)lane*DM+wid*8;
  const bf16*vsrc=Vh+(long)(16*(wid&3)+(lane>>2))*DM+(wid>>2)*32+(lane&3)*8;
  const unsigned kdst=lds0+LDS_K+wid*1024, vdst=lds0+LDS_V+wid*1024;
  #define TOFF(t) ((long)(((t)<4)?(t)*KVBLK:u_latoff+((t)-4)*KVBLK)*DM)
  #define DMA_K(t,slot) glds16(ksrc+TOFF(t),(unsigned)__builtin_amdgcn_readfirstlane(kdst+(slot)))
  #define DMA_V(t,slot) glds16(vsrc+TOFF(t),(unsigned)__builtin_amdgcn_readfirstlane(vdst+(slot)))
  const int vb0=(int)(lds0+LDS_V)+((lane>>4)&1)*32+(lane&3)*8+(4*hi+((lane&15)>>2))*64;
  const char*Kbase=shm+LDS_K; bf16x8 kf[8];
  const lds_cptr shm3=(lds_cptr)shm; const lds_cptr kp0=shm3+LDS_K+hi*1024+r32*16; const lds_cptr vp0=shm3+LDS_V+((lane>>4)&1)*32+(lane&3)*8+(4*hi+((lane&15)>>2))*64;
  const int NT=u.NT;
  DMA_K(0,0);DMA_V(0,0);DMA_K(1,SLOTB);
  bf16x8 qr[4];
  #pragma unroll
  for(int d0=0;d0<4;++d0)qr[d0]=*reinterpret_cast<const bf16x8*>(&Qw[(long)r32*DM+d0*16+hi*8]);
  float mhat=0.f,l_reg=0.f;f32x16 o[2];o[0]=f32x16{};o[1]=f32x16{};const f32x16 negm=f32x16{};
  const int qpos=u.qpos0+wid*QBLK+r32; const int kpos4=u.kpos4;
  #define CMASK(P0,P1,t) do{ if constexpr(MASK){ if((t)>=4) bandmask(P0,P1,kpos4+((t)-4)*KVBLK,qpos,hi); } }while(0)
  bool resc=false;
  #define START(P0,P1) do{ const float rm=rowmax(P0,P1); resc=false; \
    { const float dl=rm; mhat=fadd_s(mhat,dl); \
      _Pragma("unroll") for(int r=0;r<16;++r){P0[r]=fsub_s(P0[r],dl);P1[r]=fsub_s(P1[r],dl);} \
      } \
    _Pragma("unroll") for(int r=0;r<16;++r)P0[r]=__builtin_amdgcn_exp2f(P0[r]); }while(0)
  #define RESC() do{ if(resc){ asm volatile("s_waitcnt lgkmcnt(0)":::"memory"); \
      _Pragma("unroll") for(int d_=0;d_<2;++d_) _Pragma("unroll") for(int r=0;r<16;++r)o[d_][r]*=wsf[crow(r,hi)]; } }while(0)
  f32x16 pA0,pA1,pB0,pB1;
  int sl_prev=0,sl_cur=0,sl_next=SLOTB;
  #define ROT() do{sl_prev=sl_cur;sl_cur=sl_next;sl_next=(sl_next==(NSLOT-1)*SLOTB)?0:sl_next+SLOTB;}while(0)
  DMA_K(2,2*SLOTB);
  WAIT_BAR(3);
  qkt(pA0,pA1,Kbase,qr,negm,r32,hi);asm volatile("s_nop 15\n\ts_nop 7":"+v"(pA0),"+v"(pA1));CMASK(pA0,pA1,0);
  START(pA0,pA1);
  _Pragma("unroll") for(int r=0;r<16;++r)pA1[r]=__builtin_amdgcn_exp2f(pA1[r]);
  WAIT_BAR(0);
  DMA_K(3,0);DMA_V(1,SLOTB);
  ROT();
  kload8(kf,kp0+sl_cur);
  WAIT_BAR(2);
  s16x4 vlo[8],vhi[8]; u32x4 pw0,pw1,pw2,pw3;
  #define PKW(P,B) cvtpk_s(P[B],P[B+1])
  #define PAF(k) __builtin_bit_cast(bf16x8,pw##k)
  #define VFR(i) (bf16x8){vlo[i][0],vlo[i][1],vlo[i][2],vlo[i][3],vhi[i][0],vhi[i][1],vhi[i][2],vhi[i][3]}
  #define PIN(x) asm volatile("":"+v"(x))
  #define MX3(a,b,c) __builtin_fmaxf(__builtin_fmaxf((a),(b)),(c))
  #define GAPA(MF,A0,A1,A2,A3,W0,W1,PW) do{ MF; sacc+=A0; sacc+=A1; sacc+=A2; sacc+=A3; PIN(sacc); W0; W1; PIN(PW); SBAR(); }while(0)
  #define EX(v) __builtin_amdgcn_exp2f(v)
  #define GAPB(MF,X,B) do{ MF; X[B]=EX(X[B]); X[B+1]=EX(X[B+1]); X[B+2]=EX(X[B+2]); X[B+3]=EX(X[B+3]); PIN(X); SBAR(); }while(0)
  #define VRD(i) do{ vlo[i]=vtr(vp_+(((i)>>2)*4096+((i)&3)*1024)); vhi[i]=vtr(vp_+(((i)>>2)*4096+((i)&3)*1024+512)); }while(0)
  #define KRD(G,j) do{ if(G){ kload2(kf,kp0+sl_next,j); SBAR(); } }while(0)
  #define STEP(C0,C1,P0,P1,t,GK,GV,GL) do{ SBAR(); \
    const lds_cptr vp_=vp0+sl_prev; \
    VRD(0); SBAR(); float sacc=(P0[0]+P0[1]); \
    GAPA(C0=__builtin_amdgcn_mfma_f32_32x32x16_bf16(kf[0],qr[0],negm,0,0,0), P0[2],P0[3],P0[4],P0[5],     pw0[0]=PKW(P0,0), pw0[1]=PKW(P0,2), pw0); \
    VRD(4); SBAR(); GAPA(C1=__builtin_amdgcn_mfma_f32_32x32x16_bf16(kf[1],qr[0],negm,0,0,0), P0[6],P0[7],P0[8],P0[9],     pw0[2]=PKW(P0,4), pw0[3]=PKW(P0,6), pw0); \
    VRD(1); SBAR(); GAPA(C0=__builtin_amdgcn_mfma_f32_32x32x16_bf16(kf[2],qr[1],C0,0,0,0),   P0[10],P0[11],P0[12],P0[13], pw1[0]=PKW(P0,8), pw1[1]=PKW(P0,10), pw1); \
    VRD(5); SBAR(); GAPA(C1=__builtin_amdgcn_mfma_f32_32x32x16_bf16(kf[3],qr[1],C1,0,0,0),   P0[14],P0[15],P1[0],P1[1],   pw1[2]=PKW(P0,12),pw1[3]=PKW(P0,14), pw1); \
    VRD(2); SBAR(); GAPA(C0=__builtin_amdgcn_mfma_f32_32x32x16_bf16(kf[4],qr[2],C0,0,0,0),   P1[2],P1[3],P1[4],P1[5],     pw2[0]=PKW(P1,0), pw2[1]=PKW(P1,2), pw2); \
    VRD(6); SBAR(); GAPA(C1=__builtin_amdgcn_mfma_f32_32x32x16_bf16(kf[5],qr[2],C1,0,0,0),   P1[6],P1[7],P1[8],P1[9],     pw2[2]=PKW(P1,4), pw2[3]=PKW(P1,6), pw2); \
    VRD(3); SBAR(); GAPA(C0=__builtin_amdgcn_mfma_f32_32x32x16_bf16(kf[6],qr[3],C0,0,0,0),   P1[10],P1[11],P1[12],P1[13], pw3[0]=PKW(P1,8), pw3[1]=PKW(P1,10), pw3); \
    VRD(7); SBAR(); GAPA(C1=__builtin_amdgcn_mfma_f32_32x32x16_bf16(kf[7],qr[3],C1,0,0,0),   P1[14],P1[15],0.f,0.f,       pw3[2]=PKW(P1,12),pw3[3]=PKW(P1,14), pw3); \
    l_reg+=sacc; \
    if(GK){DMA_K((t)+3,sl_cur);} if(GV){DMA_V((t)+1,sl_next);} \
    CMASK(C0,C1,t); \
    { float a=MX3(C0[0],C0[1],C1[0]),b=MX3(C0[2],C0[3],C1[1]); a=MX3(a,C1[2],C1[3]); \
      _Pragma("unroll") for(int r=4;r<16;r+=4){a=MX3(a,C0[r],C0[r+1]);b=MX3(b,C0[r+2],C0[r+3]);a=MX3(a,C1[r],C1[r+1]);b=MX3(b,C1[r+2],C1[r+3]);} \
      float rm=__builtin_fmaxf(a,b); { auto rr=__builtin_amdgcn_permlane32_swap(__float_as_uint(rm),__float_as_uint(rm),false,false); rm=__builtin_fmaxf(__uint_as_float(rr[0]),__uint_as_float(rr[1])); } \
      rm-=mhat; resc=false; \
      if(__builtin_expect(__any(rm>(float)THRL),0)){ const float dl=__builtin_fmaxf(rm,0.f); mhat+=dl; \
        const float f=__builtin_amdgcn_exp2f(-dl); l_reg*=f; if(hi==0)wsf[r32]=f; resc=true; } \
      _Pragma("unroll") for(int r=0;r<16;++r){C0[r]-=mhat;C1[r]-=mhat;} } \
    SBAR(); \
    GAPB(o[0]=__builtin_amdgcn_mfma_f32_32x32x16_bf16(PAF(0),VFR(0),o[0],0,0,0), C0,0); \
    GAPB(o[1]=__builtin_amdgcn_mfma_f32_32x32x16_bf16(PAF(0),VFR(4),o[1],0,0,0), C0,4); \
    KRD(GL,0); GAPB(o[0]=__builtin_amdgcn_mfma_f32_32x32x16_bf16(PAF(1),VFR(1),o[0],0,0,0), C0,8); \
    KRD(GL,1); GAPB(o[1]=__builtin_amdgcn_mfma_f32_32x32x16_bf16(PAF(1),VFR(5),o[1],0,0,0), C0,12); \
    KRD(GL,2); GAPB(o[0]=__builtin_amdgcn_mfma_f32_32x32x16_bf16(PAF(2),VFR(2),o[0],0,0,0), C1,0); \
    KRD(GL,3); GAPB(o[1]=__builtin_amdgcn_mfma_f32_32x32x16_bf16(PAF(2),VFR(6),o[1],0,0,0), C1,4); \
    GAPB(o[0]=__builtin_amdgcn_mfma_f32_32x32x16_bf16(PAF(3),VFR(3),o[0],0,0,0), C1,8); \
    GAPB(o[1]=__builtin_amdgcn_mfma_f32_32x32x16_bf16(PAF(3),VFR(7),o[1],0,0,0), C1,12); \
    }while(0)
  int t=1;


  if constexpr(!MASK) for(;t+5<NT;t+=2){
    STEP(pB0,pB1,pA0,pA1,t,true,true,true);     WAIT_BAR(2); RESC(); ROT();
    STEP(pA0,pA1,pB0,pB1,t+1,true,true,true);   WAIT_BAR(2); RESC(); ROT();
  }


  #define ENDW(tt) do{ if((tt)+3<NT){WAIT_BAR(2);} else if((tt)+2<NT){WAIT_BAR(1);} else {WAIT_BAR(0);} }while(0)
  for(;t+1<NT;t+=2){
    STEP(pB0,pB1,pA0,pA1,t,(t+3<NT),(t+1<NT),(t+1<NT));       ENDW(t);   RESC(); ROT();
    STEP(pA0,pA1,pB0,pB1,t+1,(t+4<NT),(t+2<NT),(t+2<NT));     ENDW(t+1); RESC(); ROT();
  }
  STEP(pB0,pB1,pA0,pA1,NT-1,false,false,false); RESC();
  { float sacc=pB0[0]+pB0[1]; _Pragma("unroll") for(int r=2;r<16;++r)sacc+=pB0[r]; _Pragma("unroll") for(int r=0;r<16;++r)sacc+=pB1[r]; l_reg+=sacc;
    pw0=(u32x4){PKW(pB0,0),PKW(pB0,2),PKW(pB0,4),PKW(pB0,6)};pw1=(u32x4){PKW(pB0,8),PKW(pB0,10),PKW(pB0,12),PKW(pB0,14)};pw2=(u32x4){PKW(pB1,0),PKW(pB1,2),PKW(pB1,4),PKW(pB1,6)};pw3=(u32x4){PKW(pB1,8),PKW(pB1,10),PKW(pB1,12),PKW(pB1,14)};
    SBAR(); pv(o,vb0+sl_cur,PAF(0),PAF(1),PAF(2),PAF(3)); }
  #undef PKW
  #undef PAF
  #undef VFR
  #undef PIN
  #undef MX3
  #undef GAPA
  #undef GAPB
  #undef EX
  #undef VRD
  #undef KRD
  #undef STEP
  #undef ENDW
  {auto rr=__builtin_amdgcn_permlane32_swap(__float_as_uint(l_reg),__float_as_uint(l_reg),false,false);l_reg=__uint_as_float(rr[0])+__uint_as_float(rr[1]); l_reg+=__builtin_amdgcn_exp2f(u.sink2-mhat);}
  if(hi==0)wsf[32+r32]=l_reg;asm volatile("s_waitcnt lgkmcnt(0)":::"memory");
  float rli[16];
  #pragma unroll
  for(int r=0;r<16;++r)rli[r]=__builtin_amdgcn_rcpf(wsf[32+crow(r,hi)]);
  bf16*Ow=u.O+(long)(wid*QBLK)*DM;
  { bf16*stg=(bf16*)(shm+LDS_OST)+wid*2048;
    #pragma unroll
    for(int r=0;r<16;++r){const int orow=crow(r,hi);
      #pragma unroll
      for(int d0=0;d0<2;++d0)stg[orow*64+d0*32+r32]=__float2bfloat16(o[d0][r]*rli[r]);}
    asm volatile("s_waitcnt lgkmcnt(0)":::"memory");
    #pragma unroll
    for(int i=0;i<4;++i){const int row=i*8+(lane>>3),ch=lane&7; const u32x4 v=*(const u32x4*)(stg+row*64+ch*8); ATTN_STORE16(Ow+(long)row*DM+ch*8,v);} }
  asm volatile("s_waitcnt lgkmcnt(0)\n\ts_barrier":::"memory");
  #undef TOFF
  #undef DMA_K
  #undef DMA_V
  #undef CMASK
  #undef START
  #undef RESC
  #undef ROT
}

constexpr int SLOTV=16384;
constexpr int LDS2_V=NSLOT*SLOTB, LDS2_WS=LDS2_V+NSLOT*SLOTV, LDS2_OST=LDS2_WS+NW*64*4, LDS2_BYTES=LDS2_OST+NW*4096;
template<int THRL> __device__ __forceinline__ void attn_unit_v128(const UnitDesc&u,char*shm,const int tid_in){
  const int tid=tid_in; const int lane=tid&63,r32=lane&31,hi=lane>>5; const int wid=__builtin_amdgcn_readfirstlane(tid>>6);
  const int u_latoff=u.latoff;
  const bf16*Qw=u.Q+(long)(wid*QBLK)*DM;
  const bf16*Kh=u.K,*Vh=u.V;
  const unsigned lds0=(unsigned)(uintptr_t)shm;
  float*wsf=(float*)(shm+LDS2_WS)+wid*64;
  const bf16*ksrc=Kh+(long)lane*DM+wid*8;
  const bf16*vsrc=Vh+(long)(16*(wid&3)+(lane>>2))*DM+(wid>>2)*32+(lane&3)*8;
  const unsigned kdst=lds0+LDS_K+wid*1024, vdst=lds0+LDS2_V+wid*1024;
  #define TOFF(t) ((long)(((t)<4)?(t)*KVBLK:u_latoff+((t)-4)*KVBLK)*DM)
  #define DMA_K(t,slot) glds16(ksrc+TOFF(t),(unsigned)__builtin_amdgcn_readfirstlane(kdst+(slot)))
  #define DMA_V(t,slot) do{ glds16(vsrc+TOFF(t),(unsigned)__builtin_amdgcn_readfirstlane(vdst+2*(slot))); glds16(vsrc+64+TOFF(t),(unsigned)__builtin_amdgcn_readfirstlane(vdst+2*(slot)+8192)); }while(0)
  const int vb0=(int)(lds0+LDS2_V)+((lane>>4)&1)*32+(lane&3)*8+(4*hi+((lane&15)>>2))*64;
  const char*Kbase=shm+LDS_K; bf16x8 kf[8];
  const lds_cptr shm3=(lds_cptr)shm; const lds_cptr kp0=shm3+LDS_K+hi*1024+r32*16; const lds_cptr vp0=shm3+LDS2_V+((lane>>4)&1)*32+(lane&3)*8+(4*hi+((lane&15)>>2))*64;
  const int NT=u.NT;
  DMA_K(0,0);DMA_V(0,0);DMA_K(1,SLOTB);
  bf16x8 qr[4];
  #pragma unroll
  for(int d0=0;d0<4;++d0)qr[d0]=*reinterpret_cast<const bf16x8*>(&Qw[(long)r32*DM+d0*16+hi*8]);
  float mhat=0.f,l_reg=0.f;f32x16 o[4];o[0]=f32x16{};o[1]=f32x16{};o[2]=f32x16{};o[3]=f32x16{};const f32x16 negm=f32x16{};
  bool resc=false;
  #define START(P0,P1) do{ const float rm=rowmax(P0,P1); resc=false; \
    { const float dl=rm; mhat=fadd_s(mhat,dl); \
      _Pragma("unroll") for(int r=0;r<16;++r){P0[r]=fsub_s(P0[r],dl);P1[r]=fsub_s(P1[r],dl);} \
      } \
    _Pragma("unroll") for(int r=0;r<16;++r)P0[r]=__builtin_amdgcn_exp2f(P0[r]); }while(0)
  #define RESC() do{ if(resc){ asm volatile("s_waitcnt lgkmcnt(0)":::"memory"); \
      _Pragma("unroll") for(int d_=0;d_<4;++d_) _Pragma("unroll") for(int r=0;r<16;++r)o[d_][r]*=wsf[crow(r,hi)]; } }while(0)
  f32x16 pA0,pA1,pB0,pB1;
  int sl_prev=0,sl_cur=0,sl_next=SLOTB;
  #define ROT() do{sl_prev=sl_cur;sl_cur=sl_next;sl_next=(sl_next==(NSLOT-1)*SLOTB)?0:sl_next+SLOTB;}while(0)
  DMA_K(2,2*SLOTB);
  WAIT_BAR(3);
  qkt(pA0,pA1,Kbase,qr,negm,r32,hi);asm volatile("s_nop 15\n\ts_nop 7":"+v"(pA0),"+v"(pA1));
  START(pA0,pA1);
  _Pragma("unroll") for(int r=0;r<16;++r)pA1[r]=__builtin_amdgcn_exp2f(pA1[r]);
  WAIT_BAR(0);
  DMA_K(3,0);DMA_V(1,SLOTB);
  ROT();
  kload8(kf,kp0+sl_cur);
  WAIT_BAR(3);
  s16x4 vlo[16],vhi[16]; u32x4 pw0,pw1,pw2,pw3;
  #define PKW(P,B) cvtpk_s(P[B],P[B+1])
  #define PAF(k) __builtin_bit_cast(bf16x8,pw##k)
  #define VFR(i) (bf16x8){vlo[i][0],vlo[i][1],vlo[i][2],vlo[i][3],vhi[i][0],vhi[i][1],vhi[i][2],vhi[i][3]}
  #define PIN(x) asm volatile("":"+v"(x))
  #define MX3(a,b,c) __builtin_fmaxf(__builtin_fmaxf((a),(b)),(c))
  #define GAPA(MF,A0,A1,A2,A3,W0,W1,PW) do{ MF; sacc+=A0; sacc+=A1; sacc+=A2; sacc+=A3; PIN(sacc); W0; W1; PIN(PW); SBAR(); }while(0)
  #define EX(v) __builtin_amdgcn_exp2f(v)
  #define GAPB(MF,X,B) do{ MF; X[B]=EX(X[B]); X[B+1]=EX(X[B+1]); PIN(X); SBAR(); }while(0)
  #define VRD(i) do{ vlo[i]=vtr(vp_+(((i)>>2)*4096+((i)&3)*1024)); vhi[i]=vtr(vp_+(((i)>>2)*4096+((i)&3)*1024+512)); }while(0)
  #define KR1(G,i) do{ if(G){ kf[i]=*(const __attribute__((address_space(3))) bf16x8*)(kp0+sl_next+((i)>>1)*2048+((i)&1)*512); } }while(0)
  #define MF32(a,b,c) __builtin_amdgcn_mfma_f32_32x32x16_bf16(a,b,c,0,0,0)
  #define STEP(C0,C1,P0,P1,t,GK,GV,GL) do{ SBAR(); \
    const lds_cptr vp_=vp0+2*sl_prev; \
    float sacc=(P0[0]+P0[1]); \
    GAPA(C0=MF32(kf[0],qr[0],negm), P0[2],P0[3],P0[4],P0[5],     pw0[0]=PKW(P0,0), pw0[1]=PKW(P0,2), pw0); \
    GAPA(C1=MF32(kf[1],qr[0],negm), P0[6],P0[7],P0[8],P0[9],     pw0[2]=PKW(P0,4), pw0[3]=PKW(P0,6), pw0); \
    GAPA(C0=MF32(kf[2],qr[1],C0),   P0[10],P0[11],P0[12],P0[13], pw1[0]=PKW(P0,8), pw1[1]=PKW(P0,10), pw1); \
    GAPA(C1=MF32(kf[3],qr[1],C1),  P0[14],P0[15],P1[0],P1[1],   pw1[2]=PKW(P0,12),pw1[3]=PKW(P0,14), pw1); \
    VRD(0); SBAR(); GAPA(C0=MF32(kf[4],qr[2],C0),   P1[2],P1[3],P1[4],P1[5],     pw2[0]=PKW(P1,0), pw2[1]=PKW(P1,2), pw2); \
    VRD(4); SBAR(); GAPA(C1=MF32(kf[5],qr[2],C1),   P1[6],P1[7],P1[8],P1[9],     pw2[2]=PKW(P1,4), pw2[3]=PKW(P1,6), pw2); \
    VRD(8); SBAR(); GAPA(C0=MF32(kf[6],qr[3],C0),   P1[10],P1[11],P1[12],P1[13], pw3[0]=PKW(P1,8), pw3[1]=PKW(P1,10), pw3); \
    VRD(12); SBAR(); GAPA(C1=MF32(kf[7],qr[3],C1),  P1[14],P1[15],0.f,0.f,       pw3[2]=PKW(P1,12),pw3[3]=PKW(P1,14), pw3); \
    l_reg+=sacc; \
    if(GK){DMA_K((t)+3,sl_cur);} if(GV){DMA_V((t)+1,sl_next);} \
    SBAR(); \
    VRD(1); SBAR(); o[0]=MF32(PAF(0),VFR(0),o[0]); SBAR(); \
    VRD(5); SBAR(); o[1]=MF32(PAF(0),VFR(4),o[1]); float a_=MX3(C0[0],C0[1],C1[0]),b_=MX3(C0[2],C0[3],C1[1]); a_=MX3(a_,C1[2],C1[3]); a_=MX3(a_,C0[4],C0[5]); b_=MX3(b_,C0[6],C0[7]); a_=MX3(a_,C1[4],C1[5]); b_=MX3(b_,C1[6],C1[7]); PIN(a_); PIN(b_); SBAR(); \
    VRD(9); KR1(GL,0); SBAR(); o[2]=MF32(PAF(0),VFR(8),o[2]); a_=MX3(a_,C0[8],C0[9]); b_=MX3(b_,C0[10],C0[11]); a_=MX3(a_,C1[8],C1[9]); b_=MX3(b_,C1[10],C1[11]); a_=MX3(a_,C0[12],C0[13]); b_=MX3(b_,C0[14],C0[15]); a_=MX3(a_,C1[12],C1[13]); b_=MX3(b_,C1[14],C1[15]); PIN(a_); PIN(b_); SBAR(); \
    VRD(13); KR1(GL,1); SBAR(); o[3]=MF32(PAF(0),VFR(12),o[3]); { float rm=__builtin_fmaxf(a_,b_); { auto rr=__builtin_amdgcn_permlane32_swap(__float_as_uint(rm),__float_as_uint(rm),false,false); rm=__builtin_fmaxf(__uint_as_float(rr[0]),__uint_as_float(rr[1])); } \
      rm-=mhat; resc=false; \
      if(__builtin_expect(__any(rm>(float)THRL),0)){ const float dl=__builtin_fmaxf(rm,0.f); mhat+=dl; \
        const float f=__builtin_amdgcn_exp2f(-dl); l_reg*=f; if(hi==0)wsf[r32]=f; resc=true; } } PIN(mhat); SBAR(); \
    VRD(2); KR1(GL,2); SBAR(); o[0]=MF32(PAF(1),VFR(1),o[0]); _Pragma("unroll") for(int r=0;r<16;++r){C0[r]-=mhat;} PIN(C0); SBAR(); \
    VRD(6); KR1(GL,3); SBAR(); o[1]=MF32(PAF(1),VFR(5),o[1]); _Pragma("unroll") for(int r=0;r<16;++r){C1[r]-=mhat;} PIN(C1); SBAR(); \
    VRD(10); KR1(GL,4); SBAR(); o[2]=MF32(PAF(1),VFR(9),o[2]); C0[0]=EX(C0[0]); C0[1]=EX(C0[1]); C0[2]=EX(C0[2]); PIN(C0); SBAR(); \
    VRD(14); KR1(GL,5); SBAR(); o[3]=MF32(PAF(1),VFR(13),o[3]); C0[3]=EX(C0[3]); C0[4]=EX(C0[4]); C0[5]=EX(C0[5]); PIN(C0); SBAR(); \
    VRD(3); KR1(GL,6); SBAR(); o[0]=MF32(PAF(2),VFR(2),o[0]); C0[6]=EX(C0[6]); C0[7]=EX(C0[7]); C0[8]=EX(C0[8]); PIN(C0); SBAR(); \
    VRD(7); KR1(GL,7); SBAR(); o[1]=MF32(PAF(2),VFR(6),o[1]); C0[9]=EX(C0[9]); C0[10]=EX(C0[10]); C0[11]=EX(C0[11]); PIN(C0); SBAR(); \
    VRD(11); SBAR(); o[2]=MF32(PAF(2),VFR(10),o[2]); C0[12]=EX(C0[12]); C0[13]=EX(C0[13]); C0[14]=EX(C0[14]); PIN(C0); SBAR(); \
    VRD(15); SBAR(); o[3]=MF32(PAF(2),VFR(14),o[3]); C0[15]=EX(C0[15]); C1[0]=EX(C1[0]); C1[1]=EX(C1[1]); PIN(C0); PIN(C1); SBAR(); \
    o[0]=MF32(PAF(3),VFR(3),o[0]); C1[2]=EX(C1[2]); C1[3]=EX(C1[3]); C1[4]=EX(C1[4]); PIN(C1); SBAR(); \
    o[1]=MF32(PAF(3),VFR(7),o[1]); C1[5]=EX(C1[5]); C1[6]=EX(C1[6]); C1[7]=EX(C1[7]); PIN(C1); SBAR(); \
    o[2]=MF32(PAF(3),VFR(11),o[2]); C1[8]=EX(C1[8]); C1[9]=EX(C1[9]); C1[10]=EX(C1[10]); C1[11]=EX(C1[11]); PIN(C1); SBAR(); \
    o[3]=MF32(PAF(3),VFR(15),o[3]); C1[12]=EX(C1[12]); C1[13]=EX(C1[13]); C1[14]=EX(C1[14]); C1[15]=EX(C1[15]); PIN(C1); SBAR(); \
    }while(0)
  int t=1;
  for(;t+5<NT;t+=2){
    STEP(pB0,pB1,pA0,pA1,t,true,true,true);     WAIT_BAR(3); RESC(); ROT();
    STEP(pA0,pA1,pB0,pB1,t+1,true,true,true);   WAIT_BAR(3); RESC(); ROT();
  }
  #define ENDW(tt) do{ if((tt)+3<NT){WAIT_BAR(3);} else if((tt)+2<NT){WAIT_BAR(2);} else {WAIT_BAR(0);} }while(0)
  for(;t+1<NT;t+=2){
    STEP(pB0,pB1,pA0,pA1,t,(t+3<NT),(t+1<NT),(t+1<NT));       ENDW(t);   RESC(); ROT();
    STEP(pA0,pA1,pB0,pB1,t+1,(t+4<NT),(t+2<NT),(t+2<NT));     ENDW(t+1); RESC(); ROT();
  }
  STEP(pB0,pB1,pA0,pA1,NT-1,false,false,false); RESC();
  { float sacc=pB0[0]+pB0[1]; _Pragma("unroll") for(int r=2;r<16;++r)sacc+=pB0[r]; _Pragma("unroll") for(int r=0;r<16;++r)sacc+=pB1[r]; l_reg+=sacc;
    pw0=(u32x4){PKW(pB0,0),PKW(pB0,2),PKW(pB0,4),PKW(pB0,6)};pw1=(u32x4){PKW(pB0,8),PKW(pB0,10),PKW(pB0,12),PKW(pB0,14)};pw2=(u32x4){PKW(pB1,0),PKW(pB1,2),PKW(pB1,4),PKW(pB1,6)};pw3=(u32x4){PKW(pB1,8),PKW(pB1,10),PKW(pB1,12),PKW(pB1,14)};
    SBAR(); pv(o,vb0+2*sl_cur,PAF(0),PAF(1),PAF(2),PAF(3)); pv(o+2,vb0+2*sl_cur+8192,PAF(0),PAF(1),PAF(2),PAF(3)); }
  #undef PKW
  #undef PAF
  #undef VFR
  #undef PIN
  #undef MX3
  #undef GAPA
  #undef GAPB
  #undef EX
  #undef VRD
  #undef KR1
  #undef MF32
  #undef STEP
  #undef ENDW
  {auto rr=__builtin_amdgcn_permlane32_swap(__float_as_uint(l_reg),__float_as_uint(l_reg),false,false);l_reg=__uint_as_float(rr[0])+__uint_as_float(rr[1]); l_reg+=__builtin_amdgcn_exp2f(u.sink2-mhat);}
  if(hi==0)wsf[32+r32]=l_reg;asm volatile("s_waitcnt lgkmcnt(0)":::"memory");
  float rli[16];
  #pragma unroll
  for(int r=0;r<16;++r)rli[r]=__builtin_amdgcn_rcpf(wsf[32+crow(r,hi)]);
  bf16*Ow=u.O+(long)(wid*QBLK)*DM;
  { bf16*stg=(bf16*)(shm+LDS2_OST)+wid*2048;
    #pragma unroll
    for(int h2=0;h2<2;++h2){
      #pragma unroll
      for(int r=0;r<16;++r){const int orow=crow(r,hi);
        #pragma unroll
        for(int d0=0;d0<2;++d0)stg[orow*64+d0*32+r32]=__float2bfloat16(o[2*h2+d0][r]*rli[r]);}
      asm volatile("s_waitcnt lgkmcnt(0)":::"memory");
      #pragma unroll
      for(int i=0;i<4;++i){const int row=i*8+(lane>>3),ch=lane&7; const u32x4 v=*(const u32x4*)(stg+row*64+ch*8); ATTN_STORE16(Ow+(long)row*DM+h2*64+ch*8,v);}
      asm volatile("s_waitcnt lgkmcnt(0)":::"memory"); } }
  asm volatile("s_waitcnt lgkmcnt(0)\n\ts_barrier":::"memory");
  #undef TOFF
  #undef DMA_K
  #undef DMA_V
  #undef START
  #undef RESC
  #undef ROT
}
constexpr int ATTN_LDS_BYTES=LDS_BYTES;
#undef SBAR
#undef WAIT_BAR
}
#define GAS __attribute__((address_space(1)))
#define LAS __attribute__((address_space(3)))
typedef unsigned short bf16;
typedef unsigned v4u __attribute__((ext_vector_type(4)));
typedef float f32x4 __attribute__((ext_vector_type(4)));
typedef short bf16x8 __attribute__((ext_vector_type(8)));
typedef GAS unsigned gu32;
typedef GAS unsigned long long gu64;
#define RLX_AGENT __ATOMIC_RELAXED, __HIP_MEMORY_SCOPE_AGENT
#define LDS_WAIT() asm volatile("s_waitcnt lgkmcnt(0)" ::: "memory")
#define VM_WAIT() asm volatile("s_waitcnt vmcnt(0)" ::: "memory")
__device__ __forceinline__ unsigned long long rt() { return __builtin_amdgcn_s_memrealtime(); }
__device__ __forceinline__ unsigned f2bf(float f) { unsigned u = __builtin_bit_cast(unsigned, f); return (u + 0x7fffu + ((u >> 16) & 1u)) >> 16; }
__device__ __forceinline__ unsigned pk2(float lo, float hi) { unsigned r; asm("v_cvt_pk_bf16_f32 %0, %1, %2" : "=v"(r) : "v"(lo), "v"(hi)); return r; }

#define XB_TMO      128
#define XB_XCNT(j)  (256  + 64 * (j))
#define XB_XSUB(j)  (1280 + 64 * (j))
#define XB_XGEN(j)  (2304 + 64 * (j))
#define XB_TOP      3328
#define XB_TOPGEN   3392
#define XCD_BAR_WORDS 3456
#define XB_SPIN_CAP (1u << 29)

__device__ __forceinline__ unsigned xb_ld(unsigned* p)              { return __hip_atomic_load(p, __ATOMIC_RELAXED, __HIP_MEMORY_SCOPE_AGENT); }
__device__ __forceinline__ unsigned xb_add(unsigned* p, unsigned v) { return __hip_atomic_fetch_add(p, v, __ATOMIC_RELAXED, __HIP_MEMORY_SCOPE_AGENT); }
__device__ __forceinline__ unsigned xb_xcc_id() { return (unsigned)__builtin_amdgcn_s_getreg((3 << 11) | 20) & 0xFu; }
#define XB_SPIN(cond, bar) do { unsigned _sp = 0; while (cond) { __builtin_amdgcn_s_sleep(1); \
    if ((++_sp & 255u) == 0u) { if (xb_ld(&(bar)[XB_TMO])) break; if (_sp > XB_SPIN_CAP) { atomicAdd(&(bar)[XB_TMO], 1u); break; } } } } while (0)

struct XcdBarrier {
    unsigned* bar; unsigned x;
    volatile LAS unsigned* st;
};

__device__ __forceinline__ XcdBarrier xcd_barrier_post(unsigned* bar, volatile LAS unsigned* st, const int tid_in) {
    XcdBarrier b; b.bar = bar; b.x = xb_xcc_id(); b.st = st;
    if (tid_in == 0) (void)xb_add(&bar[XB_XCNT(b.x)], 1u);
    return b;
}
__device__ __forceinline__ void xcd_barrier_complete(unsigned* bar, unsigned x, unsigned& nloc, unsigned& nx) {
    const unsigned G = gridDim.x * gridDim.y * gridDim.z;
    unsigned sum, cnt, mine, sp = 0u;
    for (;;) {
        sum = 0u; cnt = 0u; mine = 0u;
#pragma unroll
        for (unsigned j = 0; j < 16; ++j) { const unsigned c = xb_ld(&bar[XB_XCNT(j)]); sum += c; cnt += (c > 0u) ? 1u : 0u; mine = (j == x) ? c : mine; }
        if (sum == G) break;
        __builtin_amdgcn_s_sleep(1);
        if ((++sp & 255u) == 0u) { if (xb_ld(&bar[XB_TMO])) break; if (sp > XB_SPIN_CAP) { atomicAdd(&bar[XB_TMO], 1u); break; } }
    }
    nloc = mine > 0u ? mine : 1u; nx = cnt > 0u ? cnt : 1u;
}

__device__ __forceinline__ void xcd_barrier(const XcdBarrier& b, const int tid_in) {
    asm volatile("s_waitcnt vmcnt(0)" ::: "memory");
    __syncthreads();
    if (tid_in == 0) {
        unsigned* bar = b.bar;
        __builtin_amdgcn_s_waitcnt(0);
        unsigned nloc = b.st[0], nx = b.st[1];
        if (nloc == 0u) { xcd_barrier_complete(bar, b.x, nloc, nx); b.st[0] = nloc; b.st[1] = nx; }
        const unsigned old = xb_add(&bar[XB_XSUB(b.x)], 1u);
        const unsigned gen = old / nloc;
        if (old + 1u == (gen + 1u) * nloc) {
            __builtin_amdgcn_fence(__ATOMIC_RELEASE, "agent");
            asm volatile("s_waitcnt vmcnt(0)" ::: "memory");
            const unsigned og = xb_add(&bar[XB_TOP], 1u);
            const unsigned tg = og / nx;
            if (og + 1u == (tg + 1u) * nx) xb_add(&bar[XB_TOPGEN], 1u);
            else XB_SPIN(xb_ld(&bar[XB_TOPGEN]) == tg, bar);
            __builtin_amdgcn_fence(__ATOMIC_ACQUIRE, "agent");
            xb_add(&bar[XB_XGEN(b.x)], 1u);
            asm volatile("s_waitcnt vmcnt(0)" ::: "memory");
        } else {
            XB_SPIN(xb_ld(&bar[XB_XGEN(b.x)]) == gen, bar);
            __builtin_amdgcn_fence(__ATOMIC_ACQUIRE, "agent");
            asm volatile("s_waitcnt vmcnt(0)" ::: "memory");
        }
    }
    __syncthreads();
}
constexpr int NB = 16, TL = 2048, LC = 256, SQ = TL + LC, MR = NB * SQ, DD = 1024, NLAYER = 4;
constexpr float LN_EPS = 1e-5f, DN_ALPHA = 1.6817928305074290f;
constexpr float LOG2E = 1.4426950408889634f;
constexpr int NWAVES = 8, NTHR = 512;
constexpr size_t MiB = 1u << 20;
constexpr size_t WS_CTL = 0, CTL_ZERO_BYTES = 1 * MiB;
constexpr size_t WS_MOD = 1 * MiB;
constexpr size_t WS_ROPE = 3 * MiB;
constexpr size_t WS_S5LB = 4 * MiB;
constexpr size_t WS_S5B = 4 * MiB + 128 * 1024;
constexpr size_t WS_S5C = 5 * MiB;
constexpr size_t WS_KEYS = 6 * MiB;
constexpr size_t WS_WQKV_DA = 8 * MiB;
constexpr size_t WS_WO_DA = 20 * MiB;
constexpr size_t WS_WQKV_WA = 24 * MiB;
constexpr size_t WS_WO_WA = 27 * MiB;
constexpr size_t WS_WGLU = 29 * MiB;
constexpr size_t WS_WPQ = 33 * MiB;
constexpr size_t WS_PU = 64 * MiB;
constexpr size_t WS_PV = 192 * MiB;
constexpr size_t WS_LAT = 320 * MiB;
constexpr size_t WS_H = 464 * MiB;
constexpr size_t WS_A = 536 * MiB;
constexpr size_t WS_B = 752 * MiB;
constexpr size_t WS_END = 896 * MiB;
constexpr size_t SZ72 = 72 * MiB;
constexpr int CW_TMO = 0, CW_CODE = 1, CW_ERR = 2;
constexpr int CW_BAR = 4096;
constexpr int RING_OFF = 0, RING_BYTES = 131072;
constexpr int LDSCTL_OFF = RING_BYTES, MISC_OFF = LDSCTL_OFF + 320;
constexpr int LDS_BYTES = 147456;
static_assert(MISC_OFF + 128 <= LDS_BYTES, "LDS map");

typedef __bf16 bf16x2v __attribute__((ext_vector_type(2)));
typedef float f32x16 __attribute__((ext_vector_type(16)));
__device__ __forceinline__ float dot2bf(unsigned w, unsigned x, float acc) { return __builtin_amdgcn_fdot2_f32_bf16(__builtin_bit_cast(bf16x2v, w), __builtin_bit_cast(bf16x2v, x), acc, false); }
__device__ __forceinline__ float bflo(unsigned u) { return __uint_as_float(u << 16); }
__device__ __forceinline__ float bfhi(unsigned u) { return __uint_as_float(u & 0xffff0000u); }
__device__ __forceinline__ float bf2f(bf16 h) { return __uint_as_float((unsigned)h << 16); }
__device__ __forceinline__ float wave_sum(float v) {
#pragma unroll
    for (int o = 1; o < 64; o <<= 1) v += __shfl_xor(v, o);
    return v;
}
__device__ __forceinline__ float gelu_tanh(float x) {
    const float z = 0.7978845608028654f * (x + 0.044715f * x * x * x);
    return x * __builtin_amdgcn_rcpf(1.f + __builtin_amdgcn_exp2f(-2.f * LOG2E * z));
}
__device__ __forceinline__ int mod_index(int row) { const int b = row / SQ; return (row - b * SQ) < LC ? 16 : b; }

__device__ __forceinline__ void p0_transpose_item(const float* W, int K, int N, bf16* WT, int glu, LAS float* scr, int item, int lane) {
    const int nblk = N / 32, kb = item / nblk, nb = item % nblk, k0 = 64 * kb, n0 = 32 * nb;
#pragma unroll 8
    for (int i = 0; i < 32; ++i) { const int kk = 2 * i + (lane >> 5); scr[kk * 33 + (lane & 31)] = W[(size_t)(k0 + kk) * N + n0 + (lane & 31)]; }
    LDS_WAIT(); asm volatile("" ::: "memory");
    const int c = lane & 7;
    int r0 = n0; if (glu) r0 = (n0 < 1024) ? ((n0 >> 7) * 256 + (n0 & 127)) : (((n0 - 1024) >> 7) * 256 + 128 + ((n0 - 1024) & 127));
#pragma unroll
    for (int j = 0; j < 4; ++j) { const int n = (lane >> 3) + 8 * j; const LAS float* s = scr + (8 * c) * 33 + n;
        v4u o; o.x = pk2(s[0 * 33], s[1 * 33]); o.y = pk2(s[2 * 33], s[3 * 33]); o.z = pk2(s[4 * 33], s[5 * 33]); o.w = pk2(s[6 * 33], s[7 * 33]);
        *(GAS v4u*)(WT + (size_t)(r0 + n) * K + k0 + 8 * c) = o; }
    LDS_WAIT(); asm volatile("" ::: "memory");
}
__device__ __forceinline__ void cvt_f32_bf16_stream(const float* src, bf16* dst, size_t nchunks8, size_t gt, size_t ngt) {
    for (size_t c = gt; c < nchunks8; c += ngt) { const f32x4 a = *(const GAS f32x4*)(src + c * 8), b = *(const GAS f32x4*)(src + c * 8 + 4);
        v4u o; o.x = pk2(a.x, a.y); o.y = pk2(a.z, a.w); o.z = pk2(b.x, b.y); o.w = pk2(b.z, b.w); *(GAS v4u*)(dst + c * 8) = o; }
}
struct Args;
#ifndef PEER_SLICED
#define PEER_SLICED 0
#endif
constexpr float PU_SCALE = 512.f, PV_SCALE = 32.f;
__device__ __forceinline__ unsigned pk4_fp8(float a, float b, float c, float d, float sc) {
    a = fminf(fmaxf(a * sc, -448.f), 448.f); b = fminf(fmaxf(b * sc, -448.f), 448.f); c = fminf(fmaxf(c * sc, -448.f), 448.f); d = fminf(fmaxf(d * sc, -448.f), 448.f);
    int w = 0; w = __builtin_amdgcn_cvt_pk_fp8_f32(a, b, w, false); w = __builtin_amdgcn_cvt_pk_fp8_f32(c, d, w, true); return (unsigned)w; }
__device__ __forceinline__ void cvt_f32_fp8_stream(const float* src, unsigned char* dst, size_t nchunks16, float sc, size_t gt, size_t ngt) {
    for (size_t c = gt; c < nchunks16; c += ngt) { const f32x4 a = *(const GAS f32x4*)(src + c * 16), b = *(const GAS f32x4*)(src + c * 16 + 4), cc = *(const GAS f32x4*)(src + c * 16 + 8), d = *(const GAS f32x4*)(src + c * 16 + 12);
        v4u o; o.x = pk4_fp8(a.x, a.y, a.z, a.w, sc); o.y = pk4_fp8(b.x, b.y, b.z, b.w, sc); o.z = pk4_fp8(cc.x, cc.y, cc.z, cc.w, sc); o.w = pk4_fp8(d.x, d.y, d.z, d.w, sc);
#if PEER_SLICED
        const size_t lay = c >> 20, e = (c >> 6) & 16383, c16 = c & 63; *(GAS v4u*)(dst + (lay << 24) + ((c16 >> 3) << 21) + e * 128 + (c16 & 7) * 16) = o; }
#else
        *(GAS v4u*)(dst + c * 16) = o; }
#endif
}
template <class KP> __device__ __forceinline__ void cvt_tables_layer(KP ka, unsigned char* ws, int layer, int part, int nparts, int tid) {
    const size_t per = (size_t)16384 * 1024, gt = (size_t)part * NTHR + tid, ngt = (size_t)nparts * NTHR;
    cvt_f32_fp8_stream(ka->in[10] + (size_t)layer * per, ws + WS_PU + (size_t)layer * per, per / 16, PU_SCALE, gt, ngt);
    cvt_f32_fp8_stream(ka->in[11] + (size_t)layer * per, ws + WS_PV + (size_t)layer * per, per / 16, PV_SCALE, gt, ngt);
}
constexpr size_t WS_MODP = WS_A;
constexpr size_t MODN_ = (size_t)4 * 17 * 6144;
template <class KP> __device__ __forceinline__ void p0_mod(KP ka, unsigned char* ws, LAS unsigned char* lds, int vcu, int G, int tid, int lane, int wave) {
    LAS float* sl = (LAS float*)lds;
    for (int idx = tid; idx < 17 * 1024; idx += NTHR) { const int r = idx >> 10, k = idx & 1023; const float v = (r < 16) ? ka->in[1][r * 1024 + k] : ka->in[3][k]; sl[k * 20 + r] = v / (1.f + expf(-v)); }
    __syncthreads();
    float* MODP = (float*)(ws + WS_MODP);
    const int gw = vcu * NWAVES + wave, NGW = G * NWAVES;
    for (int item = gw; item < 4 * 96 * 8; item += NGW) { const int kc = item & 7, cg = item >> 3, i = cg / 96, n0 = (cg % 96) * 64;
        const float* W = ka->in[4] + (size_t)i * 1024 * 6144 + n0 + lane;
        float acc[17];
#pragma unroll
        for (int r = 0; r < 17; ++r) acc[r] = 0.f;
#pragma unroll 8
        for (int kk = 0; kk < 128; ++kk) { const int k = kc * 128 + kk; const float w = W[(size_t)k * 6144];
            const f32x4 s0 = *(const LAS f32x4*)(sl + k * 20), s1 = *(const LAS f32x4*)(sl + k * 20 + 4), s2 = *(const LAS f32x4*)(sl + k * 20 + 8), s3 = *(const LAS f32x4*)(sl + k * 20 + 12); const float s4 = sl[k * 20 + 16];
            acc[0] += s0.x * w; acc[1] += s0.y * w; acc[2] += s0.z * w; acc[3] += s0.w * w; acc[4] += s1.x * w; acc[5] += s1.y * w; acc[6] += s1.z * w; acc[7] += s1.w * w;
            acc[8] += s2.x * w; acc[9] += s2.y * w; acc[10] += s2.z * w; acc[11] += s2.w * w; acc[12] += s3.x * w; acc[13] += s3.y * w; acc[14] += s3.z * w; acc[15] += s3.w * w; acc[16] += s4 * w; }
#pragma unroll
        for (int r = 0; r < 17; ++r) MODP[(size_t)kc * MODN_ + ((size_t)i * 17 + r) * 6144 + n0 + lane] = acc[r]; }
    __syncthreads();
}
template <class KP> __device__ __forceinline__ void p0_prologue(KP ka, unsigned char* ws, LAS unsigned char* lds, int vcu, int G, int tid, int lane, int wave) {
    p0_mod(ka, ws, lds, vcu, G, tid, lane, wave);
    const int gw = vcu * NWAVES + wave, NGW = G * NWAVES; const size_t gt = (size_t)vcu * NTHR + tid, ngt = (size_t)G * NTHR;
    { LAS float* scr = (LAS float*)(lds + wave * 16384);
      constexpr int I_QKV = 16 * 96, I_O = 16 * 32, I_WA = 16 * 48, I_G = 16 * 64, I_PQ = 16 * 64;
      constexpr int NITEMS = 2 * I_QKV + 2 * I_O + I_WA + I_O + I_G + 4 * I_PQ;
      for (int it = gw; it < NITEMS; it += NGW) { int r = it;
          if (r < 2 * I_QKV) { const int l = r / I_QKV; p0_transpose_item(ka->in[12] + (size_t)l * 1024 * 3072, 1024, 3072, (bf16*)(ws + WS_WQKV_DA) + (size_t)l * 3072 * 1024, 0, scr, r % I_QKV, lane); continue; } r -= 2 * I_QKV;
          if (r < 2 * I_O) { const int l = r / I_O; p0_transpose_item(ka->in[13] + (size_t)l * 1024 * 1024, 1024, 1024, (bf16*)(ws + WS_WO_DA) + (size_t)l * 1024 * 1024, 0, scr, r % I_O, lane); continue; } r -= 2 * I_O;
          if (r < I_WA) { p0_transpose_item(ka->in[16], 1024, 1536, (bf16*)(ws + WS_WQKV_WA), 0, scr, r, lane); continue; } r -= I_WA;
          if (r < I_O) { p0_transpose_item(ka->in[17], 1024, 1024, (bf16*)(ws + WS_WO_WA), 0, scr, r, lane); continue; } r -= I_O;
          if (r < I_G) { p0_transpose_item(ka->in[27], 1024, 2048, (bf16*)(ws + WS_WGLU), 1, scr, r, lane); continue; } r -= I_G;
          { const int l = r / I_PQ; p0_transpose_item(ka->in[8] + (size_t)l * 1024 * 2048, 1024, 2048, (bf16*)(ws + WS_WPQ) + (size_t)l * 2048 * 1024, 0, scr, r % I_PQ, lane); } }
    }
    cvt_f32_bf16_stream(ka->in[9], (bf16*)(ws + WS_KEYS), (size_t)4 * 2 * 8 * 128 * 128 / 8, gt, ngt);
    cvt_f32_fp8_stream(ka->in[10], ws + WS_PU, (size_t)16384 * 1024 / 16, PU_SCALE, gt, ngt);
    cvt_f32_fp8_stream(ka->in[11], ws + WS_PV, (size_t)16384 * 1024 / 16, PV_SCALE, gt, ngt);
    { float* cosT = (float*)(ws + WS_ROPE); float* sinT = cosT + 2048 * 32;
      for (size_t idx = gt; idx < 2048 * 32; idx += ngt) { const int t = (int)(idx >> 5), i = (int)(idx & 31), f = i & 15;
          const float inv = exp2f(-(float)f * (13.287712379549449f / 16.f));
          const float pos = (float)((i < 16) ? (t >> 6) : (t & 63)); const float ang = pos * inv;
          cosT[idx] = cosf(ang); sinT[idx] = sinf(ang); } }
    { float* LB = (float*)(ws + WS_S5LB); bf16* Bop = (bf16*)(ws + WS_S5B); bf16* Cop = (bf16*)(ws + WS_S5C);
      for (size_t idx = gt; idx < 2 * 64 * 64; idx += ngt) { const int p = (int)(idx & 63), rg = (int)(idx >> 6);
          const float re = ka->in[19][idx], im = ka->in[20][idx], step = expf(ka->in[21][rg]);
          const float mag = expf(re * step), lbr = mag * cosf(im * step), lbi = mag * sinf(im * step);
          const float a = lbr - 1.f, b = lbi, den = re * re + im * im, qr = (a * re + b * im) / den, qi = (b * re - a * im) / den;
          LB[idx * 2] = lbr; LB[idx * 2 + 1] = lbi;
          const int nre = (p >> 5) * 64 + (p & 31), nim = nre + 32;
          for (int h = 0; h < 16; ++h) { const float br = ka->in[22][idx * 16 + h], bi = ka->in[23][idx * 16 + h];
              Bop[((size_t)rg * 128 + nre) * 16 + h] = (bf16)f2bf(br * qr - bi * qi); Bop[((size_t)rg * 128 + nim) * 16 + h] = (bf16)f2bf(br * qi + bi * qr);
              const float cr = ka->in[24][((size_t)rg * 16 + h) * 64 + p], ci = ka->in[25][((size_t)rg * 16 + h) * 64 + p];
              Cop[((size_t)rg * 16 + h) * 128 + 2 * p] = (bf16)f2bf(cr); Cop[((size_t)rg * 16 + h) * 128 + 2 * p + 1] = (bf16)f2bf(-ci); } } }
}
__device__ __forceinline__ void modred_phase(const float* mod_b, unsigned char* ws, int gw, int NGW, int lane) {
    float* MOD = (float*)(ws + WS_MOD); const float* MODP = (const float*)(ws + WS_MODP);
    for (size_t q = (size_t)gw * 64 + lane; q < MODN_ / 4; q += (size_t)NGW * 64) { const size_t idx = q * 4; const int i = (int)(idx / (17 * 6144)), n = (int)(idx % 6144);
        f32x4 s = *(const GAS f32x4*)(mod_b + (size_t)i * 6144 + n);
#pragma unroll
        for (int kc = 0; kc < 8; ++kc) s = s + *(const GAS f32x4*)(MODP + (size_t)kc * MODN_ + idx);
        *(GAS f32x4*)(MOD + idx) = s; }
}
__device__ __forceinline__ void p1_embed(const float* x, const float* ctx, unsigned char* ws, int gw, int NGW, int lane) {
    bf16* LAT = (bf16*)(ws + WS_LAT); bf16* H = (bf16*)(ws + WS_H); const float* MOD = (const float*)(ws + WS_MOD);
    for (int row = gw; row < MR; row += NGW) { const int b = row / SQ, s = row - b * SQ;
        const float* src = (s < LC) ? ctx + ((size_t)b * LC + s) * DD : x + ((size_t)b * TL + (s - LC)) * DD;
        const float* md = MOD + (size_t)((s < LC) ? 16 : b) * 6144;
#pragma unroll
        for (int j = 0; j < 4; ++j) { const int c = 256 * j + 4 * lane; const f32x4 v = *(const GAS f32x4*)(src + c), sh = *(const GAS f32x4*)(md + c), sc = *(const GAS f32x4*)(md + 1024 + c);
            *(GAS unsigned long long*)(LAT + (size_t)row * DD + c) = (unsigned long long)pk2(v.x, v.y) | ((unsigned long long)pk2(v.z, v.w) << 32); const f32x4 h = v * (sc + 1.f) + sh;
            *(GAS unsigned long long*)(H + (size_t)row * DD + c) = (unsigned long long)pk2(h.x, h.y) | ((unsigned long long)pk2(h.z, h.w) << 32); } }
}
__device__ __forceinline__ void ln1_phase(unsigned char* ws, const float* lng, const float* lnb, int layer, int skip_ctx, int gw, int NGW, int lane) {
    const bf16* R = (const bf16*)(ws + WS_B); bf16* LAT = (bf16*)(ws + WS_LAT); bf16* H = (bf16*)(ws + WS_H); const float* MOD = (const float*)(ws + WS_MOD) + (size_t)layer * 17 * 6144;
    const int nrows = skip_ctx ? NB * TL : MR;
    f32x4 g[4], bb[4];
#pragma unroll
    for (int j = 0; j < 4; ++j) { g[j] = *(const GAS f32x4*)(lng + 256 * j + 4 * lane); bb[j] = *(const GAS f32x4*)(lnb + 256 * j + 4 * lane); }
    for (int lr = gw; lr < nrows; lr += 2 * NGW) {
        int rows[2]; bool ok[2];
#pragma unroll
        for (int u = 0; u < 2; ++u) { const int l2 = lr + u * NGW; ok[u] = l2 < nrows; const int l3 = ok[u] ? l2 : lr; rows[u] = skip_ctx ? (l3 >> 11) * SQ + LC + (l3 & 2047) : l3; }
        f32x4 v[2][4]; float sm[2];
#pragma unroll
        for (int u = 0; u < 2; ++u) { sm[u] = 0.f;
#pragma unroll
            for (int j = 0; j < 4; ++j) { const unsigned long long rb = *(const GAS unsigned long long*)(R + (size_t)rows[u] * DD + 256 * j + 4 * lane); const unsigned r0 = (unsigned)rb, r1 = (unsigned)(rb >> 32);
                v[u][j].x = bflo(r0); v[u][j].y = bfhi(r0); v[u][j].z = bflo(r1); v[u][j].w = bfhi(r1); sm[u] += (v[u][j].x + v[u][j].y) + (v[u][j].z + v[u][j].w); } }
#pragma unroll
        for (int o = 1; o < 64; o <<= 1) { sm[0] += __shfl_xor(sm[0], o); sm[1] += __shfl_xor(sm[1], o); }
        float s2[2];
#pragma unroll
        for (int u = 0; u < 2; ++u) { const float mean = sm[u] * (1.f / DD); s2[u] = 0.f;
#pragma unroll
            for (int j = 0; j < 4; ++j) { v[u][j] = v[u][j] - mean; s2[u] += (v[u][j].x * v[u][j].x + v[u][j].y * v[u][j].y) + (v[u][j].z * v[u][j].z + v[u][j].w * v[u][j].w); } }
#pragma unroll
        for (int o = 1; o < 64; o <<= 1) { s2[0] += __shfl_xor(s2[0], o); s2[1] += __shfl_xor(s2[1], o); }
#pragma unroll
        for (int u = 0; u < 2; ++u) { if (!ok[u]) continue; const int row = rows[u]; const int b = row / SQ, s = row - b * SQ; const float* md = MOD + (size_t)((s < LC) ? 16 : b) * 6144;
            const float rstd = 1.f / sqrtf(s2[u] * (1.f / DD) + LN_EPS);
#pragma unroll
            for (int j = 0; j < 4; ++j) { const int c = 256 * j + 4 * lane;
                const f32x4 y = v[u][j] * rstd * g[j] + bb[j]; *(GAS unsigned long long*)(LAT + (size_t)row * DD + c) = (unsigned long long)pk2(y.x, y.y) | ((unsigned long long)pk2(y.z, y.w) << 32);
                const f32x4 sh = *(const GAS f32x4*)(md + 3072 + c), sc = *(const GAS f32x4*)(md + 4096 + c); const f32x4 h = y * (sc + 1.f) + sh;
                *(GAS unsigned long long*)(H + (size_t)row * DD + c) = (unsigned long long)pk2(h.x, h.y) | ((unsigned long long)pk2(h.z, h.w) << 32); } }
    }
}
__device__ __forceinline__ void da_combine_phase(unsigned char* ws, const float* lam_p, const float* subln, float lam_init, int skip_ctx, int gw, int NGW, int lane) {
    const bf16* O0 = (const bf16*)(ws + WS_B); const bf16* O1 = (const bf16*)(ws + WS_B + SZ72); bf16* OC = (bf16*)(ws + WS_A);
    float d01 = lam_p[lane] * lam_p[64 + lane], d23 = lam_p[128 + lane] * lam_p[192 + lane];
    d01 = wave_sum(d01); d23 = wave_sum(d23);
    const float lam = expf(d01) - expf(d23) + lam_init, post = 1.f - lam_init;
    float gs[16];
#pragma unroll
    for (int j = 0; j < 16; ++j) gs[j] = subln[((lane & 7) * 16 + j)] * post;
    for (int row = gw; row < MR; row += NGW) { const int b = row / SQ, s = row - b * SQ; if (skip_ctx && s < LC) continue;
        const size_t off = (size_t)row * DD + 16 * lane;
        const v4u a0 = *(const GAS v4u*)(O0 + off), a1 = *(const GAS v4u*)(O0 + off + 8), b0 = *(const GAS v4u*)(O1 + off), b1 = *(const GAS v4u*)(O1 + off + 8);
        float o[16];
        o[0] = bflo(a0.x) - lam * bflo(b0.x); o[1] = bfhi(a0.x) - lam * bfhi(b0.x); o[2] = bflo(a0.y) - lam * bflo(b0.y); o[3] = bfhi(a0.y) - lam * bfhi(b0.y);
        o[4] = bflo(a0.z) - lam * bflo(b0.z); o[5] = bfhi(a0.z) - lam * bfhi(b0.z); o[6] = bflo(a0.w) - lam * bflo(b0.w); o[7] = bfhi(a0.w) - lam * bfhi(b0.w);
        o[8] = bflo(a1.x) - lam * bflo(b1.x); o[9] = bfhi(a1.x) - lam * bfhi(b1.x); o[10] = bflo(a1.y) - lam * bflo(b1.y); o[11] = bfhi(a1.y) - lam * bfhi(b1.y);
        o[12] = bflo(a1.z) - lam * bflo(b1.z); o[13] = bfhi(a1.z) - lam * bfhi(b1.z); o[14] = bflo(a1.w) - lam * bflo(b1.w); o[15] = bfhi(a1.w) - lam * bfhi(b1.w);
        float ss = 0.f;
#pragma unroll
        for (int j = 0; j < 16; ++j) ss += o[j] * o[j];
        ss += __shfl_xor(ss, 1); ss += __shfl_xor(ss, 2); ss += __shfl_xor(ss, 4);
        const float rs = 1.f / sqrtf(ss * (1.f / 128.f) + LN_EPS);
        v4u w0, w1;
        w0.x = pk2(o[0] * rs * gs[0], o[1] * rs * gs[1]); w0.y = pk2(o[2] * rs * gs[2], o[3] * rs * gs[3]); w0.z = pk2(o[4] * rs * gs[4], o[5] * rs * gs[5]); w0.w = pk2(o[6] * rs * gs[6], o[7] * rs * gs[7]);
        w1.x = pk2(o[8] * rs * gs[8], o[9] * rs * gs[9]); w1.y = pk2(o[10] * rs * gs[10], o[11] * rs * gs[11]); w1.z = pk2(o[12] * rs * gs[12], o[13] * rs * gs[13]); w1.w = pk2(o[14] * rs * gs[14], o[15] * rs * gs[15]);
        *(GAS v4u*)(OC + off) = w0; *(GAS v4u*)(OC + off + 8) = w1; }
}
template <int N> __device__ __forceinline__ void sort_desc_u32(unsigned (&v)[N]) {
#pragma unroll
    for (int k = 2; k <= N; k <<= 1)
#pragma unroll
        for (int j = k >> 1; j > 0; j >>= 1)
#pragma unroll
            for (int i = 0; i < N; ++i) { const int l = i ^ j; if (l > i) { const unsigned a = v[i], b = v[l]; const unsigned mx = a > b ? a : b, mn = a > b ? b : a; const bool desc = ((i & k) == 0) || (k == N);
                    v[i] = desc ? mx : mn; v[l] = desc ? mn : mx; } }
}
template <int N> __device__ __forceinline__ void merge_desc_u32(unsigned (&v)[N]) {
#pragma unroll
    for (int j = N >> 1; j > 0; j >>= 1)
#pragma unroll
        for (int i = 0; i < N; ++i) { const int l = i ^ j; if (l > i) { const unsigned a = v[i], b = v[l]; v[i] = a > b ? a : b; v[l] = a > b ? b : a; } }
}
__device__ __forceinline__ void top16_u32(unsigned (&a)[16], const unsigned (&b)[16]) {
#pragma unroll
    for (int i = 0; i < 16; ++i) a[i] = a[i] > b[15 - i] ? a[i] : b[15 - i];
    merge_desc_u32<16>(a);
}
#define CE_F(i, l, up) do { const bool gt_ = s[i] > s[l]; const float s_hi = gt_ ? s[i] : s[l], s_lo = gt_ ? s[l] : s[i]; const int e_hi = gt_ ? e[i] : e[l], e_lo = gt_ ? e[l] : e[i]; \
        if (up) { s[i] = s_hi; s[l] = s_lo; e[i] = e_hi; e[l] = e_lo; } else { s[i] = s_lo; s[l] = s_hi; e[i] = e_lo; e[l] = e_hi; } } while (0)
template <int N> __device__ __forceinline__ void sort_desc_f(float (&s)[N], int (&e)[N]) {
#pragma unroll
    for (int k = 2; k <= N; k <<= 1)
#pragma unroll
        for (int j = k >> 1; j > 0; j >>= 1)
#pragma unroll
            for (int i = 0; i < N; ++i) { const int l = i ^ j; if (l > i) { const bool desc = ((i & k) == 0) || (k == N); CE_F(i, l, desc); } }
}
template <int N> __device__ __forceinline__ void merge_desc_f(float (&s)[N], int (&e)[N]) {
#pragma unroll
    for (int j = N >> 1; j > 0; j >>= 1)
#pragma unroll
        for (int i = 0; i < N; ++i) { const int l = i ^ j; if (l > i) { CE_F(i, l, true); } }
}
__device__ __forceinline__ unsigned fkey(float f) { const unsigned u = __float_as_uint(f); return u ^ ((unsigned)((int)u >> 31) | 0x80000000u); }
__device__ __forceinline__ float fdec(unsigned k) { const unsigned u = (k & 0x80000000u) ? (k ^ 0x80000000u) : ~k; return __uint_as_float(u); }

__device__ __forceinline__ void topk_phase(unsigned char* ws, int layer, int skip_ctx, LAS unsigned char* lds, int vcu, int G, int tid, int lane, int wave) {
    const bf16* PQ = (const bf16*)(ws + WS_A); const bf16* KEYS = (const bf16*)(ws + WS_KEYS) + (size_t)layer * 2 * 8 * 128 * 128;
    int* EIDX = (int*)(ws + WS_B); float* EG = (float*)(ws + WS_B + (size_t)MR * 128 * 4);
    const int nrt = skip_ctx ? 128 : 144, nunits = nrt * 8;
    const int r32 = lane & 31, hi = lane >> 5;
    constexpr int KP = 272;
    int cur_h = -1;
    const int gq = G >> 3, hgrp = vcu / gq, wq = vcu - hgrp * gq;
    for (int u2 = wq; u2 < nrt; u2 += gq) {
        const int h = hgrp & 7, rtl = u2; const int rt = skip_ctx ? (rtl >> 3) * 9 + 1 + (rtl & 7) : rtl;
        if (h != cur_h) { __syncthreads();
            for (int c = tid; c < 2 * 128 * 16; c += NTHR) { const int j = c >> 11, k = (c >> 4) & 127, ch = c & 15;
                const v4u v = *(const GAS v4u*)(KEYS + ((size_t)(j * 8 + h) * 128 + k) * 128 + ch * 8); *(LAS v4u*)(lds + (j * 128 + k) * KP + ch * 16) = v; }
            __syncthreads(); cur_h = h; }
        const int row = rt * 256 + wave * 32 + r32;
        unsigned top[2][16];
#pragma unroll
        for (int j = 0; j < 2; ++j) {
            const bf16* qp = PQ + (size_t)row * 2048 + h * 256 + j * 128 + hi * 8;
            bf16x8 bq[8];
#pragma unroll
            for (int ks = 0; ks < 8; ++ks) bq[ks] = *(const GAS bf16x8*)(qp + ks * 16);
            unsigned t0[16];
#pragma unroll
            for (int r = 0; r < 16; ++r) t0[r] = 0u;
#pragma unroll 1
            for (int blk = 0; blk < 4; ++blk) { f32x16 acc = (f32x16){};
#pragma unroll
                for (int ks = 0; ks < 8; ++ks) { const bf16x8 ka = *(const LAS bf16x8*)(lds + (j * 128 + blk * 32 + r32) * KP + (ks * 16 + hi * 8) * 2);
                    acc = __builtin_amdgcn_mfma_f32_32x32x16_bf16(ka, bq[ks], acc, 0, 0, 0); }
                unsigned g[16]; const unsigned kb0 = (unsigned)(blk * 32 + 4 * hi);
#pragma unroll
                for (int r = 0; r < 16; ++r) g[r] = (fkey(acc[r]) & ~127u) | (kb0 + (unsigned)((r & 3) + 8 * (r >> 2)));
                sort_desc_u32<16>(g);
                top16_u32(t0, g); }
            unsigned oth[16];
#pragma unroll
            for (int r = 0; r < 16; ++r) oth[r] = (unsigned)__shfl_xor((int)t0[r], 32);
            top16_u32(t0, oth);
#pragma unroll
            for (int r = 0; r < 16; ++r) top[j][r] = t0[r];
        }
        LAS unsigned char* tab = lds + 2 * 128 * KP + wave * (64 * 36) + lane * 36;
#pragma unroll
        for (int r = 0; r < 16; ++r) { tab[r] = (unsigned char)(top[0][r] & 127u); tab[16 + r] = (unsigned char)(top[1][r] & 127u); }
        float sA[16], sB[16];
#pragma unroll
        for (int r = 0; r < 16; ++r) { sA[r] = fdec(top[0][r] & ~127u); sB[r] = fdec(top[1][r] & ~127u); }
        unsigned ck[32];
        { int c = 0;
#pragma unroll
          for (int a = 0; a < 16; ++a)
#pragma unroll
              for (int b = 0; b < 16; ++b) if ((a + 1) * (b + 1) <= 16) { const int slot = c >> 1; const unsigned kk = (fkey(sA[a] + sB[b]) & ~255u) | (unsigned)(a * 16 + b);
                      if ((c & 1) == 0) ck[slot] = kk; else ck[slot] = hi ? kk : ck[slot];
                      ++c; }
#pragma unroll
          for (int slot = 25; slot < 32; ++slot) ck[slot] = 0u; }
        sort_desc_u32<32>(ck);
        unsigned k16[16];
#pragma unroll
        for (int r = 0; r < 16; ++r) k16[r] = ck[r];
        { unsigned oth[16];
#pragma unroll
          for (int r = 0; r < 16; ++r) oth[r] = (unsigned)__shfl_xor((int)k16[r], 32);
          top16_u32(k16, oth); }
        asm volatile("s_waitcnt lgkmcnt(0)" ::: "memory");
        float s16[16]; int e16[16];
#pragma unroll
        for (int r = 0; r < 16; ++r) { s16[r] = fdec(k16[r] & ~255u); const int ia = tab[(k16[r] >> 4) & 15u], ib = tab[16 + (k16[r] & 15u)]; e16[r] = ia * 128 + ib; }
        float den = 0.f, p[16];
#pragma unroll
        for (int r = 0; r < 16; ++r) { p[r] = __builtin_amdgcn_exp2f((s16[r] - s16[0]) * LOG2E); den += p[r]; }
        const float rden = 1.f / den;
        const size_t ob = ((size_t)row * 8 + h) * 16;
        if (hi == 0) {
#pragma unroll
            for (int q = 0; q < 4; ++q) { v4u w; w.x = (unsigned)e16[4 * q]; w.y = (unsigned)e16[4 * q + 1]; w.z = (unsigned)e16[4 * q + 2]; w.w = (unsigned)e16[4 * q + 3]; *(GAS v4u*)(EIDX + ob + 4 * q) = w; }
        } else {
#pragma unroll
            for (int q = 0; q < 4; ++q) { f32x4 w; w.x = p[4 * q] * rden; w.y = p[4 * q + 1] * rden; w.z = p[4 * q + 2] * rden; w.w = p[4 * q + 3] * rden; *(GAS f32x4*)(EG + ob + 4 * q) = w; }
        }
    }
}

typedef float f32x2p __attribute__((ext_vector_type(2)));
__device__ __forceinline__ void peer_phase(unsigned char* ws, float* d_out, const float* lng, const float* lnb, int layer, int last, int dry, int gw, int NGW, int lane) {
    const bf16* H = (const bf16*)(ws + WS_H); bf16* LAT = (bf16*)(ws + WS_LAT); bf16* Hn = (bf16*)(ws + WS_H);
    const unsigned char* PU = ws + WS_PU + (size_t)layer * 16384 * 1024; const unsigned char* PV = ws + WS_PV + (size_t)layer * 16384 * 1024;
    const int* EIDX = (const int*)(ws + WS_B); const float* EG = (const float*)(ws + WS_B + (size_t)MR * 128 * 4);
    const float* MOD = (const float*)(ws + WS_MOD) + (size_t)layer * 17 * 6144; const float* MODN = MOD + 17 * 6144;
    const int b3 = (lane >> 3) & 1, b4 = (lane >> 4) & 1, b5 = lane >> 5;
    for (int row = gw; row < MR; row += NGW) { const int b = row / SQ, s = row - b * SQ; if (last && s < LC) continue;
        const int midx = (s < LC) ? 16 : b;
        float x[16];
        { const v4u xa = *(const GAS v4u*)(H + (size_t)row * DD + 16 * lane), xb = *(const GAS v4u*)(H + (size_t)row * DD + 16 * lane + 8);
          x[0] = bflo(xa.x); x[1] = bfhi(xa.x); x[2] = bflo(xa.y); x[3] = bfhi(xa.y); x[4] = bflo(xa.z); x[5] = bfhi(xa.z); x[6] = bflo(xa.w); x[7] = bfhi(xa.w);
          x[8] = bflo(xb.x); x[9] = bfhi(xb.x); x[10] = bflo(xb.y); x[11] = bfhi(xb.y); x[12] = bflo(xb.z); x[13] = bfhi(xb.z); x[14] = bflo(xb.w); x[15] = bfhi(xb.w); }
        const int e_lo = EIDX[(size_t)row * 128 + lane], e_hi = EIDX[(size_t)row * 128 + 64 + lane];
        const float g_lo = EG[(size_t)row * 128 + lane], g_hi = EG[(size_t)row * 128 + 64 + lane];
        float out[16];
#pragma unroll
        for (int j = 0; j < 16; ++j) out[j] = 0.f;
        for (int kb = 0; kb < 128; kb += 8) {
            const int esel = (kb < 64) ? e_lo : e_hi; const float gsel = (kb < 64) ? g_lo : g_hi;
            v4u u8[8], v8[8];
#pragma unroll
            for (int k = 0; k < 8; ++k) { const int ek = __builtin_amdgcn_readlane(esel, (kb & 63) + k); u8[k] = *(const GAS v4u*)(PU + (size_t)ek * 1024 + 16 * lane); }
#pragma unroll
            for (int k = 0; k < 8; ++k) { const int ek = __builtin_amdgcn_readlane(esel, (kb & 63) + k); v8[k] = *(const GAS v4u*)(PV + (size_t)ek * 1024 + 16 * lane); }
            float d[8];
#pragma unroll
            for (int k = 0; k < 8; ++k) { float a0 = 0.f, a1 = 0.f;
#pragma unroll
                for (int q = 0; q < 4; ++q) { const int w = (int)u8[k][q]; const f32x2p lo = __builtin_amdgcn_cvt_pk_f32_fp8(w, false), hi2 = __builtin_amdgcn_cvt_pk_f32_fp8(w, true);
                    a0 = fmaf(lo.x, x[4 * q], a0); a1 = fmaf(lo.y, x[4 * q + 1], a1); a0 = fmaf(hi2.x, x[4 * q + 2], a0); a1 = fmaf(hi2.y, x[4 * q + 3], a1); }
                d[k] = a0 + a1; }
            float s4[4], s2[2], s1;
#pragma unroll
            for (int k = 0; k < 4; ++k) { const float snd = b5 ? d[k] : d[k + 4], mine = b5 ? d[k + 4] : d[k]; s4[k] = mine + __shfl_xor(snd, 32); }
#pragma unroll
            for (int k = 0; k < 2; ++k) { const float snd = b4 ? s4[k] : s4[k + 2], mine = b4 ? s4[k + 2] : s4[k]; s2[k] = mine + __shfl_xor(snd, 16); }
            { const float snd = b3 ? s2[0] : s2[1], mine = b3 ? s2[1] : s2[0]; s1 = mine + __shfl_xor(snd, 8); }
            s1 += __shfl_xor(s1, 4); s1 += __shfl_xor(s1, 2); s1 += __shfl_xor(s1, 1);
            const float gk = __shfl(gsel, (kb & 63) + (lane >> 3));
            const float w = gk * gelu_tanh(s1 * (1.f / PU_SCALE)) * (1.f / PV_SCALE);
#pragma unroll
            for (int k = 0; k < 8; ++k) { const float wk = __uint_as_float((unsigned)__builtin_amdgcn_readlane((int)__float_as_uint(w), 8 * k));
#pragma unroll
                for (int q = 0; q < 4; ++q) { const int vw = (int)v8[k][q]; const f32x2p lo = __builtin_amdgcn_cvt_pk_f32_fp8(vw, false), hi2 = __builtin_amdgcn_cvt_pk_f32_fp8(vw, true);
                    out[4 * q] = fmaf(wk, lo.x, out[4 * q]); out[4 * q + 1] = fmaf(wk, lo.y, out[4 * q + 1]); out[4 * q + 2] = fmaf(wk, hi2.x, out[4 * q + 2]); out[4 * q + 3] = fmaf(wk, hi2.y, out[4 * q + 3]); } }
        }
        const float* md = MOD + (size_t)midx * 6144; float r[16]; float sm = 0.f;
#pragma unroll
        for (int q = 0; q < 4; ++q) { const int c = 16 * lane + 4 * q; const unsigned long long lb = *(const GAS unsigned long long*)(LAT + (size_t)row * DD + c); const unsigned l0 = (unsigned)lb, l1 = (unsigned)(lb >> 32);
            f32x4 lv; lv[0] = bflo(l0); lv[1] = bfhi(l0); lv[2] = bflo(l1); lv[3] = bfhi(l1); const f32x4 gv = *(const GAS f32x4*)(md + 5120 + c);
#pragma unroll
            for (int j = 0; j < 4; ++j) { const float t = DN_ALPHA * lv[j] + gv[j] * out[4 * q + j]; r[4 * q + j] = t; sm += t; } }
        const float mean = wave_sum(sm) * (1.f / DD); float s2s = 0.f;
#pragma unroll
        for (int j = 0; j < 16; ++j) { r[j] -= mean; s2s += r[j] * r[j]; }
        const float rstd = 1.f / sqrtf(wave_sum(s2s) * (1.f / DD) + LN_EPS);
        const float* mdn = MODN + (size_t)midx * 6144;
        float y[16];
#pragma unroll
        for (int q = 0; q < 4; ++q) { const int c = 16 * lane + 4 * q; const f32x4 g = *(const GAS f32x4*)(lng + c), bb = *(const GAS f32x4*)(lnb + c);
#pragma unroll
            for (int j = 0; j < 4; ++j) y[4 * q + j] = r[4 * q + j] * rstd * g[j] + bb[j]; }
        const int c0 = 16 * lane;
        if (dry) { if (y[0] == 123.456f) LAT[0] = (bf16)f2bf(y[1] + y[2] + y[3] + y[4] + y[5] + y[6] + y[7] + y[8] + y[9] + y[10] + y[11] + y[12] + y[13] + y[14] + y[15]); }
        else if (last) { float* op = d_out + ((size_t)b * TL + (s - LC)) * DD + c0;
#pragma unroll
            for (int q = 0; q < 4; ++q) *(GAS f32x4*)(op + 4 * q) = (f32x4){y[4 * q], y[4 * q + 1], y[4 * q + 2], y[4 * q + 3]}; }
        else { { v4u l0, l1; l0.x = pk2(y[0], y[1]); l0.y = pk2(y[2], y[3]); l0.z = pk2(y[4], y[5]); l0.w = pk2(y[6], y[7]); l1.x = pk2(y[8], y[9]); l1.y = pk2(y[10], y[11]); l1.z = pk2(y[12], y[13]); l1.w = pk2(y[14], y[15]);
              *(GAS v4u*)(LAT + (size_t)row * DD + c0) = l0; *(GAS v4u*)(LAT + (size_t)row * DD + c0 + 8) = l1; }
            float hh[16];
#pragma unroll
            for (int q = 0; q < 4; ++q) { const f32x4 sh = *(const GAS f32x4*)(mdn + c0 + 4 * q), sc = *(const GAS f32x4*)(mdn + 1024 + c0 + 4 * q);
#pragma unroll
                for (int j = 0; j < 4; ++j) hh[4 * q + j] = y[4 * q + j] * (1.f + sc[j]) + sh[j]; }
            v4u w0, w1; w0.x = pk2(hh[0], hh[1]); w0.y = pk2(hh[2], hh[3]); w0.z = pk2(hh[4], hh[5]); w0.w = pk2(hh[6], hh[7]); w1.x = pk2(hh[8], hh[9]); w1.y = pk2(hh[10], hh[11]); w1.z = pk2(hh[12], hh[13]); w1.w = pk2(hh[14], hh[15]);
            *(GAS v4u*)(Hn + (size_t)row * DD + c0) = w0; *(GAS v4u*)(Hn + (size_t)row * DD + c0 + 8) = w1; }
    }
}

__device__ __forceinline__ int peer_row(int t, int last) { return last ? (t >> 11) * SQ + LC + (t & 2047) : t; }
typedef _Float16 h2v __attribute__((ext_vector_type(2)));
__device__ __forceinline__ h2v pkh(float lo, float hi) { return __builtin_bit_cast(h2v, __builtin_amdgcn_cvt_pkrtz(lo, hi)); }
__device__ __forceinline__ void peer_gu_phase(unsigned char* ws, float* d_out, const float* lng, const float* lnb, int layer, int last, int dry, int gw, int NGW, int lane) {
    const bf16* H = (const bf16*)(ws + WS_H); bf16* LAT = (bf16*)(ws + WS_LAT); bf16* Hn = (bf16*)(ws + WS_H);
    const unsigned char* PU = ws + WS_PU + (size_t)layer * 16384 * 1024; const unsigned char* PV = ws + WS_PV + (size_t)layer * 16384 * 1024;
    float* Wb = (float*)(ws + WS_B + (size_t)2 * MR * 128 * 4);
    const int* EIDX = (const int*)(ws + WS_B); const float* EG = (const float*)(ws + WS_B + (size_t)MR * 128 * 4);
    const float* MOD = (const float*)(ws + WS_MOD) + (size_t)layer * 17 * 6144; const float* MODN = MOD + 17 * 6144;
    const int b2 = (lane >> 2) & 1, b3 = (lane >> 3) & 1, b4 = (lane >> 4) & 1, b5 = lane >> 5;
    const int ntok = last ? NB * TL : MR;
    v4u nxa, nxb; int ne_lo = 0, ne_hi = 0; float ng_lo = 0.f, ng_hi = 0.f;
    if (gw < ntok) { const int r0 = peer_row(gw, last); nxa = *(const GAS v4u*)(H + (size_t)r0 * DD + 16 * lane); nxb = *(const GAS v4u*)(H + (size_t)r0 * DD + 16 * lane + 8);
        ne_lo = EIDX[(size_t)r0 * 128 + lane]; ne_hi = EIDX[(size_t)r0 * 128 + 64 + lane]; ng_lo = EG[(size_t)r0 * 128 + lane]; ng_hi = EG[(size_t)r0 * 128 + 64 + lane]; }
    for (int t = gw; t < ntok; t += NGW) { const int row = peer_row(t, last);
        const v4u xa = nxa, xb = nxb; const int e_lo = ne_lo, e_hi = ne_hi; const float g_lo = ng_lo, g_hi = ng_hi;
        if (t + NGW < ntok) { const int r1 = peer_row(t + NGW, last); nxa = *(const GAS v4u*)(H + (size_t)r1 * DD + 16 * lane); nxb = *(const GAS v4u*)(H + (size_t)r1 * DD + 16 * lane + 8);
            ne_lo = EIDX[(size_t)r1 * 128 + lane]; ne_hi = EIDX[(size_t)r1 * 128 + 64 + lane]; ng_lo = EG[(size_t)r1 * 128 + lane]; ng_hi = EG[(size_t)r1 * 128 + 64 + lane]; }
        h2v xh[8];
        xh[0] = pkh(bflo(xa.x), bfhi(xa.x)); xh[1] = pkh(bflo(xa.y), bfhi(xa.y)); xh[2] = pkh(bflo(xa.z), bfhi(xa.z)); xh[3] = pkh(bflo(xa.w), bfhi(xa.w));
        xh[4] = pkh(bflo(xb.x), bfhi(xb.x)); xh[5] = pkh(bflo(xb.y), bfhi(xb.y)); xh[6] = pkh(bflo(xb.z), bfhi(xb.z)); xh[7] = pkh(bflo(xb.w), bfhi(xb.w));
        for (int kb = 0; kb < 128; kb += 16) {
            const int esel = (kb < 64) ? e_lo : e_hi; const float gsel = (kb < 64) ? g_lo : g_hi;
            v4u u8[16];
#pragma unroll
            for (int k = 0; k < 16; ++k) { const int ek = __builtin_amdgcn_readlane(esel, (kb & 63) + k); u8[k] = *(const GAS v4u*)(PU + (size_t)ek * 1024 + 16 * lane); }
            float d[16];
#pragma unroll
            for (int k = 0; k < 16; ++k) { float a0 = 0.f, a1 = 0.f;
#pragma unroll
                for (int q = 0; q < 4; ++q) { const int w = (int)u8[k][q];
                    a0 = __builtin_amdgcn_fdot2(__builtin_bit_cast(h2v, __builtin_amdgcn_cvt_scalef32_pk_f16_fp8(w, 1.0f, false)), xh[2 * q], a0, false); a1 = __builtin_amdgcn_fdot2(__builtin_bit_cast(h2v, __builtin_amdgcn_cvt_scalef32_pk_f16_fp8(w, 1.0f, true)), xh[2 * q + 1], a1, false); }
                d[k] = a0 + a1; }
            float s8[8], s4[4], s2[2], s1;
#pragma unroll
            for (int k = 0; k < 8; ++k) { const float snd = b5 ? d[k] : d[k + 8], mine = b5 ? d[k + 8] : d[k]; s8[k] = mine + __shfl_xor(snd, 32); }
#pragma unroll
            for (int k = 0; k < 4; ++k) { const float snd = b4 ? s8[k] : s8[k + 4], mine = b4 ? s8[k + 4] : s8[k]; s4[k] = mine + __shfl_xor(snd, 16); }
#pragma unroll
            for (int k = 0; k < 2; ++k) { const float snd = b3 ? s4[k] : s4[k + 2], mine = b3 ? s4[k + 2] : s4[k]; s2[k] = mine + __shfl_xor(snd, 8); }
            { const float snd = b2 ? s2[0] : s2[1], mine = b2 ? s2[1] : s2[0]; s1 = mine + __shfl_xor(snd, 4); }
            s1 += __shfl_xor(s1, 2); s1 += __shfl_xor(s1, 1);
            const float gk = __shfl(gsel, (kb & 63) + (lane >> 2));
            const float w = gk * gelu_tanh(s1 * (1.f / PU_SCALE));
            if ((lane & 3) == 0) Wb[(size_t)row * 128 + kb + (lane >> 2)] = w;
        }
    }
}
template <int CTRL> __device__ __forceinline__ float dppx(float x) { return __builtin_bit_cast(float, __builtin_amdgcn_update_dpp(0, __builtin_bit_cast(int, x), CTRL, 0xF, 0xF, false)); }
typedef int v4i_q __attribute__((ext_vector_type(4)));
constexpr size_t WS_PQP = WS_A;
__device__ __forceinline__ void peer_uq_phase(unsigned char* ws, int layer, int last, int quarter, int widx, int nwq, int lane) {
    const bf16* H = (const bf16*)(ws + WS_H); const int* EIDX = (const int*)(ws + WS_B);
    const unsigned char* tb = ws + WS_PU + (size_t)layer * 16384 * 1024 + 256 * quarter;
    float* P = (float*)(ws + WS_PQP) + (size_t)quarter * MR * 128;
    const int rsel = lane >> 4, csel = lane & 15, b0 = lane & 1, b1 = (lane >> 1) & 1, b2 = (lane >> 2) & 1, b3 = (lane >> 3) & 1;
    const unsigned c16 = 16u * (unsigned)csel;
    const int ntok = last ? NB * TL : MR;
    v4i_q ne[8]; v4u nx0, nx1;
#define UQ_LOADTOK(t_) do { const int tc_ = ((t_) < ntok) ? (t_) : ntok - 1; const int r_ = peer_row(tc_, last); const int* ip_ = EIDX + (size_t)r_ * 128 + 32 * rsel; \
        _Pragma("unroll") for (int q_ = 0; q_ < 8; ++q_) ne[q_] = *(const GAS v4i_q*)(ip_ + 4 * q_); \
        const bf16* hp_ = H + (size_t)r_ * DD + 256 * quarter + 16 * csel; nx0 = *(const GAS v4u*)hp_; nx1 = *(const GAS v4u*)(hp_ + 8); } while (0)
    UQ_LOADTOK(widx);
    for (int t = widx; t < ntok; t += nwq) { const int row = peer_row(t, last);
        v4i_q ce[8];
#pragma unroll
        for (int q = 0; q < 8; ++q) ce[q] = ne[q];
        const v4u xa = nx0, xb = nx1;
        UQ_LOADTOK(t + nwq);
        h2v xh[8];
        xh[0] = pkh(bflo(xa.x), bfhi(xa.x)); xh[1] = pkh(bflo(xa.y), bfhi(xa.y)); xh[2] = pkh(bflo(xa.z), bfhi(xa.z)); xh[3] = pkh(bflo(xa.w), bfhi(xa.w));
        xh[4] = pkh(bflo(xb.x), bfhi(xb.x)); xh[5] = pkh(bflo(xb.y), bfhi(xb.y)); xh[6] = pkh(bflo(xb.z), bfhi(xb.z)); xh[7] = pkh(bflo(xb.w), bfhi(xb.w));
#pragma unroll
        for (int bt = 0; bt < 2; ++bt) {
            v4u u8[16];
#pragma unroll
            for (int i = 0; i < 16; ++i) { const unsigned vo = ((unsigned)ce[4 * bt + (i >> 2)][i & 3] << 10) + c16; u8[i] = *(const GAS v4u*)(tb + vo); }
            float d[16];
#pragma unroll
            for (int i = 0; i < 16; ++i) { float a0 = 0.f, a1 = 0.f;
#pragma unroll
                for (int q = 0; q < 4; ++q) { const int w = (int)u8[i][q];
                    a0 = __builtin_amdgcn_fdot2(__builtin_bit_cast(h2v, __builtin_amdgcn_cvt_scalef32_pk_f16_fp8(w, 1.0f, false)), xh[2 * q], a0, false); a1 = __builtin_amdgcn_fdot2(__builtin_bit_cast(h2v, __builtin_amdgcn_cvt_scalef32_pk_f16_fp8(w, 1.0f, true)), xh[2 * q + 1], a1, false); }
                d[i] = a0 + a1; }
            float r8[8], r4[4], r2[2], r1;
#pragma unroll
            for (int c = 0; c < 8; ++c) { const float snd = b3 ? d[c] : d[c + 8], mine = b3 ? d[c + 8] : d[c]; r8[c] = mine + dppx<0x128>(snd); }
#pragma unroll
            for (int c = 0; c < 4; ++c) { const float snd = b2 ? r8[c] : r8[c + 4], mine = b2 ? r8[c + 4] : r8[c]; r4[c] = mine + dppx<0x141>(snd); }
#pragma unroll
            for (int c = 0; c < 2; ++c) { const float snd = b1 ? r4[c] : r4[c + 2], mine = b1 ? r4[c + 2] : r4[c]; r2[c] = mine + dppx<0x4E>(snd); }
            { const float snd = b0 ? r2[0] : r2[1], mine = b0 ? r2[1] : r2[0]; r1 = mine + dppx<0xB1>(snd); }
            P[(size_t)row * 128 + 32 * rsel + 16 * bt + csel] = r1;
        }
    }
#undef UQ_LOADTOK
}
__device__ __forceinline__ void peer_gv_phase(unsigned char* ws, float* d_out, const float* lng, const float* lnb, int layer, int last, int dry, int gw, int NGW, int lane) {
    const bf16* H = (const bf16*)(ws + WS_H); bf16* LAT = (bf16*)(ws + WS_LAT); bf16* Hn = (bf16*)(ws + WS_H);
    const unsigned char* PU = ws + WS_PU + (size_t)layer * 16384 * 1024; const unsigned char* PV = ws + WS_PV + (size_t)layer * 16384 * 1024;
    const float* PQP = (const float*)(ws + WS_PQP);
    const int* EIDX = (const int*)(ws + WS_B); const float* EG = (const float*)(ws + WS_B + (size_t)MR * 128 * 4);
    const float* MOD = (const float*)(ws + WS_MOD) + (size_t)layer * 17 * 6144; const float* MODN = MOD + 17 * 6144;
    const int b3 = (lane >> 3) & 1, b4 = (lane >> 4) & 1, b5 = lane >> 5;
    const int ntok = last ? NB * TL : MR;
    int ne_lo = 0, ne_hi = 0; float ng_lo = 0.f, ng_hi = 0.f, np_lo[4], np_hi[4];
#pragma unroll
    for (int q = 0; q < 4; ++q) { np_lo[q] = 0.f; np_hi[q] = 0.f; }
#define GV_LOADTOK(r_) do { const size_t o_ = (size_t)(r_) * 128 + lane; ne_lo = EIDX[o_]; ne_hi = EIDX[o_ + 64]; ng_lo = EG[o_]; ng_hi = EG[o_ + 64]; \
        _Pragma("unroll") for (int q_ = 0; q_ < 4; ++q_) { np_lo[q_] = PQP[(size_t)q_ * MR * 128 + o_]; np_hi[q_] = PQP[(size_t)q_ * MR * 128 + o_ + 64]; } } while (0)
    if (gw < ntok) { const int r0 = peer_row(gw, last); GV_LOADTOK(r0); }
    for (int t = gw; t < ntok; t += NGW) { const int row = peer_row(t, last); const int b = row / SQ, s = row - b * SQ;
        const int midx = (s < LC) ? 16 : b;
        const int e_lo = ne_lo, e_hi = ne_hi;
        const float g_lo = ng_lo * gelu_tanh(((np_lo[0] + np_lo[1]) + (np_lo[2] + np_lo[3])) * (1.f / PU_SCALE)), g_hi = ng_hi * gelu_tanh(((np_hi[0] + np_hi[1]) + (np_hi[2] + np_hi[3])) * (1.f / PU_SCALE));
        if (t + NGW < ntok) { const int r1 = peer_row(t + NGW, last); GV_LOADTOK(r1); }
        float out[16];
#pragma unroll
        for (int j = 0; j < 16; ++j) out[j] = 0.f;
        for (int kb = 0; kb < 128; kb += 16) {
            const int esel = (kb < 64) ? e_lo : e_hi; const float gsel = (kb < 64) ? g_lo : g_hi;
            v4u v8[16];
#pragma unroll
            for (int k = 0; k < 16; ++k) { const int ek = __builtin_amdgcn_readlane(esel, (kb & 63) + k); v8[k] = *(const GAS v4u*)(PV + (size_t)ek * 1024 + 16 * lane); }
            const float w = __shfl(gsel, (kb & 63) + (lane >> 2));
            const int w16 = __builtin_bit_cast(int, pkh(w, w));
            h2v acc16[8];
#pragma unroll
            for (int q = 0; q < 8; ++q) acc16[q] = (h2v){(_Float16)0.f, (_Float16)0.f};
#pragma unroll
            for (int k = 0; k < 16; ++k) { const h2v wk2 = __builtin_bit_cast(h2v, __builtin_amdgcn_readlane(w16, 4 * k));
#pragma unroll
                for (int q = 0; q < 4; ++q) { const int vw = (int)v8[k][q];
                    acc16[2 * q] = __builtin_elementwise_fma(wk2, __builtin_bit_cast(h2v, __builtin_amdgcn_cvt_scalef32_pk_f16_fp8(vw, 1.0f, false)), acc16[2 * q]);
                    acc16[2 * q + 1] = __builtin_elementwise_fma(wk2, __builtin_bit_cast(h2v, __builtin_amdgcn_cvt_scalef32_pk_f16_fp8(vw, 1.0f, true)), acc16[2 * q + 1]); } }
#pragma unroll
            for (int q = 0; q < 8; ++q) { out[2 * q] += (float)acc16[q].x; out[2 * q + 1] += (float)acc16[q].y; }
        }
#pragma unroll
        for (int j = 0; j < 16; ++j) out[j] *= (1.f / PV_SCALE);
        const float* md = MOD + (size_t)midx * 6144; float r[16]; float sm = 0.f;
#pragma unroll
        for (int q = 0; q < 4; ++q) { const int c = 16 * lane + 4 * q; const unsigned long long lb = *(const GAS unsigned long long*)(LAT + (size_t)row * DD + c); const unsigned l0 = (unsigned)lb, l1 = (unsigned)(lb >> 32);
            f32x4 lv; lv[0] = bflo(l0); lv[1] = bfhi(l0); lv[2] = bflo(l1); lv[3] = bfhi(l1); const f32x4 gv = *(const GAS f32x4*)(md + 5120 + c);
#pragma unroll
            for (int j = 0; j < 4; ++j) { const float t = DN_ALPHA * lv[j] + gv[j] * out[4 * q + j]; r[4 * q + j] = t; sm += t; } }
        const float mean = wave_sum(sm) * (1.f / DD); float s2s = 0.f;
#pragma unroll
        for (int j = 0; j < 16; ++j) { r[j] -= mean; s2s += r[j] * r[j]; }
        const float rstd = 1.f / sqrtf(wave_sum(s2s) * (1.f / DD) + LN_EPS);
        const float* mdn = MODN + (size_t)midx * 6144;
        float y[16];
#pragma unroll
        for (int q = 0; q < 4; ++q) { const int c = 16 * lane + 4 * q; const f32x4 g = *(const GAS f32x4*)(lng + c), bb = *(const GAS f32x4*)(lnb + c);
#pragma unroll
            for (int j = 0; j < 4; ++j) y[4 * q + j] = r[4 * q + j] * rstd * g[j] + bb[j]; }
        const int c0 = 16 * lane;
        if (dry) { if (y[0] == 123.456f) LAT[0] = (bf16)f2bf(y[1] + y[2] + y[3] + y[4] + y[5] + y[6] + y[7] + y[8] + y[9] + y[10] + y[11] + y[12] + y[13] + y[14] + y[15]); }
        else if (last) { float* op = d_out + ((size_t)b * TL + (s - LC)) * DD + c0;
#pragma unroll
            for (int q = 0; q < 4; ++q) *(GAS f32x4*)(op + 4 * q) = (f32x4){y[4 * q], y[4 * q + 1], y[4 * q + 2], y[4 * q + 3]}; }
        else { { v4u l0, l1; l0.x = pk2(y[0], y[1]); l0.y = pk2(y[2], y[3]); l0.z = pk2(y[4], y[5]); l0.w = pk2(y[6], y[7]); l1.x = pk2(y[8], y[9]); l1.y = pk2(y[10], y[11]); l1.z = pk2(y[12], y[13]); l1.w = pk2(y[14], y[15]);
              *(GAS v4u*)(LAT + (size_t)row * DD + c0) = l0; *(GAS v4u*)(LAT + (size_t)row * DD + c0 + 8) = l1; }
            float hh[16];
#pragma unroll
            for (int q = 0; q < 4; ++q) { const f32x4 sh = *(const GAS f32x4*)(mdn + c0 + 4 * q), sc = *(const GAS f32x4*)(mdn + 1024 + c0 + 4 * q);
#pragma unroll
                for (int j = 0; j < 4; ++j) hh[4 * q + j] = y[4 * q + j] * (1.f + sc[j]) + sh[j]; }
            v4u w0, w1; w0.x = pk2(hh[0], hh[1]); w0.y = pk2(hh[2], hh[3]); w0.z = pk2(hh[4], hh[5]); w0.w = pk2(hh[6], hh[7]); w1.x = pk2(hh[8], hh[9]); w1.y = pk2(hh[10], hh[11]); w1.z = pk2(hh[12], hh[13]); w1.w = pk2(hh[14], hh[15]);
            *(GAS v4u*)(Hn + (size_t)row * DD + c0) = w0; *(GAS v4u*)(Hn + (size_t)row * DD + c0 + 8) = w1; }
    }
}

#if PEER_SLICED
constexpr size_t WS_W = WS_B + (size_t)2 * MR * 128 * 4;
constexpr size_t WS_OUT = WS_B + SZ72;
constexpr size_t WS_P = WS_A;
template <int MODE> __device__ __forceinline__ void peer_slice_pass(unsigned char* ws, int layer, int last, int slice, int widx, int nwg_slice, int lane, int wave) {
    const unsigned char* TAB = ws + (MODE == 0 ? WS_PU : WS_PV) + (size_t)layer * 16384 * 1024;
    const bf16* H = (const bf16*)(ws + WS_H); const int* EIDX = (const int*)(ws + WS_B); const float* W = (const float*)(ws + WS_W); bf16* OUT = (bf16*)(ws + WS_OUT);
    const int nwv = nwg_slice * NWAVES; const int ntok = last ? NB * TL : MR;
    float* P = (float*)(ws + WS_P) + (size_t)slice * MR * 128;
    const int b0 = lane & 1, b1 = (lane >> 1) & 1, b2 = (lane >> 2) & 1, b3 = (lane >> 3) & 1, b4 = (lane >> 4) & 1, b5 = lane >> 5, grp = lane >> 3, sub = lane & 7;
    const unsigned char* tl = TAB + ((size_t)slice << 21) + 16 * sub;
    const int t0 = widx * NWAVES + wave;
    int ec0, ec1, en0, en1, em0, em1; float wc0, wc1, wn0, wn1, wm0, wm1; v4u xc0, xc1, xn0, xn1;
    v4u rX[8], rY[8]; float fX[8], fY[8];
#define PS_LOADIDX(E0_, E1_, W0_, W1_, t_) do { if ((t_) < ntok) { const int row_ = peer_row((t_), last); E0_ = __builtin_nontemporal_load(EIDX + (size_t)row_ * 128 + lane); E1_ = __builtin_nontemporal_load(EIDX + (size_t)row_ * 128 + 64 + lane); \
        if (MODE == 1) { W0_ = __builtin_nontemporal_load(W + (size_t)row_ * 128 + lane); W1_ = __builtin_nontemporal_load(W + (size_t)row_ * 128 + 64 + lane); } } } while (0)
#define PS_LOADX(X0_, X1_, t_) do { if (MODE == 0 && (t_) < ntok) { const int row_ = peer_row((t_), last); X0_ = __builtin_nontemporal_load((const v4u*)(H + (size_t)row_ * DD + 128 * slice + 16 * sub)); X1_ = __builtin_nontemporal_load((const v4u*)(H + (size_t)row_ * DD + 128 * slice + 16 * sub + 8)); } } while (0)
#define PS_ISSUE(R_, F_, E_, W_) do { _Pragma("unroll") for (int i = 0; i < 8; ++i) { const int src = 8 * i + grp; const int e = __shfl(E_, src); \
        if (MODE == 1) F_[i] = __shfl(W_, src); R_[i] = *(const GAS v4u*)(tl + (size_t)e * 128); } } while (0)
    PS_LOADIDX(ec0, ec1, wc0, wc1, t0); PS_LOADIDX(en0, en1, wn0, wn1, t0 + nwv); PS_LOADX(xc0, xc1, t0);
    if (t0 < ntok) { PS_ISSUE(rX, fX, ec0, wc0); PS_ISSUE(rY, fY, ec1, wc1); }
    for (int t = t0; t < ntok; t += nwv) {
        const int row = peer_row(t, last); const bool more = (t + nwv) < ntok;
        PS_LOADIDX(em0, em1, wm0, wm1, t + 2 * nwv); PS_LOADX(xn0, xn1, t + nwv);
        float acc[16];
        if (MODE == 1) {
#pragma unroll
            for (int c = 0; c < 16; ++c) acc[c] = 0.f;
#pragma unroll
            for (int i = 0; i < 8; ++i) {
#pragma unroll
                for (int q = 0; q < 4; ++q) { const int vw = (int)rX[i][q]; const f32x2p lo = __builtin_amdgcn_cvt_pk_f32_fp8(vw, false), hi2 = __builtin_amdgcn_cvt_pk_f32_fp8(vw, true);
                    acc[4 * q] = fmaf(fX[i], lo.x, acc[4 * q]); acc[4 * q + 1] = fmaf(fX[i], lo.y, acc[4 * q + 1]); acc[4 * q + 2] = fmaf(fX[i], hi2.x, acc[4 * q + 2]); acc[4 * q + 3] = fmaf(fX[i], hi2.y, acc[4 * q + 3]); } }
            if (more) PS_ISSUE(rX, fX, en0, wn0);
#pragma unroll
            for (int i = 0; i < 8; ++i) {
#pragma unroll
                for (int q = 0; q < 4; ++q) { const int vw = (int)rY[i][q]; const f32x2p lo = __builtin_amdgcn_cvt_pk_f32_fp8(vw, false), hi2 = __builtin_amdgcn_cvt_pk_f32_fp8(vw, true);
                    acc[4 * q] = fmaf(fY[i], lo.x, acc[4 * q]); acc[4 * q + 1] = fmaf(fY[i], lo.y, acc[4 * q + 1]); acc[4 * q + 2] = fmaf(fY[i], hi2.x, acc[4 * q + 2]); acc[4 * q + 3] = fmaf(fY[i], hi2.y, acc[4 * q + 3]); } }
            if (more) PS_ISSUE(rY, fY, en1, wn1);
            float r8[8], r4[4], r2[2];
#pragma unroll
            for (int c = 0; c < 8; ++c) { const float snd = b5 ? acc[c] : acc[c + 8], mine = b5 ? acc[c + 8] : acc[c]; r8[c] = mine + __shfl_xor(snd, 32); }
#pragma unroll
            for (int c = 0; c < 4; ++c) { const float snd = b4 ? r8[c] : r8[c + 4], mine = b4 ? r8[c + 4] : r8[c]; r4[c] = mine + __shfl_xor(snd, 16); }
#pragma unroll
            for (int c = 0; c < 2; ++c) { const float snd = b3 ? r4[c] : r4[c + 2], mine = b3 ? r4[c + 2] : r4[c]; r2[c] = mine + __shfl_xor(snd, 8); }
            __builtin_nontemporal_store(pk2(r2[0], r2[1]), (unsigned*)(OUT + (size_t)row * DD + 128 * slice + 16 * sub + 8 * b5 + 4 * b4 + 2 * b3));
        } else {
            float x[16]; x[0] = bflo(xc0.x); x[1] = bfhi(xc0.x); x[2] = bflo(xc0.y); x[3] = bfhi(xc0.y); x[4] = bflo(xc0.z); x[5] = bfhi(xc0.z); x[6] = bflo(xc0.w); x[7] = bfhi(xc0.w);
            x[8] = bflo(xc1.x); x[9] = bfhi(xc1.x); x[10] = bflo(xc1.y); x[11] = bfhi(xc1.y); x[12] = bflo(xc1.z); x[13] = bfhi(xc1.z); x[14] = bflo(xc1.w); x[15] = bfhi(xc1.w);
#pragma unroll
            for (int i = 0; i < 8; ++i) { float a0 = 0.f, a1 = 0.f;
#pragma unroll
                for (int q = 0; q < 4; ++q) { const int uw = (int)rX[i][q]; const f32x2p lo = __builtin_amdgcn_cvt_pk_f32_fp8(uw, false), hi2 = __builtin_amdgcn_cvt_pk_f32_fp8(uw, true);
                    a0 = fmaf(lo.x, x[4 * q], a0); a1 = fmaf(lo.y, x[4 * q + 1], a1); a0 = fmaf(hi2.x, x[4 * q + 2], a0); a1 = fmaf(hi2.y, x[4 * q + 3], a1); }
                acc[i] = a0 + a1; }
            if (more) PS_ISSUE(rX, fX, en0, wn0);
#pragma unroll
            for (int i = 0; i < 8; ++i) { float a0 = 0.f, a1 = 0.f;
#pragma unroll
                for (int q = 0; q < 4; ++q) { const int uw = (int)rY[i][q]; const f32x2p lo = __builtin_amdgcn_cvt_pk_f32_fp8(uw, false), hi2 = __builtin_amdgcn_cvt_pk_f32_fp8(uw, true);
                    a0 = fmaf(lo.x, x[4 * q], a0); a1 = fmaf(lo.y, x[4 * q + 1], a1); a0 = fmaf(hi2.x, x[4 * q + 2], a0); a1 = fmaf(hi2.y, x[4 * q + 3], a1); }
                acc[8 + i] = a0 + a1; }
            if (more) PS_ISSUE(rY, fY, en1, wn1);
            float r8[8], r4[4], r2[2];
#pragma unroll
            for (int c = 0; c < 8; ++c) { const float snd = b2 ? acc[c] : acc[c + 8], mine = b2 ? acc[c + 8] : acc[c]; r8[c] = mine + __shfl_xor(snd, 4); }
#pragma unroll
            for (int c = 0; c < 4; ++c) { const float snd = b1 ? r8[c] : r8[c + 4], mine = b1 ? r8[c + 4] : r8[c]; r4[c] = mine + __shfl_xor(snd, 2); }
#pragma unroll
            for (int c = 0; c < 2; ++c) { const float snd = b0 ? r4[c] : r4[c + 2], mine = b0 ? r4[c + 2] : r4[c]; r2[c] = mine + __shfl_xor(snd, 1); }
            __builtin_nontemporal_store((unsigned long long)__float_as_uint(r2[0]) | ((unsigned long long)__float_as_uint(r2[1]) << 32), (unsigned long long*)(P + (size_t)row * 128 + 2 * lane));
        }
        ec0 = en0; ec1 = en1; wc0 = wn0; wc1 = wn1; xc0 = xn0; xc1 = xn1;
        en0 = em0; en1 = em1; wn0 = wm0; wn1 = wm1;
    }
#undef PS_LOADIDX
#undef PS_LOADX
#undef PS_ISSUE
}
__device__ __forceinline__ void peer_act_phase(unsigned char* ws, int last, int gw, int NGW, int lane) {
    const float* P = (const float*)(ws + WS_P); const float* EG = (const float*)(ws + WS_B + (size_t)MR * 128 * 4); float* W = (float*)(ws + WS_W);
    const int ntok = last ? NB * TL : MR; const int grp = lane >> 3, ib = 8 * ((lane >> 2) & 1) + 4 * ((lane >> 1) & 1) + 2 * (lane & 1);
    for (int t = gw; t < ntok; t += NGW) { const int row = peer_row(t, last); float s0 = 0.f, s1 = 0.f;
#pragma unroll
        for (int sl = 0; sl < 8; ++sl) { const unsigned long long v = *(const GAS unsigned long long*)(P + ((size_t)sl * MR + row) * 128 + 2 * lane); s0 += __uint_as_float((unsigned)v); s1 += __uint_as_float((unsigned)(v >> 32)); }
        const int k0 = 8 * ib + grp, k1 = 8 * (ib + 1) + grp;
        W[(size_t)row * 128 + k0] = EG[(size_t)row * 128 + k0] * gelu_tanh(s0 * (1.f / PU_SCALE)) * (1.f / PV_SCALE);
        W[(size_t)row * 128 + k1] = EG[(size_t)row * 128 + k1] * gelu_tanh(s1 * (1.f / PU_SCALE)) * (1.f / PV_SCALE); }
}
__device__ __forceinline__ void ln2_phase(unsigned char* ws, float* d_out, const float* lng, const float* lnb, int layer, int last, int gw, int NGW, int lane) {
    const bf16* OUT = (const bf16*)(ws + WS_OUT); bf16* LAT = (bf16*)(ws + WS_LAT); bf16* H = (bf16*)(ws + WS_H);
    const float* MOD = (const float*)(ws + WS_MOD) + (size_t)layer * 17 * 6144; const float* MODN = MOD + 17 * 6144;
    const int nrows = last ? NB * TL : MR;
    f32x4 g[4], bb[4];
#pragma unroll
    for (int j = 0; j < 4; ++j) { g[j] = *(const GAS f32x4*)(lng + 256 * j + 4 * lane); bb[j] = *(const GAS f32x4*)(lnb + 256 * j + 4 * lane); }
    for (int lr = gw; lr < nrows; lr += 2 * NGW) {
        int rows[2]; bool ok[2];
#pragma unroll
        for (int u = 0; u < 2; ++u) { const int l2 = lr + u * NGW; ok[u] = l2 < nrows; rows[u] = peer_row(ok[u] ? l2 : lr, last); }
        f32x4 v[2][4]; float sm[2];
#pragma unroll
        for (int u = 0; u < 2; ++u) { sm[u] = 0.f; const int row = rows[u]; const int b = row / SQ, s = row - b * SQ; const float* md = MOD + (size_t)((s < LC) ? 16 : b) * 6144;
#pragma unroll
            for (int j = 0; j < 4; ++j) { const int c = 256 * j + 4 * lane; const unsigned long long lb = *(const GAS unsigned long long*)(LAT + (size_t)row * DD + c); const unsigned l0 = (unsigned)lb, l1 = (unsigned)(lb >> 32);
                f32x4 lv; lv.x = bflo(l0); lv.y = bfhi(l0); lv.z = bflo(l1); lv.w = bfhi(l1); const f32x4 gv = *(const GAS f32x4*)(md + 5120 + c);
                const unsigned long long ob = *(const GAS unsigned long long*)(OUT + (size_t)row * DD + c); const unsigned olo = (unsigned)ob, ohi = (unsigned)(ob >> 32);
                f32x4 o; o.x = bflo(olo); o.y = bfhi(olo); o.z = bflo(ohi); o.w = bfhi(ohi);
                v[u][j] = lv * DN_ALPHA + gv * o; sm[u] += (v[u][j].x + v[u][j].y) + (v[u][j].z + v[u][j].w); } }
#pragma unroll
        for (int o = 1; o < 64; o <<= 1) { sm[0] += __shfl_xor(sm[0], o); sm[1] += __shfl_xor(sm[1], o); }
        float s2[2];
#pragma unroll
        for (int u = 0; u < 2; ++u) { const float mean = sm[u] * (1.f / DD); s2[u] = 0.f;
#pragma unroll
            for (int j = 0; j < 4; ++j) { v[u][j] = v[u][j] - mean; s2[u] += (v[u][j].x * v[u][j].x + v[u][j].y * v[u][j].y) + (v[u][j].z * v[u][j].z + v[u][j].w * v[u][j].w); } }
#pragma unroll
        for (int o = 1; o < 64; o <<= 1) { s2[0] += __shfl_xor(s2[0], o); s2[1] += __shfl_xor(s2[1], o); }
#pragma unroll
        for (int u = 0; u < 2; ++u) { if (!ok[u]) continue; const int row = rows[u]; const int b = row / SQ, s = row - b * SQ; const float* mdn = MODN + (size_t)((s < LC) ? 16 : b) * 6144;
            const float rstd = 1.f / sqrtf(s2[u] * (1.f / DD) + LN_EPS);
#pragma unroll
            for (int j = 0; j < 4; ++j) { const int c = 256 * j + 4 * lane; const f32x4 y = v[u][j] * rstd * g[j] + bb[j];
                if (last) { *(GAS f32x4*)(d_out + ((size_t)b * TL + (s - LC)) * DD + c) = y; }
                else { *(GAS unsigned long long*)(LAT + (size_t)row * DD + c) = (unsigned long long)pk2(y.x, y.y) | ((unsigned long long)pk2(y.z, y.w) << 32);
                    const f32x4 sh = *(const GAS f32x4*)(mdn + c), sc = *(const GAS f32x4*)(mdn + 1024 + c); const f32x4 h = y * (sc + 1.f) + sh;
                    *(GAS unsigned long long*)(H + (size_t)row * DD + c) = (unsigned long long)pk2(h.x, h.y) | ((unsigned long long)pk2(h.z, h.w) << 32); } } }
    }
}

#endif
__device__ __forceinline__ int s5_pos(int dir, int step) { return dir == 0 ? step : (step < LC ? (LC - 1 - step) : (SQ + LC - 1 - step)); }
__device__ __forceinline__ int s5_other_tile(int dir, int pos) { const int st = (dir == 0) ? (pos < LC ? (LC - 1 - pos) : (SQ + LC - 1 - pos)) : pos; return st >> 4; }
__device__ __forceinline__ int s5_mirror(int t) { return t < 16 ? 15 - t : 159 - t; }
__device__ __forceinline__ void s5_phase(unsigned char* ws, const float* dskip, LAS unsigned char* lds, int vcu, int tid, int lane, int wave) {
    const bf16* U = (const bf16*)(ws + WS_H); float* YP = (float*)(ws + WS_A + SZ72); bf16* YG = (bf16*)(ws + WS_A);
    const float* LB = (const float*)(ws + WS_S5LB); const bf16* Bop = (const bf16*)(ws + WS_S5B); const bf16* Cop = (const bf16*)(ws + WS_S5C);
    const int half = wave & 1, dir = (wave >> 1) & 1, wt = vcu * 2 + (wave >> 2); const bool active = (wt < 512);
    const int bp = (wt >> 6) & 7, g = wt & 63; const int r32 = lane & 31, hi = lane >> 5, t16 = lane & 15, q4 = lane >> 4;
    constexpr int XP = 272, IMGB = 9216, NTILE = SQ / 16;
    LAS unsigned char* img0 = lds + (wave >> 1) * (2 * IMGB);
    const int a_b = 2 * bp + ((r32 >> 2) & 1), a_t = (r32 & 3) + 4 * (r32 >> 3);
    const f32x4 dv = *(const GAS f32x4*)(dskip + g * 16 + 4 * q4);
    const int rg = dir * 64 + g; const int bb = half;
    bf16x8 Bf[2], Cf[4];
#pragma unroll
    for (int i = 0; i < 2; ++i) Bf[i] = *(const GAS bf16x8*)(Bop + ((size_t)rg * 128 + (2 * half + i) * 32 + r32) * 16 + 8 * hi);
#pragma unroll
    for (int ks = 0; ks < 4; ++ks) Cf[ks] = *(const GAS bf16x8*)(Cop + ((size_t)rg * 16 + t16) * 128 + 32 * ks + 8 * q4);
    const float lr = LB[((size_t)rg * 64 + 32 * half + r32) * 2], li = LB[((size_t)rg * 64 + 32 * half + r32) * 2 + 1];
    float xr = 0.f, xi = 0.f;
    const bf16* Ua = U + (size_t)a_b * SQ * DD + g * 16 + 8 * hi;
    const size_t eoff = (size_t)(2 * bp + bb) * SQ * DD + g * 16 + 4 * q4;
    bf16x8 an[2]; unsigned long long un[2]; f32x4 pn[2];
#define S5_LOAD_A(slot_, tile_) do { const bf16* p_ = Ua + (size_t)s5_pos(dir, (tile_) * 16 + a_t) * DD; asm volatile("global_load_dwordx4 %0, %1, off" : "=v"(an[slot_]) : "v"(p_) : "memory"); } while (0)
#define S5_LOAD_E(slot_, tile_) do { const int tp_ = (tile_); const size_t o_ = eoff + (size_t)s5_pos(dir, tp_ * 16 + t16) * DD; \
        const bf16* p_ = U + o_; const float* q_ = (tp_ - s5_mirror(tp_) >= 6) ? (const float*)(YP + o_) : (const float*)p_; \
        asm volatile("global_load_dwordx2 %0, %2, off\n\tglobal_load_dwordx4 %1, %3, off nt" : "=&v"(un[slot_]), "=&v"(pn[slot_]) : "v"(p_), "v"(q_) : "memory"); } while (0)
#define S5_TILE(slot_, tile_) do { \
        const int tile = (tile_); LAS unsigned char* img = img0 + (tile & 1) * IMGB; \
        const int mir = s5_mirror(tile); const bool second = mir < tile, farv = (tile - mir) >= 6; \
        const int tnx = (tile + 2 < NTILE) ? tile + 2 : NTILE - 1; \
        const size_t off = eoff + (size_t)s5_pos(dir, tile * 16 + t16) * DD; \
        if (active) { \
        asm volatile("s_waitcnt vmcnt(7)" : "+v"(an[slot_]) :: "memory");        \
        f32x16 acc[2]; \
        _Pragma("unroll") for (int i = 0; i < 2; ++i) acc[i] = __builtin_amdgcn_mfma_f32_32x32x16_bf16(an[slot_], Bf[i], (f32x16){}, 0, 0, 0); \
        __builtin_amdgcn_sched_barrier(0); \
        S5_LOAD_A(slot_, tnx); \
        __builtin_amdgcn_sched_barrier(0); \
        _Pragma("unroll") for (int r = 0; r < 16; ++r) { \
            const float nr = lr * xr - li * xi + acc[0][r], ni = lr * xi + li * xr + acc[1][r]; xr = nr; xi = ni; \
            *(LAS unsigned*)(img + (hi * 16 + r) * XP + 128 * half + r32 * 4) = pk2(nr, ni); } \
        } \
        asm volatile("s_waitcnt lgkmcnt(0)" ::: "memory"); \
        __builtin_amdgcn_s_barrier();        \
        if (active) { \
        f32x4 y = (f32x4){0.f, 0.f, 0.f, 0.f}; \
        _Pragma("unroll") for (int ks = 0; ks < 4; ++ks) { const bf16x8 xb = *(const LAS bf16x8*)(img + (bb * 16 + t16) * XP + (32 * ks + 8 * q4) * 2); \
            y = __builtin_amdgcn_mfma_f32_16x16x32_bf16(Cf[ks], xb, y, 0, 0, 0); } \
        asm volatile("s_waitcnt vmcnt(5)" : "+v"(pn[slot_]), "+v"(un[slot_]) :: "memory");        \
        if (!second) { *(GAS f32x4*)(YP + off) = y; } \
        else { f32x4 pc = pn[slot_]; const unsigned long long uc = un[slot_]; \
            if (!farv) { const float* p_ = YP + off; asm volatile("global_load_dwordx4 %0, %1, off nt\n\ts_waitcnt vmcnt(0)" : "=&v"(pc) : "v"(p_) : "memory"); }        \
            const unsigned ulo = (unsigned)uc, uhi = (unsigned)(uc >> 32); \
            const float o0 = gelu_tanh(pc.x + y.x + dv.x * bflo(ulo)), o1 = gelu_tanh(pc.y + y.y + dv.y * bfhi(ulo)), o2 = gelu_tanh(pc.z + y.z + dv.z * bflo(uhi)), o3 = gelu_tanh(pc.w + y.w + dv.w * bfhi(uhi)); \
            *(GAS unsigned long long*)(YG + off) = (unsigned long long)pk2(o0, o1) | ((unsigned long long)pk2(o2, o3) << 32); } \
        __builtin_amdgcn_sched_barrier(0); \
        S5_LOAD_E(slot_, tnx); \
        if (tile == 7 || tile == 79) asm volatile("s_waitcnt vmcnt(0)" ::: "memory"); else asm volatile("s_waitcnt vmcnt(6)" ::: "memory");        \
        } \
    } while (0)
    if (active) { S5_LOAD_A(0, 0); S5_LOAD_A(1, 1); S5_LOAD_E(0, 0); S5_LOAD_E(1, 1); asm volatile("s_waitcnt vmcnt(0)" : "+v"(an[0]), "+v"(an[1]), "+v"(un[0]), "+v"(un[1]), "+v"(pn[0]), "+v"(pn[1]) :: "memory"); }
    for (int t2 = 0; t2 < NTILE; t2 += 2) { S5_TILE(0, t2); S5_TILE(1, t2 + 1); }
    asm volatile("s_waitcnt vmcnt(0) lgkmcnt(0)" ::: "memory");
#undef S5_TILE
#undef S5_LOAD_A
#undef S5_LOAD_E
}
#ifndef MK_DEBUG
#define MK_DEBUG 0
#endif
#if MK_DEBUG
__device__ __forceinline__ void chk_fail(gu32* ctl, unsigned code) { unsigned expect = 0u; __hip_atomic_compare_exchange_strong((unsigned*)(ctl + CW_ERR), &expect, code, __ATOMIC_RELAXED, __ATOMIC_RELAXED, __HIP_MEMORY_SCOPE_AGENT); }
__device__ __forceinline__ bool chk_close(float got, float ref, float rtol, float atol) { const float d = fabsf(got - ref); return (d <= atol + rtol * fabsf(ref)) && (got == got); }
__device__ __forceinline__ float fp8f(unsigned char v) { return __builtin_amdgcn_cvt_f32_fp8((int)v, 0); }
__device__ __forceinline__ float bfround(float f) { return __uint_as_float(f2bf(f) << 16); }
__device__ __forceinline__ float chk_dot(const bf16* arow, const float* W, int N, int col) { float s = 0.f; for (int k = 0; k < 1024; ++k) s += bf2f(arow[k]) * bfround(W[(size_t)k * N + col]); return s; }
__device__ __forceinline__ int chk_row(int i) { const int b = (i * 5) & 15; const int sel = i & 7; const int s = (sel == 0) ? 3 : (sel == 1) ? 255 : (sel == 2) ? 256 : (sel == 3) ? 2303 : (sel == 4) ? 777 : (sel == 5) ? 1400 : (sel == 6) ? 130 : 2000; return b * SQ + s; }

__device__ __forceinline__ void check_pre_peer(unsigned char* ws, int layer, int tid) {
    const int row = chk_row(3 + 2 * layer);
    for (int c = tid; c < 1024; c += NTHR) { ((float*)(ws + WS_CTL + 262144))[c] = bf2f(((const bf16*)(ws + WS_LAT))[(size_t)row * DD + c]); ((bf16*)(ws + WS_CTL + 262144 + 4096))[c] = ((const bf16*)(ws + WS_H))[(size_t)row * DD + c]; }
}
template <class KP> __device__ __forceinline__ void check_step(KP ka, unsigned char* ws, LAS unsigned char* lds, int op, int layer, int code, int tid, int lane, int wave) {
#define CHK_FRESH asm volatile("" : "+v"(lane), "+v"(tid), "+s"(ws));
    const int kind = layer % 3, jj = layer / 3, last = (layer == NLAYER - 1);
#ifndef CHK_MASK
#define CHK_MASK 0xFFFF
#endif
    if (!((CHK_MASK >> op) & 1)) return;
    bool bad = false;
#define MOD ((const float*)(ws + WS_MOD) + (size_t)layer * 17 * 6144)
    if (op == 9) { CHK_FRESH
        if (wave == 0) {
            { const int i = lane & 3, r = lane % 17, n = (lane * 97 + 13) % 6144; float s = 0.f;
              for (int k = 0; k < 1024; ++k) { const float v = (r < 16) ? ka->in[1][r * 1024 + k] : ka->in[3][k]; s += v / (1.f + expf(-v)) * ka->in[4][((size_t)i * 1024 + k) * 6144 + n]; }
              s += ka->in[5][i * 6144 + n]; bad |= !chk_close(((const float*)(ws + WS_MOD))[((size_t)i * 17 + r) * 6144 + n], s, 1e-3f, 1e-3f); }
            { const int n = (lane * 131 + 7) % 3072, k = (lane * 37 + 5) % 1024; bad |= bf2f(((const bf16*)(ws + WS_WQKV_DA))[((size_t)3072 + n) * 1024 + k]) != bfround(ka->in[12][(size_t)1024 * 3072 + (size_t)k * 3072 + n]); }
            { const int n = (lane * 131 + 7) % 1536, k = (lane * 37 + 5) % 1024; bad |= bf2f(((const bf16*)(ws + WS_WQKV_WA))[(size_t)n * 1024 + k]) != bfround(ka->in[16][(size_t)k * 1536 + n]); }
            { const int n = (lane * 131 + 7) % 1024, k = (lane * 37 + 5) % 1024; bad |= bf2f(((const bf16*)(ws + WS_WO_DA))[((size_t)1024 + n) * 1024 + k]) != bfround(ka->in[13][(size_t)1024 * 1024 + (size_t)k * 1024 + n]);
              bad |= bf2f(((const bf16*)(ws + WS_WO_WA))[(size_t)n * 1024 + k]) != bfround(ka->in[17][(size_t)k * 1024 + n]); }
            { const int n = (lane * 131 + 7) % 2048, k = (lane * 37 + 5) % 1024; const int pr = (n < 1024) ? ((n >> 7) * 256 + (n & 127)) : (((n - 1024) >> 7) * 256 + 128 + ((n - 1024) & 127));
              bad |= bf2f(((const bf16*)(ws + WS_WGLU))[(size_t)pr * 1024 + k]) != bfround(ka->in[27][(size_t)k * 2048 + n]);
              bad |= bf2f(((const bf16*)(ws + WS_WPQ))[((size_t)3 * 2048 + n) * 1024 + k]) != bfround(ka->in[8][(size_t)3 * 1024 * 2048 + (size_t)k * 2048 + n]); }
            { const size_t idx = (size_t)lane * 1048583u + 12345u; bad |= bf2f(((const bf16*)(ws + WS_KEYS))[idx % 2097152]) != bfround(ka->in[9][idx % 2097152]); }
            { const int t = (lane * 31 + 3) % 2048, i = lane & 31; const float inv = powf(10000.f, -(float)(i & 15) / 16.f); const float ang = (float)((i < 16) ? (t >> 6) : (t & 63)) * inv;
              bad |= !chk_close(((const float*)(ws + WS_ROPE))[t * 32 + i], cosf(ang), 0.f, 2e-5f); bad |= !chk_close(((const float*)(ws + WS_ROPE))[2048 * 32 + t * 32 + i], sinf(ang), 0.f, 2e-5f); }
        }
    } else if (op == 10) { CHK_FRESH
        if (wave == 0) { const int row = chk_row(lane), b = row / SQ, s = row - b * SQ, c = (lane * 53 + 1) % 1024; const float v = (s < LC) ? ka->in[2][((size_t)b * LC + s) * DD + c] : ka->in[0][((size_t)b * TL + s - LC) * DD + c];
            const float* md = (const float*)(ws + WS_MOD) + (size_t)((s < LC) ? 16 : b) * 6144;
            bad |= bf2f(((const bf16*)(ws + WS_LAT))[(size_t)row * DD + c]) != bfround(v); bad |= !chk_close(bf2f(((const bf16*)(ws + WS_H))[(size_t)row * DD + c]), v * (1.f + md[1024 + c]) + md[c], 1e-2f, 1e-2f); }
    } else if (op == 0) { CHK_FRESH
        if (wave == 0) { const int row = chk_row(lane), b = row / SQ, s = row - b * SQ; const int N = (kind == 0) ? 3072 : 1536; const int col = ((lane * 211 + 17) % N) & ~1;
            const float* W = (kind == 0) ? ka->in[12] + (size_t)jj * 1024 * 3072 : ka->in[16]; const bf16* hrow = (const bf16*)(ws + WS_H) + (size_t)row * DD;
            float e = chk_dot(hrow, W, N, col), o = chk_dot(hrow, W, N, col + 1);
            const int kstart = 1024, vstart = (kind == 0) ? 2048 : 1280; const int reg = (col < kstart) ? 0 : (col < vstart) ? 1 : 2; const int lc = col - ((reg == 0) ? 0 : (reg == 1) ? kstart : vstart);
            if (reg < 2 && s >= LC) { const int t = s - LC, i = (lc & 63) >> 1; const float cs = ((const float*)(ws + WS_ROPE))[t * 32 + i], sn = ((const float*)(ws + WS_ROPE))[2048 * 32 + t * 32 + i]; const float e2 = e * cs - o * sn, o2 = e * sn + o * cs; e = e2; o = o2; }
            if (reg == 0) { e *= 0.125f * LOG2E; o *= 0.125f * LOG2E; }
            const bf16* dst = (const bf16*)(ws + WS_A + (size_t)reg * SZ72) + (size_t)row * DD + lc;
            bad |= !chk_close(bf2f(dst[0]), e, 2e-2f, 2e-2f); bad |= !chk_close(bf2f(dst[1]), o, 2e-2f, 2e-2f);
            if (kind == 1) { const int hq = (lane * 5 + 2) & 15; bf16* sv = (bf16*)(ws + WS_CTL + 300000) + lane * 64; for (int cc = 0; cc < 64; ++cc) sv[cc] = ((const bf16*)(ws + WS_A))[(size_t)row * DD + hq * 64 + cc]; } }
    } else if (op == 1) { CHK_FRESH
        if (wave == 0 && kind == 0) { const int row = chk_row(lane), b = row / SQ, s = row - b * SQ; if (!(last && s < LC)) { const int hh = (lane * 7 + 3) & 31, h = hh >> 2, j = (hh >> 1) & 1, vh = hh & 1, d = (lane * 11) & 63;
            const bf16* q = (const bf16*)(ws + WS_A) + (size_t)row * DD + h * 128 + j * 64; const bf16* Kb = (const bf16*)(ws + WS_A + SZ72) + (size_t)b * SQ * DD + h * 128 + j * 64; const bf16* Vb = (const bf16*)(ws + WS_A + 2 * SZ72) + (size_t)b * SQ * DD + h * 128 + vh * 64 + d;
            const int nk = (s < LC) ? LC : SQ; float m = -INFINITY;
            for (int k = 0; k < nk; ++k) { float sc = 0.f; for (int c = 0; c < 64; ++c) sc += bf2f(q[c]) * bf2f(Kb[(size_t)k * DD + c]); m = fmaxf(m, sc); }
            float l = 0.f, o = 0.f;
            for (int k = 0; k < nk; ++k) { float sc = 0.f; for (int c = 0; c < 64; ++c) sc += bf2f(q[c]) * bf2f(Kb[(size_t)k * DD + c]); const float p = exp2f(sc - m); l += p; o += p * bf2f(Vb[(size_t)k * DD]); }
            const bf16* O = (const bf16*)(ws + WS_B + (size_t)j * SZ72) + (size_t)row * DD + h * 128 + vh * 64 + d;
            bad |= !chk_close(bf2f(O[0]), o / l, 3e-2f, 1e-2f); } }
        if (wave == 0 && kind == 1) { const int row = chk_row(lane), b = row / SQ, s = row - b * SQ; if (!(last && s < LC)) { const int hq = (lane * 5 + 2) & 15, d = (lane * 11) & 63;
            const bf16* q = (const bf16*)(ws + WS_CTL + 300000) + lane * 64; const bf16* Kb = (const bf16*)(ws + WS_A + SZ72) + (size_t)b * SQ * DD + (hq >> 2) * 64; const bf16* Vb = (const bf16*)(ws + WS_A + 2 * SZ72) + (size_t)b * SQ * DD + (hq >> 2) * 64 + d;
            float m = -INFINITY;
            for (int k = 0; k < SQ; ++k) { if (k >= LC) { if (s < LC) break; const int dd = (k - LC) - (s - LC); if (dd > 128 || dd < -128) continue; }
                float sc = 0.f; for (int c2 = 0; c2 < 64; ++c2) sc += bf2f(q[c2]) * bf2f(Kb[(size_t)k * DD + c2]); m = fmaxf(m, sc); }
            float l = 0.f, o = 0.f;
            for (int k = 0; k < SQ; ++k) { if (k >= LC) { if (s < LC) break; const int dd = (k - LC) - (s - LC); if (dd > 128 || dd < -128) continue; }
                float sc = 0.f; for (int c2 = 0; c2 < 64; ++c2) sc += bf2f(q[c2]) * bf2f(Kb[(size_t)k * DD + c2]); const float p = exp2f(sc - m); l += p; o += p * bf2f(Vb[(size_t)k * DD]); }
            l += exp2f(ka->in[18][hq] * LOG2E - m);
            bad |= !chk_close(bf2f(((const bf16*)(ws + WS_A))[(size_t)row * DD + hq * 64 + d]), o / l, 3e-2f, 1e-2f); } }
    } else if (op == 2) { CHK_FRESH
        if (wave == 0) { const int row = chk_row(lane), b = row / SQ, s = row - b * SQ; if (!(last && s < LC)) { const int h = lane & 7, e0 = (lane * 13) & 127;
            const float* lp = ka->in[14] + jj * 256; float d01 = 0.f, d23 = 0.f; for (int i = 0; i < 64; ++i) { d01 += lp[i] * lp[64 + i]; d23 += lp[128 + i] * lp[192 + i]; }
            const float lam_init = 0.8f - 0.6f * expf(-0.3f * (float)layer), lam = expf(d01) - expf(d23) + lam_init;
            const bf16* o0 = (const bf16*)(ws + WS_B) + (size_t)row * DD + h * 128; const bf16* o1 = (const bf16*)(ws + WS_B + SZ72) + (size_t)row * DD + h * 128; float ss = 0.f;
            for (int e = 0; e < 128; ++e) { const float v = bf2f(o0[e]) - lam * bf2f(o1[e]); ss += v * v; }
            const float v = (bf2f(o0[e0]) - lam * bf2f(o1[e0])) / sqrtf(ss / 128.f + LN_EPS) * ka->in[15][jj * 128 + e0] * (1.f - lam_init);
            bad |= !chk_close(bf2f(((const bf16*)(ws + WS_A))[(size_t)row * DD + h * 128 + e0]), v, 2e-2f, 1e-2f); } }
    } else if (op == 3) { CHK_FRESH
        if (wave == 0) { const int row = chk_row(lane), b = row / SQ, s = row - b * SQ; if (!(last && s < LC)) { const int col = (lane * 67 + 9) % 1024; const bf16* arow = (const bf16*)(ws + WS_A) + (size_t)row * DD;
            float val;
            if (kind == 2) { const float a = chk_dot(arow, ka->in[27], 2048, col), g = chk_dot(arow, ka->in[27], 2048, 1024 + col); val = a / (1.f + expf(-g)); }
            else val = chk_dot(arow, (kind == 0) ? ka->in[13] + (size_t)jj * 1024 * 1024 : ka->in[17], 1024, col);
            const float ref = DN_ALPHA * bf2f(((const bf16*)(ws + WS_LAT))[(size_t)row * DD + col]) + MOD[(size_t)((s < LC) ? 16 : b) * 6144 + 2048 + col] * val;
            bad |= !chk_close(bf2f(((const bf16*)(ws + WS_B))[(size_t)row * DD + col]), ref, 2e-2f, 2e-2f); } }
    } else if (op == 4) { CHK_FRESH
        if (wave == 0) { const int row = chk_row(lane), b = row / SQ, s = row - b * SQ; if (!(last && s < LC)) { const int col = (lane * 67 + 9) % 1024; const bf16* r = (const bf16*)(ws + WS_B) + (size_t)row * DD;
            float s1 = 0.f, s2 = 0.f;
#pragma clang loop vectorize(disable) unroll(disable)
            for (int c = 0; c < 1024; ++c) { float v = bf2f(r[c]); asm volatile("" : "+v"(v)); s1 += v; s2 = fmaf(v, v, s2); }
            const float mu = s1 / 1024.f, var = s2 / 1024.f - mu * mu;
            float y = (bf2f(r[col]) - mu) / sqrtf(var + LN_EPS); asm volatile("" : "+v"(y)); y = fmaf(y, ka->in[6][(layer * 2) * 1024 + col], ka->in[7][(layer * 2) * 1024 + col]); asm volatile("" : "+v"(y)); const float* md = MOD + (size_t)((s < LC) ? 16 : b) * 6144;
            float hm = fmaf(y, md[4096 + col], y); asm volatile("" : "+v"(hm)); hm += md[3072 + col]; asm volatile("" : "+v"(hm));
            bad |= !chk_close(bf2f(((const bf16*)(ws + WS_LAT))[(size_t)row * DD + col]), y, 1e-2f, 1e-2f); bad |= !chk_close(bf2f(((const bf16*)(ws + WS_H))[(size_t)row * DD + col]), hm, 1e-2f, 1e-2f); } }
    } else if (op == 5) { CHK_FRESH
        if (wave == 0) { const int row = chk_row(lane), s = row % SQ; if (!(last && s < LC)) { const int col = (lane * 139 + 9) % 2048;
            const float ref = chk_dot((const bf16*)(ws + WS_H) + (size_t)row * DD, ka->in[8] + (size_t)layer * 1024 * 2048, 2048, col);
            bad |= !chk_close(bf2f(((const bf16*)(ws + WS_A))[(size_t)row * 2048 + col]), ref, 2e-2f, 2e-2f); } }
    } else if (op == 6) { CHK_FRESH
        if (wave == 0) { const int row = chk_row(lane), s = row % SQ; const int h = (lane * 3 + 1) & 7; LAS float* sc = (LAS float*)lds + lane * 257; LAS unsigned char* used = lds + 66048 + lane * 260;
            if (!(last && s < LC)) {
                const bf16* q = (const bf16*)(ws + WS_A) + (size_t)row * 2048 + h * 256; const bf16* KEYS = (const bf16*)(ws + WS_KEYS) + (size_t)layer * 2 * 8 * 128 * 128;
                for (int j = 0; j < 2; ++j) for (int k = 0; k < 128; ++k) { float a = 0.f; for (int c = 0; c < 128; ++c) a += bf2f(q[j * 128 + c]) * bf2f(KEYS[((size_t)(j * 8 + h) * 128 + k) * 128 + c]); sc[j * 128 + k] = a; }
                LAS float* tv = (LAS float*)(lds + 83200) + lane * 65; LAS int* ti = (LAS int*)(lds + 100096) + lane * 65;
                for (int j = 0; j < 2; ++j) for (int it = 0; it < 16; ++it) { float bv = -INFINITY; int bi = 0; for (int k = 0; k < 128; ++k) { const float v = sc[j * 128 + k]; if (v > bv) { bv = v; bi = k; } } tv[j * 16 + it] = bv; ti[j * 16 + it] = bi; sc[j * 128 + bi] = -INFINITY; }
                for (int i = 0; i < 256; ++i) used[i] = 0;
                float rs[1]; int nmatch = 0; float gsum_err = 0.f; (void)rs;
                const int* E = (const int*)(ws + WS_B) + ((size_t)row * 8 + h) * 16; const float* Gt = (const float*)(ws + WS_B + (size_t)MR * 128 * 4) + ((size_t)row * 8 + h) * 16;
                float topv0 = 0.f, den = 0.f;
                for (int it = 0; it < 16; ++it) { float bv = -INFINITY; int bi = 0; for (int i = 0; i < 256; ++i) if (!used[i]) { const float v = tv[i >> 4] + tv[16 + (i & 15)]; if (v > bv) { bv = v; bi = i; } } used[bi] = (unsigned char)(it + 1); if (it == 0) topv0 = bv; den += expf(bv - topv0); }
                for (int i = 0; i < 256; ++i) if (used[i]) { const float v = tv[i >> 4] + tv[16 + (i & 15)]; const int e = ti[i >> 4] * 128 + ti[16 + (i & 15)]; const float g = expf(v - topv0) / den;
                        for (int r = 0; r < 16; ++r) if (E[r] == e) { ++nmatch; gsum_err += fabsf(Gt[r] - g); } }
                float gs = 0.f; for (int r = 0; r < 16; ++r) { gs += Gt[r]; bad |= (E[r] < 0 || E[r] >= 16384); }
                bad |= (nmatch < 14) || (gsum_err > 0.05f) || !chk_close(gs, 1.f, 0.f, 1e-3f);
            } }
        __syncthreads(); check_pre_peer(ws, layer, tid);
    } else if (op == (PEER_SLICED ? 12 : (PEER_SPLIT ? 11 : 7))) { CHK_FRESH
        const int row = chk_row(3 + 2 * layer), b = row / SQ, s = row - b * SQ;
        if (!(last && s < LC)) {
            LAS float* act = (LAS float*)lds; LAS float* rr = (LAS float*)lds + 256; LAS float* red = (LAS float*)lds + 256 + 1024;
            const bf16* hrow = (const bf16*)(ws + WS_H) + (size_t)row * DD; const float* latold = (const float*)(ws + WS_CTL + 262144);
            const bf16* hold = (const bf16*)(ws + WS_CTL + 262144 + 4096);
            const int* E = (const int*)(ws + WS_B) + (size_t)row * 128; const float* Gt = (const float*)(ws + WS_B + (size_t)MR * 128 * 4) + (size_t)row * 128;
            const unsigned char* PU = ws + WS_PU + (size_t)layer * 16384 * 1024; const unsigned char* PV = ws + WS_PV + (size_t)layer * 16384 * 1024;
            (void)hrow;
            if (tid < 128) { const int e = E[tid]; float a = 0.f; for (int dd = 0; dd < 1024; ++dd) a += bf2f(hold[dd]) * fp8f(PU[PEER_SLICED ? (((size_t)(dd >> 7) << 21) + (size_t)e * 128 + (dd & 127)) : ((size_t)e * 1024 + dd)]); act[tid] = Gt[tid] * gelu_tanh(a * (1.f / PU_SCALE)) * (1.f / PV_SCALE); }
            __syncthreads();
            for (int c = tid; c < 1024; c += NTHR) { float o = 0.f; for (int k = 0; k < 128; ++k) o += act[k] * fp8f(PV[PEER_SLICED ? (((size_t)(c >> 7) << 21) + (size_t)E[k] * 128 + (c & 127)) : ((size_t)E[k] * 1024 + c)]); rr[c] = DN_ALPHA * latold[c] + MOD[(size_t)((s < LC) ? 16 : b) * 6144 + 5120 + c] * o; }
            __syncthreads();
            if (tid == 0) { float mu = 0.f; for (int c = 0; c < 1024; ++c) mu += rr[c]; mu /= 1024.f; float var = 0.f; for (int c = 0; c < 1024; ++c) var += (rr[c] - mu) * (rr[c] - mu); red[0] = mu; red[1] = 1.f / sqrtf(var / 1024.f + LN_EPS); }
            __syncthreads();
            for (int c = tid; c < 1024; c += NTHR) { const float y = (rr[c] - red[0]) * red[1] * ka->in[6][(layer * 2 + 1) * 1024 + c] + ka->in[7][(layer * 2 + 1) * 1024 + c];
                const float got = last ? ka->out[((size_t)b * TL + s - LC) * DD + c] : bf2f(((const bf16*)(ws + WS_LAT))[(size_t)row * DD + c]); bad |= !chk_close(got, y, 2e-2f, 2e-2f); }
            __syncthreads();
        }
    } else if (op == 8) { CHK_FRESH
        { const int b = (wave * 5 + 1) & 15, g = (wave * 23 + 7) & 63; const int p = lane; const bf16* U = (const bf16*)(ws + WS_H); const bf16* YG = (const bf16*)(ws + WS_A);
          float yacc[3][16];
#pragma unroll
          for (int a = 0; a < 3; ++a)
#pragma unroll
              for (int h = 0; h < 16; ++h) yacc[a][h] = 0.f;
          for (int dir = 0; dir < 2; ++dir) { const int rg = dir * 64 + g; const float re = ka->in[19][rg * 64 + p], im = ka->in[20][rg * 64 + p], stp = expf(ka->in[21][rg]);
              const float mag = expf(re * stp), lbr = mag * cosf(im * stp), lbi = mag * sinf(im * stp); const float aa = lbr - 1.f, bb = lbi, den = re * re + im * im, qr = (aa * re + bb * im) / den, qi = (bb * re - aa * im) / den;
              float bbr[16], bbi[16], cr[16], ci[16];
#pragma unroll
              for (int h = 0; h < 16; ++h) { const float br = ka->in[22][((size_t)rg * 64 + p) * 16 + h], bi = ka->in[23][((size_t)rg * 64 + p) * 16 + h]; bbr[h] = br * qr - bi * qi; bbi[h] = br * qi + bi * qr; cr[h] = ka->in[24][((size_t)rg * 16 + h) * 64 + p]; ci[h] = ka->in[25][((size_t)rg * 16 + h) * 64 + p]; }
              float xr = 0.f, xi = 0.f;
              for (int step = 0; step < SQ; ++step) { const int pos = s5_pos(dir, step); const bf16* u = U + ((size_t)b * SQ + pos) * DD + g * 16; float bur = 0.f, bui = 0.f;
#pragma unroll
                  for (int h = 0; h < 16; ++h) { const float uv = bf2f(u[h]); bur += uv * bbr[h]; bui += uv * bbi[h]; }
                  const float nr = lbr * xr - lbi * xi + bur, ni = lbr * xi + lbi * xr + bui; xr = nr; xi = ni;
                  const int a = (pos == 255) ? 0 : (pos == 256) ? 1 : (pos == 1777) ? 2 : -1;
                  if (a >= 0) {
#pragma unroll
                      for (int aa2 = 0; aa2 < 3; ++aa2) if (aa2 == a) {
#pragma unroll
                          for (int h = 0; h < 16; ++h) yacc[aa2][h] += wave_sum(xr * cr[h] - xi * ci[h]); } } } }
#pragma unroll
          for (int a = 0; a < 3; ++a) { const int pos = (a == 0) ? 255 : (a == 1) ? 256 : 1777; const bf16* u = U + ((size_t)b * SQ + pos) * DD + g * 16;
#pragma unroll
              for (int h = 0; h < 16; ++h) { const float y = gelu_tanh(yacc[a][h] + ka->in[26][g * 16 + h] * bf2f(u[h])); bad |= !chk_close(bf2f(YG[((size_t)b * SQ + pos) * DD + g * 16 + h]), y, 3e-2f, 2e-2f); } } }
    }
    if (bad) chk_fail((gu32*)(ws + WS_CTL), (unsigned)code);
#undef CHK_FRESH
#undef MOD
}
#endif
__device__ __forceinline__ void attn_phase_da(unsigned char* ws, int last, LAS unsigned char* lds, int vcu, int G, int tid) {
    typedef attn_body::bf16 abf;
    const abf* Qb = (const abf*)(ws + WS_A); const abf* Kb = (const abf*)(ws + WS_A + SZ72); const abf* Vb = (const abf*)(ws + WS_A + 2 * SZ72);
    abf* O0 = (abf*)(ws + WS_B); abf* O1 = (abf*)(ws + WS_B + SZ72);
    const int nlat = NB * 16 * 8, nctx = last ? 0 : NB * 16;
    for (int u = vcu; u < nlat + nctx; u += G) {
        int b, hh, qb;
        if (u < nlat) { const int idx = u >> 3; b = idx >> 4; hh = idx & 15; qb = (u & 7) + 1; } else { const int v = u - nlat; b = v >> 4; hh = v & 15; qb = 0; }
        const int h = hh >> 1, j = hh & 1;
        attn_body::UnitDesc d;
        const size_t qrow = (size_t)b * SQ + 256 * qb, krow = (size_t)b * SQ;
        d.Q = Qb + qrow * DD + h * 128 + j * 64; d.K = Kb + krow * DD + h * 128 + j * 64; d.V = Vb + krow * DD + h * 128;
        d.O = (j ? O1 : O0) + qrow * DD + h * 128;
        d.NT = qb ? 36 : 4; d.latoff = 256; d.kpos4 = 0; d.qpos0 = 0; d.sink2 = -INFINITY;
        attn_body::attn_unit_v128<8>(d, (char*)lds, tid);
    }
}
__device__ __forceinline__ void attn_phase_wa(unsigned char* ws, const float* sink, int last, LAS unsigned char* lds, int vcu, int G, int tid) {
    typedef attn_body::bf16 abf;
    const abf* Qb = (const abf*)(ws + WS_A); const abf* Kb = (const abf*)(ws + WS_A + SZ72); const abf* Vb = (const abf*)(ws + WS_A + 2 * SZ72);
    abf* OC = (abf*)(ws + WS_A);
    const int nlat = NB * 16 * 8, nctx = last ? 0 : NB * 16;
    for (int u = vcu; u < nlat + nctx; u += G) {
        int b, hq, qb;
        if (u < nlat) { const int idx = u >> 3; b = idx >> 4; hq = idx & 15; qb = (u & 7) + 1; } else { const int v = u - nlat; b = v >> 4; hq = v & 15; qb = 0; }
        attn_body::UnitDesc d;
        const size_t qrow = (size_t)b * SQ + 256 * qb, krow = (size_t)b * SQ;
        d.Q = Qb + qrow * DD + hq * 64; d.K = Kb + krow * DD + (hq >> 2) * 64; d.V = Vb + krow * DD + (hq >> 2) * 64; d.O = OC + qrow * DD + hq * 64;
        if (qb) { const int qpos0 = 256 * (qb - 1); const int ks = (qpos0 - 128) < 0 ? 0 : (qpos0 - 128), ke = (qpos0 + 384) > TL ? TL : (qpos0 + 384);
            d.NT = 4 + (ke - ks) / 64; d.latoff = 256 + ks; d.kpos4 = ks; d.qpos0 = qpos0; }
        else { d.NT = 4; d.latoff = 256; d.kpos4 = 0; d.qpos0 = 0; }
        d.sink2 = sink[hq] * LOG2E;
        attn_body::attn_unit<8, true>(d, (char*)lds, tid);
    }
}

#ifndef PHM
#define PHM 0xFFFFF
#endif
#define PH_ON(k) (((PHM) >> (k)) & 1)
#ifndef PEER_SLICED
#define PEER_SLICED 0
#endif
#ifndef PEER_SPLIT
#define PEER_SPLIT 0
#endif
constexpr int NSTEPS = PEER_SLICED ? (3 + 11 + 10 + 9 + 11) : (PEER_SPLIT ? (3 + 9 + 8 + 7 + 9) : (3 + 8 + 7 + 6 + 8));
struct Args { const float* in[28]; float* out; unsigned char* ws; int ph_lo, ph_hi; };
static_assert(sizeof(Args) == 28 * 8 + 8 + 8 + 8, "Args has no padding");

__global__ void __launch_bounds__(NTHR, 2) mk_fwd(Args args) {
    extern __shared__ __attribute__((aligned(16))) unsigned char lds_raw[];
    volatile LAS unsigned* MISC = (volatile LAS unsigned*)((LAS unsigned char*)lds_raw + MISC_OFF);
    typedef const __attribute__((address_space(4))) Args* KArgP;
    KArgP ka = (KArgP)__builtin_amdgcn_kernarg_segment_ptr();
#define KA_IN(k) (ka->in[k])
#define KA_FRESH() asm volatile("" : "+s"(ka))
    const int wave0 = __builtin_amdgcn_readfirstlane(threadIdx.x >> 6);
    { const int t0 = threadIdx.x; for (int u = t0; u < (LDS_BYTES - LDSCTL_OFF) / 4; u += NTHR) ((LAS unsigned*)((LAS unsigned char*)lds_raw + LDSCTL_OFF))[u] = 0u; }
    __syncthreads();
    const int lo = ka->ph_lo, hi = ka->ph_hi;
    const bool multi = (hi - lo) > 1 || MK_DEBUG;
    XcdBarrier bar; bar.bar = (unsigned*)((gu32*)(ka->ws + WS_CTL) + CW_BAR); bar.x = 0; bar.st = nullptr;
    if (multi) bar = xcd_barrier_post((unsigned*)((gu32*)(ka->ws + WS_CTL) + CW_BAR), MISC + 8, (int)threadIdx.x);
#if 1
    if (threadIdx.x == 0) { const unsigned xcc = xb_xcc_id() & 7u; MISC[12] = xcc; MISC[13] = __hip_atomic_fetch_add((unsigned*)((gu32*)(ka->ws + WS_CTL) + 2048 + 64 * xcc), 1u, __ATOMIC_RELAXED, __HIP_MEMORY_SCOPE_AGENT); }
    __syncthreads();
#endif
#define PH_TID int wv_b = wave0; asm volatile("" : "+s"(wv_b)); int ln_b = (int)__builtin_amdgcn_mbcnt_hi(~0u, __builtin_amdgcn_mbcnt_lo(~0u, 0u)); asm volatile("" : "+v"(ln_b)); const int tid_b = wv_b * 64 + ln_b;
#define PS_MAP int ps_slice = bx & 7, ps_widx = bx >> 3; const int ps_n = G >> 3; { bool even_ = true; for (int j_ = 0; j_ < 8; ++j_) even_ = even_ && (__hip_atomic_load((unsigned*)((gu32*)(ws + WS_CTL) + 2048 + 64 * j_), __ATOMIC_RELAXED, __HIP_MEMORY_SCOPE_AGENT) == (unsigned)ps_n); if (even_) { ps_slice = (int)MISC[12]; ps_widx = (int)MISC[13]; } }
#define UQ_MAP int uq_x = bx & 7, uq_r = bx >> 3; { bool even_ = true; for (int j_ = 0; j_ < 8; ++j_) even_ = even_ && (__hip_atomic_load((unsigned*)((gu32*)(ws + WS_CTL) + 2048 + 64 * j_), __ATOMIC_RELAXED, __HIP_MEMORY_SCOPE_AGENT) == (unsigned)(G >> 3)); if (even_) { uq_x = (int)MISC[12]; uq_r = (int)MISC[13]; } } \
    int uq_quarter = uq_x >> 1, uq_widx = ((uq_x & 1) * (G >> 3) + uq_r) * NWAVES + wave, uq_n = (G >> 2) * NWAVES; \
    if ((G & 7) != 0) { uq_quarter = bx & 3; uq_widx = (bx >> 2) * NWAVES + wave; uq_n = ((G - (bx & 3) + 3) >> 2) * NWAVES; }
#define PH_LOCALS \
    int wave = wave0; asm volatile("" : "+s"(wave)); \
    int lane = (int)__builtin_amdgcn_mbcnt_hi(~0u, __builtin_amdgcn_mbcnt_lo(~0u, 0u)); asm volatile("" : "+v"(lane)); const int tid = wave * 64 + lane; \
    int G = gridDim.x, bx = blockIdx.x; asm volatile("" : "+s"(G), "+s"(bx)); \
    const int vcu = (G % 8 == 0) ? (bx % 8) * (G / 8) + bx / 8 : bx; \
    const int gw = vcu * NWAVES + wave, NGW = G * NWAVES; \
    KA_FRESH(); unsigned char* ws = ka->ws; \
    unsigned ldsb = 0; asm volatile("" : "+s"(ldsb)); \
    LAS unsigned char* lds = (LAS unsigned char*)lds_raw + ldsb; \
    (void)lane; (void)wave; (void)vcu; (void)gw; (void)NGW; (void)ws; (void)lds; (void)tid;
#if MK_DEBUG
    for (int it = 0; it <= 2 * NSTEPS; ++it) { const int step = it >> 1; const bool is_check = (it & 1) != 0; const bool is_report = (it == 2 * NSTEPS);
#else
    for (int step = lo; step < hi; ++step) {
#endif
        KA_FRESH();
        int layer = 0, op;
        if (step < 3) op = (step == 0) ? 9 : (step == 1) ? 16 : 10;
#if PEER_SLICED
        else { const int s = step - 3;
            int k, base;
            if (s < 11) { layer = 0; k = s; } else if (s < 21) { layer = 1; k = s - 11; } else if (s < 30) { layer = 2; k = s - 21; } else { layer = 3; k = s - 30; }
            const int kd = layer % 3; base = (kd == 0) ? 4 : (kd == 1) ? 3 : 2;
            if (k < base) { op = (kd == 0) ? k : (kd == 1) ? ((k < 2) ? k : 3) : ((k == 0) ? 8 : 3); }
            else { const int j = k - base; op = (j == 0) ? 4 : (j == 1) ? 5 : (j == 2) ? 6 : (j == 3) ? 7 : (j == 4) ? 13 : (j == 5) ? 11 : 12; } }
#elif PEER_SPLIT
        else { const int s = step - 3;
            if (s < 9) { layer = 0; op = (s < 8) ? s : 11; }
            else if (s < 17) { layer = 1; op = s - 9; if (op >= 2) ++op; if (op == 8) op = 11; }
            else if (s < 24) { layer = 2; op = s - 17; op = (op == 0) ? 8 : op + 2; if (op == 8 && s - 17 == 6) op = 11; }
            else { layer = 3; op = s - 24; if (op == 8) op = 11; } }
#else
        else { const int s = step - 3;
            if (s < 8) { layer = 0; op = s; }
            else if (s < 15) { layer = 1; op = s - 8; if (op >= 2) ++op; }
            else if (s < 21) { layer = 2; op = s - 15; op = (op == 0) ? 8 : op + 2; }
            else { layer = 3; op = s - 21; } }
#endif
        const int kind = layer % 3, jj = layer / 3, last = (layer == NLAYER - 1) ? 1 : 0;
#ifndef PROBE_REPEAT_OP
#define PROBE_REPEAT_OP -1
#endif
        const int nrep = (op == PROBE_REPEAT_OP && !(op == 1 && kind == 1)) ? 2 : 1;
        for (int rep = 0; rep < nrep; ++rep) {
        const int dry = (nrep == 2 && rep == 0) ? 1 : 0; (void)dry;
#if MK_DEBUG
        if (is_report) { PH_LOCALS const unsigned code = __hip_atomic_load((unsigned*)((gu32*)(ws + WS_CTL) + CW_ERR), __ATOMIC_RELAXED, __HIP_MEMORY_SCOPE_AGENT);
            if (code) { const float v = sqrtf((float)code); float* o = ka->out; for (size_t i = (size_t)vcu * NTHR + tid; i < (size_t)NB * TL * DD; i += (size_t)G * NTHR) o[i] = v; } }
        else if (is_check) { PH_LOCALS if (bx == 0) check_step(ka, ws, lds, op, layer, step + 1, tid, lane, wave); }
        else
#endif
        if (op == 9) { if constexpr (PH_ON(0)) { PH_LOCALS p0_prologue(ka, ws, lds, vcu, G, tid, lane, wave); } }
        else if (op == 10) { if constexpr (PH_ON(1)) { PH_LOCALS p1_embed(KA_IN(0), KA_IN(2), ws, gw, NGW, lane); } }
        else if (op == 16) { if constexpr (PH_ON(1)) { PH_LOCALS modred_phase(KA_IN(5), ws, gw, NGW, lane); } }
        else if (op == 0) { if constexpr (PH_ON(2)) { PH_LOCALS
            pg8::Gemm g; g.A = (const pg8::bf16_t*)(ws + WS_H); g.K = 1024; g.M = MR;
            pg8::EpiQKV E; E.Q = (pg8::bf16_t*)(ws + WS_A); E.K = (pg8::bf16_t*)(ws + WS_A + SZ72); E.V = (pg8::bf16_t*)(ws + WS_A + 2 * SZ72);
            E.cosT = (const float*)(ws + WS_ROPE); E.sinT = E.cosT + 2048 * 32; E.qscale = 0.125f * LOG2E;
            int nN;
            if (kind == 0) { g.Bt = (const pg8::bf16_t*)(ws + WS_WQKV_DA) + (size_t)jj * 3072 * 1024; g.N = 3072; E.nq = 4; E.nk = 4; nN = 12; }
            else { g.Bt = (const pg8::bf16_t*)(ws + WS_WQKV_WA); g.N = 1536; E.nq = 4; E.nk = 1; nN = 6; }
            pg8::RowOrder S; S.init(144, nN, G, bx, 0);
            pg8::gemm_phase<pg8::EpiQKV, pg8::RowOrder, true, true>(lds + RING_OFF, g, S, E, tid); } }
        else if (op == 1) { if (kind == 0) { if constexpr (PH_ON(3)) { PH_LOCALS attn_phase_da(ws, last, lds, vcu, G, tid); } } else { if constexpr (PH_ON(4)) { PH_LOCALS attn_phase_wa(ws, KA_IN(18), last, lds, vcu, G, tid); } } }
        else if (op == 2) { if constexpr (PH_ON(5)) { PH_LOCALS
            int ly = layer; asm volatile("" : "+s"(ly)); const float lam_init = (ly == 0) ? 0.2f : 0.55605820416f;
            da_combine_phase(ws, KA_IN(14) + jj * 256, KA_IN(15) + jj * 128, lam_init, last, gw, NGW, lane); } }
        else if (op == 8) { if constexpr (PH_ON(6)) { PH_LOCALS s5_phase(ws, KA_IN(26), lds, vcu, tid, lane, wave); } }
        else if (op == 3) {
            if (kind != 2) { if constexpr (PH_ON(7)) { PH_LOCALS
                pg8::Gemm g; g.A = (const pg8::bf16_t*)(ws + WS_A); g.K = 1024; g.M = MR; g.N = 1024;
                g.Bt = (kind == 0) ? (const pg8::bf16_t*)(ws + WS_WO_DA) + (size_t)jj * 1024 * 1024 : (const pg8::bf16_t*)(ws + WS_WO_WA);
                pg8::EpiRes E; E.lat = (const pg8::bf16_t*)(ws + WS_LAT); E.R = (pg8::bf16_t*)(ws + WS_B); E.mod = (const float*)(ws + WS_MOD) + (size_t)layer * 17 * 6144; E.alpha = DN_ALPHA;
                pg8::RowOrder S; S.init(last ? 128 : 144, 4, G, bx, last);
                pg8::gemm_phase<pg8::EpiRes, pg8::RowOrder, true, true>(lds + RING_OFF, g, S, E, tid);
                if (layer + 1 < NLAYER) { const int nfull = ((last ? 128 : 144) * 4) % G; if (nfull == 0 || bx >= nfull) cvt_tables_layer(ka, ws, layer + 1, nfull ? bx - nfull : bx, nfull ? G - nfull : G, tid); } } }
            else { if constexpr (PH_ON(8)) { PH_LOCALS
                pg8::Gemm g; g.A = (const pg8::bf16_t*)(ws + WS_A); g.K = 1024; g.M = MR; g.N = 2048; g.Bt = (const pg8::bf16_t*)(ws + WS_WGLU);
                pg8::EpiGlu E; E.lat = (const pg8::bf16_t*)(ws + WS_LAT); E.R = (pg8::bf16_t*)(ws + WS_B); E.mod = (const float*)(ws + WS_MOD) + (size_t)layer * 17 * 6144; E.alpha = DN_ALPHA;
                pg8::RowOrder S; S.init(144, 8, G, bx, 0);
                pg8::gemm_phase<pg8::EpiGlu, pg8::RowOrder, true, true>(lds + RING_OFF, g, S, E, tid);
                if (layer + 1 < NLAYER) { const int nfull = (144 * 8) % G; if (nfull == 0 || bx >= nfull) cvt_tables_layer(ka, ws, layer + 1, nfull ? bx - nfull : bx, nfull ? G - nfull : G, tid); } } } }
        else if (op == 4) { if constexpr (PH_ON(9)) { PH_LOCALS ln1_phase(ws, KA_IN(6) + (size_t)(layer * 2) * 1024, KA_IN(7) + (size_t)(layer * 2) * 1024, layer, last, gw, NGW, lane); } }
        else if (op == 5) { if constexpr (PH_ON(10)) { PH_LOCALS
            pg8::Gemm g; g.A = (const pg8::bf16_t*)(ws + WS_H); g.K = 1024; g.M = MR; g.N = 2048; g.Bt = (const pg8::bf16_t*)(ws + WS_WPQ) + (size_t)layer * 2048 * 1024;
            pg8::EpiPlain E; E.O = (pg8::bf16_t*)(ws + WS_A); E.ldc = 2048;
            pg8::RowOrder S; S.init(last ? 128 : 144, 8, G, bx, last);
            pg8::gemm_phase<pg8::EpiPlain, pg8::RowOrder, true, true>(lds + RING_OFF, g, S, E, tid); } }
        else if (op == 6) { if constexpr (PH_ON(11)) { PH_LOCALS topk_phase(ws, layer, last, lds, vcu, G, tid, lane, wave); } }
#if PEER_SLICED
        else if (op == 7) { if constexpr (PH_ON(12)) { PH_LOCALS PS_MAP peer_slice_pass<0>(ws, layer, last, ps_slice, ps_widx, ps_n, lane, wave); } }
#elif PEER_SPLIT
        else if (op == 7) { if constexpr (PH_ON(12)) { PH_LOCALS UQ_MAP peer_uq_phase(ws, layer, last, uq_quarter, uq_widx, uq_n, lane); } }
        else if (op == 11) { if constexpr (PH_ON(13)) { PH_LOCALS peer_gv_phase(ws, ka->out, KA_IN(6) + (size_t)(layer * 2 + 1) * 1024, KA_IN(7) + (size_t)(layer * 2 + 1) * 1024, layer, last, dry, gw, NGW, lane); } }
#else
        else if (op == 7) { if constexpr (PH_ON(12)) { PH_LOCALS peer_phase(ws, ka->out, KA_IN(6) + (size_t)(layer * 2 + 1) * 1024, KA_IN(7) + (size_t)(layer * 2 + 1) * 1024, layer, last, dry, gw, NGW, lane); } }
#endif
#if PEER_SLICED
        else if (op == 11) { if constexpr (PH_ON(13)) { PH_LOCALS PS_MAP peer_slice_pass<1>(ws, layer, last, ps_slice, ps_widx, ps_n, lane, wave); } }
        else if (op == 13) { if constexpr (PH_ON(15)) { PH_LOCALS peer_act_phase(ws, last, gw, NGW, lane); } }
        else { if constexpr (PH_ON(14)) { PH_LOCALS ln2_phase(ws, ka->out, KA_IN(6) + (size_t)(layer * 2 + 1) * 1024, KA_IN(7) + (size_t)(layer * 2 + 1) * 1024, layer, last, gw, NGW, lane); } }
#endif
        if (rep + 1 < nrep) { XcdBarrier b2 = bar; asm volatile("" : "+s"(b2.bar)); PH_TID xcd_barrier(b2, tid_b); }
        }
#if MK_DEBUG
        { XcdBarrier b2 = bar; asm volatile("" : "+s"(b2.bar)); PH_TID xcd_barrier(b2, tid_b); }
#else
        if (step + 1 < hi) { XcdBarrier b2 = bar; asm volatile("" : "+s"(b2.bar)); PH_TID xcd_barrier(b2, tid_b); }
#endif
    }
}

#ifndef MK_ONE_LAUNCH
#define MK_ONE_LAUNCH 1
#endif
extern "C" void kernel_launch(void* const* d_in, const int* in_sizes, int n_in, void* d_out, int out_size, void* d_ws, size_t ws_size, hipStream_t stream) {
    static int grid = 0;
    if (grid == 0) {
        if (n_in != 28 || ws_size < WS_END || out_size != NB * TL * DD) { fprintf(stderr, "kernel_launch: unexpected shapes (n_in %d, ws %zu, out %d); nothing launched\n", n_in, ws_size, out_size); grid = -1; return; }
        int dev = 0, cus = 0, per_cu = 0;
        if (hipGetDevice(&dev) != hipSuccess || hipDeviceGetAttribute(&cus, hipDeviceAttributeMultiprocessorCount, dev) != hipSuccess) { grid = -1; return; }
        if (hipFuncSetAttribute((const void*)mk_fwd, hipFuncAttributeMaxDynamicSharedMemorySize, LDS_BYTES) != hipSuccess) { fprintf(stderr, "kernel_launch: hipFuncSetAttribute failed\n"); grid = -1; return; }
        if (hipOccupancyMaxActiveBlocksPerMultiprocessor(&per_cu, (const void*)mk_fwd, NTHR, LDS_BYTES) != hipSuccess || per_cu < 1) fprintf(stderr, "kernel_launch: occupancy query reports %d\n", per_cu);
        (void)hipGetLastError();
        grid = cus;
    }
    if (grid < 0) return;
    if (hipMemsetAsync((char*)d_ws + WS_CTL, 0, CTL_ZERO_BYTES, stream) != hipSuccess) return;
    Args a{};
    for (int i = 0; i < 28; ++i) a.in[i] = (const float*)d_in[i];
    a.out = (float*)d_out; a.ws = (unsigned char*)d_ws;
#if MK_ONE_LAUNCH
    a.ph_lo = 0; a.ph_hi = NSTEPS;
    hipLaunchKernelGGL(mk_fwd, dim3(grid), dim3(NTHR), LDS_BYTES, stream, a);
#else
    for (int s = 0; s < NSTEPS; ++s) { a.ph_lo = s; a.ph_hi = s + 1; hipLaunchKernelGGL(mk_fwd, dim3(grid), dim3(NTHR), LDS_BYTES, stream, a); }
#endif
}
```

```cpp
#include <hip/hip_runtime.h>
#include <cstdio>
#include <cstdint>
#define MK_DEBUG 0
#define CHK_MASK 0xFDFF
#define PEER_SLICED 0
#define PEER_SPLIT 1
namespace pg8 {
#define PG8_LAS __attribute__((address_space(3)))
typedef unsigned short bf16_t;
typedef short bf16x8 __attribute__((ext_vector_type(8)));
typedef float f32x4 __attribute__((ext_vector_type(4)));
typedef unsigned u32x4 __attribute__((ext_vector_type(4)));
constexpr int BM = 256, BK = 64, HALF = 128, HTB = HALF * BK * 2  , STAGE_BYTES = 8 * HTB, NXCD = 8, WGM = 8;

__host__ __device__ __forceinline__ int lds_byte(int r, int c) { const int st = (r >> 4) * 2 + (c >> 5), rr = r & 15, cc = c & 31, ob = rr * 64 + cc * 2; return st * 1024 + (ob ^ (((ob >> 9) & 1) << 5)); }
__host__ __device__ __forceinline__ void stage_rc(int b, int& R, int& C) { const int st = b / 1024, sb = b % 1024, swz = sb ^ (((sb >> 9) & 1) << 5); R = (st >> 1) * 16 + swz / 64; C = (st & 1) * 32 + (swz % 64) / 2; }
__host__ __device__ __forceinline__ int perm32(int rho) { const int n = rho >> 4, i = rho & 15; return 8 * (i >> 2) + 4 * n + (i & 3); }

struct Unit { int pm, pn; };
struct Gemm { const bf16_t* A; const bf16_t* Bt; int M, N, K; };

struct StaticOrder {
    int nM, nN, nwg, G, c;
    __host__ __device__ void init(int M, int N, int G_, int c_) { nM = M / BM; nN = N / BM; nwg = nM * nN; G = G_; c = c_; }
    __host__ __device__ bool next(int i, Unit& u) const {
        const long L = (long)i * G + c; if (L >= nwg) return false;
        int wgid = (int)L; { const int q = nwg / NXCD, r = nwg % NXCD, xcd = wgid % NXCD, off = wgid / NXCD; wgid = (xcd < r ? xcd * (q + 1) : r * (q + 1) + (xcd - r) * q) + off; }
        const int nig = WGM * nN, gid = wgid / nig, fm = gid * WGM, gsz = (nM - fm) < WGM ? (nM - fm) : WGM;
        u.pm = fm + ((wgid % nig) % gsz); u.pn = (wgid % nig) / gsz; return true;
    }
    __device__ __forceinline__ void a_ready(const Unit&) const {}
    __device__ __forceinline__ void done(const Unit&) const {}
};

__device__ __forceinline__ unsigned cvt_pk_bf16(float lo, float hi) { unsigned r; asm volatile("v_cvt_pk_bf16_f32 %0, %1, %2" : "=v"(r) : "v"(lo), "v"(hi)); return r; }
typedef float f32x2 __attribute__((ext_vector_type(2)));
struct RowOrder {
    int nM, nN, nwg, G, c, skip;
    __device__ __forceinline__ void init(int nM_, int nN_, int G_, int c_, int skip_) { nM = nM_; nN = nN_; nwg = nM * nN; G = G_; c = c_; skip = skip_; }
    __device__ __forceinline__ bool next(int i, Unit& u) const {
        const long L = (long)i * G + c; if (L >= nwg) return false;
        int wgid = (int)L; { const int q = nwg / NXCD, r = nwg % NXCD, xcd = wgid % NXCD, off = wgid / NXCD; wgid = (xcd < r ? xcd * (q + 1) : r * (q + 1) + (xcd - r) * q) + off; }
        const int nig = WGM * nN, gid = wgid / nig, fm = gid * WGM, gsz = (nM - fm) < WGM ? (nM - fm) : WGM;
        const int pm = fm + ((wgid % nig) % gsz); u.pn = (wgid % nig) / gsz;
        u.pm = skip ? (pm >> 3) * 9 + 1 + (pm & 7) : pm; return true;
    }
    __device__ __forceinline__ void a_ready(const Unit&) const {}
    __device__ __forceinline__ void done(const Unit&) const {}
};
typedef unsigned u32x4e __attribute__((ext_vector_type(4)));
struct EpiQKV {
    static constexpr bool PERM = true, AFTER_DRAIN = false;
    bf16_t* Q; bf16_t* K; bf16_t* V; int nq, nk; const float* cosT; const float* sinT; float qscale;
    __device__ __forceinline__ void operator()(const f32x4 (&acc)[2][2][4][2], const Unit& u, int wr, int wc, int fr, int fq) const {
        bf16_t* base; int kind, pl;
        if (u.pn < nq) { base = Q; kind = 0; pl = u.pn; } else if (u.pn < nq + nk) { base = K; kind = 1; pl = u.pn - nq; } else { base = V; kind = 2; pl = u.pn - nq - nk; }
        const int bq = u.pm / 9; const bool lat = (u.pm - bq * 9) != 0; const bool rope = lat && kind < 2;
        const float sc = (kind == 0) ? qscale : 1.f;
        const int row0 = u.pm * BM + wr * 64 + fr, col0 = pl * BM + wc * 32 + 8 * fq;
#pragma unroll
        for (int ai = 0; ai < 2; ++ai)
#pragma unroll
            for (int m = 0; m < 4; ++m) { const int row = row0 + ai * HALF + m * 16; const int t = row - bq * 2304 - 256;
                f32x4 cs = (f32x4){1.f, 1.f, 1.f, 1.f}, sn = (f32x4){0.f, 0.f, 0.f, 0.f};
                if (rope) { const int i0 = (col0 & 63) >> 1; cs = *(const f32x4*)(cosT + t * 32 + i0); sn = *(const f32x4*)(sinT + t * 32 + i0); }
#pragma unroll
                for (int bj = 0; bj < 2; ++bj) { const int col = col0 + bj * HALF; f32x4 v0 = acc[ai][bj][m][0], v1 = acc[ai][bj][m][1];
                    if (rope) {
                        float e, o;
                        e = v0[0]; o = v0[1]; v0[0] = e * cs[0] - o * sn[0]; v0[1] = e * sn[0] + o * cs[0];
                        e = v0[2]; o = v0[3]; v0[2] = e * cs[1] - o * sn[1]; v0[3] = e * sn[1] + o * cs[1];
                        e = v1[0]; o = v1[1]; v1[0] = e * cs[2] - o * sn[2]; v1[1] = e * sn[2] + o * cs[2];
                        e = v1[2]; o = v1[3]; v1[2] = e * cs[3] - o * sn[3]; v1[3] = e * sn[3] + o * cs[3]; }
                    v0 = v0 * sc; v1 = v1 * sc; u32x4e w; w.x = cvt_pk_bf16(v0[0], v0[1]); w.y = cvt_pk_bf16(v0[2], v0[3]); w.z = cvt_pk_bf16(v1[0], v1[1]); w.w = cvt_pk_bf16(v1[2], v1[3]);
                    *(u32x4e*)(base + (size_t)row * 1024 + col) = w; } }
    }
};
struct EpiPlain {
    static constexpr bool PERM = true, AFTER_DRAIN = false;
    bf16_t* O; int ldc;
    __device__ __forceinline__ void operator()(const f32x4 (&acc)[2][2][4][2], const Unit& u, int wr, int wc, int fr, int fq) const {
        const int row0 = u.pm * BM + wr * 64 + fr, col0 = u.pn * BM + wc * 32 + 8 * fq;
#pragma unroll
        for (int ai = 0; ai < 2; ++ai)
#pragma unroll
            for (int m = 0; m < 4; ++m) { bf16_t* rowp = O + (size_t)(row0 + ai * HALF + m * 16) * ldc + col0;
#pragma unroll
                for (int bj = 0; bj < 2; ++bj) { const f32x4 v0 = acc[ai][bj][m][0], v1 = acc[ai][bj][m][1];
                    u32x4e w; w.x = cvt_pk_bf16(v0[0], v0[1]); w.y = cvt_pk_bf16(v0[2], v0[3]); w.z = cvt_pk_bf16(v1[0], v1[1]); w.w = cvt_pk_bf16(v1[2], v1[3]);
                    *(u32x4e*)(rowp + bj * HALF) = w; } }
    }
};
__device__ __forceinline__ void unpack8(const u32x4e w, f32x4& lo, f32x4& hi) {
    lo[0] = __uint_as_float(w.x << 16); lo[1] = __uint_as_float(w.x & 0xffff0000u); lo[2] = __uint_as_float(w.y << 16); lo[3] = __uint_as_float(w.y & 0xffff0000u);
    hi[0] = __uint_as_float(w.z << 16); hi[1] = __uint_as_float(w.z & 0xffff0000u); hi[2] = __uint_as_float(w.w << 16); hi[3] = __uint_as_float(w.w & 0xffff0000u); }
struct EpiRes {
    static constexpr bool PERM = true, AFTER_DRAIN = false;
    const bf16_t* lat; bf16_t* R; const float* mod; float alpha;
    __device__ __forceinline__ void operator()(const f32x4 (&acc)[2][2][4][2], const Unit& u, int wr, int wc, int fr, int fq) const {
        const int bq = u.pm / 9; const int midx = ((u.pm - bq * 9) == 0) ? 16 : bq; const float* gate = mod + midx * 6144 + 2048;
        const int row0 = u.pm * BM + wr * 64 + fr, col0 = u.pn * BM + wc * 32 + 8 * fq;
#pragma unroll
        for (int bj = 0; bj < 2; ++bj) { const int col = col0 + bj * HALF; const f32x4 g0 = *(const f32x4*)(gate + col), g1 = *(const f32x4*)(gate + col + 4);
#pragma unroll
            for (int ai = 0; ai < 2; ++ai)
#pragma unroll
                for (int m = 0; m < 4; ++m) { const size_t off = (size_t)(row0 + ai * HALF + m * 16) * 1024 + col; f32x4 l0, l1; unpack8(*(const u32x4e*)(lat + off), l0, l1);
                    const f32x4 o0 = l0 * alpha + g0 * acc[ai][bj][m][0], o1 = l1 * alpha + g1 * acc[ai][bj][m][1];
                    u32x4e w; w.x = cvt_pk_bf16(o0[0], o0[1]); w.y = cvt_pk_bf16(o0[2], o0[3]); w.z = cvt_pk_bf16(o1[0], o1[1]); w.w = cvt_pk_bf16(o1[2], o1[3]); *(u32x4e*)(R + off) = w; } }
    }
};
struct EpiGlu {
    static constexpr bool PERM = true, AFTER_DRAIN = false;
    const bf16_t* lat; bf16_t* R; const float* mod; float alpha;
    __device__ __forceinline__ void operator()(const f32x4 (&acc)[2][2][4][2], const Unit& u, int wr, int wc, int fr, int fq) const {
        const int bq = u.pm / 9; const int midx = ((u.pm - bq * 9) == 0) ? 16 : bq; const float* gate = mod + midx * 6144 + 2048;
        const int row0 = u.pm * BM + wr * 64 + fr, col = u.pn * HALF + wc * 32 + 8 * fq;
        const f32x4 g0 = *(const f32x4*)(gate + col), g1 = *(const f32x4*)(gate + col + 4);
#pragma unroll
        for (int ai = 0; ai < 2; ++ai)
#pragma unroll
            for (int m = 0; m < 4; ++m) { const size_t off = (size_t)(row0 + ai * HALF + m * 16) * 1024 + col; f32x4 l0, l1; unpack8(*(const u32x4e*)(lat + off), l0, l1);
                f32x4 v0, v1;
#pragma unroll
                for (int j = 0; j < 4; ++j) { v0[j] = acc[ai][0][m][0][j] * __builtin_amdgcn_rcpf(1.f + __builtin_amdgcn_exp2f(-1.4426950408889634f * acc[ai][1][m][0][j]));
                    v1[j] = acc[ai][0][m][1][j] * __builtin_amdgcn_rcpf(1.f + __builtin_amdgcn_exp2f(-1.4426950408889634f * acc[ai][1][m][1][j])); }
                const f32x4 o0 = l0 * alpha + g0 * v0, o1 = l1 * alpha + g1 * v1;
                u32x4e w; w.x = cvt_pk_bf16(o0[0], o0[1]); w.y = cvt_pk_bf16(o0[2], o0[3]); w.z = cvt_pk_bf16(o1[0], o1[1]); w.w = cvt_pk_bf16(o1[2], o1[3]); *(u32x4e*)(R + off) = w; }
    }
};
template <class Epi, class Sched, bool ALIGN_EPI = false, bool SP2 = false>
__device__ __forceinline__ void gemm_phase(PG8_LAS unsigned char* lds, const Gemm g, const Sched& S, const Epi& E, const int tid_in) {
    const int tid = tid_in; const int wid = __builtin_amdgcn_readfirstlane(tid >> 6), lane = tid & 63, wr = wid >> 2, wc = wid & 3, fr = lane & 15, fq = lane >> 4;
    const int K = g.K, nt = K / BK;
    unsigned voffA[2], voffB[2];
#pragma unroll
    for (int i = 0; i < 2; ++i) { int R, C; stage_rc(tid * 16 + i * 8192, R, C); const int Rb = Epi::PERM ? ((R & ~31) + perm32(R & 31)) : R;
        voffA[i] = (unsigned)(R * K + C) * 2u; voffB[i] = (unsigned)(Rb * K + C) * 2u; }
    const size_t kstep = (size_t)(BK * 2);
    const size_t hstep = (size_t)HALF * K * 2;
    const size_t tstep = 2 * hstep;
    const unsigned ldsw = (unsigned)wid * 1024u;
    const int aoff = lds_byte(wr * 64 + fr, fq * 8), boff = lds_byte(wc * 32 + fr, fq * 8);
#define PG8_SA(b, h) (((b) * 2 + (h)) * HTB)
#define PG8_SB(b, h) ((4 + (b) * 2 + (h)) * HTB)
#define PG8_STAGE(bufoff, gbase, voff) do { _Pragma("unroll") for (int _i = 0; _i < 2; ++_i) \
        __builtin_amdgcn_global_load_lds((const unsigned*)((const char*)(gbase) + (voff)[_i]), (PG8_LAS unsigned*)(lds + (bufoff) + ldsw + _i * 8192), 16, 0, 0); } while (0)
#define PG8_LDA(dst, b, h) do { _Pragma("unroll") for (int m = 0; m < 4; ++m) _Pragma("unroll") for (int k = 0; k < 2; ++k) dst[m][k] = *(const PG8_LAS bf16x8*)(lds + PG8_SA(b, h) + aoff + m * 2048 + k * 1024); } while (0)
#define PG8_LDB(dst, b, h) do { _Pragma("unroll") for (int n = 0; n < 2; ++n) _Pragma("unroll") for (int k = 0; k < 2; ++k) dst[n][k] = *(const PG8_LAS bf16x8*)(lds + PG8_SB(b, h) + boff + n * 2048 + k * 1024); } while (0)
#define PG8_MMA(ai, bj, At, Bt) do { __builtin_amdgcn_s_setprio(1); _Pragma("unroll") for (int m = 0; m < 4; ++m) _Pragma("unroll") for (int n = 0; n < 2; ++n) _Pragma("unroll") for (int k = 0; k < 2; ++k) \
        acc[ai][bj][m][n] = __builtin_amdgcn_mfma_f32_16x16x32_bf16(Bt[n][k], At[m][k], acc[ai][bj][m][n], 0, 0, 0); __builtin_amdgcn_s_setprio(0); } while (0)
#define PG8_WAIT_V(n) asm volatile("s_waitcnt vmcnt(" #n ")" ::: "memory")
#define PG8_WAIT_L(n) asm volatile("s_waitcnt lgkmcnt(" #n ")" ::: "memory")
#define PG8_BAR __builtin_amdgcn_s_barrier()
#define PG8_SCHED __builtin_amdgcn_sched_barrier(0)
    Unit cur, nxt; int ui = 0;
    if (!S.next(0, cur)) return;
    f32x4 acc[2][2][4][2];
#pragma unroll
    for (int a = 0; a < 2; ++a)
#pragma unroll
        for (int b = 0; b < 2; ++b)
#pragma unroll
            for (int m = 0; m < 4; ++m)
#pragma unroll
                for (int n = 0; n < 2; ++n) acc[a][b][m][n] = (f32x4){0.f, 0.f, 0.f, 0.f};
    bf16x8 At[4][2], B0[2][2], B1[2][2];
    const char* cA = (const char*)g.A + (size_t)cur.pm * tstep; const char* cB = (const char*)g.Bt + (size_t)cur.pn * tstep;
    S.a_ready(cur);
    if constexpr (SP2) {
        PG8_STAGE(PG8_SB(0, 0), cB, voffB); PG8_STAGE(PG8_SB(0, 1), cB + hstep, voffB); PG8_STAGE(PG8_SA(0, 0), cA, voffA); PG8_STAGE(PG8_SA(0, 1), cA + hstep, voffA);
        if (wr == 1) PG8_BAR;
        PG8_WAIT_V(2); PG8_BAR;
        PG8_STAGE(PG8_SB(1, 0), cB + kstep, voffB); PG8_STAGE(PG8_SA(1, 0), cA + kstep, voffA); PG8_STAGE(PG8_SB(1, 1), cB + hstep + kstep, voffB);
        PG8_WAIT_V(6); PG8_BAR;
    } else {
        PG8_STAGE(PG8_SB(0, 0), cB, voffB); PG8_STAGE(PG8_SA(0, 0), cA, voffA); PG8_STAGE(PG8_SB(0, 1), cB + hstep, voffB); PG8_STAGE(PG8_SA(0, 1), cA + hstep, voffA);
        if (wr == 1) PG8_BAR;
        PG8_WAIT_V(4); PG8_BAR;
        PG8_STAGE(PG8_SB(1, 0), cB + kstep, voffB); PG8_STAGE(PG8_SA(1, 0), cA + kstep, voffA); PG8_STAGE(PG8_SB(1, 1), cB + hstep + kstep, voffB);
        PG8_WAIT_V(6); PG8_BAR;
    }
    for (;;) {
        const bool has_next = S.next(ui + 1, nxt);
        const char* nA = has_next ? (const char*)g.A + (size_t)nxt.pm * tstep : cA; const char* nB = has_next ? (const char*)g.Bt + (size_t)nxt.pn * tstep : cB;
        for (int t = 0; t < nt; t += 2) {
            const bool last = (t == nt - 2);
            const char* a1 = cA + (size_t)(t + 1) * kstep;
            const char* a2 = last ? nA : cA + (size_t)(t + 2) * kstep; const char* b2 = last ? nB : cB + (size_t)(t + 2) * kstep;
            const char* a3 = a2 + kstep; const char* b3 = b2 + kstep;
            if (last && has_next) S.a_ready(nxt);
            if constexpr (SP2) {
            PG8_LDB(B0, 0, 0); PG8_LDB(B1, 0, 1); PG8_SCHED; PG8_LDA(At, 0, 0); PG8_STAGE(PG8_SA(1, 1), a1 + hstep, voffA);
            PG8_WAIT_V(8); PG8_WAIT_L(0); PG8_BAR; PG8_MMA(0, 0, At, B0); PG8_MMA(0, 1, At, B1); PG8_BAR; PG8_SCHED;
            PG8_LDA(At, 0, 1); PG8_STAGE(PG8_SB(0, 0), b2, voffB); PG8_STAGE(PG8_SB(0, 1), b2 + hstep, voffB); PG8_STAGE(PG8_SA(0, 0), a2, voffA);
            PG8_WAIT_V(8); PG8_WAIT_L(0); PG8_BAR; PG8_MMA(1, 0, At, B0); PG8_MMA(1, 1, At, B1); PG8_BAR; PG8_SCHED;
            PG8_LDB(B0, 1, 0); PG8_LDB(B1, 1, 1); PG8_SCHED; PG8_LDA(At, 1, 0); PG8_STAGE(PG8_SA(0, 1), a2 + hstep, voffA);
            PG8_WAIT_V(8); PG8_WAIT_L(0); PG8_BAR; PG8_MMA(0, 0, At, B0); PG8_MMA(0, 1, At, B1); PG8_BAR; PG8_SCHED;
            PG8_LDA(At, 1, 1); PG8_STAGE(PG8_SB(1, 0), b3, voffB); PG8_STAGE(PG8_SB(1, 1), b3 + hstep, voffB); PG8_STAGE(PG8_SA(1, 0), a3, voffA);
            PG8_WAIT_V(8); PG8_WAIT_L(0); PG8_BAR; PG8_MMA(1, 0, At, B0); PG8_MMA(1, 1, At, B1); PG8_BAR; PG8_SCHED;
            } else {
            PG8_LDB(B0, 0, 0); PG8_SCHED; PG8_LDA(At, 0, 0); PG8_STAGE(PG8_SA(1, 1), a1 + hstep, voffA);
            PG8_WAIT_L(8); PG8_BAR; PG8_WAIT_L(0); PG8_MMA(0, 0, At, B0); PG8_BAR; PG8_SCHED;
            PG8_LDB(B1, 0, 1); PG8_STAGE(PG8_SB(0, 0), b2, voffB);
            PG8_BAR; PG8_WAIT_L(0); PG8_MMA(0, 1, At, B1); PG8_BAR;
            PG8_LDA(At, 0, 1); PG8_STAGE(PG8_SA(0, 0), a2, voffA);
            PG8_BAR; PG8_WAIT_L(0); PG8_MMA(1, 0, At, B0); PG8_BAR; PG8_SCHED;
            PG8_STAGE(PG8_SB(0, 1), b2 + hstep, voffB);
            PG8_WAIT_V(6); PG8_BAR; PG8_MMA(1, 1, At, B1); PG8_BAR;
            PG8_LDB(B0, 1, 0); PG8_SCHED; PG8_LDA(At, 1, 0); PG8_STAGE(PG8_SA(0, 1), a2 + hstep, voffA);
            PG8_WAIT_L(8); PG8_BAR; PG8_WAIT_L(0); PG8_MMA(0, 0, At, B0); PG8_BAR; PG8_SCHED;
            PG8_LDB(B1, 1, 1); PG8_STAGE(PG8_SB(1, 0), b3, voffB);
            PG8_BAR; PG8_WAIT_L(0); PG8_MMA(0, 1, At, B1); PG8_BAR;
            PG8_LDA(At, 1, 1); PG8_STAGE(PG8_SA(1, 0), a3, voffA);
            PG8_BAR; PG8_WAIT_L(0); PG8_MMA(1, 0, At, B0); PG8_BAR; PG8_SCHED;
            PG8_STAGE(PG8_SB(1, 1), b3 + hstep, voffB);
            PG8_WAIT_V(6); PG8_BAR; PG8_MMA(1, 1, At, B1); PG8_BAR;
            }
        }
        if constexpr (ALIGN_EPI) { if (wr == 0) PG8_BAR; }
        if constexpr (!Epi::AFTER_DRAIN) { E(acc, cur, wr, wc, fr, fq); S.done(cur); }
        if (!has_next) break;
#pragma unroll
        for (int a = 0; a < 2; ++a)
#pragma unroll
            for (int b = 0; b < 2; ++b)
#pragma unroll
                for (int m = 0; m < 4; ++m)
#pragma unroll
                    for (int n = 0; n < 2; ++n) acc[a][b][m][n] = (f32x4){0.f, 0.f, 0.f, 0.f};
        cur = nxt; cA = nA; cB = nB; ++ui;
        if constexpr (ALIGN_EPI) { if (wr == 1) PG8_BAR; }
    }
    PG8_WAIT_V(0);
    if constexpr (!ALIGN_EPI) { if (wr == 0) PG8_BAR; }
    PG8_BAR;
    if constexpr (Epi::AFTER_DRAIN) { E.fused(acc, cur, wr, wc, fr, fq, lds, wid, lane); S.done(cur); }
#undef PG8_SA
#undef PG8_SB
#undef PG8_STAGE
#undef PG8_LDA
#undef PG8_LDB
#undef PG8_MMA
#undef PG8_WAIT_V
#undef PG8_WAIT_L
#undef PG8_BAR
#undef PG8_SCHED
}
}
#include <hip/hip_bf16.h>
#include <cmath>
namespace attn_body {
using bf16=__hip_bfloat16;
using bf16x8=__attribute__((ext_vector_type(8)))short;
using s16x4=__attribute__((ext_vector_type(4)))short;
using f32x16=__attribute__((ext_vector_type(16)))float;
using u32x4=__attribute__((ext_vector_type(4)))unsigned;
constexpr int D=64,DM=1024;
constexpr int NW=8,QBLK=32,QB=QBLK*NW,KVBLK=64;
constexpr int ATTN_PITCH=DM, ATTN_UNIT_ROWS=QB;
__device__ __forceinline__ int crow(int r,int hi){return (r&3)+8*(r>>2)+4*hi;}
#define SBAR() __builtin_amdgcn_sched_barrier(0)
__device__ __forceinline__ void bandmask(f32x16&p0,f32x16&p1,int kb,int qpos,int hi){
  const float NEG=-INFINITY; const int d0=kb+4*hi-qpos;
  #pragma unroll
  for(int r=0;r<16;++r){const int d=d0+(r&3)+8*(r>>2); if(d>128||d<-128)p0[r]=NEG; if(d+32>128||d+32<-128)p1[r]=NEG;}
}

constexpr int NSLOT=3, SLOTB=8192;
constexpr int LDS_K=0, LDS_V=NSLOT*SLOTB, LDS_WS=2*NSLOT*SLOTB, LDS_OST=LDS_WS+NW*64*4, LDS_BYTES=LDS_OST+NW*4096;
constexpr float C2=0.125f*1.4426950408889634f;
__device__ __forceinline__ void glds16(const void*gsrc,unsigned lds_dst){unsigned keep;
  asm volatile("s_mov_b32 %0, m0\n\ts_mov_b32 m0, %2\n\ts_nop 0\n\tglobal_load_lds_dwordx4 %1, off\n\ts_mov_b32 m0, %0":"=&s"(keep):"v"(gsrc),"s"(lds_dst):"memory");}
__device__ __forceinline__ float max3f(float a,float b,float c){float r;asm("v_max3_f32 %0, %1, %2, %3":"=v"(r):"v"(a),"v"(b),"v"(c));return r;}
__device__ __forceinline__ float max2f(float a,float b){float r;asm("v_max_f32_e32 %0, %1, %2":"=v"(r):"v"(a),"v"(b));return r;}
__device__ __forceinline__ float fadd_s(float a,float b){float r;asm("v_add_f32_e32 %0, %1, %2":"=v"(r):"v"(a),"v"(b));return r;}
__device__ __forceinline__ float fsub_s(float a,float b){float r;asm("v_sub_f32_e32 %0, %1, %2":"=v"(r):"v"(a),"v"(b));return r;}
typedef float f32x2_t __attribute__((ext_vector_type(2))); typedef __bf16 bf16x2_t __attribute__((ext_vector_type(2)));
__device__ __forceinline__ unsigned cvtpk_s(float lo,float hi){f32x2_t v={lo,hi};bf16x2_t b=__builtin_convertvector(v,bf16x2_t);return __builtin_bit_cast(unsigned,b);}
#define WAIT_BAR(N) asm volatile("s_waitcnt vmcnt(" #N ") lgkmcnt(0)\n\ts_barrier":::"memory")

__device__ __forceinline__ void qkt(f32x16&p0,f32x16&p1,const char*Kslot,const bf16x8*qr,const f32x16&negm,int r32,int hi){
  const char*kb=Kslot+hi*1024+r32*16;
  #pragma unroll
  for(int d0=0;d0<4;++d0){
    const bf16x8 b0=*reinterpret_cast<const bf16x8*>(kb+d0*2048);
    const bf16x8 b1=*reinterpret_cast<const bf16x8*>(kb+d0*2048+512);
    if(d0==0){p0=__builtin_amdgcn_mfma_f32_32x32x16_bf16(b0,qr[0],negm,0,0,0);p1=__builtin_amdgcn_mfma_f32_32x32x16_bf16(b1,qr[0],negm,0,0,0);}
    else{p0=__builtin_amdgcn_mfma_f32_32x32x16_bf16(b0,qr[d0],p0,0,0,0);p1=__builtin_amdgcn_mfma_f32_32x32x16_bf16(b1,qr[d0],p1,0,0,0);}}
}
typedef __attribute__((address_space(3))) const char* lds_cptr;
typedef short v4i16_t __attribute__((ext_vector_type(4)));
__device__ __forceinline__ void kload8(bf16x8*kf,lds_cptr kp){
  kf[0]=*(const __attribute__((address_space(3))) bf16x8*)(kp);      kf[1]=*(const __attribute__((address_space(3))) bf16x8*)(kp+512);
  kf[2]=*(const __attribute__((address_space(3))) bf16x8*)(kp+2048); kf[3]=*(const __attribute__((address_space(3))) bf16x8*)(kp+2560);
  kf[4]=*(const __attribute__((address_space(3))) bf16x8*)(kp+4096); kf[5]=*(const __attribute__((address_space(3))) bf16x8*)(kp+4608);
  kf[6]=*(const __attribute__((address_space(3))) bf16x8*)(kp+6144); kf[7]=*(const __attribute__((address_space(3))) bf16x8*)(kp+6656);
}
__device__ __forceinline__ void kload2(bf16x8*kf,lds_cptr kp,int j){ kf[2*j]=*(const __attribute__((address_space(3))) bf16x8*)(kp+j*2048); kf[2*j+1]=*(const __attribute__((address_space(3))) bf16x8*)(kp+j*2048+512); }
__device__ __forceinline__ s16x4 vtr(lds_cptr p){ return __builtin_bit_cast(s16x4,__builtin_amdgcn_ds_read_tr16_b64_v4i16((__attribute__((address_space(3))) v4i16_t*)p)); }
__device__ __forceinline__ float rowmax(const f32x16&p0,const f32x16&p1){
  float a=max3f(p0[0],p0[1],p1[0]),b=max3f(p0[2],p0[3],p1[1]);a=max3f(a,p1[2],p1[3]);
  #pragma unroll
  for(int r=4;r<16;r+=4){a=max3f(a,p0[r],p0[r+1]);b=max3f(b,p0[r+2],p0[r+3]);a=max3f(a,p1[r],p1[r+1]);b=max3f(b,p1[r+2],p1[r+3]);}
  const float m=max2f(a,b);
  auto rr=__builtin_amdgcn_permlane32_swap(__float_as_uint(m),__float_as_uint(m),false,false);
  return max2f(__uint_as_float(rr[0]),__uint_as_float(rr[1]));
}
__device__ __forceinline__ void pv(f32x16*o,int vb,bf16x8 pa0,bf16x8 pa1,bf16x8 pa2,bf16x8 pa3){
  #pragma unroll
  for(int d0=0;d0<2;++d0){s16x4 lo[4],hi[4];
    #pragma unroll
    for(int ks=0;ks<4;++ks){
      asm volatile("ds_read_b64_tr_b16 %0,%1 offset:%c2":"=&v"(lo[ks]):"v"(vb),"i"(d0*4096+ks*1024):"memory");
      asm volatile("ds_read_b64_tr_b16 %0,%1 offset:%c2":"=&v"(hi[ks]):"v"(vb),"i"(d0*4096+ks*1024+512):"memory");}
    asm volatile("s_waitcnt lgkmcnt(0)":::"memory");SBAR();
    #define PK(k) (bf16x8){lo[k][0],lo[k][1],lo[k][2],lo[k][3],hi[k][0],hi[k][1],hi[k][2],hi[k][3]}
    o[d0]=__builtin_amdgcn_mfma_f32_32x32x16_bf16(pa0,PK(0),o[d0],0,0,0);
    o[d0]=__builtin_amdgcn_mfma_f32_32x32x16_bf16(pa1,PK(1),o[d0],0,0,0);
    o[d0]=__builtin_amdgcn_mfma_f32_32x32x16_bf16(pa2,PK(2),o[d0],0,0,0);
    o[d0]=__builtin_amdgcn_mfma_f32_32x32x16_bf16(pa3,PK(3),o[d0],0,0,0);
    #undef PK
  }
}

#ifndef ATTN_STORE16
#define ATTN_STORE16(p,v) (*(u32x4*)(p)=(v))
#endif
struct UnitDesc { const bf16* Q; const bf16* K; const bf16* V; bf16* O; int NT, latoff, kpos4, qpos0; float sink2; };
template<int THRL,bool MASK> __device__ __forceinline__ void attn_unit(const UnitDesc&u,char*shm,const int tid_in){
  const int tid=tid_in; const int lane=tid&63,r32=lane&31,hi=lane>>5; const int wid=__builtin_amdgcn_readfirstlane(tid>>6);
  const int u_latoff=u.latoff;
  const bf16*Qw=u.Q+(long)(wid*QBLK)*DM;
  const bf16*Kh=u.K,*Vh=u.V;
  const unsigned lds0=(unsigned)(uintptr_t)shm;
  float*wsf=(float*)(shm+LDS_WS)+wid*64;
  const bf16*ksrc=Kh+(long)lane*DM+wid*8;
  const bf16*vsrc=Vh+(long)(16*(wid&3)+(lane>>2))*DM+(wid>>2)*32+(lane&3)*8;
  const unsigned kdst=lds0+LDS_K+wid*1024, vdst=lds0+LDS_V+wid*1024;
  #define TOFF(t) ((long)(((t)<4)?(t)*KVBLK:u_latoff+((t)-4)*KVBLK)*DM)
  #define DMA_K(t,slot) glds16(ksrc+TOFF(t),(unsigned)__builtin_amdgcn_readfirstlane(kdst+(slot)))
  #define DMA_V(t,slot) glds16(vsrc+TOFF(t),(unsigned)__builtin_amdgcn_readfirstlane(vdst+(slot)))
  const int vb0=(int)(lds0+LDS_V)+((lane>>4)&1)*32+(lane&3)*8+(4*hi+((lane&15)>>2))*64;
  const char*Kbase=shm+LDS_K; bf16x8 kf[8];
  const lds_cptr shm3=(lds_cptr)shm; const lds_cptr kp0=shm3+LDS_K+hi*1024+r32*16; const lds_cptr vp0=shm3+LDS_V+((lane>>4)&1)*32+(lane&3)*8+(4*hi+((lane&15)>>2))*64;
  const int NT=u.NT;
  DMA_K(0,0);DMA_V(0,0);DMA_K(1,SLOTB);
  bf16x8 qr[4];
  #pragma unroll
  for(int d0=0;d0<4;++d0)qr[d0]=*reinterpret_cast<const bf16x8*>(&Qw[(long)r32*DM+d0*16+hi*8]);
  float mhat=0.f,l_reg=0.f;f32x16 o[2];o[0]=f32x16{};o[1]=f32x16{};const f32x16 negm=f32x16{};
  const int qpos=u.qpos0+wid*QBLK+r32; const int kpos4=u.kpos4;
  #define CMASK(P0,P1,t) do{ if constexpr(MASK){ if((t)>=4) bandmask(P0,P1,kpos4+((t)-4)*KVBLK,qpos,hi); } }while(0)
  bool resc=false;
  #define START(P0,P1) do{ const float rm=rowmax(P0,P1); resc=false; \
    { const float dl=rm; mhat=fadd_s(mhat,dl); \
      _Pragma("unroll") for(int r=0;r<16;++r){P0[r]=fsub_s(P0[r],dl);P1[r]=fsub_s(P1[r],dl);} \
      } \
    _Pragma("unroll") for(int r=0;r<16;++r)P0[r]=__builtin_amdgcn_exp2f(P0[r]); }while(0)
  #define RESC() do{ if(resc){ asm volatile("s_waitcnt lgkmcnt(0)":::"memory"); \
      _Pragma("unroll") for(int d_=0;d_<2;++d_) _Pragma("unroll") for(int r=0;r<16;++r)o[d_][r]*=wsf[crow(r,hi)]; } }while(0)
  f32x16 pA0,pA1,pB0,pB1;
  int sl_prev=0,sl_cur=0,sl_next=SLOTB;
  #define ROT() do{sl_prev=sl_cur;sl_cur=sl_next;sl_next=(sl_next==(NSLOT-1)*SLOTB)?0:sl_next+SLOTB;}while(0)
  DMA_K(2,2*SLOTB);
  WAIT_BAR(3);
  qkt(pA0,pA1,Kbase,qr,negm,r32,hi);asm volatile("s_nop 15\n\ts_nop 7":"+v"(pA0),"+v"(pA1));CMASK(pA0,pA1,0);
  START(pA0,pA1);
  _Pragma("unroll") for(int r=0;r<16;++r)pA1[r]=__builtin_amdgcn_exp2f(pA1[r]);
  WAIT_BAR(0);
  DMA_K(3,0);DMA_V(1,SLOTB);
  ROT();
  kload8(kf,kp0+sl_cur);
  WAIT_BAR(2);
  s16x4 vlo[8],vhi[8]; u32x4 pw0,pw1,pw2,pw3;
  #define PKW(P,B) cvtpk_s(P[B],P[B+1])
  #define PAF(k) __builtin_bit_cast(bf16x8,pw##k)
  #define VFR(i) (bf16x8){vlo[i][0],vlo[i][1],vlo[i][2],vlo[i][3],vhi[i][0],vhi[i][1],vhi[i][2],vhi[i][3]}
  #define PIN(x) asm volatile("":"+v"(x))
  #define MX3(a,b,c) __builtin_fmaxf(__builtin_fmaxf((a),(b)),(c))
  #define GAPA(MF,A0,A1,A2,A3,W0,W1,PW) do{ MF; sacc+=A0; sacc+=A1; sacc+=A2; sacc+=A3; PIN(sacc); W0; W1; PIN(PW); SBAR(); }while(0)
  #define EX(v) __builtin_amdgcn_exp2f(v)
  #define GAPB(MF,X,B) do{ MF; X[B]=EX(X[B]); X[B+1]=EX(X[B+1]); X[B+2]=EX(X[B+2]); X[B+3]=EX(X[B+3]); PIN(X); SBAR(); }while(0)
  #define VRD(i) do{ vlo[i]=vtr(vp_+(((i)>>2)*4096+((i)&3)*1024)); vhi[i]=vtr(vp_+(((i)>>2)*4096+((i)&3)*1024+512)); }while(0)
  #define KRD(G,j) do{ if(G){ kload2(kf,kp0+sl_next,j); SBAR(); } }while(0)
  #define STEP(C0,C1,P0,P1,t,GK,GV,GL) do{ SBAR(); \
    const lds_cptr vp_=vp0+sl_prev; \
    VRD(0); SBAR(); float sacc=(P0[0]+P0[1]); \
    GAPA(C0=__builtin_amdgcn_mfma_f32_32x32x16_bf16(kf[0],qr[0],negm,0,0,0), P0[2],P0[3],P0[4],P0[5],     pw0[0]=PKW(P0,0), pw0[1]=PKW(P0,2), pw0); \
    VRD(4); SBAR(); GAPA(C1=__builtin_amdgcn_mfma_f32_32x32x16_bf16(kf[1],qr[0],negm,0,0,0), P0[6],P0[7],P0[8],P0[9],     pw0[2]=PKW(P0,4), pw0[3]=PKW(P0,6), pw0); \
    VRD(1); SBAR(); GAPA(C0=__builtin_amdgcn_mfma_f32_32x32x16_bf16(kf[2],qr[1],C0,0,0,0),   P0[10],P0[11],P0[12],P0[13], pw1[0]=PKW(P0,8), pw1[1]=PKW(P0,10), pw1); \
    VRD(5); SBAR(); GAPA(C1=__builtin_amdgcn_mfma_f32_32x32x16_bf16(kf[3],qr[1],C1,0,0,0),   P0[14],P0[15],P1[0],P1[1],   pw1[2]=PKW(P0,12),pw1[3]=PKW(P0,14), pw1); \
    VRD(2); SBAR(); GAPA(C0=__builtin_amdgcn_mfma_f32_32x32x16_bf16(kf[4],qr[2],C0,0,0,0),   P1[2],P1[3],P1[4],P1[5],     pw2[0]=PKW(P1,0), pw2[1]=PKW(P1,2), pw2); \
    VRD(6); SBAR(); GAPA(C1=__builtin_amdgcn_mfma_f32_32x32x16_bf16(kf[5],qr[2],C1,0,0,0),   P1[6],P1[7],P1[8],P1[9],     pw2[2]=PKW(P1,4), pw2[3]=PKW(P1,6), pw2); \
    VRD(3); SBAR(); GAPA(C0=__builtin_amdgcn_mfma_f32_32x32x16_bf16(kf[6],qr[3],C0,0,0,0),   P1[10],P1[11],P1[12],P1[13], pw3[0]=PKW(P1,8), pw3[1]=PKW(P1,10), pw3); \
    VRD(7); SBAR(); GAPA(C1=__builtin_amdgcn_mfma_f32_32x32x16_bf16(kf[7],qr[3],C1,0,0,0),   P1[14],P1[15],0.f,0.f,       pw3[2]=PKW(P1,12),pw3[3]=PKW(P1,14), pw3); \
    l_reg+=sacc; \
    if(GK){DMA_K((t)+3,sl_cur);} if(GV){DMA_V((t)+1,sl_next);} \
    CMASK(C0,C1,t); \
    { float a=MX3(C0[0],C0[1],C1[0]),b=MX3(C0[2],C0[3],C1[1]); a=MX3(a,C1[2],C1[3]); \
      _Pragma("unroll") for(int r=4;r<16;r+=4){a=MX3(a,C0[r],C0[r+1]);b=MX3(b,C0[r+2],C0[r+3]);a=MX3(a,C1[r],C1[r+1]);b=MX3(b,C1[r+2],C1[r+3]);} \
      float rm=__builtin_fmaxf(a,b); { auto rr=__builtin_amdgcn_permlane32_swap(__float_as_uint(rm),__float_as_uint(rm),false,false); rm=__builtin_fmaxf(__uint_as_float(rr[0]),__uint_as_float(rr[1])); } \
      rm-=mhat; resc=false; \
      if(__builtin_expect(__any(rm>(float)THRL),0)){ const float dl=__builtin_fmaxf(rm,0.f); mhat+=dl; \
        const float f=__builtin_amdgcn_exp2f(-dl); l_reg*=f; if(hi==0)wsf[r32]=f; resc=true; } \
      _Pragma("unroll") for(int r=0;r<16;++r){C0[r]-=mhat;C1[r]-=mhat;} } \
    SBAR(); \
    GAPB(o[0]=__builtin_amdgcn_mfma_f32_32x32x16_bf16(PAF(0),VFR(0),o[0],0,0,0), C0,0); \
    GAPB(o[1]=__builtin_amdgcn_mfma_f32_32x32x16_bf16(PAF(0),VFR(4),o[1],0,0,0), C0,4); \
    KRD(GL,0); GAPB(o[0]=__builtin_amdgcn_mfma_f32_32x32x16_bf16(PAF(1),VFR(1),o[0],0,0,0), C0,8); \
    KRD(GL,1); GAPB(o[1]=__builtin_amdgcn_mfma_f32_32x32x16_bf16(PAF(1),VFR(5),o[1],0,0,0), C0,12); \
    KRD(GL,2); GAPB(o[0]=__builtin_amdgcn_mfma_f32_32x32x16_bf16(PAF(2),VFR(2),o[0],0,0,0), C1,0); \
    KRD(GL,3); GAPB(o[1]=__builtin_amdgcn_mfma_f32_32x32x16_bf16(PAF(2),VFR(6),o[1],0,0,0), C1,4); \
    GAPB(o[0]=__builtin_amdgcn_mfma_f32_32x32x16_bf16(PAF(3),VFR(3),o[0],0,0,0), C1,8); \
    GAPB(o[1]=__builtin_amdgcn_mfma_f32_32x32x16_bf16(PAF(3),VFR(7),o[1],0,0,0), C1,12); \
    }while(0)
  int t=1;


  if constexpr(!MASK) for(;t+5<NT;t+=2){
    STEP(pB0,pB1,pA0,pA1,t,true,true,true);     WAIT_BAR(2); RESC(); ROT();
    STEP(pA0,pA1,pB0,pB1,t+1,true,true,true);   WAIT_BAR(2); RESC(); ROT();
  }


  #define ENDW(tt) do{ if((tt)+3<NT){WAIT_BAR(2);} else if((tt)+2<NT){WAIT_BAR(1);} else {WAIT_BAR(0);} }while(0)
  for(;t+1<NT;t+=2){
    STEP(pB0,pB1,pA0,pA1,t,(t+3<NT),(t+1<NT),(t+1<NT));       ENDW(t);   RESC(); ROT();
    STEP(pA0,pA1,pB0,pB1,t+1,(t+4<NT),(t+2<NT),(t+2<NT));     ENDW(t+1); RESC(); ROT();
  }
  STEP(pB0,pB1,pA0,pA1,NT-1,false,false,false); RESC();
  { float sacc=pB0[0]+pB0[1]; _Pragma("unroll") for(int r=2;r<16;++r)sacc+=pB0[r]; _Pragma("unroll") for(int r=0;r<16;++r)sacc+=pB1[r]; l_reg+=sacc;
    pw0=(u32x4){PKW(pB0,0),PKW(pB0,2),PKW(pB0,4),PKW(pB0,6)};pw1=(u32x4){PKW(pB0,8),PKW(pB0,10),PKW(pB0,12),PKW(pB0,14)};pw2=(u32x4){PKW(pB1,0),PKW(pB1,2),PKW(pB1,4),PKW(pB1,6)};pw3=(u32x4){PKW(pB1,8),PKW(pB1,10),PKW(pB1,12),PKW(pB1,14)};
    SBAR(); pv(o,vb0+sl_cur,PAF(0),PAF(1),PAF(2),PAF(3)); }
  #undef PKW
  #undef PAF
  #undef VFR
  #undef PIN
  #undef MX3
  #undef GAPA
  #undef GAPB
  #undef EX
  #undef VRD
  #undef KRD
  #undef STEP
  #undef ENDW
  {auto rr=__builtin_amdgcn_permlane32_swap(__float_as_uint(l_reg),__float_as_uint(l_reg),false,false);l_reg=__uint_as_float(rr[0])+__uint_as_float(rr[1]); l_reg+=__builtin_amdgcn_exp2f(u.sink2-mhat);}
  if(hi==0)wsf[32+r32]=l_reg;asm volatile("s_waitcnt lgkmcnt(0)":::"memory");
  float rli[16];
  #pragma unroll
  for(int r=0;r<16;++r)rli[r]=__builtin_amdgcn_rcpf(wsf[32+crow(r,hi)]);
  bf16*Ow=u.O+(long)(wid*QBLK)*DM;
  { bf16*stg=(bf16*)(shm+LDS_OST)+wid*2048;
    #pragma unroll
    for(int r=0;r<16;++r){const int orow=crow(r,hi);
      #pragma unroll
      for(int d0=0;d0<2;++d0)stg[orow*64+d0*32+r32]=__float2bfloat16(o[d0][r]*rli[r]);}
    asm volatile("s_waitcnt lgkmcnt(0)":::"memory");
    #pragma unroll
    for(int i=0;i<4;++i){const int row=i*8+(lane>>3),ch=lane&7; const u32x4 v=*(const u32x4*)(stg+row*64+ch*8); ATTN_STORE16(Ow+(long)row*DM+ch*8,v);} }
  asm volatile("s_waitcnt lgkmcnt(0)\n\ts_barrier":::"memory");
  #undef TOFF
  #undef DMA_K
  #undef DMA_V
  #undef CMASK
  #undef START
  #undef RESC
  #undef ROT
}

constexpr int SLOTV=16384;
constexpr int LDS2_V=NSLOT*SLOTB, LDS2_WS=LDS2_V+NSLOT*SLOTV, LDS2_OST=LDS2_WS+NW*64*4, LDS2_BYTES=LDS2_OST+NW*4096;
template<int THRL> __device__ __forceinline__ void attn_unit_v128(const UnitDesc&u,char*shm,const int tid_in){
  const int tid=tid_in; const int lane=tid&63,r32=lane&31,hi=lane>>5; const int wid=__builtin_amdgcn_readfirstlane(tid>>6);
  const int u_latoff=u.latoff;
  const bf16*Qw=u.Q+(long)(wid*QBLK)*DM;
  const bf16*Kh=u.K,*Vh=u.V;
  const unsigned lds0=(unsigned)(uintptr_t)shm;
  float*wsf=(float*)(shm+LDS2_WS)+wid*64;
  const bf16*ksrc=Kh+(long)lane*DM+wid*8;
  const bf16*vsrc=Vh+(long)(16*(wid&3)+(lane>>2))*DM+(wid>>2)*32+(lane&3)*8;
  const unsigned kdst=lds0+LDS_K+wid*1024, vdst=lds0+LDS2_V+wid*1024;
  #define TOFF(t) ((long)(((t)<4)?(t)*KVBLK:u_latoff+((t)-4)*KVBLK)*DM)
  #define DMA_K(t,slot) glds16(ksrc+TOFF(t),(unsigned)__builtin_amdgcn_readfirstlane(kdst+(slot)))
  #define DMA_V(t,slot) do{ glds16(vsrc+TOFF(t),(unsigned)__builtin_amdgcn_readfirstlane(vdst+2*(slot))); glds16(vsrc+64+TOFF(t),(unsigned)__builtin_amdgcn_readfirstlane(vdst+2*(slot)+8192)); }while(0)
  const int vb0=(int)(lds0+LDS2_V)+((lane>>4)&1)*32+(lane&3)*8+(4*hi+((lane&15)>>2))*64;
  const char*Kbase=shm+LDS_K; bf16x8 kf[8];
  const lds_cptr shm3=(lds_cptr)shm; const lds_cptr kp0=shm3+LDS_K+hi*1024+r32*16; const lds_cptr vp0=shm3+LDS2_V+((lane>>4)&1)*32+(lane&3)*8+(4*hi+((lane&15)>>2))*64;
  const int NT=u.NT;
  DMA_K(0,0);DMA_V(0,0);DMA_K(1,SLOTB);
  bf16x8 qr[4];
  #pragma unroll
  for(int d0=0;d0<4;++d0)qr[d0]=*reinterpret_cast<const bf16x8*>(&Qw[(long)r32*DM+d0*16+hi*8]);
  float mhat=0.f,l_reg=0.f;f32x16 o[4];o[0]=f32x16{};o[1]=f32x16{};o[2]=f32x16{};o[3]=f32x16{};const f32x16 negm=f32x16{};
  bool resc=false;
  #define START(P0,P1) do{ const float rm=rowmax(P0,P1); resc=false; \
    { const float dl=rm; mhat=fadd_s(mhat,dl); \
      _Pragma("unroll") for(int r=0;r<16;++r){P0[r]=fsub_s(P0[r],dl);P1[r]=fsub_s(P1[r],dl);} \
      } \
    _Pragma("unroll") for(int r=0;r<16;++r)P0[r]=__builtin_amdgcn_exp2f(P0[r]); }while(0)
  #define RESC() do{ if(resc){ asm volatile("s_waitcnt lgkmcnt(0)":::"memory"); \
      _Pragma("unroll") for(int d_=0;d_<4;++d_) _Pragma("unroll") for(int r=0;r<16;++r)o[d_][r]*=wsf[crow(r,hi)]; } }while(0)
  f32x16 pA0,pA1,pB0,pB1;
  int sl_prev=0,sl_cur=0,sl_next=SLOTB;
  #define ROT() do{sl_prev=sl_cur;sl_cur=sl_next;sl_next=(sl_next==(NSLOT-1)*SLOTB)?0:sl_next+SLOTB;}while(0)
  DMA_K(2,2*SLOTB);
  WAIT_BAR(3);
  qkt(pA0,pA1,Kbase,qr,negm,r32,hi);asm volatile("s_nop 15\n\ts_nop 7":"+v"(pA0),"+v"(pA1));
  START(pA0,pA1);
  _Pragma("unroll") for(int r=0;r<16;++r)pA1[r]=__builtin_amdgcn_exp2f(pA1[r]);
  WAIT_BAR(0);
  DMA_K(3,0);DMA_V(1,SLOTB);
  ROT();
  kload8(kf,kp0+sl_cur);
  WAIT_BAR(3);
  s16x4 vlo[16],vhi[16]; u32x4 pw0,pw1,pw2,pw3;
  #define PKW(P,B) cvtpk_s(P[B],P[B+1])
  #define PAF(k) __builtin_bit_cast(bf16x8,pw##k)
  #define VFR(i) (bf16x8){vlo[i][0],vlo[i][1],vlo[i][2],vlo[i][3],vhi[i][0],vhi[i][1],vhi[i][2],vhi[i][3]}
  #define PIN(x) asm volatile("":"+v"(x))
  #define MX3(a,b,c) __builtin_fmaxf(__builtin_fmaxf((a),(b)),(c))
  #define GAPA(MF,A0,A1,A2,A3,W0,W1,PW) do{ MF; sacc+=A0; sacc+=A1; sacc+=A2; sacc+=A3; PIN(sacc); W0; W1; PIN(PW); SBAR(); }while(0)
  #define EX(v) __builtin_amdgcn_exp2f(v)
  #define GAPB(MF,X,B) do{ MF; X[B]=EX(X[B]); X[B+1]=EX(X[B+1]); PIN(X); SBAR(); }while(0)
  #define VRD(i) do{ vlo[i]=vtr(vp_+(((i)>>2)*4096+((i)&3)*1024)); vhi[i]=vtr(vp_+(((i)>>2)*4096+((i)&3)*1024+512)); }while(0)
  #define KR1(G,i) do{ if(G){ kf[i]=*(const __attribute__((address_space(3))) bf16x8*)(kp0+sl_next+((i)>>1)*2048+((i)&1)*512); } }while(0)
  #define MF32(a,b,c) __builtin_amdgcn_mfma_f32_32x32x16_bf16(a,b,c,0,0,0)
  #define STEP(C0,C1,P0,P1,t,GK,GV,GL) do{ SBAR(); \
    const lds_cptr vp_=vp0+2*sl_prev; \
    float sacc=(P0[0]+P0[1]); \
    GAPA(C0=MF32(kf[0],qr[0],negm), P0[2],P0[3],P0[4],P0[5],     pw0[0]=PKW(P0,0), pw0[1]=PKW(P0,2), pw0); \
    GAPA(C1=MF32(kf[1],qr[0],negm), P0[6],P0[7],P0[8],P0[9],     pw0[2]=PKW(P0,4), pw0[3]=PKW(P0,6), pw0); \
    GAPA(C0=MF32(kf[2],qr[1],C0),   P0[10],P0[11],P0[12],P0[13], pw1[0]=PKW(P0,8), pw1[1]=PKW(P0,10), pw1); \
    GAPA(C1=MF32(kf[3],qr[1],C1),  P0[14],P0[15],P1[0],P1[1],   pw1[2]=PKW(P0,12),pw1[3]=PKW(P0,14), pw1); \
    VRD(0); SBAR(); GAPA(C0=MF32(kf[4],qr[2],C0),   P1[2],P1[3],P1[4],P1[5],     pw2[0]=PKW(P1,0), pw2[1]=PKW(P1,2), pw2); \
    VRD(4); SBAR(); GAPA(C1=MF32(kf[5],qr[2],C1),   P1[6],P1[7],P1[8],P1[9],     pw2[2]=PKW(P1,4), pw2[3]=PKW(P1,6), pw2); \
    VRD(8); SBAR(); GAPA(C0=MF32(kf[6],qr[3],C0),   P1[10],P1[11],P1[12],P1[13], pw3[0]=PKW(P1,8), pw3[1]=PKW(P1,10), pw3); \
    VRD(12); SBAR(); GAPA(C1=MF32(kf[7],qr[3],C1),  P1[14],P1[15],0.f,0.f,       pw3[2]=PKW(P1,12),pw3[3]=PKW(P1,14), pw3); \
    l_reg+=sacc; \
    if(GK){DMA_K((t)+3,sl_cur);} if(GV){DMA_V((t)+1,sl_next);} \
    SBAR(); \
    VRD(1); SBAR(); o[0]=MF32(PAF(0),VFR(0),o[0]); SBAR(); \
    VRD(5); SBAR(); o[1]=MF32(PAF(0),VFR(4),o[1]); float a_=MX3(C0[0],C0[1],C1[0]),b_=MX3(C0[2],C0[3],C1[1]); a_=MX3(a_,C1[2],C1[3]); a_=MX3(a_,C0[4],C0[5]); b_=MX3(b_,C0[6],C0[7]); a_=MX3(a_,C1[4],C1[5]); b_=MX3(b_,C1[6],C1[7]); PIN(a_); PIN(b_); SBAR(); \
    VRD(9); KR1(GL,0); SBAR(); o[2]=MF32(PAF(0),VFR(8),o[2]); a_=MX3(a_,C0[8],C0[9]); b_=MX3(b_,C0[10],C0[11]); a_=MX3(a_,C1[8],C1[9]); b_=MX3(b_,C1[10],C1[11]); a_=MX3(a_,C0[12],C0[13]); b_=MX3(b_,C0[14],C0[15]); a_=MX3(a_,C1[12],C1[13]); b_=MX3(b_,C1[14],C1[15]); PIN(a_); PIN(b_); SBAR(); \
    VRD(13); KR1(GL,1); SBAR(); o[3]=MF32(PAF(0),VFR(12),o[3]); { float rm=__builtin_fmaxf(a_,b_); { auto rr=__builtin_amdgcn_permlane32_swap(__float_as_uint(rm),__float_as_uint(rm),false,false); rm=__builtin_fmaxf(__uint_as_float(rr[0]),__uint_as_float(rr[1])); } \
      rm-=mhat; resc=false; \
      if(__builtin_expect(__any(rm>(float)THRL),0)){ const float dl=__builtin_fmaxf(rm,0.f); mhat+=dl; \
        const float f=__builtin_amdgcn_exp2f(-dl); l_reg*=f; if(hi==0)wsf[r32]=f; resc=true; } } PIN(mhat); SBAR(); \
    VRD(2); KR1(GL,2); SBAR(); o[0]=MF32(PAF(1),VFR(1),o[0]); _Pragma("unroll") for(int r=0;r<16;++r){C0[r]-=mhat;} PIN(C0); SBAR(); \
    VRD(6); KR1(GL,3); SBAR(); o[1]=MF32(PAF(1),VFR(5),o[1]); _Pragma("unroll") for(int r=0;r<16;++r){C1[r]-=mhat;} PIN(C1); SBAR(); \
    VRD(10); KR1(GL,4); SBAR(); o[2]=MF32(PAF(1),VFR(9),o[2]); C0[0]=EX(C0[0]); C0[1]=EX(C0[1]); C0[2]=EX(C0[2]); PIN(C0); SBAR(); \
    VRD(14); KR1(GL,5); SBAR(); o[3]=MF32(PAF(1),VFR(13),o[3]); C0[3]=EX(C0[3]); C0[4]=EX(C0[4]); C0[5]=EX(C0[5]); PIN(C0); SBAR(); \
    VRD(3); KR1(GL,6); SBAR(); o[0]=MF32(PAF(2),VFR(2),o[0]); C0[6]=EX(C0[6]); C0[7]=EX(C0[7]); C0[8]=EX(C0[8]); PIN(C0); SBAR(); \
    VRD(7); KR1(GL,7); SBAR(); o[1]=MF32(PAF(2),VFR(6),o[1]); C0[9]=EX(C0[9]); C0[10]=EX(C0[10]); C0[11]=EX(C0[11]); PIN(C0); SBAR(); \
    VRD(11); SBAR(); o[2]=MF32(PAF(2),VFR(10),o[2]); C0[12]=EX(C0[12]); C0[13]=EX(C0[13]); C0[14]=EX(C0[14]); PIN(C0); SBAR(); \
    VRD(15); SBAR(); o[3]=MF32(PAF(2),VFR(14),o[3]); C0[15]=EX(C0[15]); C1[0]=EX(C1[0]); C1[1]=EX(C1[1]); PIN(C0); PIN(C1); SBAR(); \
    o[0]=MF32(PAF(3),VFR(3),o[0]); C1[2]=EX(C1[2]); C1[3]=EX(C1[3]); C1[4]=EX(C1[4]); PIN(C1); SBAR(); \
    o[1]=MF32(PAF(3),VFR(7),o[1]); C1[5]=EX(C1[5]); C1[6]=EX(C1[6]); C1[7]=EX(C1[7]); PIN(C1); SBAR(); \
    o[2]=MF32(PAF(3),VFR(11),o[2]); C1[8]=EX(C1[8]); C1[9]=EX(C1[9]); C1[10]=EX(C1[10]); C1[11]=EX(C1[11]); PIN(C1); SBAR(); \
    o[3]=MF32(PAF(3),VFR(15),o[3]); C1[12]=EX(C1[12]); C1[13]=EX(C1[13]); C1[14]=EX(C1[14]); C1[15]=EX(C1[15]); PIN(C1); SBAR(); \
    }while(0)
  int t=1;
  for(;t+5<NT;t+=2){
    STEP(pB0,pB1,pA0,pA1,t,true,true,true);     WAIT_BAR(3); RESC(); ROT();
    STEP(pA0,pA1,pB0,pB1,t+1,true,true,true);   WAIT_BAR(3); RESC(); ROT();
  }
  #define ENDW(tt) do{ if((tt)+3<NT){WAIT_BAR(3);} else if((tt)+2<NT){WAIT_BAR(2);} else {WAIT_BAR(0);} }while(0)
  for(;t+1<NT;t+=2){
    STEP(pB0,pB1,pA0,pA1,t,(t+3<NT),(t+1<NT),(t+1<NT));       ENDW(t);   RESC(); ROT();
    STEP(pA0,pA1,pB0,pB1,t+1,(t+4<NT),(t+2<NT),(t+2<NT));     ENDW(t+1); RESC(); ROT();
  }
  STEP(pB0,pB1,pA0,pA1,NT-1,false,false,false); RESC();
  { float sacc=pB0[0]+pB0[1]; _Pragma("unroll") for(int r=2;r<16;++r)sacc+=pB0[r]; _Pragma("unroll") for(int r=0;r<16;++r)sacc+=pB1[r]; l_reg+=sacc;
    pw0=(u32x4){PKW(pB0,0),PKW(pB0,2),PKW(pB0,4),PKW(pB0,6)};pw1=(u32x4){PKW(pB0,8),PKW(pB0,10),PKW(pB0,12),PKW(pB0,14)};pw2=(u32x4){PKW(pB1,0),PKW(pB1,2),PKW(pB1,4),PKW(pB1,6)};pw3=(u32x4){PKW(pB1,8),PKW(pB1,10),PKW(pB1,12),PKW(pB1,14)};
    SBAR(); pv(o,vb0+2*sl_cur,PAF(0),PAF(1),PAF(2),PAF(3)); pv(o+2,vb0+2*sl_cur+8192,PAF(0),PAF(1),PAF(2),PAF(3)); }
  #undef PKW
  #undef PAF
  #undef VFR
  #undef PIN
  #undef MX3
  #undef GAPA
  #undef GAPB
  #undef EX
  #undef VRD
  #undef KR1
  #undef MF32
  #undef STEP
  #undef ENDW
  {auto rr=__builtin_amdgcn_permlane32_swap(__float_as_uint(l_reg),__float_as_uint(l_reg),false,false);l_reg=__uint_as_float(rr[0])+__uint_as_float(rr[1]); l_reg+=__builtin_amdgcn_exp2f(u.sink2-mhat);}
  if(hi==0)wsf[32+r32]=l_reg;asm volatile("s_waitcnt lgkmcnt(0)":::"memory");
  float rli[16];
  #pragma unroll
  for(int r=0;r<16;++r)rli[r]=__builtin_amdgcn_rcpf(wsf[32+crow(r,hi)]);
  bf16*Ow=u.O+(long)(wid*QBLK)*DM;
  { bf16*stg=(bf16*)(shm+LDS2_OST)+wid*2048;
    #pragma unroll
    for(int h2=0;h2<2;++h2){
      #pragma unroll
      for(int r=0;r<16;++r){const int orow=crow(r,hi);
        #pragma unroll
        for(int d0=0;d0<2;++d0)stg[orow*64+d0*32+r32]=__float2bfloat16(o[2*h2+d0][r]*rli[r]);}
      asm volatile("s_waitcnt lgkmcnt(0)":::"memory");
      #pragma unroll
      for(int i=0;i<4;++i){const int row=i*8+(lane>>3),ch=lane&7; const u32x4 v=*(const u32x4*)(stg+row*64+ch*8); ATTN_STORE16(Ow+(long)row*DM+h2*64+ch*8,v);}
      asm volatile("s_waitcnt lgkmcnt(0)":::"memory"); } }
  asm volatile("s_waitcnt lgkmcnt(0)\n\ts_barrier":::"memory");
  #undef TOFF
  #undef DMA_K
  #undef DMA_V
  #undef START
  #undef RESC
  #undef ROT
}
constexpr int ATTN_LDS_BYTES=LDS_BYTES;
#undef SBAR
#undef WAIT_BAR
}
#define GAS __attribute__((address_space(1)))
#define LAS __attribute__((address_space(3)))
typedef unsigned short bf16;
typedef unsigned v4u __attribute__((ext_vector_type(4)));
typedef float f32x4 __attribute__((ext_vector_type(4)));
typedef short bf16x8 __attribute__((ext_vector_type(8)));
typedef GAS unsigned gu32;
typedef GAS unsigned long long gu64;
#define RLX_AGENT __ATOMIC_RELAXED, __HIP_MEMORY_SCOPE_AGENT
#define LDS_WAIT() asm volatile("s_waitcnt lgkmcnt(0)" ::: "memory")
#define VM_WAIT() asm volatile("s_waitcnt vmcnt(0)" ::: "memory")
__device__ __forceinline__ unsigned long long rt() { return __builtin_amdgcn_s_memrealtime(); }
__device__ __forceinline__ unsigned f2bf(float f) { unsigned u = __builtin_bit_cast(unsigned, f); return (u + 0x7fffu + ((u >> 16) & 1u)) >> 16; }
__device__ __forceinline__ unsigned pk2(float lo, float hi) { unsigned r; asm("v_cvt_pk_bf16_f32 %0, %1, %2" : "=v"(r) : "v"(lo), "v"(hi)); return r; }

#define XB_TMO      128
#define XB_XCNT(j)  (256  + 64 * (j))
#define XB_XSUB(j)  (1280 + 64 * (j))
#define XB_XGEN(j)  (2304 + 64 * (j))
#define XB_TOP      3328
#define XB_TOPGEN   3392
#define XCD_BAR_WORDS 3456
#define XB_SPIN_CAP (1u << 29)

__device__ __forceinline__ unsigned xb_ld(unsigned* p)              { return __hip_atomic_load(p, __ATOMIC_RELAXED, __HIP_MEMORY_SCOPE_AGENT); }
__device__ __forceinline__ unsigned xb_add(unsigned* p, unsigned v) { return __hip_atomic_fetch_add(p, v, __ATOMIC_RELAXED, __HIP_MEMORY_SCOPE_AGENT); }
__device__ __forceinline__ unsigned xb_xcc_id() { return (unsigned)__builtin_amdgcn_s_getreg((3 << 11) | 20) & 0xFu; }
#define XB_SPIN(cond, bar) do { unsigned _sp = 0; while (cond) { __builtin_amdgcn_s_sleep(1); \
    if ((++_sp & 255u) == 0u) { if (xb_ld(&(bar)[XB_TMO])) break; if (_sp > XB_SPIN_CAP) { atomicAdd(&(bar)[XB_TMO], 1u); break; } } } } while (0)

struct XcdBarrier {
    unsigned* bar; unsigned x;
    volatile LAS unsigned* st;
};

__device__ __forceinline__ XcdBarrier xcd_barrier_post(unsigned* bar, volatile LAS unsigned* st, const int tid_in) {
    XcdBarrier b; b.bar = bar; b.x = xb_xcc_id(); b.st = st;
    if (tid_in == 0) (void)xb_add(&bar[XB_XCNT(b.x)], 1u);
    return b;
}
__device__ __forceinline__ void xcd_barrier_complete(unsigned* bar, unsigned x, unsigned& nloc, unsigned& nx) {
    const unsigned G = gridDim.x * gridDim.y * gridDim.z;
    unsigned sum, cnt, mine, sp = 0u;
    for (;;) {
        sum = 0u; cnt = 0u; mine = 0u;
#pragma unroll
        for (unsigned j = 0; j < 16; ++j) { const unsigned c = xb_ld(&bar[XB_XCNT(j)]); sum += c; cnt += (c > 0u) ? 1u : 0u; mine = (j == x) ? c : mine; }
        if (sum == G) break;
        __builtin_amdgcn_s_sleep(1);
        if ((++sp & 255u) == 0u) { if (xb_ld(&bar[XB_TMO])) break; if (sp > XB_SPIN_CAP) { atomicAdd(&bar[XB_TMO], 1u); break; } }
    }
    nloc = mine > 0u ? mine : 1u; nx = cnt > 0u ? cnt : 1u;
}

__device__ __forceinline__ void xcd_barrier(const XcdBarrier& b, const int tid_in) {
    asm volatile("s_waitcnt vmcnt(0)" ::: "memory");
    __syncthreads();
    if (tid_in == 0) {
        unsigned* bar = b.bar;
        __builtin_amdgcn_s_waitcnt(0);
        unsigned nloc = b.st[0], nx = b.st[1];
        if (nloc == 0u) { xcd_barrier_complete(bar, b.x, nloc, nx); b.st[0] = nloc; b.st[1] = nx; }
        const unsigned old = xb_add(&bar[XB_XSUB(b.x)], 1u);
        const unsigned gen = old / nloc;
        if (old + 1u == (gen + 1u) * nloc) {
            __builtin_amdgcn_fence(__ATOMIC_RELEASE, "agent");
            asm volatile("s_waitcnt vmcnt(0)" ::: "memory");
            const unsigned og = xb_add(&bar[XB_TOP], 1u);
            const unsigned tg = og / nx;
            if (og + 1u == (tg + 1u) * nx) xb_add(&bar[XB_TOPGEN], 1u);
            else XB_SPIN(xb_ld(&bar[XB_TOPGEN]) == tg, bar);
            __builtin_amdgcn_fence(__ATOMIC_ACQUIRE, "agent");
            xb_add(&bar[XB_XGEN(b.x)], 1u);
            asm volatile("s_waitcnt vmcnt(0)" ::: "memory");
        } else {
            XB_SPIN(xb_ld(&bar[XB_XGEN(b.x)]) == gen, bar);
            __builtin_amdgcn_fence(__ATOMIC_ACQUIRE, "agent");
            asm volatile("s_waitcnt vmcnt(0)" ::: "memory");
        }
    }
    __syncthreads();
}
constexpr int NB = 16, TL = 2048, LC = 256, SQ = TL + LC, MR = NB * SQ, DD = 1024, NLAYER = 4;
constexpr float LN_EPS = 1e-5f, DN_ALPHA = 1.6817928305074290f;
constexpr float LOG2E = 1.4426950408889634f;
constexpr int NWAVES = 8, NTHR = 512;
constexpr size_t MiB = 1u << 20;
constexpr size_t WS_CTL = 0, CTL_ZERO_BYTES = 1 * MiB;
constexpr size_t WS_MOD = 1 * MiB;
constexpr size_t WS_ROPE = 3 * MiB;
constexpr size_t WS_S5LB = 4 * MiB;
constexpr size_t WS_S5B = 4 * MiB + 128 * 1024;
constexpr size_t WS_S5C = 5 * MiB;
constexpr size_t WS_KEYS = 6 * MiB;
constexpr size_t WS_WQKV_DA = 8 * MiB;
constexpr size_t WS_WO_DA = 20 * MiB;
constexpr size_t WS_WQKV_WA = 24 * MiB;
constexpr size_t WS_WO_WA = 27 * MiB;
constexpr size_t WS_WGLU = 29 * MiB;
constexpr size_t WS_WPQ = 33 * MiB;
constexpr size_t WS_PU = 64 * MiB;
constexpr size_t WS_PV = 192 * MiB;
constexpr size_t WS_LAT = 320 * MiB;
constexpr size_t WS_H = 464 * MiB;
constexpr size_t WS_A = 536 * MiB;
constexpr size_t WS_B = 752 * MiB;
constexpr size_t WS_END = 896 * MiB;
constexpr size_t SZ72 = 72 * MiB;
constexpr int CW_TMO = 0, CW_CODE = 1, CW_ERR = 2;
constexpr int CW_BAR = 4096;
constexpr int RING_OFF = 0, RING_BYTES = 131072;
constexpr int LDSCTL_OFF = RING_BYTES, MISC_OFF = LDSCTL_OFF + 320;
constexpr int LDS_BYTES = 147456;
static_assert(MISC_OFF + 128 <= LDS_BYTES, "LDS map");

typedef __bf16 bf16x2v __attribute__((ext_vector_type(2)));
typedef float f32x16 __attribute__((ext_vector_type(16)));
__device__ __forceinline__ float dot2bf(unsigned w, unsigned x, float acc) { return __builtin_amdgcn_fdot2_f32_bf16(__builtin_bit_cast(bf16x2v, w), __builtin_bit_cast(bf16x2v, x), acc, false); }
__device__ __forceinline__ float bflo(unsigned u) { return __uint_as_float(u << 16); }
__device__ __forceinline__ float bfhi(unsigned u) { return __uint_as_float(u & 0xffff0000u); }
__device__ __forceinline__ float bf2f(bf16 h) { return __uint_as_float((unsigned)h << 16); }
__device__ __forceinline__ float wave_sum(float v) {
#pragma unroll
    for (int o = 1; o < 64; o <<= 1) v += __shfl_xor(v, o);
    return v;
}
__device__ __forceinline__ float gelu_tanh(float x) {
    const float z = 0.7978845608028654f * (x + 0.044715f * x * x * x);
    return x * __builtin_amdgcn_rcpf(1.f + __builtin_amdgcn_exp2f(-2.f * LOG2E * z));
}
__device__ __forceinline__ int mod_index(int row) { const int b = row / SQ; return (row - b * SQ) < LC ? 16 : b; }

__device__ __forceinline__ void p0_transpose_item(const float* W, int K, int N, bf16* WT, int glu, LAS float* scr, int item, int lane) {
    const int nblk = N / 32, kb = item / nblk, nb = item % nblk, k0 = 64 * kb, n0 = 32 * nb;
#pragma unroll 8
    for (int i = 0; i < 32; ++i) { const int kk = 2 * i + (lane >> 5); scr[kk * 33 + (lane & 31)] = W[(size_t)(k0 + kk) * N + n0 + (lane & 31)]; }
    LDS_WAIT(); asm volatile("" ::: "memory");
    const int c = lane & 7;
    int r0 = n0; if (glu) r0 = (n0 < 1024) ? ((n0 >> 7) * 256 + (n0 & 127)) : (((n0 - 1024) >> 7) * 256 + 128 + ((n0 - 1024) & 127));
#pragma unroll
    for (int j = 0; j < 4; ++j) { const int n = (lane >> 3) + 8 * j; const LAS float* s = scr + (8 * c) * 33 + n;
        v4u o; o.x = pk2(s[0 * 33], s[1 * 33]); o.y = pk2(s[2 * 33], s[3 * 33]); o.z = pk2(s[4 * 33], s[5 * 33]); o.w = pk2(s[6 * 33], s[7 * 33]);
        *(GAS v4u*)(WT + (size_t)(r0 + n) * K + k0 + 8 * c) = o; }
    LDS_WAIT(); asm volatile("" ::: "memory");
}
__device__ __forceinline__ void cvt_f32_bf16_stream(const float* src, bf16* dst, size_t nchunks8, size_t gt, size_t ngt) {
    for (size_t c = gt; c < nchunks8; c += ngt) { const f32x4 a = *(const GAS f32x4*)(src + c * 8), b = *(const GAS f32x4*)(src + c * 8 + 4);
        v4u o; o.x = pk2(a.x, a.y); o.y = pk2(a.z, a.w); o.z = pk2(b.x, b.y); o.w = pk2(b.z, b.w); *(GAS v4u*)(dst + c * 8) = o; }
}
struct Args;
#ifndef PEER_SLICED
#define PEER_SLICED 0
#endif
constexpr float PU_SCALE = 512.f, PV_SCALE = 32.f;
__device__ __forceinline__ unsigned pk4_fp8(float a, float b, float c, float d, float sc) {
    a = fminf(fmaxf(a * sc, -448.f), 448.f); b = fminf(fmaxf(b * sc, -448.f), 448.f); c = fminf(fmaxf(c * sc, -448.f), 448.f); d = fminf(fmaxf(d * sc, -448.f), 448.f);
    int w = 0; w = __builtin_amdgcn_cvt_pk_fp8_f32(a, b, w, false); w = __builtin_amdgcn_cvt_pk_fp8_f32(c, d, w, true); return (unsigned)w; }
__device__ __forceinline__ void cvt_f32_fp8_stream(const float* src, unsigned char* dst, size_t nchunks16, float sc, size_t gt, size_t ngt) {
    for (size_t c = gt; c < nchunks16; c += ngt) { const f32x4 a = *(const GAS f32x4*)(src + c * 16), b = *(const GAS f32x4*)(src + c * 16 + 4), cc = *(const GAS f32x4*)(src + c * 16 + 8), d = *(const GAS f32x4*)(src + c * 16 + 12);
        v4u o; o.x = pk4_fp8(a.x, a.y, a.z, a.w, sc); o.y = pk4_fp8(b.x, b.y, b.z, b.w, sc); o.z = pk4_fp8(cc.x, cc.y, cc.z, cc.w, sc); o.w = pk4_fp8(d.x, d.y, d.z, d.w, sc);
#if PEER_SLICED
        const size_t lay = c >> 20, e = (c >> 6) & 16383, c16 = c & 63; *(GAS v4u*)(dst + (lay << 24) + ((c16 >> 3) << 21) + e * 128 + (c16 & 7) * 16) = o; }
#else
        *(GAS v4u*)(dst + c * 16) = o; }
#endif
}
template <class KP> __device__ __forceinline__ void cvt_tables_layer(KP ka, unsigned char* ws, int layer, int part, int nparts, int tid) {
    const size_t per = (size_t)16384 * 1024, gt = (size_t)part * NTHR + tid, ngt = (size_t)nparts * NTHR;
    cvt_f32_fp8_stream(ka->in[10] + (size_t)layer * per, ws + WS_PU + (size_t)layer * per, per / 16, PU_SCALE, gt, ngt);
    cvt_f32_fp8_stream(ka->in[11] + (size_t)layer * per, ws + WS_PV + (size_t)layer * per, per / 16, PV_SCALE, gt, ngt);
}
constexpr size_t WS_MODP = WS_A;
constexpr size_t MODN_ = (size_t)4 * 17 * 6144;
template <class KP> __device__ __forceinline__ void p0_mod(KP ka, unsigned char* ws, LAS unsigned char* lds, int vcu, int G, int tid, int lane, int wave) {
    LAS float* sl = (LAS float*)lds;
    for (int idx = tid; idx < 17 * 1024; idx += NTHR) { const int r = idx >> 10, k = idx & 1023; const float v = (r < 16) ? ka->in[1][r * 1024 + k] : ka->in[3][k]; sl[k * 20 + r] = v / (1.f + expf(-v)); }
    __syncthreads();
    float* MODP = (float*)(ws + WS_MODP);
    const int gw = vcu * NWAVES + wave, NGW = G * NWAVES;
    for (int item = gw; item < 4 * 96 * 8; item += NGW) { const int kc = item & 7, cg = item >> 3, i = cg / 96, n0 = (cg % 96) * 64;
        const float* W = ka->in[4] + (size_t)i * 1024 * 6144 + n0 + lane;
        float acc[17];
#pragma unroll
        for (int r = 0; r < 17; ++r) acc[r] = 0.f;
#pragma unroll 8
        for (int kk = 0; kk < 128; ++kk) { const int k = kc * 128 + kk; const float w = W[(size_t)k * 6144];
            const f32x4 s0 = *(const LAS f32x4*)(sl + k * 20), s1 = *(const LAS f32x4*)(sl + k * 20 + 4), s2 = *(const LAS f32x4*)(sl + k * 20 + 8), s3 = *(const LAS f32x4*)(sl + k * 20 + 12); const float s4 = sl[k * 20 + 16];
            acc[0] += s0.x * w; acc[1] += s0.y * w; acc[2] += s0.z * w; acc[3] += s0.w * w; acc[4] += s1.x * w; acc[5] += s1.y * w; acc[6] += s1.z * w; acc[7] += s1.w * w;
            acc[8] += s2.x * w; acc[9] += s2.y * w; acc[10] += s2.z * w; acc[11] += s2.w * w; acc[12] += s3.x * w; acc[13] += s3.y * w; acc[14] += s3.z * w; acc[15] += s3.w * w; acc[16] += s4 * w; }
#pragma unroll
        for (int r = 0; r < 17; ++r) MODP[(size_t)kc * MODN_ + ((size_t)i * 17 + r) * 6144 + n0 + lane] = acc[r]; }
    __syncthreads();
}
template <class KP> __device__ __forceinline__ void p0_prologue(KP ka, unsigned char* ws, LAS unsigned char* lds, int vcu, int G, int tid, int lane, int wave) {
    p0_mod(ka, ws, lds, vcu, G, tid, lane, wave);
    const int gw = vcu * NWAVES + wave, NGW = G * NWAVES; const size_t gt = (size_t)vcu * NTHR + tid, ngt = (size_t)G * NTHR;
    { LAS float* scr = (LAS float*)(lds + wave * 16384);
      constexpr int I_QKV = 16 * 96, I_O = 16 * 32, I_WA = 16 * 48, I_G = 16 * 64, I_PQ = 16 * 64;
      constexpr int NITEMS = 2 * I_QKV + 2 * I_O + I_WA + I_O + I_G + 4 * I_PQ;
      for (int it = gw; it < NITEMS; it += NGW) { int r = it;
          if (r < 2 * I_QKV) { const int l = r / I_QKV; p0_transpose_item(ka->in[12] + (size_t)l * 1024 * 3072, 1024, 3072, (bf16*)(ws + WS_WQKV_DA) + (size_t)l * 3072 * 1024, 0, scr, r % I_QKV, lane); continue; } r -= 2 * I_QKV;
          if (r < 2 * I_O) { const int l = r / I_O; p0_transpose_item(ka->in[13] + (size_t)l * 1024 * 1024, 1024, 1024, (bf16*)(ws + WS_WO_DA) + (size_t)l * 1024 * 1024, 0, scr, r % I_O, lane); continue; } r -= 2 * I_O;
          if (r < I_WA) { p0_transpose_item(ka->in[16], 1024, 1536, (bf16*)(ws + WS_WQKV_WA), 0, scr, r, lane); continue; } r -= I_WA;
          if (r < I_O) { p0_transpose_item(ka->in[17], 1024, 1024, (bf16*)(ws + WS_WO_WA), 0, scr, r, lane); continue; } r -= I_O;
          if (r < I_G) { p0_transpose_item(ka->in[27], 1024, 2048, (bf16*)(ws + WS_WGLU), 1, scr, r, lane); continue; } r -= I_G;
          { const int l = r / I_PQ; p0_transpose_item(ka->in[8] + (size_t)l * 1024 * 2048, 1024, 2048, (bf16*)(ws + WS_WPQ) + (size_t)l * 2048 * 1024, 0, scr, r % I_PQ, lane); } }
    }
    cvt_f32_bf16_stream(ka->in[9], (bf16*)(ws + WS_KEYS), (size_t)4 * 2 * 8 * 128 * 128 / 8, gt, ngt);
    cvt_f32_fp8_stream(ka->in[10], ws + WS_PU, (size_t)16384 * 1024 / 16, PU_SCALE, gt, ngt);
    cvt_f32_fp8_stream(ka->in[11], ws + WS_PV, (size_t)16384 * 1024 / 16, PV_SCALE, gt, ngt);
    { float* cosT = (float*)(ws + WS_ROPE); float* sinT = cosT + 2048 * 32;
      for (size_t idx = gt; idx < 2048 * 32; idx += ngt) { const int t = (int)(idx >> 5), i = (int)(idx & 31), f = i & 15;
          const float inv = exp2f(-(float)f * (13.287712379549449f / 16.f));
          const float pos = (float)((i < 16) ? (t >> 6) : (t & 63)); const float ang = pos * inv;
          cosT[idx] = cosf(ang); sinT[idx] = sinf(ang); } }
    { float* LB = (float*)(ws + WS_S5LB); bf16* Bop = (bf16*)(ws + WS_S5B); bf16* Cop = (bf16*)(ws + WS_S5C);
      for (size_t idx = gt; idx < 2 * 64 * 64; idx += ngt) { const int p = (int)(idx & 63), rg = (int)(idx >> 6);
          const float re = ka->in[19][idx], im = ka->in[20][idx], step = expf(ka->in[21][rg]);
          const float mag = expf(re * step), lbr = mag * cosf(im * step), lbi = mag * sinf(im * step);
          const float a = lbr - 1.f, b = lbi, den = re * re + im * im, qr = (a * re + b * im) / den, qi = (b * re - a * im) / den;
          LB[idx * 2] = lbr; LB[idx * 2 + 1] = lbi;
          const int nre = (p >> 5) * 64 + (p & 31), nim = nre + 32;
          for (int h = 0; h < 16; ++h) { const float br = ka->in[22][idx * 16 + h], bi = ka->in[23][idx * 16 + h];
              Bop[((size_t)rg * 128 + nre) * 16 + h] = (bf16)f2bf(br * qr - bi * qi); Bop[((size_t)rg * 128 + nim) * 16 + h] = (bf16)f2bf(br * qi + bi * qr);
              const float cr = ka->in[24][((size_t)rg * 16 + h) * 64 + p], ci = ka->in[25][((size_t)rg * 16 + h) * 64 + p];
              Cop[((size_t)rg * 16 + h) * 128 + 2 * p] = (bf16)f2bf(cr); Cop[((size_t)rg * 16 + h) * 128 + 2 * p + 1] = (bf16)f2bf(-ci); } } }
}
__device__ __forceinline__ void modred_phase(const float* mod_b, unsigned char* ws, int gw, int NGW, int lane) {
    float* MOD = (float*)(ws + WS_MOD); const float* MODP = (const float*)(ws + WS_MODP);
    for (size_t q = (size_t)gw * 64 + lane; q < MODN_ / 4; q += (size_t)NGW * 64) { const size_t idx = q * 4; const int i = (int)(idx / (17 * 6144)), n = (int)(idx % 6144);
        f32x4 s = *(const GAS f32x4*)(mod_b + (size_t)i * 6144 + n);
#pragma unroll
        for (int kc = 0; kc < 8; ++kc) s = s + *(const GAS f32x4*)(MODP + (size_t)kc * MODN_ + idx);
        *(GAS f32x4*)(MOD + idx) = s; }
}
__device__ __forceinline__ void p1_embed(const float* x, const float* ctx, unsigned char* ws, int gw, int NGW, int lane) {
    bf16* LAT = (bf16*)(ws + WS_LAT); bf16* H = (bf16*)(ws + WS_H); const float* MOD = (const float*)(ws + WS_MOD);
    for (int row = gw; row < MR; row += NGW) { const int b = row / SQ, s = row - b * SQ;
        const float* src = (s < LC) ? ctx + ((size_t)b * LC + s) * DD : x + ((size_t)b * TL + (s - LC)) * DD;
        const float* md = MOD + (size_t)((s < LC) ? 16 : b) * 6144;
#pragma unroll
        for (int j = 0; j < 4; ++j) { const int c = 256 * j + 4 * lane; const f32x4 v = *(const GAS f32x4*)(src + c), sh = *(const GAS f32x4*)(md + c), sc = *(const GAS f32x4*)(md + 1024 + c);
            *(GAS unsigned long long*)(LAT + (size_t)row * DD + c) = (unsigned long long)pk2(v.x, v.y) | ((unsigned long long)pk2(v.z, v.w) << 32); const f32x4 h = v * (sc + 1.f) + sh;
            *(GAS unsigned long long*)(H + (size_t)row * DD + c) = (unsigned long long)pk2(h.x, h.y) | ((unsigned long long)pk2(h.z, h.w) << 32); } }
}
__device__ __forceinline__ void ln1_phase(unsigned char* ws, const float* lng, const float* lnb, int layer, int skip_ctx, int gw, int NGW, int lane) {
    const bf16* R = (const bf16*)(ws + WS_B); bf16* LAT = (bf16*)(ws + WS_LAT); bf16* H = (bf16*)(ws + WS_H); const float* MOD = (const float*)(ws + WS_MOD) + (size_t)layer * 17 * 6144;
    const int nrows = skip_ctx ? NB * TL : MR;
    f32x4 g[4], bb[4];
#pragma unroll
    for (int j = 0; j < 4; ++j) { g[j] = *(const GAS f32x4*)(lng + 256 * j + 4 * lane); bb[j] = *(const GAS f32x4*)(lnb + 256 * j + 4 * lane); }
    for (int lr = gw; lr < nrows; lr += 2 * NGW) {
        int rows[2]; bool ok[2];
#pragma unroll
        for (int u = 0; u < 2; ++u) { const int l2 = lr + u * NGW; ok[u] = l2 < nrows; const int l3 = ok[u] ? l2 : lr; rows[u] = skip_ctx ? (l3 >> 11) * SQ + LC + (l3 & 2047) : l3; }
        f32x4 v[2][4]; float sm[2];
#pragma unroll
        for (int u = 0; u < 2; ++u) { sm[u] = 0.f;
#pragma unroll
            for (int j = 0; j < 4; ++j) { const unsigned long long rb = *(const GAS unsigned long long*)(R + (size_t)rows[u] * DD + 256 * j + 4 * lane); const unsigned r0 = (unsigned)rb, r1 = (unsigned)(rb >> 32);
                v[u][j].x = bflo(r0); v[u][j].y = bfhi(r0); v[u][j].z = bflo(r1); v[u][j].w = bfhi(r1); sm[u] += (v[u][j].x + v[u][j].y) + (v[u][j].z + v[u][j].w); } }
#pragma unroll
        for (int o = 1; o < 64; o <<= 1) { sm[0] += __shfl_xor(sm[0], o); sm[1] += __shfl_xor(sm[1], o); }
        float s2[2];
#pragma unroll
        for (int u = 0; u < 2; ++u) { const float mean = sm[u] * (1.f / DD); s2[u] = 0.f;
#pragma unroll
            for (int j = 0; j < 4; ++j) { v[u][j] = v[u][j] - mean; s2[u] += (v[u][j].x * v[u][j].x + v[u][j].y * v[u][j].y) + (v[u][j].z * v[u][j].z + v[u][j].w * v[u][j].w); } }
#pragma unroll
        for (int o = 1; o < 64; o <<= 1) { s2[0] += __shfl_xor(s2[0], o); s2[1] += __shfl_xor(s2[1], o); }
#pragma unroll
        for (int u = 0; u < 2; ++u) { if (!ok[u]) continue; const int row = rows[u]; const int b = row / SQ, s = row - b * SQ; const float* md = MOD + (size_t)((s < LC) ? 16 : b) * 6144;
            const float rstd = 1.f / sqrtf(s2[u] * (1.f / DD) + LN_EPS);
#pragma unroll
            for (int j = 0; j < 4; ++j) { const int c = 256 * j + 4 * lane;
                const f32x4 y = v[u][j] * rstd * g[j] + bb[j]; *(GAS unsigned long long*)(LAT + (size_t)row * DD + c) = (unsigned long long)pk2(y.x, y.y) | ((unsigned long long)pk2(y.z, y.w) << 32);
                const f32x4 sh = *(const GAS f32x4*)(md + 3072 + c), sc = *(const GAS f32x4*)(md + 4096 + c); const f32x4 h = y * (sc + 1.f) + sh;
                *(GAS unsigned long long*)(H + (size_t)row * DD + c) = (unsigned long long)pk2(h.x, h.y) | ((unsigned long long)pk2(h.z, h.w) << 32); } }
    }
}
__device__ __forceinline__ void da_combine_phase(unsigned char* ws, const float* lam_p, const float* subln, float lam_init, int skip_ctx, int gw, int NGW, int lane) {
    const bf16* O0 = (const bf16*)(ws + WS_B); const bf16* O1 = (const bf16*)(ws + WS_B + SZ72); bf16* OC = (bf16*)(ws + WS_A);
    float d01 = lam_p[lane] * lam_p[64 + lane], d23 = lam_p[128 + lane] * lam_p[192 + lane];
    d01 = wave_sum(d01); d23 = wave_sum(d23);
    const float lam = expf(d01) - expf(d23) + lam_init, post = 1.f - lam_init;
    float gs[16];
#pragma unroll
    for (int j = 0; j < 16; ++j) gs[j] = subln[((lane & 7) * 16 + j)] * post;
    for (int row = gw; row < MR; row += NGW) { const int b = row / SQ, s = row - b * SQ; if (skip_ctx && s < LC) continue;
        const size_t off = (size_t)row * DD + 16 * lane;
        const v4u a0 = *(const GAS v4u*)(O0 + off), a1 = *(const GAS v4u*)(O0 + off + 8), b0 = *(const GAS v4u*)(O1 + off), b1 = *(const GAS v4u*)(O1 + off + 8);
        float o[16];
        o[0] = bflo(a0.x) - lam * bflo(b0.x); o[1] = bfhi(a0.x) - lam * bfhi(b0.x); o[2] = bflo(a0.y) - lam * bflo(b0.y); o[3] = bfhi(a0.y) - lam * bfhi(b0.y);
        o[4] = bflo(a0.z) - lam * bflo(b0.z); o[5] = bfhi(a0.z) - lam * bfhi(b0.z); o[6] = bflo(a0.w) - lam * bflo(b0.w); o[7] = bfhi(a0.w) - lam * bfhi(b0.w);
        o[8] = bflo(a1.x) - lam * bflo(b1.x); o[9] = bfhi(a1.x) - lam * bfhi(b1.x); o[10] = bflo(a1.y) - lam * bflo(b1.y); o[11] = bfhi(a1.y) - lam * bfhi(b1.y);
        o[12] = bflo(a1.z) - lam * bflo(b1.z); o[13] = bfhi(a1.z) - lam * bfhi(b1.z); o[14] = bflo(a1.w) - lam * bflo(b1.w); o[15] = bfhi(a1.w) - lam * bfhi(b1.w);
        float ss = 0.f;
#pragma unroll
        for (int j = 0; j < 16; ++j) ss += o[j] * o[j];
        ss += __shfl_xor(ss, 1); ss += __shfl_xor(ss, 2); ss += __shfl_xor(ss, 4);
        const float rs = 1.f / sqrtf(ss * (1.f / 128.f) + LN_EPS);
        v4u w0, w1;
        w0.x = pk2(o[0] * rs * gs[0], o[1] * rs * gs[1]); w0.y = pk2(o[2] * rs * gs[2], o[3] * rs * gs[3]); w0.z = pk2(o[4] * rs * gs[4], o[5] * rs * gs[5]); w0.w = pk2(o[6] * rs * gs[6], o[7] * rs * gs[7]);
        w1.x = pk2(o[8] * rs * gs[8], o[9] * rs * gs[9]); w1.y = pk2(o[10] * rs * gs[10], o[11] * rs * gs[11]); w1.z = pk2(o[12] * rs * gs[12], o[13] * rs * gs[13]); w1.w = pk2(o[14] * rs * gs[14], o[15] * rs * gs[15]);
        *(GAS v4u*)(OC + off) = w0; *(GAS v4u*)(OC + off + 8) = w1; }
}
template <int N> __device__ __forceinline__ void sort_desc_u32(unsigned (&v)[N]) {
#pragma unroll
    for (int k = 2; k <= N; k <<= 1)
#pragma unroll
        for (int j = k >> 1; j > 0; j >>= 1)
#pragma unroll
            for (int i = 0; i < N; ++i) { const int l = i ^ j; if (l > i) { const unsigned a = v[i], b = v[l]; const unsigned mx = a > b ? a : b, mn = a > b ? b : a; const bool desc = ((i & k) == 0) || (k == N);
                    v[i] = desc ? mx : mn; v[l] = desc ? mn : mx; } }
}
template <int N> __device__ __forceinline__ void merge_desc_u32(unsigned (&v)[N]) {
#pragma unroll
    for (int j = N >> 1; j > 0; j >>= 1)
#pragma unroll
        for (int i = 0; i < N; ++i) { const int l = i ^ j; if (l > i) { const unsigned a = v[i], b = v[l]; v[i] = a > b ? a : b; v[l] = a > b ? b : a; } }
}
__device__ __forceinline__ void top16_u32(unsigned (&a)[16], const unsigned (&b)[16]) {
#pragma unroll
    for (int i = 0; i < 16; ++i) a[i] = a[i] > b[15 - i] ? a[i] : b[15 - i];
    merge_desc_u32<16>(a);
}
#define CE_F(i, l, up) do { const bool gt_ = s[i] > s[l]; const float s_hi = gt_ ? s[i] : s[l], s_lo = gt_ ? s[l] : s[i]; const int e_hi = gt_ ? e[i] : e[l], e_lo = gt_ ? e[l] : e[i]; \
        if (up) { s[i] = s_hi; s[l] = s_lo; e[i] = e_hi; e[l] = e_lo; } else { s[i] = s_lo; s[l] = s_hi; e[i] = e_lo; e[l] = e_hi; } } while (0)
template <int N> __device__ __forceinline__ void sort_desc_f(float (&s)[N], int (&e)[N]) {
#pragma unroll
    for (int k = 2; k <= N; k <<= 1)
#pragma unroll
        for (int j = k >> 1; j > 0; j >>= 1)
#pragma unroll
            for (int i = 0; i < N; ++i) { const int l = i ^ j; if (l > i) { const bool desc = ((i & k) == 0) || (k == N); CE_F(i, l, desc); } }
}
template <int N> __device__ __forceinline__ void merge_desc_f(float (&s)[N], int (&e)[N]) {
#pragma unroll
    for (int j = N >> 1; j > 0; j >>= 1)
#pragma unroll
        for (int i = 0; i < N; ++i) { const int l = i ^ j; if (l > i) { CE_F(i, l, true); } }
}
__device__ __forceinline__ unsigned fkey(float f) { const unsigned u = __float_as_uint(f); return u ^ ((unsigned)((int)u >> 31) | 0x80000000u); }
__device__ __forceinline__ float fdec(unsigned k) { const unsigned u = (k & 0x80000000u) ? (k ^ 0x80000000u) : ~k; return __uint_as_float(u); }

__device__ __forceinline__ void topk_phase(unsigned char* ws, int layer, int skip_ctx, LAS unsigned char* lds, int vcu, int G, int tid, int lane, int wave) {
    const bf16* PQ = (const bf16*)(ws + WS_A); const bf16* KEYS = (const bf16*)(ws + WS_KEYS) + (size_t)layer * 2 * 8 * 128 * 128;
    int* EIDX = (int*)(ws + WS_B); float* EG = (float*)(ws + WS_B + (size_t)MR * 128 * 4);
    const int nrt = skip_ctx ? 128 : 144, nunits = nrt * 8;
    const int r32 = lane & 31, hi = lane >> 5;
    constexpr int KP = 272;
    int cur_h = -1;
    const int gq = G >> 3, hgrp = vcu / gq, wq = vcu - hgrp * gq;
    for (int u2 = wq; u2 < nrt; u2 += gq) {
        const int h = hgrp & 7, rtl = u2; const int rt = skip_ctx ? (rtl >> 3) * 9 + 1 + (rtl & 7) : rtl;
        if (h != cur_h) { __syncthreads();
            for (int c = tid; c < 2 * 128 * 16; c += NTHR) { const int j = c >> 11, k = (c >> 4) & 127, ch = c & 15;
                const v4u v = *(const GAS v4u*)(KEYS + ((size_t)(j * 8 + h) * 128 + k) * 128 + ch * 8); *(LAS v4u*)(lds + (j * 128 + k) * KP + ch * 16) = v; }
            __syncthreads(); cur_h = h; }
        const int row = rt * 256 + wave * 32 + r32;
        unsigned top[2][16];
#pragma unroll
        for (int j = 0; j < 2; ++j) {
            const bf16* qp = PQ + (size_t)row * 2048 + h * 256 + j * 128 + hi * 8;
            bf16x8 bq[8];
#pragma unroll
            for (int ks = 0; ks < 8; ++ks) bq[ks] = *(const GAS bf16x8*)(qp + ks * 16);
            unsigned t0[16];
#pragma unroll
            for (int r = 0; r < 16; ++r) t0[r] = 0u;
#pragma unroll 1
            for (int blk = 0; blk < 4; ++blk) { f32x16 acc = (f32x16){};
#pragma unroll
                for (int ks = 0; ks < 8; ++ks) { const bf16x8 ka = *(const LAS bf16x8*)(lds + (j * 128 + blk * 32 + r32) * KP + (ks * 16 + hi * 8) * 2);
                    acc = __builtin_amdgcn_mfma_f32_32x32x16_bf16(ka, bq[ks], acc, 0, 0, 0); }
                unsigned g[16]; const unsigned kb0 = (unsigned)(blk * 32 + 4 * hi);
#pragma unroll
                for (int r = 0; r < 16; ++r) g[r] = (fkey(acc[r]) & ~127u) | (kb0 + (unsigned)((r & 3) + 8 * (r >> 2)));
                sort_desc_u32<16>(g);
                top16_u32(t0, g); }
            unsigned oth[16];
#pragma unroll
            for (int r = 0; r < 16; ++r) oth[r] = (unsigned)__shfl_xor((int)t0[r], 32);
            top16_u32(t0, oth);
#pragma unroll
            for (int r = 0; r < 16; ++r) top[j][r] = t0[r];
        }
        LAS unsigned char* tab = lds + 2 * 128 * KP + wave * (64 * 36) + lane * 36;
#pragma unroll
        for (int r = 0; r < 16; ++r) { tab[r] = (unsigned char)(top[0][r] & 127u); tab[16 + r] = (unsigned char)(top[1][r] & 127u); }
        float sA[16], sB[16];
#pragma unroll
        for (int r = 0; r < 16; ++r) { sA[r] = fdec(top[0][r] & ~127u); sB[r] = fdec(top[1][r] & ~127u); }
        unsigned ck[32];
        { int c = 0;
#pragma unroll
          for (int a = 0; a < 16; ++a)
#pragma unroll
              for (int b = 0; b < 16; ++b) if ((a + 1) * (b + 1) <= 16) { const int slot = c >> 1; const unsigned kk = (fkey(sA[a] + sB[b]) & ~255u) | (unsigned)(a * 16 + b);
                      if ((c & 1) == 0) ck[slot] = kk; else ck[slot] = hi ? kk : ck[slot];
                      ++c; }
#pragma unroll
          for (int slot = 25; slot < 32; ++slot) ck[slot] = 0u; }
        sort_desc_u32<32>(ck);
        unsigned k16[16];
#pragma unroll
        for (int r = 0; r < 16; ++r) k16[r] = ck[r];
        { unsigned oth[16];
#pragma unroll
          for (int r = 0; r < 16; ++r) oth[r] = (unsigned)__shfl_xor((int)k16[r], 32);
          top16_u32(k16, oth); }
        asm volatile("s_waitcnt lgkmcnt(0)" ::: "memory");
        float s16[16]; int e16[16];
#pragma unroll
        for (int r = 0; r < 16; ++r) { s16[r] = fdec(k16[r] & ~255u); const int ia = tab[(k16[r] >> 4) & 15u], ib = tab[16 + (k16[r] & 15u)]; e16[r] = ia * 128 + ib; }
        float den = 0.f, p[16];
#pragma unroll
        for (int r = 0; r < 16; ++r) { p[r] = __builtin_amdgcn_exp2f((s16[r] - s16[0]) * LOG2E); den += p[r]; }
        const float rden = 1.f / den;
        const size_t ob = ((size_t)row * 8 + h) * 16;
        if (hi == 0) {
#pragma unroll
            for (int q = 0; q < 4; ++q) { v4u w; w.x = (unsigned)e16[4 * q]; w.y = (unsigned)e16[4 * q + 1]; w.z = (unsigned)e16[4 * q + 2]; w.w = (unsigned)e16[4 * q + 3]; *(GAS v4u*)(EIDX + ob + 4 * q) = w; }
        } else {
#pragma unroll
            for (int q = 0; q < 4; ++q) { f32x4 w; w.x = p[4 * q] * rden; w.y = p[4 * q + 1] * rden; w.z = p[4 * q + 2] * rden; w.w = p[4 * q + 3] * rden; *(GAS f32x4*)(EG + ob + 4 * q) = w; }
        }
    }
}

typedef float f32x2p __attribute__((ext_vector_type(2)));
__device__ __forceinline__ void peer_phase(unsigned char* ws, float* d_out, const float* lng, const float* lnb, int layer, int last, int dry, int gw, int NGW, int lane) {
    const bf16* H = (const bf16*)(ws + WS_H); bf16* LAT = (bf16*)(ws + WS_LAT); bf16* Hn = (bf16*)(ws + WS_H);
    const unsigned char* PU = ws + WS_PU + (size_t)layer * 16384 * 1024; const unsigned char* PV = ws + WS_PV + (size_t)layer * 16384 * 1024;
    const int* EIDX = (const int*)(ws + WS_B); const float* EG = (const float*)(ws + WS_B + (size_t)MR * 128 * 4);
    const float* MOD = (const float*)(ws + WS_MOD) + (size_t)layer * 17 * 6144; const float* MODN = MOD + 17 * 6144;
    const int b3 = (lane >> 3) & 1, b4 = (lane >> 4) & 1, b5 = lane >> 5;
    for (int row = gw; row < MR; row += NGW) { const int b = row / SQ, s = row - b * SQ; if (last && s < LC) continue;
        const int midx = (s < LC) ? 16 : b;
        float x[16];
        { const v4u xa = *(const GAS v4u*)(H + (size_t)row * DD + 16 * lane), xb = *(const GAS v4u*)(H + (size_t)row * DD + 16 * lane + 8);
          x[0] = bflo(xa.x); x[1] = bfhi(xa.x); x[2] = bflo(xa.y); x[3] = bfhi(xa.y); x[4] = bflo(xa.z); x[5] = bfhi(xa.z); x[6] = bflo(xa.w); x[7] = bfhi(xa.w);
          x[8] = bflo(xb.x); x[9] = bfhi(xb.x); x[10] = bflo(xb.y); x[11] = bfhi(xb.y); x[12] = bflo(xb.z); x[13] = bfhi(xb.z); x[14] = bflo(xb.w); x[15] = bfhi(xb.w); }
        const int e_lo = EIDX[(size_t)row * 128 + lane], e_hi = EIDX[(size_t)row * 128 + 64 + lane];
        const float g_lo = EG[(size_t)row * 128 + lane], g_hi = EG[(size_t)row * 128 + 64 + lane];
        float out[16];
#pragma unroll
        for (int j = 0; j < 16; ++j) out[j] = 0.f;
        for (int kb = 0; kb < 128; kb += 8) {
            const int esel = (kb < 64) ? e_lo : e_hi; const float gsel = (kb < 64) ? g_lo : g_hi;
            v4u u8[8], v8[8];
#pragma unroll
            for (int k = 0; k < 8; ++k) { const int ek = __builtin_amdgcn_readlane(esel, (kb & 63) + k); u8[k] = *(const GAS v4u*)(PU + (size_t)ek * 1024 + 16 * lane); }
#pragma unroll
            for (int k = 0; k < 8; ++k) { const int ek = __builtin_amdgcn_readlane(esel, (kb & 63) + k); v8[k] = *(const GAS v4u*)(PV + (size_t)ek * 1024 + 16 * lane); }
            float d[8];
#pragma unroll
            for (int k = 0; k < 8; ++k) { float a0 = 0.f, a1 = 0.f;
#pragma unroll
                for (int q = 0; q < 4; ++q) { const int w = (int)u8[k][q]; const f32x2p lo = __builtin_amdgcn_cvt_pk_f32_fp8(w, false), hi2 = __builtin_amdgcn_cvt_pk_f32_fp8(w, true);
                    a0 = fmaf(lo.x, x[4 * q], a0); a1 = fmaf(lo.y, x[4 * q + 1], a1); a0 = fmaf(hi2.x, x[4 * q + 2], a0); a1 = fmaf(hi2.y, x[4 * q + 3], a1); }
                d[k] = a0 + a1; }
            float s4[4], s2[2], s1;
#pragma unroll
            for (int k = 0; k < 4; ++k) { const float snd = b5 ? d[k] : d[k + 4], mine = b5 ? d[k + 4] : d[k]; s4[k] = mine + __shfl_xor(snd, 32); }
#pragma unroll
            for (int k = 0; k < 2; ++k) { const float snd = b4 ? s4[k] : s4[k + 2], mine = b4 ? s4[k + 2] : s4[k]; s2[k] = mine + __shfl_xor(snd, 16); }
            { const float snd = b3 ? s2[0] : s2[1], mine = b3 ? s2[1] : s2[0]; s1 = mine + __shfl_xor(snd, 8); }
            s1 += __shfl_xor(s1, 4); s1 += __shfl_xor(s1, 2); s1 += __shfl_xor(s1, 1);
            const float gk = __shfl(gsel, (kb & 63) + (lane >> 3));
            const float w = gk * gelu_tanh(s1 * (1.f / PU_SCALE)) * (1.f / PV_SCALE);
#pragma unroll
            for (int k = 0; k < 8; ++k) { const float wk = __uint_as_float((unsigned)__builtin_amdgcn_readlane((int)__float_as_uint(w), 8 * k));
#pragma unroll
                for (int q = 0; q < 4; ++q) { const int vw = (int)v8[k][q]; const f32x2p lo = __builtin_amdgcn_cvt_pk_f32_fp8(vw, false), hi2 = __builtin_amdgcn_cvt_pk_f32_fp8(vw, true);
                    out[4 * q] = fmaf(wk, lo.x, out[4 * q]); out[4 * q + 1] = fmaf(wk, lo.y, out[4 * q + 1]); out[4 * q + 2] = fmaf(wk, hi2.x, out[4 * q + 2]); out[4 * q + 3] = fmaf(wk, hi2.y, out[4 * q + 3]); } }
        }
        const float* md = MOD + (size_t)midx * 6144; float r[16]; float sm = 0.f;
#pragma unroll
        for (int q = 0; q < 4; ++q) { const int c = 16 * lane + 4 * q; const unsigned long long lb = *(const GAS unsigned long long*)(LAT + (size_t)row * DD + c); const unsigned l0 = (unsigned)lb, l1 = (unsigned)(lb >> 32);
            f32x4 lv; lv[0] = bflo(l0); lv[1] = bfhi(l0); lv[2] = bflo(l1); lv[3] = bfhi(l1); const f32x4 gv = *(const GAS f32x4*)(md + 5120 + c);
#pragma unroll
            for (int j = 0; j < 4; ++j) { const float t = DN_ALPHA * lv[j] + gv[j] * out[4 * q + j]; r[4 * q + j] = t; sm += t; } }
        const float mean = wave_sum(sm) * (1.f / DD); float s2s = 0.f;
#pragma unroll
        for (int j = 0; j < 16; ++j) { r[j] -= mean; s2s += r[j] * r[j]; }
        const float rstd = 1.f / sqrtf(wave_sum(s2s) * (1.f / DD) + LN_EPS);
        const float* mdn = MODN + (size_t)midx * 6144;
        float y[16];
#pragma unroll
        for (int q = 0; q < 4; ++q) { const int c = 16 * lane + 4 * q; const f32x4 g = *(const GAS f32x4*)(lng + c), bb = *(const GAS f32x4*)(lnb + c);
#pragma unroll
            for (int j = 0; j < 4; ++j) y[4 * q + j] = r[4 * q + j] * rstd * g[j] + bb[j]; }
        const int c0 = 16 * lane;
        if (dry) { if (y[0] == 123.456f) LAT[0] = (bf16)f2bf(y[1] + y[2] + y[3] + y[4] + y[5] + y[6] + y[7] + y[8] + y[9] + y[10] + y[11] + y[12] + y[13] + y[14] + y[15]); }
        else if (last) { float* op = d_out + ((size_t)b * TL + (s - LC)) * DD + c0;
#pragma unroll
            for (int q = 0; q < 4; ++q) *(GAS f32x4*)(op + 4 * q) = (f32x4){y[4 * q], y[4 * q + 1], y[4 * q + 2], y[4 * q + 3]}; }
        else { { v4u l0, l1; l0.x = pk2(y[0], y[1]); l0.y = pk2(y[2], y[3]); l0.z = pk2(y[4], y[5]); l0.w = pk2(y[6], y[7]); l1.x = pk2(y[8], y[9]); l1.y = pk2(y[10], y[11]); l1.z = pk2(y[12], y[13]); l1.w = pk2(y[14], y[15]);
              *(GAS v4u*)(LAT + (size_t)row * DD + c0) = l0; *(GAS v4u*)(LAT + (size_t)row * DD + c0 + 8) = l1; }
            float hh[16];
#pragma unroll
            for (int q = 0; q < 4; ++q) { const f32x4 sh = *(const GAS f32x4*)(mdn + c0 + 4 * q), sc = *(const GAS f32x4*)(mdn + 1024 + c0 + 4 * q);
#pragma unroll
                for (int j = 0; j < 4; ++j) hh[4 * q + j] = y[4 * q + j] * (1.f + sc[j]) + sh[j]; }
            v4u w0, w1; w0.x = pk2(hh[0], hh[1]); w0.y = pk2(hh[2], hh[3]); w0.z = pk2(hh[4], hh[5]); w0.w = pk2(hh[6], hh[7]); w1.x = pk2(hh[8], hh[9]); w1.y = pk2(hh[10], hh[11]); w1.z = pk2(hh[12], hh[13]); w1.w = pk2(hh[14], hh[15]);
            *(GAS v4u*)(Hn + (size_t)row * DD + c0) = w0; *(GAS v4u*)(Hn + (size_t)row * DD + c0 + 8) = w1; }
    }
}

__device__ __forceinline__ int peer_row(int t, int last) { return last ? (t >> 11) * SQ + LC + (t & 2047) : t; }
typedef _Float16 h2v __attribute__((ext_vector_type(2)));
__device__ __forceinline__ h2v pkh(float lo, float hi) { return __builtin_bit_cast(h2v, __builtin_amdgcn_cvt_pkrtz(lo, hi)); }
__device__ __forceinline__ void peer_gu_phase(unsigned char* ws, float* d_out, const float* lng, const float* lnb, int layer, int last, int dry, int gw, int NGW, int lane) {
    const bf16* H = (const bf16*)(ws + WS_H); bf16* LAT = (bf16*)(ws + WS_LAT); bf16* Hn = (bf16*)(ws + WS_H);
    const unsigned char* PU = ws + WS_PU + (size_t)layer * 16384 * 1024; const unsigned char* PV = ws + WS_PV + (size_t)layer * 16384 * 1024;
    float* Wb = (float*)(ws + WS_B + (size_t)2 * MR * 128 * 4);
    const int* EIDX = (const int*)(ws + WS_B); const float* EG = (const float*)(ws + WS_B + (size_t)MR * 128 * 4);
    const float* MOD = (const float*)(ws + WS_MOD) + (size_t)layer * 17 * 6144; const float* MODN = MOD + 17 * 6144;
    const int b2 = (lane >> 2) & 1, b3 = (lane >> 3) & 1, b4 = (lane >> 4) & 1, b5 = lane >> 5;
    const int ntok = last ? NB * TL : MR;
    v4u nxa, nxb; int ne_lo = 0, ne_hi = 0; float ng_lo = 0.f, ng_hi = 0.f;
    if (gw < ntok) { const int r0 = peer_row(gw, last); nxa = *(const GAS v4u*)(H + (size_t)r0 * DD + 16 * lane); nxb = *(const GAS v4u*)(H + (size_t)r0 * DD + 16 * lane + 8);
        ne_lo = EIDX[(size_t)r0 * 128 + lane]; ne_hi = EIDX[(size_t)r0 * 128 + 64 + lane]; ng_lo = EG[(size_t)r0 * 128 + lane]; ng_hi = EG[(size_t)r0 * 128 + 64 + lane]; }
    for (int t = gw; t < ntok; t += NGW) { const int row = peer_row(t, last);
        const v4u xa = nxa, xb = nxb; const int e_lo = ne_lo, e_hi = ne_hi; const float g_lo = ng_lo, g_hi = ng_hi;
        if (t + NGW < ntok) { const int r1 = peer_row(t + NGW, last); nxa = *(const GAS v4u*)(H + (size_t)r1 * DD + 16 * lane); nxb = *(const GAS v4u*)(H + (size_t)r1 * DD + 16 * lane + 8);
            ne_lo = EIDX[(size_t)r1 * 128 + lane]; ne_hi = EIDX[(size_t)r1 * 128 + 64 + lane]; ng_lo = EG[(size_t)r1 * 128 + lane]; ng_hi = EG[(size_t)r1 * 128 + 64 + lane]; }
        h2v xh[8];
        xh[0] = pkh(bflo(xa.x), bfhi(xa.x)); xh[1] = pkh(bflo(xa.y), bfhi(xa.y)); xh[2] = pkh(bflo(xa.z), bfhi(xa.z)); xh[3] = pkh(bflo(xa.w), bfhi(xa.w));
        xh[4] = pkh(bflo(xb.x), bfhi(xb.x)); xh[5] = pkh(bflo(xb.y), bfhi(xb.y)); xh[6] = pkh(bflo(xb.z), bfhi(xb.z)); xh[7] = pkh(bflo(xb.w), bfhi(xb.w));
        for (int kb = 0; kb < 128; kb += 16) {
            const int esel = (kb < 64) ? e_lo : e_hi; const float gsel = (kb < 64) ? g_lo : g_hi;
            v4u u8[16];
#pragma unroll
            for (int k = 0; k < 16; ++k) { const int ek = __builtin_amdgcn_readlane(esel, (kb & 63) + k); u8[k] = *(const GAS v4u*)(PU + (size_t)ek * 1024 + 16 * lane); }
            float d[16];
#pragma unroll
            for (int k = 0; k < 16; ++k) { float a0 = 0.f, a1 = 0.f;
#pragma unroll
                for (int q = 0; q < 4; ++q) { const int w = (int)u8[k][q];
                    a0 = __builtin_amdgcn_fdot2(__builtin_bit_cast(h2v, __builtin_amdgcn_cvt_scalef32_pk_f16_fp8(w, 1.0f, false)), xh[2 * q], a0, false); a1 = __builtin_amdgcn_fdot2(__builtin_bit_cast(h2v, __builtin_amdgcn_cvt_scalef32_pk_f16_fp8(w, 1.0f, true)), xh[2 * q + 1], a1, false); }
                d[k] = a0 + a1; }
            float s8[8], s4[4], s2[2], s1;
#pragma unroll
            for (int k = 0; k < 8; ++k) { const float snd = b5 ? d[k] : d[k + 8], mine = b5 ? d[k + 8] : d[k]; s8[k] = mine + __shfl_xor(snd, 32); }
#pragma unroll
            for (int k = 0; k < 4; ++k) { const float snd = b4 ? s8[k] : s8[k + 4], mine = b4 ? s8[k + 4] : s8[k]; s4[k] = mine + __shfl_xor(snd, 16); }
#pragma unroll
            for (int k = 0; k < 2; ++k) { const float snd = b3 ? s4[k] : s4[k + 2], mine = b3 ? s4[k + 2] : s4[k]; s2[k] = mine + __shfl_xor(snd, 8); }
            { const float snd = b2 ? s2[0] : s2[1], mine = b2 ? s2[1] : s2[0]; s1 = mine + __shfl_xor(snd, 4); }
            s1 += __shfl_xor(s1, 2); s1 += __shfl_xor(s1, 1);
            const float gk = __shfl(gsel, (kb & 63) + (lane >> 2));
            const float w = gk * gelu_tanh(s1 * (1.f / PU_SCALE));
            if ((lane & 3) == 0) Wb[(size_t)row * 128 + kb + (lane >> 2)] = w;
        }
    }
}
template <int CTRL> __device__ __forceinline__ float dppx(float x) { return __builtin_bit_cast(float, __builtin_amdgcn_update_dpp(0, __builtin_bit_cast(int, x), CTRL, 0xF, 0xF, false)); }
typedef int v4i_q __attribute__((ext_vector_type(4)));
constexpr size_t WS_PQP = WS_A;
__device__ __forceinline__ void peer_uq_phase(unsigned char* ws, int layer, int last, int quarter, int widx, int nwq, int lane) {
    const bf16* H = (const bf16*)(ws + WS_H); const int* EIDX = (const int*)(ws + WS_B);
    const unsigned char* tb = ws + WS_PU + (size_t)layer * 16384 * 1024 + 256 * quarter;
    float* P = (float*)(ws + WS_PQP) + (size_t)quarter * MR * 128;
    const int rsel = lane >> 4, csel = lane & 15, b0 = lane & 1, b1 = (lane >> 1) & 1, b2 = (lane >> 2) & 1, b3 = (lane >> 3) & 1;
    const unsigned c16 = 16u * (unsigned)csel;
    const int ntok = last ? NB * TL : MR;
    v4i_q ne[8]; v4u nx0, nx1; v4u uA[16], uB[16];
#define UQ_LOADTOK(t_) do { const int tc_ = ((t_) < ntok) ? (t_) : ntok - 1; const int r_ = peer_row(tc_, last); const int* ip_ = EIDX + (size_t)r_ * 128 + 32 * rsel; \
        _Pragma("unroll") for (int q_ = 0; q_ < 8; ++q_) ne[q_] = *(const GAS v4i_q*)(ip_ + 4 * q_); \
        const bf16* hp_ = H + (size_t)r_ * DD + 256 * quarter + 16 * csel; nx0 = *(const GAS v4u*)hp_; nx1 = *(const GAS v4u*)(hp_ + 8); } while (0)
#define UQ_ISSUE(U_, E_, bt_) do { _Pragma("unroll") for (int i = 0; i < 16; ++i) { const unsigned vo = ((unsigned)E_[4 * (bt_) + (i >> 2)][i & 3] << 10) + c16; U_[i] = *(const GAS v4u*)(tb + vo); } } while (0)
#define UQ_BATCH(U_, bt_) do { float d[16]; \
        _Pragma("unroll") for (int i = 0; i < 16; ++i) { float a0, a1; \
            { const int w = (int)U_[i][0]; const h2v c0 = __builtin_bit_cast(h2v, __builtin_amdgcn_cvt_scalef32_pk_f16_fp8(w, 1.0f, false)), c1 = __builtin_bit_cast(h2v, __builtin_amdgcn_cvt_scalef32_pk_f16_fp8(w, 1.0f, true)); \
              asm("v_dot2_f32_f16 %0, %1, %2, 0" : "=v"(a0) : "v"(c0), "v"(xh[0])); asm("v_dot2_f32_f16 %0, %1, %2, 0" : "=v"(a1) : "v"(c1), "v"(xh[1])); }        \
            _Pragma("unroll") for (int q = 1; q < 4; ++q) { const int w = (int)U_[i][q]; \
                a0 = __builtin_amdgcn_fdot2(__builtin_bit_cast(h2v, __builtin_amdgcn_cvt_scalef32_pk_f16_fp8(w, 1.0f, false)), xh[2 * q], a0, false); a1 = __builtin_amdgcn_fdot2(__builtin_bit_cast(h2v, __builtin_amdgcn_cvt_scalef32_pk_f16_fp8(w, 1.0f, true)), xh[2 * q + 1], a1, false); } \
            d[i] = a0 + a1; } \
        float r8[8], r4[4], r2[2], r1; \
        _Pragma("unroll") for (int c = 0; c < 8; ++c) { const float snd = b3 ? d[c] : d[c + 8], mine = b3 ? d[c + 8] : d[c]; r8[c] = mine + dppx<0x128>(snd); }          \
        _Pragma("unroll") for (int c = 0; c < 4; ++c) { const float snd = b2 ? r8[c] : r8[c + 4], mine = b2 ? r8[c + 4] : r8[c]; r4[c] = mine + dppx<0x141>(snd); }        \
        _Pragma("unroll") for (int c = 0; c < 2; ++c) { const float snd = b1 ? r4[c] : r4[c + 2], mine = b1 ? r4[c + 2] : r4[c]; r2[c] = mine + dppx<0x4E>(snd); }         \
        { const float snd = b0 ? r2[0] : r2[1], mine = b0 ? r2[1] : r2[0]; r1 = mine + dppx<0xB1>(snd); }                                                                   \
        P[(size_t)row * 128 + 32 * rsel + 16 * (bt_) + csel] = r1; } while (0)
    UQ_LOADTOK(widx);
    UQ_ISSUE(uA, ne, 0);
    for (int t = widx; t < ntok; t += nwq) { const int row = peer_row(t, last);
        UQ_ISSUE(uB, ne, 1);
        const v4u xa = nx0, xb = nx1;
        UQ_LOADTOK(t + nwq);
        h2v xh[8];
        xh[0] = pkh(bflo(xa.x), bfhi(xa.x)); xh[1] = pkh(bflo(xa.y), bfhi(xa.y)); xh[2] = pkh(bflo(xa.z), bfhi(xa.z)); xh[3] = pkh(bflo(xa.w), bfhi(xa.w));
        xh[4] = pkh(bflo(xb.x), bfhi(xb.x)); xh[5] = pkh(bflo(xb.y), bfhi(xb.y)); xh[6] = pkh(bflo(xb.z), bfhi(xb.z)); xh[7] = pkh(bflo(xb.w), bfhi(xb.w));
        UQ_BATCH(uA, 0);
        UQ_ISSUE(uA, ne, 0);
        UQ_BATCH(uB, 1);
    }
#undef UQ_LOADTOK
#undef UQ_ISSUE
#undef UQ_BATCH
}
constexpr size_t WS_OUTQ = WS_B + SZ72;
__device__ __forceinline__ void peer_vq_phase(unsigned char* ws, int layer, int last, int quarter, int widx, int nwq, int lane, int wave, LAS unsigned char* lds) {
    const int* EIDX = (const int*)(ws + WS_B); const float* EG = (const float*)(ws + WS_B + (size_t)MR * 128 * 4); const float* PQP = (const float*)(ws + WS_PQP); bf16* OUT = (bf16*)(ws + WS_OUTQ);
    const unsigned char* tb = ws + WS_PV + (size_t)layer * 16384 * 1024 + 256 * quarter;
    const int rsel = lane >> 4, csel = lane & 15, b4 = (lane >> 4) & 1, b5 = lane >> 5;
    const unsigned c16 = 16u * (unsigned)csel;
    LAS float* wl = (LAS float*)(lds + wave * 512);
    const int ntok = last ? NB * TL : MR;
    v4i_q ne[8]; float ng_lo, ng_hi, np_lo[4], np_hi[4];
#define VQ_LOADTOK(t_) do { const int tc_ = ((t_) < ntok) ? (t_) : ntok - 1; const int r_ = peer_row(tc_, last); const int* ip_ = EIDX + (size_t)r_ * 128 + 32 * rsel; \
        _Pragma("unroll") for (int q_ = 0; q_ < 8; ++q_) ne[q_] = *(const GAS v4i_q*)(ip_ + 4 * q_); \
        const size_t o_ = (size_t)r_ * 128 + lane; ng_lo = EG[o_]; ng_hi = EG[o_ + 64]; \
        _Pragma("unroll") for (int q_ = 0; q_ < 4; ++q_) { np_lo[q_] = PQP[(size_t)q_ * MR * 128 + o_]; np_hi[q_] = PQP[(size_t)q_ * MR * 128 + o_ + 64]; } } while (0)
    VQ_LOADTOK(widx);
    for (int t = widx; t < ntok; t += nwq) { const int row = peer_row(t, last);
        v4i_q ce[8];
#pragma unroll
        for (int q = 0; q < 8; ++q) ce[q] = ne[q];
        const float w_lo = ng_lo * gelu_tanh(((np_lo[0] + np_lo[1]) + (np_lo[2] + np_lo[3])) * (1.f / PU_SCALE)), w_hi = ng_hi * gelu_tanh(((np_hi[0] + np_hi[1]) + (np_hi[2] + np_hi[3])) * (1.f / PU_SCALE));
        VQ_LOADTOK(t + nwq);
        wl[lane] = w_lo; wl[64 + lane] = w_hi;
        f32x4 wv[8];
#pragma unroll
        for (int j = 0; j < 8; ++j) wv[j] = *(const LAS f32x4*)(wl + 32 * rsel + 4 * j);
        float out[16];
#pragma unroll
        for (int j = 0; j < 16; ++j) out[j] = 0.f;
#pragma unroll
        for (int bt = 0; bt < 2; ++bt) {
            v4u v8[16];
#pragma unroll
            for (int i = 0; i < 16; ++i) { const unsigned vo = ((unsigned)ce[4 * bt + (i >> 2)][i & 3] << 10) + c16; v8[i] = *(const GAS v4u*)(tb + vo); }
            h2v acc16[8];
#pragma unroll
            for (int q = 0; q < 8; ++q) acc16[q] = (h2v){(_Float16)0.f, (_Float16)0.f};
#pragma unroll
            for (int i = 0; i < 16; ++i) { const float wf = wv[4 * bt + (i >> 2)][i & 3]; const h2v wk2 = pkh(wf, wf);
#pragma unroll
                for (int q = 0; q < 4; ++q) { const int vw = (int)v8[i][q];
                    acc16[2 * q] = __builtin_elementwise_fma(wk2, __builtin_bit_cast(h2v, __builtin_amdgcn_cvt_scalef32_pk_f16_fp8(vw, 1.0f, false)), acc16[2 * q]);
                    acc16[2 * q + 1] = __builtin_elementwise_fma(wk2, __builtin_bit_cast(h2v, __builtin_amdgcn_cvt_scalef32_pk_f16_fp8(vw, 1.0f, true)), acc16[2 * q + 1]); } }
#pragma unroll
            for (int q = 0; q < 8; ++q) { out[2 * q] += (float)acc16[q].x; out[2 * q + 1] += (float)acc16[q].y; }
        }
        float r8[8], r4[4];
#pragma unroll
        for (int c = 0; c < 8; ++c) { auto s = __builtin_amdgcn_permlane32_swap(__float_as_uint(out[c]), __float_as_uint(out[c + 8]), false, false); r8[c] = __uint_as_float(s[0]) + __uint_as_float(s[1]); }
#pragma unroll
        for (int c = 0; c < 4; ++c) { auto s = __builtin_amdgcn_permlane16_swap(__float_as_uint(r8[c]), __float_as_uint(r8[c + 4]), false, false); r4[c] = __uint_as_float(s[0]) + __uint_as_float(s[1]); }
        *(GAS unsigned long long*)(OUT + (size_t)row * DD + 256 * quarter + 16 * csel + 8 * b5 + 4 * b4) = (unsigned long long)pk2(r4[0] * (1.f / PV_SCALE), r4[1] * (1.f / PV_SCALE)) | ((unsigned long long)pk2(r4[2] * (1.f / PV_SCALE), r4[3] * (1.f / PV_SCALE)) << 32);
    }
#undef VQ_LOADTOK
}
__device__ __forceinline__ void ln2q_phase(unsigned char* ws, float* d_out, const float* lng, const float* lnb, int layer, int last, int gw, int NGW, int lane) {
    const bf16* OUT = (const bf16*)(ws + WS_OUTQ); bf16* LAT = (bf16*)(ws + WS_LAT); bf16* H = (bf16*)(ws + WS_H);
    const float* MOD = (const float*)(ws + WS_MOD) + (size_t)layer * 17 * 6144; const float* MODN = MOD + 17 * 6144;
    const int nrows = last ? NB * TL : MR;
    f32x4 g[4], bb[4];
#pragma unroll
    for (int j = 0; j < 4; ++j) { g[j] = *(const GAS f32x4*)(lng + 256 * j + 4 * lane); bb[j] = *(const GAS f32x4*)(lnb + 256 * j + 4 * lane); }
    for (int lr = gw; lr < nrows; lr += 2 * NGW) {
        int rows[2]; bool ok[2];
#pragma unroll
        for (int u = 0; u < 2; ++u) { const int l2 = lr + u * NGW; ok[u] = l2 < nrows; rows[u] = peer_row(ok[u] ? l2 : lr, last); }
        f32x4 v[2][4]; float sm[2];
#pragma unroll
        for (int u = 0; u < 2; ++u) { sm[u] = 0.f; const int row = rows[u]; const int b = row / SQ, s = row - b * SQ; const float* md = MOD + (size_t)((s < LC) ? 16 : b) * 6144;
#pragma unroll
            for (int j = 0; j < 4; ++j) { const int c = 256 * j + 4 * lane; const unsigned long long lb = *(const GAS unsigned long long*)(LAT + (size_t)row * DD + c); const unsigned l0 = (unsigned)lb, l1 = (unsigned)(lb >> 32);
                f32x4 lv; lv.x = bflo(l0); lv.y = bfhi(l0); lv.z = bflo(l1); lv.w = bfhi(l1); const f32x4 gv = *(const GAS f32x4*)(md + 5120 + c);
                const unsigned long long ob = *(const GAS unsigned long long*)(OUT + (size_t)row * DD + c); const unsigned olo = (unsigned)ob, ohi = (unsigned)(ob >> 32);
                f32x4 o; o.x = bflo(olo); o.y = bfhi(olo); o.z = bflo(ohi); o.w = bfhi(ohi);
                v[u][j] = lv * DN_ALPHA + gv * o; sm[u] += (v[u][j].x + v[u][j].y) + (v[u][j].z + v[u][j].w); } }
#pragma unroll
        for (int o = 1; o < 64; o <<= 1) { sm[0] += __shfl_xor(sm[0], o); sm[1] += __shfl_xor(sm[1], o); }
        float s2[2];
#pragma unroll
        for (int u = 0; u < 2; ++u) { const float mean = sm[u] * (1.f / DD); s2[u] = 0.f;
#pragma unroll
            for (int j = 0; j < 4; ++j) { v[u][j] = v[u][j] - mean; s2[u] += (v[u][j].x * v[u][j].x + v[u][j].y * v[u][j].y) + (v[u][j].z * v[u][j].z + v[u][j].w * v[u][j].w); } }
#pragma unroll
        for (int o = 1; o < 64; o <<= 1) { s2[0] += __shfl_xor(s2[0], o); s2[1] += __shfl_xor(s2[1], o); }
#pragma unroll
        for (int u = 0; u < 2; ++u) { if (!ok[u]) continue; const int row = rows[u]; const int b = row / SQ, s = row - b * SQ; const float* mdn = MODN + (size_t)((s < LC) ? 16 : b) * 6144;
            const float rstd = 1.f / sqrtf(s2[u] * (1.f / DD) + LN_EPS);
#pragma unroll
            for (int j = 0; j < 4; ++j) { const int c = 256 * j + 4 * lane; const f32x4 y = v[u][j] * rstd * g[j] + bb[j];
                if (last) { *(GAS f32x4*)(d_out + ((size_t)b * TL + (s - LC)) * DD + c) = y; }
                else { *(GAS unsigned long long*)(LAT + (size_t)row * DD + c) = (unsigned long long)pk2(y.x, y.y) | ((unsigned long long)pk2(y.z, y.w) << 32);
                    const f32x4 sh = *(const GAS f32x4*)(mdn + c), sc = *(const GAS f32x4*)(mdn + 1024 + c); const f32x4 h = y * (sc + 1.f) + sh;
                    *(GAS unsigned long long*)(H + (size_t)row * DD + c) = (unsigned long long)pk2(h.x, h.y) | ((unsigned long long)pk2(h.z, h.w) << 32); } } }
    }
}

__device__ __forceinline__ void peer_gv_phase(unsigned char* ws, float* d_out, const float* lng, const float* lnb, int layer, int last, int dry, int gw, int NGW, int lane) {
    const bf16* H = (const bf16*)(ws + WS_H); bf16* LAT = (bf16*)(ws + WS_LAT); bf16* Hn = (bf16*)(ws + WS_H);
    const unsigned char* PU = ws + WS_PU + (size_t)layer * 16384 * 1024; const unsigned char* PV = ws + WS_PV + (size_t)layer * 16384 * 1024;
    const float* PQP = (const float*)(ws + WS_PQP);
    const int* EIDX = (const int*)(ws + WS_B); const float* EG = (const float*)(ws + WS_B + (size_t)MR * 128 * 4);
    const float* MOD = (const float*)(ws + WS_MOD) + (size_t)layer * 17 * 6144; const float* MODN = MOD + 17 * 6144;
    const int b3 = (lane >> 3) & 1, b4 = (lane >> 4) & 1, b5 = lane >> 5;
    const int ntok = last ? NB * TL : MR;
    int ne_lo = 0, ne_hi = 0; float ng_lo = 0.f, ng_hi = 0.f, np_lo[4], np_hi[4];
#pragma unroll
    for (int q = 0; q < 4; ++q) { np_lo[q] = 0.f; np_hi[q] = 0.f; }
#define GV_LOADTOK(r_) do { const size_t o_ = (size_t)(r_) * 128 + lane; ne_lo = EIDX[o_]; ne_hi = EIDX[o_ + 64]; ng_lo = EG[o_]; ng_hi = EG[o_ + 64]; \
        _Pragma("unroll") for (int q_ = 0; q_ < 4; ++q_) { np_lo[q_] = PQP[(size_t)q_ * MR * 128 + o_]; np_hi[q_] = PQP[(size_t)q_ * MR * 128 + o_ + 64]; } } while (0)
    if (gw < ntok) { const int r0 = peer_row(gw, last); GV_LOADTOK(r0); }
    for (int t = gw; t < ntok; t += NGW) { const int row = peer_row(t, last); const int b = row / SQ, s = row - b * SQ;
        const int midx = (s < LC) ? 16 : b;
        const int e_lo = ne_lo, e_hi = ne_hi;
        const float g_lo = ng_lo * gelu_tanh(((np_lo[0] + np_lo[1]) + (np_lo[2] + np_lo[3])) * (1.f / PU_SCALE)), g_hi = ng_hi * gelu_tanh(((np_hi[0] + np_hi[1]) + (np_hi[2] + np_hi[3])) * (1.f / PU_SCALE));
        if (t + NGW < ntok) { const int r1 = peer_row(t + NGW, last); GV_LOADTOK(r1); }
        float out[16];
#pragma unroll
        for (int j = 0; j < 16; ++j) out[j] = 0.f;
        for (int kb = 0; kb < 128; kb += 16) {
            const int esel = (kb < 64) ? e_lo : e_hi; const float gsel = (kb < 64) ? g_lo : g_hi;
            v4u v8[16];
#pragma unroll
            for (int k = 0; k < 16; ++k) { const int ek = __builtin_amdgcn_readlane(esel, (kb & 63) + k); v8[k] = *(const GAS v4u*)(PV + (size_t)ek * 1024 + 16 * lane); }
            const float w = __shfl(gsel, (kb & 63) + (lane >> 2));
            const int w16 = __builtin_bit_cast(int, pkh(w, w));
            h2v acc16[8];
#pragma unroll
            for (int q = 0; q < 8; ++q) acc16[q] = (h2v){(_Float16)0.f, (_Float16)0.f};
#pragma unroll
            for (int k = 0; k < 16; ++k) { const h2v wk2 = __builtin_bit_cast(h2v, __builtin_amdgcn_readlane(w16, 4 * k));
#pragma unroll
                for (int q = 0; q < 4; ++q) { const int vw = (int)v8[k][q];
                    acc16[2 * q] = __builtin_elementwise_fma(wk2, __builtin_bit_cast(h2v, __builtin_amdgcn_cvt_scalef32_pk_f16_fp8(vw, 1.0f, false)), acc16[2 * q]);
                    acc16[2 * q + 1] = __builtin_elementwise_fma(wk2, __builtin_bit_cast(h2v, __builtin_amdgcn_cvt_scalef32_pk_f16_fp8(vw, 1.0f, true)), acc16[2 * q + 1]); } }
#pragma unroll
            for (int q = 0; q < 8; ++q) { out[2 * q] += (float)acc16[q].x; out[2 * q + 1] += (float)acc16[q].y; }
        }
#pragma unroll
        for (int j = 0; j < 16; ++j) out[j] *= (1.f / PV_SCALE);
        const float* md = MOD + (size_t)midx * 6144; float r[16]; float sm = 0.f;
#pragma unroll
        for (int q = 0; q < 4; ++q) { const int c = 16 * lane + 4 * q; const unsigned long long lb = *(const GAS unsigned long long*)(LAT + (size_t)row * DD + c); const unsigned l0 = (unsigned)lb, l1 = (unsigned)(lb >> 32);
            f32x4 lv; lv[0] = bflo(l0); lv[1] = bfhi(l0); lv[2] = bflo(l1); lv[3] = bfhi(l1); const f32x4 gv = *(const GAS f32x4*)(md + 5120 + c);
#pragma unroll
            for (int j = 0; j < 4; ++j) { const float t = DN_ALPHA * lv[j] + gv[j] * out[4 * q + j]; r[4 * q + j] = t; sm += t; } }
        const float mean = wave_sum(sm) * (1.f / DD); float s2s = 0.f;
#pragma unroll
        for (int j = 0; j < 16; ++j) { r[j] -= mean; s2s += r[j] * r[j]; }
        const float rstd = 1.f / sqrtf(wave_sum(s2s) * (1.f / DD) + LN_EPS);
        const float* mdn = MODN + (size_t)midx * 6144;
        float y[16];
#pragma unroll
        for (int q = 0; q < 4; ++q) { const int c = 16 * lane + 4 * q; const f32x4 g = *(const GAS f32x4*)(lng + c), bb = *(const GAS f32x4*)(lnb + c);
#pragma unroll
            for (int j = 0; j < 4; ++j) y[4 * q + j] = r[4 * q + j] * rstd * g[j] + bb[j]; }
        const int c0 = 16 * lane;
        if (dry) { if (y[0] == 123.456f) LAT[0] = (bf16)f2bf(y[1] + y[2] + y[3] + y[4] + y[5] + y[6] + y[7] + y[8] + y[9] + y[10] + y[11] + y[12] + y[13] + y[14] + y[15]); }
        else if (last) { float* op = d_out + ((size_t)b * TL + (s - LC)) * DD + c0;
#pragma unroll
            for (int q = 0; q < 4; ++q) *(GAS f32x4*)(op + 4 * q) = (f32x4){y[4 * q], y[4 * q + 1], y[4 * q + 2], y[4 * q + 3]}; }
        else { { v4u l0, l1; l0.x = pk2(y[0], y[1]); l0.y = pk2(y[2], y[3]); l0.z = pk2(y[4], y[5]); l0.w = pk2(y[6], y[7]); l1.x = pk2(y[8], y[9]); l1.y = pk2(y[10], y[11]); l1.z = pk2(y[12], y[13]); l1.w = pk2(y[14], y[15]);
              *(GAS v4u*)(LAT + (size_t)row * DD + c0) = l0; *(GAS v4u*)(LAT + (size_t)row * DD + c0 + 8) = l1; }
            float hh[16];
#pragma unroll
            for (int q = 0; q < 4; ++q) { const f32x4 sh = *(const GAS f32x4*)(mdn + c0 + 4 * q), sc = *(const GAS f32x4*)(mdn + 1024 + c0 + 4 * q);
#pragma unroll
                for (int j = 0; j < 4; ++j) hh[4 * q + j] = y[4 * q + j] * (1.f + sc[j]) + sh[j]; }
            v4u w0, w1; w0.x = pk2(hh[0], hh[1]); w0.y = pk2(hh[2], hh[3]); w0.z = pk2(hh[4], hh[5]); w0.w = pk2(hh[6], hh[7]); w1.x = pk2(hh[8], hh[9]); w1.y = pk2(hh[10], hh[11]); w1.z = pk2(hh[12], hh[13]); w1.w = pk2(hh[14], hh[15]);
            *(GAS v4u*)(Hn + (size_t)row * DD + c0) = w0; *(GAS v4u*)(Hn + (size_t)row * DD + c0 + 8) = w1; }
    }
}

#if PEER_SLICED
constexpr size_t WS_W = WS_B + (size_t)2 * MR * 128 * 4;
constexpr size_t WS_OUT = WS_B + SZ72;
constexpr size_t WS_P = WS_A;
template <int MODE> __device__ __forceinline__ void peer_slice_pass(unsigned char* ws, int layer, int last, int slice, int widx, int nwg_slice, int lane, int wave) {
    const unsigned char* TAB = ws + (MODE == 0 ? WS_PU : WS_PV) + (size_t)layer * 16384 * 1024;
    const bf16* H = (const bf16*)(ws + WS_H); const int* EIDX = (const int*)(ws + WS_B); const float* W = (const float*)(ws + WS_W); bf16* OUT = (bf16*)(ws + WS_OUT);
    const int nwv = nwg_slice * NWAVES; const int ntok = last ? NB * TL : MR;
    float* P = (float*)(ws + WS_P) + (size_t)slice * MR * 128;
    const int b0 = lane & 1, b1 = (lane >> 1) & 1, b2 = (lane >> 2) & 1, b3 = (lane >> 3) & 1, b4 = (lane >> 4) & 1, b5 = lane >> 5, grp = lane >> 3, sub = lane & 7;
    const unsigned char* tl = TAB + ((size_t)slice << 21) + 16 * sub;
    const int t0 = widx * NWAVES + wave;
    int ec0, ec1, en0, en1, em0, em1; float wc0, wc1, wn0, wn1, wm0, wm1; v4u xc0, xc1, xn0, xn1;
    v4u rX[8], rY[8]; float fX[8], fY[8];
#define PS_LOADIDX(E0_, E1_, W0_, W1_, t_) do { if ((t_) < ntok) { const int row_ = peer_row((t_), last); E0_ = __builtin_nontemporal_load(EIDX + (size_t)row_ * 128 + lane); E1_ = __builtin_nontemporal_load(EIDX + (size_t)row_ * 128 + 64 + lane); \
        if (MODE == 1) { W0_ = __builtin_nontemporal_load(W + (size_t)row_ * 128 + lane); W1_ = __builtin_nontemporal_load(W + (size_t)row_ * 128 + 64 + lane); } } } while (0)
#define PS_LOADX(X0_, X1_, t_) do { if (MODE == 0 && (t_) < ntok) { const int row_ = peer_row((t_), last); X0_ = __builtin_nontemporal_load((const v4u*)(H + (size_t)row_ * DD + 128 * slice + 16 * sub)); X1_ = __builtin_nontemporal_load((const v4u*)(H + (size_t)row_ * DD + 128 * slice + 16 * sub + 8)); } } while (0)
#define PS_ISSUE(R_, F_, E_, W_) do { _Pragma("unroll") for (int i = 0; i < 8; ++i) { const int src = 8 * i + grp; const int e = __shfl(E_, src); \
        if (MODE == 1) F_[i] = __shfl(W_, src); R_[i] = *(const GAS v4u*)(tl + (size_t)e * 128); } } while (0)
    PS_LOADIDX(ec0, ec1, wc0, wc1, t0); PS_LOADIDX(en0, en1, wn0, wn1, t0 + nwv); PS_LOADX(xc0, xc1, t0);
    if (t0 < ntok) { PS_ISSUE(rX, fX, ec0, wc0); PS_ISSUE(rY, fY, ec1, wc1); }
    for (int t = t0; t < ntok; t += nwv) {
        const int row = peer_row(t, last); const bool more = (t + nwv) < ntok;
        PS_LOADIDX(em0, em1, wm0, wm1, t + 2 * nwv); PS_LOADX(xn0, xn1, t + nwv);
        float acc[16];
        if (MODE == 1) {
#pragma unroll
            for (int c = 0; c < 16; ++c) acc[c] = 0.f;
#pragma unroll
            for (int i = 0; i < 8; ++i) {
#pragma unroll
                for (int q = 0; q < 4; ++q) { const int vw = (int)rX[i][q]; const f32x2p lo = __builtin_amdgcn_cvt_pk_f32_fp8(vw, false), hi2 = __builtin_amdgcn_cvt_pk_f32_fp8(vw, true);
                    acc[4 * q] = fmaf(fX[i], lo.x, acc[4 * q]); acc[4 * q + 1] = fmaf(fX[i], lo.y, acc[4 * q + 1]); acc[4 * q + 2] = fmaf(fX[i], hi2.x, acc[4 * q + 2]); acc[4 * q + 3] = fmaf(fX[i], hi2.y, acc[4 * q + 3]); } }
            if (more) PS_ISSUE(rX, fX, en0, wn0);
#pragma unroll
            for (int i = 0; i < 8; ++i) {
#pragma unroll
                for (int q = 0; q < 4; ++q) { const int vw = (int)rY[i][q]; const f32x2p lo = __builtin_amdgcn_cvt_pk_f32_fp8(vw, false), hi2 = __builtin_amdgcn_cvt_pk_f32_fp8(vw, true);
                    acc[4 * q] = fmaf(fY[i], lo.x, acc[4 * q]); acc[4 * q + 1] = fmaf(fY[i], lo.y, acc[4 * q + 1]); acc[4 * q + 2] = fmaf(fY[i], hi2.x, acc[4 * q + 2]); acc[4 * q + 3] = fmaf(fY[i], hi2.y, acc[4 * q + 3]); } }
            if (more) PS_ISSUE(rY, fY, en1, wn1);
            float r8[8], r4[4], r2[2];
#pragma unroll
            for (int c = 0; c < 8; ++c) { const float snd = b5 ? acc[c] : acc[c + 8], mine = b5 ? acc[c + 8] : acc[c]; r8[c] = mine + __shfl_xor(snd, 32); }
#pragma unroll
            for (int c = 0; c < 4; ++c) { const float snd = b4 ? r8[c] : r8[c + 4], mine = b4 ? r8[c + 4] : r8[c]; r4[c] = mine + __shfl_xor(snd, 16); }
#pragma unroll
            for (int c = 0; c < 2; ++c) { const float snd = b3 ? r4[c] : r4[c + 2], mine = b3 ? r4[c + 2] : r4[c]; r2[c] = mine + __shfl_xor(snd, 8); }
            __builtin_nontemporal_store(pk2(r2[0], r2[1]), (unsigned*)(OUT + (size_t)row * DD + 128 * slice + 16 * sub + 8 * b5 + 4 * b4 + 2 * b3));
        } else {
            float x[16]; x[0] = bflo(xc0.x); x[1] = bfhi(xc0.x); x[2] = bflo(xc0.y); x[3] = bfhi(xc0.y); x[4] = bflo(xc0.z); x[5] = bfhi(xc0.z); x[6] = bflo(xc0.w); x[7] = bfhi(xc0.w);
            x[8] = bflo(xc1.x); x[9] = bfhi(xc1.x); x[10] = bflo(xc1.y); x[11] = bfhi(xc1.y); x[12] = bflo(xc1.z); x[13] = bfhi(xc1.z); x[14] = bflo(xc1.w); x[15] = bfhi(xc1.w);
#pragma unroll
            for (int i = 0; i < 8; ++i) { float a0 = 0.f, a1 = 0.f;
#pragma unroll
                for (int q = 0; q < 4; ++q) { const int uw = (int)rX[i][q]; const f32x2p lo = __builtin_amdgcn_cvt_pk_f32_fp8(uw, false), hi2 = __builtin_amdgcn_cvt_pk_f32_fp8(uw, true);
                    a0 = fmaf(lo.x, x[4 * q], a0); a1 = fmaf(lo.y, x[4 * q + 1], a1); a0 = fmaf(hi2.x, x[4 * q + 2], a0); a1 = fmaf(hi2.y, x[4 * q + 3], a1); }
                acc[i] = a0 + a1; }
            if (more) PS_ISSUE(rX, fX, en0, wn0);
#pragma unroll
            for (int i = 0; i < 8; ++i) { float a0 = 0.f, a1 = 0.f;
#pragma unroll
                for (int q = 0; q < 4; ++q) { const int uw = (int)rY[i][q]; const f32x2p lo = __builtin_amdgcn_cvt_pk_f32_fp8(uw, false), hi2 = __builtin_amdgcn_cvt_pk_f32_fp8(uw, true);
                    a0 = fmaf(lo.x, x[4 * q], a0); a1 = fmaf(lo.y, x[4 * q + 1], a1); a0 = fmaf(hi2.x, x[4 * q + 2], a0); a1 = fmaf(hi2.y, x[4 * q + 3], a1); }
                acc[8 + i] = a0 + a1; }
            if (more) PS_ISSUE(rY, fY, en1, wn1);
            float r8[8], r4[4], r2[2];
#pragma unroll
            for (int c = 0; c < 8; ++c) { const float snd = b2 ? acc[c] : acc[c + 8], mine = b2 ? acc[c + 8] : acc[c]; r8[c] = mine + __shfl_xor(snd, 4); }
#pragma unroll
            for (int c = 0; c < 4; ++c) { const float snd = b1 ? r8[c] : r8[c + 4], mine = b1 ? r8[c + 4] : r8[c]; r4[c] = mine + __shfl_xor(snd, 2); }
#pragma unroll
            for (int c = 0; c < 2; ++c) { const float snd = b0 ? r4[c] : r4[c + 2], mine = b0 ? r4[c + 2] : r4[c]; r2[c] = mine + __shfl_xor(snd, 1); }
            __builtin_nontemporal_store((unsigned long long)__float_as_uint(r2[0]) | ((unsigned long long)__float_as_uint(r2[1]) << 32), (unsigned long long*)(P + (size_t)row * 128 + 2 * lane));
        }
        ec0 = en0; ec1 = en1; wc0 = wn0; wc1 = wn1; xc0 = xn0; xc1 = xn1;
        en0 = em0; en1 = em1; wn0 = wm0; wn1 = wm1;
    }
#undef PS_LOADIDX
#undef PS_LOADX
#undef PS_ISSUE
}
__device__ __forceinline__ void peer_act_phase(unsigned char* ws, int last, int gw, int NGW, int lane) {
    const float* P = (const float*)(ws + WS_P); const float* EG = (const float*)(ws + WS_B + (size_t)MR * 128 * 4); float* W = (float*)(ws + WS_W);
    const int ntok = last ? NB * TL : MR; const int grp = lane >> 3, ib = 8 * ((lane >> 2) & 1) + 4 * ((lane >> 1) & 1) + 2 * (lane & 1);
    for (int t = gw; t < ntok; t += NGW) { const int row = peer_row(t, last); float s0 = 0.f, s1 = 0.f;
#pragma unroll
        for (int sl = 0; sl < 8; ++sl) { const unsigned long long v = *(const GAS unsigned long long*)(P + ((size_t)sl * MR + row) * 128 + 2 * lane); s0 += __uint_as_float((unsigned)v); s1 += __uint_as_float((unsigned)(v >> 32)); }
        const int k0 = 8 * ib + grp, k1 = 8 * (ib + 1) + grp;
        W[(size_t)row * 128 + k0] = EG[(size_t)row * 128 + k0] * gelu_tanh(s0 * (1.f / PU_SCALE)) * (1.f / PV_SCALE);
        W[(size_t)row * 128 + k1] = EG[(size_t)row * 128 + k1] * gelu_tanh(s1 * (1.f / PU_SCALE)) * (1.f / PV_SCALE); }
}
__device__ __forceinline__ void ln2_phase(unsigned char* ws, float* d_out, const float* lng, const float* lnb, int layer, int last, int gw, int NGW, int lane) {
    const bf16* OUT = (const bf16*)(ws + WS_OUT); bf16* LAT = (bf16*)(ws + WS_LAT); bf16* H = (bf16*)(ws + WS_H);
    const float* MOD = (const float*)(ws + WS_MOD) + (size_t)layer * 17 * 6144; const float* MODN = MOD + 17 * 6144;
    const int nrows = last ? NB * TL : MR;
    f32x4 g[4], bb[4];
#pragma unroll
    for (int j = 0; j < 4; ++j) { g[j] = *(const GAS f32x4*)(lng + 256 * j + 4 * lane); bb[j] = *(const GAS f32x4*)(lnb + 256 * j + 4 * lane); }
    for (int lr = gw; lr < nrows; lr += 2 * NGW) {
        int rows[2]; bool ok[2];
#pragma unroll
        for (int u = 0; u < 2; ++u) { const int l2 = lr + u * NGW; ok[u] = l2 < nrows; rows[u] = peer_row(ok[u] ? l2 : lr, last); }
        f32x4 v[2][4]; float sm[2];
#pragma unroll
        for (int u = 0; u < 2; ++u) { sm[u] = 0.f; const int row = rows[u]; const int b = row / SQ, s = row - b * SQ; const float* md = MOD + (size_t)((s < LC) ? 16 : b) * 6144;
#pragma unroll
            for (int j = 0; j < 4; ++j) { const int c = 256 * j + 4 * lane; const unsigned long long lb = *(const GAS unsigned long long*)(LAT + (size_t)row * DD + c); const unsigned l0 = (unsigned)lb, l1 = (unsigned)(lb >> 32);
                f32x4 lv; lv.x = bflo(l0); lv.y = bfhi(l0); lv.z = bflo(l1); lv.w = bfhi(l1); const f32x4 gv = *(const GAS f32x4*)(md + 5120 + c);
                const unsigned long long ob = *(const GAS unsigned long long*)(OUT + (size_t)row * DD + c); const unsigned olo = (unsigned)ob, ohi = (unsigned)(ob >> 32);
                f32x4 o; o.x = bflo(olo); o.y = bfhi(olo); o.z = bflo(ohi); o.w = bfhi(ohi);
                v[u][j] = lv * DN_ALPHA + gv * o; sm[u] += (v[u][j].x + v[u][j].y) + (v[u][j].z + v[u][j].w); } }
#pragma unroll
        for (int o = 1; o < 64; o <<= 1) { sm[0] += __shfl_xor(sm[0], o); sm[1] += __shfl_xor(sm[1], o); }
        float s2[2];
#pragma unroll
        for (int u = 0; u < 2; ++u) { const float mean = sm[u] * (1.f / DD); s2[u] = 0.f;
#pragma unroll
            for (int j = 0; j < 4; ++j) { v[u][j] = v[u][j] - mean; s2[u] += (v[u][j].x * v[u][j].x + v[u][j].y * v[u][j].y) + (v[u][j].z * v[u][j].z + v[u][j].w * v[u][j].w); } }
#pragma unroll
        for (int o = 1; o < 64; o <<= 1) { s2[0] += __shfl_xor(s2[0], o); s2[1] += __shfl_xor(s2[1], o); }
#pragma unroll
        for (int u = 0; u < 2; ++u) { if (!ok[u]) continue; const int row = rows[u]; const int b = row / SQ, s = row - b * SQ; const float* mdn = MODN + (size_t)((s < LC) ? 16 : b) * 6144;
            const float rstd = 1.f / sqrtf(s2[u] * (1.f / DD) + LN_EPS);
#pragma unroll
            for (int j = 0; j < 4; ++j) { const int c = 256 * j + 4 * lane; const f32x4 y = v[u][j] * rstd * g[j] + bb[j];
                if (last) { *(GAS f32x4*)(d_out + ((size_t)b * TL + (s - LC)) * DD + c) = y; }
                else { *(GAS unsigned long long*)(LAT + (size_t)row * DD + c) = (unsigned long long)pk2(y.x, y.y) | ((unsigned long long)pk2(y.z, y.w) << 32);
                    const f32x4 sh = *(const GAS f32x4*)(mdn + c), sc = *(const GAS f32x4*)(mdn + 1024 + c); const f32x4 h = y * (sc + 1.f) + sh;
                    *(GAS unsigned long long*)(H + (size_t)row * DD + c) = (unsigned long long)pk2(h.x, h.y) | ((unsigned long long)pk2(h.z, h.w) << 32); } } }
    }
}

#endif
__device__ __forceinline__ int s5_pos(int dir, int step) { return dir == 0 ? step : (step < LC ? (LC - 1 - step) : (SQ + LC - 1 - step)); }
__device__ __forceinline__ int s5_other_tile(int dir, int pos) { const int st = (dir == 0) ? (pos < LC ? (LC - 1 - pos) : (SQ + LC - 1 - pos)) : pos; return st >> 4; }
__device__ __forceinline__ int s5_mirror(int t) { return t < 16 ? 15 - t : 159 - t; }
__device__ __forceinline__ void s5_phase(unsigned char* ws, const float* dskip, LAS unsigned char* lds, int vcu, int tid, int lane, int wave) {
    const bf16* U = (const bf16*)(ws + WS_H); float* YP = (float*)(ws + WS_A + SZ72); bf16* YG = (bf16*)(ws + WS_A);
    const float* LB = (const float*)(ws + WS_S5LB); const bf16* Bop = (const bf16*)(ws + WS_S5B); const bf16* Cop = (const bf16*)(ws + WS_S5C);
    const int half = wave & 1, dir = (wave >> 1) & 1, wt = vcu * 2 + (wave >> 2); const bool active = (wt < 512);
    const int bp = (wt >> 6) & 7, g = wt & 63; const int r32 = lane & 31, hi = lane >> 5, t16 = lane & 15, q4 = lane >> 4;
    constexpr int XP = 272, IMGB = 9216, NTILE = SQ / 16;
    LAS unsigned char* img0 = lds + (wave >> 1) * (2 * IMGB);
    const int a_b = 2 * bp + ((r32 >> 2) & 1), a_t = (r32 & 3) + 4 * (r32 >> 3);
    const f32x4 dv = *(const GAS f32x4*)(dskip + g * 16 + 4 * q4);
    const int rg = dir * 64 + g; const int bb = half;
    bf16x8 Bf[2], Cf[4];
#pragma unroll
    for (int i = 0; i < 2; ++i) Bf[i] = *(const GAS bf16x8*)(Bop + ((size_t)rg * 128 + (2 * half + i) * 32 + r32) * 16 + 8 * hi);
#pragma unroll
    for (int ks = 0; ks < 4; ++ks) Cf[ks] = *(const GAS bf16x8*)(Cop + ((size_t)rg * 16 + t16) * 128 + 32 * ks + 8 * q4);
    const float lr = LB[((size_t)rg * 64 + 32 * half + r32) * 2], li = LB[((size_t)rg * 64 + 32 * half + r32) * 2 + 1];
    float xr = 0.f, xi = 0.f;
    const bf16* Ua = U + (size_t)a_b * SQ * DD + g * 16 + 8 * hi;
    const size_t eoff = (size_t)(2 * bp + bb) * SQ * DD + g * 16 + 4 * q4;
    bf16x8 an[2]; unsigned long long un[2]; f32x4 pn[2];
#define S5_LOAD_A(slot_, tile_) do { const bf16* p_ = Ua + (size_t)s5_pos(dir, (tile_) * 16 + a_t) * DD; asm volatile("global_load_dwordx4 %0, %1, off" : "=v"(an[slot_]) : "v"(p_) : "memory"); } while (0)
#define S5_LOAD_E(slot_, tile_) do { const int tp_ = (tile_); const size_t o_ = eoff + (size_t)s5_pos(dir, tp_ * 16 + t16) * DD; \
        const bf16* p_ = U + o_; const float* q_ = (tp_ - s5_mirror(tp_) >= 6) ? (const float*)(YP + o_) : (const float*)p_; \
        asm volatile("global_load_dwordx2 %0, %2, off\n\tglobal_load_dwordx4 %1, %3, off nt" : "=&v"(un[slot_]), "=&v"(pn[slot_]) : "v"(p_), "v"(q_) : "memory"); } while (0)
#define S5_TILE(slot_, tile_) do { \
        const int tile = (tile_); LAS unsigned char* img = img0 + (tile & 1) * IMGB; \
        const int mir = s5_mirror(tile); const bool second = mir < tile, farv = (tile - mir) >= 6; \
        const int tnx = (tile + 2 < NTILE) ? tile + 2 : NTILE - 1; \
        const size_t off = eoff + (size_t)s5_pos(dir, tile * 16 + t16) * DD; \
        if (active) { \
        asm volatile("s_waitcnt vmcnt(7)" : "+v"(an[slot_]) :: "memory");        \
        f32x16 acc[2]; \
        _Pragma("unroll") for (int i = 0; i < 2; ++i) acc[i] = __builtin_amdgcn_mfma_f32_32x32x16_bf16(an[slot_], Bf[i], (f32x16){}, 0, 0, 0); \
        __builtin_amdgcn_sched_barrier(0); \
        S5_LOAD_A(slot_, tnx); \
        __builtin_amdgcn_sched_barrier(0); \
        _Pragma("unroll") for (int r = 0; r < 16; ++r) { \
            const float nr = lr * xr - li * xi + acc[0][r], ni = lr * xi + li * xr + acc[1][r]; xr = nr; xi = ni; \
            *(LAS unsigned*)(img + (hi * 16 + r) * XP + 128 * half + r32 * 4) = pk2(nr, ni); } \
        } \
        asm volatile("s_waitcnt lgkmcnt(0)" ::: "memory"); \
        __builtin_amdgcn_s_barrier();        \
        if (active) { \
        f32x4 y = (f32x4){0.f, 0.f, 0.f, 0.f}; \
        _Pragma("unroll") for (int ks = 0; ks < 4; ++ks) { const bf16x8 xb = *(const LAS bf16x8*)(img + (bb * 16 + t16) * XP + (32 * ks + 8 * q4) * 2); \
            y = __builtin_amdgcn_mfma_f32_16x16x32_bf16(Cf[ks], xb, y, 0, 0, 0); } \
        asm volatile("s_waitcnt vmcnt(5)" : "+v"(pn[slot_]), "+v"(un[slot_]) :: "memory");        \
        if (!second) { *(GAS f32x4*)(YP + off) = y; } \
        else { f32x4 pc = pn[slot_]; const unsigned long long uc = un[slot_]; \
            if (!farv) { const float* p_ = YP + off; asm volatile("global_load_dwordx4 %0, %1, off nt\n\ts_waitcnt vmcnt(0)" : "=&v"(pc) : "v"(p_) : "memory"); }        \
            const unsigned ulo = (unsigned)uc, uhi = (unsigned)(uc >> 32); \
            const float o0 = gelu_tanh(pc.x + y.x + dv.x * bflo(ulo)), o1 = gelu_tanh(pc.y + y.y + dv.y * bfhi(ulo)), o2 = gelu_tanh(pc.z + y.z + dv.z * bflo(uhi)), o3 = gelu_tanh(pc.w + y.w + dv.w * bfhi(uhi)); \
            *(GAS unsigned long long*)(YG + off) = (unsigned long long)pk2(o0, o1) | ((unsigned long long)pk2(o2, o3) << 32); } \
        __builtin_amdgcn_sched_barrier(0); \
        S5_LOAD_E(slot_, tnx); \
        if (tile == 7 || tile == 79) asm volatile("s_waitcnt vmcnt(0)" ::: "memory"); else asm volatile("s_waitcnt vmcnt(6)" ::: "memory");        \
        } \
    } while (0)
    if (active) { S5_LOAD_A(0, 0); S5_LOAD_A(1, 1); S5_LOAD_E(0, 0); S5_LOAD_E(1, 1); asm volatile("s_waitcnt vmcnt(0)" : "+v"(an[0]), "+v"(an[1]), "+v"(un[0]), "+v"(un[1]), "+v"(pn[0]), "+v"(pn[1]) :: "memory"); }
    for (int t2 = 0; t2 < NTILE; t2 += 2) { S5_TILE(0, t2); S5_TILE(1, t2 + 1); }
    asm volatile("s_waitcnt vmcnt(0) lgkmcnt(0)" ::: "memory");
#undef S5_TILE
#undef S5_LOAD_A
#undef S5_LOAD_E
}
#ifndef MK_DEBUG
#define MK_DEBUG 0
#endif
#if MK_DEBUG
__device__ __forceinline__ void chk_fail(gu32* ctl, unsigned code) { unsigned expect = 0u; __hip_atomic_compare_exchange_strong((unsigned*)(ctl + CW_ERR), &expect, code, __ATOMIC_RELAXED, __ATOMIC_RELAXED, __HIP_MEMORY_SCOPE_AGENT); }
__device__ __forceinline__ bool chk_close(float got, float ref, float rtol, float atol) { const float d = fabsf(got - ref); return (d <= atol + rtol * fabsf(ref)) && (got == got); }
__device__ __forceinline__ float fp8f(unsigned char v) { return __builtin_amdgcn_cvt_f32_fp8((int)v, 0); }
__device__ __forceinline__ float bfround(float f) { return __uint_as_float(f2bf(f) << 16); }
__device__ __forceinline__ float chk_dot(const bf16* arow, const float* W, int N, int col) { float s = 0.f; for (int k = 0; k < 1024; ++k) s += bf2f(arow[k]) * bfround(W[(size_t)k * N + col]); return s; }
__device__ __forceinline__ int chk_row(int i) { const int b = (i * 5) & 15; const int sel = i & 7; const int s = (sel == 0) ? 3 : (sel == 1) ? 255 : (sel == 2) ? 256 : (sel == 3) ? 2303 : (sel == 4) ? 777 : (sel == 5) ? 1400 : (sel == 6) ? 130 : 2000; return b * SQ + s; }

__device__ __forceinline__ void check_pre_peer(unsigned char* ws, int layer, int tid) {
    const int row = chk_row(3 + 2 * layer);
    for (int c = tid; c < 1024; c += NTHR) { ((float*)(ws + WS_CTL + 262144))[c] = bf2f(((const bf16*)(ws + WS_LAT))[(size_t)row * DD + c]); ((bf16*)(ws + WS_CTL + 262144 + 4096))[c] = ((const bf16*)(ws + WS_H))[(size_t)row * DD + c]; }
}
template <class KP> __device__ __forceinline__ void check_step(KP ka, unsigned char* ws, LAS unsigned char* lds, int op, int layer, int code, int tid, int lane, int wave) {
#define CHK_FRESH asm volatile("" : "+v"(lane), "+v"(tid), "+s"(ws));
    const int kind = layer % 3, jj = layer / 3, last = (layer == NLAYER - 1);
#ifndef CHK_MASK
#define CHK_MASK 0xFFFF
#endif
    if (!((CHK_MASK >> op) & 1)) return;
    bool bad = false;
#define MOD ((const float*)(ws + WS_MOD) + (size_t)layer * 17 * 6144)
    if (op == 9) { CHK_FRESH
        if (wave == 0) {
            { const int i = lane & 3, r = lane % 17, n = (lane * 97 + 13) % 6144; float s = 0.f;
              for (int k = 0; k < 1024; ++k) { const float v = (r < 16) ? ka->in[1][r * 1024 + k] : ka->in[3][k]; s += v / (1.f + expf(-v)) * ka->in[4][((size_t)i * 1024 + k) * 6144 + n]; }
              s += ka->in[5][i * 6144 + n]; bad |= !chk_close(((const float*)(ws + WS_MOD))[((size_t)i * 17 + r) * 6144 + n], s, 1e-3f, 1e-3f); }
            { const int n = (lane * 131 + 7) % 3072, k = (lane * 37 + 5) % 1024; bad |= bf2f(((const bf16*)(ws + WS_WQKV_DA))[((size_t)3072 + n) * 1024 + k]) != bfround(ka->in[12][(size_t)1024 * 3072 + (size_t)k * 3072 + n]); }
            { const int n = (lane * 131 + 7) % 1536, k = (lane * 37 + 5) % 1024; bad |= bf2f(((const bf16*)(ws + WS_WQKV_WA))[(size_t)n * 1024 + k]) != bfround(ka->in[16][(size_t)k * 1536 + n]); }
            { const int n = (lane * 131 + 7) % 1024, k = (lane * 37 + 5) % 1024; bad |= bf2f(((const bf16*)(ws + WS_WO_DA))[((size_t)1024 + n) * 1024 + k]) != bfround(ka->in[13][(size_t)1024 * 1024 + (size_t)k * 1024 + n]);
              bad |= bf2f(((const bf16*)(ws + WS_WO_WA))[(size_t)n * 1024 + k]) != bfround(ka->in[17][(size_t)k * 1024 + n]); }
            { const int n = (lane * 131 + 7) % 2048, k = (lane * 37 + 5) % 1024; const int pr = (n < 1024) ? ((n >> 7) * 256 + (n & 127)) : (((n - 1024) >> 7) * 256 + 128 + ((n - 1024) & 127));
              bad |= bf2f(((const bf16*)(ws + WS_WGLU))[(size_t)pr * 1024 + k]) != bfround(ka->in[27][(size_t)k * 2048 + n]);
              bad |= bf2f(((const bf16*)(ws + WS_WPQ))[((size_t)3 * 2048 + n) * 1024 + k]) != bfround(ka->in[8][(size_t)3 * 1024 * 2048 + (size_t)k * 2048 + n]); }
            { const size_t idx = (size_t)lane * 1048583u + 12345u; bad |= bf2f(((const bf16*)(ws + WS_KEYS))[idx % 2097152]) != bfround(ka->in[9][idx % 2097152]); }
            { const int t = (lane * 31 + 3) % 2048, i = lane & 31; const float inv = powf(10000.f, -(float)(i & 15) / 16.f); const float ang = (float)((i < 16) ? (t >> 6) : (t & 63)) * inv;
              bad |= !chk_close(((const float*)(ws + WS_ROPE))[t * 32 + i], cosf(ang), 0.f, 2e-5f); bad |= !chk_close(((const float*)(ws + WS_ROPE))[2048 * 32 + t * 32 + i], sinf(ang), 0.f, 2e-5f); }
        }
    } else if (op == 10) { CHK_FRESH
        if (wave == 0) { const int row = chk_row(lane), b = row / SQ, s = row - b * SQ, c = (lane * 53 + 1) % 1024; const float v = (s < LC) ? ka->in[2][((size_t)b * LC + s) * DD + c] : ka->in[0][((size_t)b * TL + s - LC) * DD + c];
            const float* md = (const float*)(ws + WS_MOD) + (size_t)((s < LC) ? 16 : b) * 6144;
            bad |= bf2f(((const bf16*)(ws + WS_LAT))[(size_t)row * DD + c]) != bfround(v); bad |= !chk_close(bf2f(((const bf16*)(ws + WS_H))[(size_t)row * DD + c]), v * (1.f + md[1024 + c]) + md[c], 1e-2f, 1e-2f); }
    } else if (op == 0) { CHK_FRESH
        if (wave == 0) { const int row = chk_row(lane), b = row / SQ, s = row - b * SQ; const int N = (kind == 0) ? 3072 : 1536; const int col = ((lane * 211 + 17) % N) & ~1;
            const float* W = (kind == 0) ? ka->in[12] + (size_t)jj * 1024 * 3072 : ka->in[16]; const bf16* hrow = (const bf16*)(ws + WS_H) + (size_t)row * DD;
            float e = chk_dot(hrow, W, N, col), o = chk_dot(hrow, W, N, col + 1);
            const int kstart = 1024, vstart = (kind == 0) ? 2048 : 1280; const int reg = (col < kstart) ? 0 : (col < vstart) ? 1 : 2; const int lc = col - ((reg == 0) ? 0 : (reg == 1) ? kstart : vstart);
            if (reg < 2 && s >= LC) { const int t = s - LC, i = (lc & 63) >> 1; const float cs = ((const float*)(ws + WS_ROPE))[t * 32 + i], sn = ((const float*)(ws + WS_ROPE))[2048 * 32 + t * 32 + i]; const float e2 = e * cs - o * sn, o2 = e * sn + o * cs; e = e2; o = o2; }
            if (reg == 0) { e *= 0.125f * LOG2E; o *= 0.125f * LOG2E; }
            const bf16* dst = (const bf16*)(ws + WS_A + (size_t)reg * SZ72) + (size_t)row * DD + lc;
            bad |= !chk_close(bf2f(dst[0]), e, 2e-2f, 2e-2f); bad |= !chk_close(bf2f(dst[1]), o, 2e-2f, 2e-2f);
            if (kind == 1) { const int hq = (lane * 5 + 2) & 15; bf16* sv = (bf16*)(ws + WS_CTL + 300000) + lane * 64; for (int cc = 0; cc < 64; ++cc) sv[cc] = ((const bf16*)(ws + WS_A))[(size_t)row * DD + hq * 64 + cc]; } }
    } else if (op == 1) { CHK_FRESH
        if (wave == 0 && kind == 0) { const int row = chk_row(lane), b = row / SQ, s = row - b * SQ; if (!(last && s < LC)) { const int hh = (lane * 7 + 3) & 31, h = hh >> 2, j = (hh >> 1) & 1, vh = hh & 1, d = (lane * 11) & 63;
            const bf16* q = (const bf16*)(ws + WS_A) + (size_t)row * DD + h * 128 + j * 64; const bf16* Kb = (const bf16*)(ws + WS_A + SZ72) + (size_t)b * SQ * DD + h * 128 + j * 64; const bf16* Vb = (const bf16*)(ws + WS_A + 2 * SZ72) + (size_t)b * SQ * DD + h * 128 + vh * 64 + d;
            const int nk = (s < LC) ? LC : SQ; float m = -INFINITY;
            for (int k = 0; k < nk; ++k) { float sc = 0.f; for (int c = 0; c < 64; ++c) sc += bf2f(q[c]) * bf2f(Kb[(size_t)k * DD + c]); m = fmaxf(m, sc); }
            float l = 0.f, o = 0.f;
            for (int k = 0; k < nk; ++k) { float sc = 0.f; for (int c = 0; c < 64; ++c) sc += bf2f(q[c]) * bf2f(Kb[(size_t)k * DD + c]); const float p = exp2f(sc - m); l += p; o += p * bf2f(Vb[(size_t)k * DD]); }
            const bf16* O = (const bf16*)(ws + WS_B + (size_t)j * SZ72) + (size_t)row * DD + h * 128 + vh * 64 + d;
            bad |= !chk_close(bf2f(O[0]), o / l, 3e-2f, 1e-2f); } }
        if (wave == 0 && kind == 1) { const int row = chk_row(lane), b = row / SQ, s = row - b * SQ; if (!(last && s < LC)) { const int hq = (lane * 5 + 2) & 15, d = (lane * 11) & 63;
            const bf16* q = (const bf16*)(ws + WS_CTL + 300000) + lane * 64; const bf16* Kb = (const bf16*)(ws + WS_A + SZ72) + (size_t)b * SQ * DD + (hq >> 2) * 64; const bf16* Vb = (const bf16*)(ws + WS_A + 2 * SZ72) + (size_t)b * SQ * DD + (hq >> 2) * 64 + d;
            float m = -INFINITY;
            for (int k = 0; k < SQ; ++k) { if (k >= LC) { if (s < LC) break; const int dd = (k - LC) - (s - LC); if (dd > 128 || dd < -128) continue; }
                float sc = 0.f; for (int c2 = 0; c2 < 64; ++c2) sc += bf2f(q[c2]) * bf2f(Kb[(size_t)k * DD + c2]); m = fmaxf(m, sc); }
            float l = 0.f, o = 0.f;
            for (int k = 0; k < SQ; ++k) { if (k >= LC) { if (s < LC) break; const int dd = (k - LC) - (s - LC); if (dd > 128 || dd < -128) continue; }
                float sc = 0.f; for (int c2 = 0; c2 < 64; ++c2) sc += bf2f(q[c2]) * bf2f(Kb[(size_t)k * DD + c2]); const float p = exp2f(sc - m); l += p; o += p * bf2f(Vb[(size_t)k * DD]); }
            l += exp2f(ka->in[18][hq] * LOG2E - m);
            bad |= !chk_close(bf2f(((const bf16*)(ws + WS_A))[(size_t)row * DD + hq * 64 + d]), o / l, 3e-2f, 1e-2f); } }
    } else if (op == 2) { CHK_FRESH
        if (wave == 0) { const int row = chk_row(lane), b = row / SQ, s = row - b * SQ; if (!(last && s < LC)) { const int h = lane & 7, e0 = (lane * 13) & 127;
            const float* lp = ka->in[14] + jj * 256; float d01 = 0.f, d23 = 0.f; for (int i = 0; i < 64; ++i) { d01 += lp[i] * lp[64 + i]; d23 += lp[128 + i] * lp[192 + i]; }
            const float lam_init = 0.8f - 0.6f * expf(-0.3f * (float)layer), lam = expf(d01) - expf(d23) + lam_init;
            const bf16* o0 = (const bf16*)(ws + WS_B) + (size_t)row * DD + h * 128; const bf16* o1 = (const bf16*)(ws + WS_B + SZ72) + (size_t)row * DD + h * 128; float ss = 0.f;
            for (int e = 0; e < 128; ++e) { const float v = bf2f(o0[e]) - lam * bf2f(o1[e]); ss += v * v; }
            const float v = (bf2f(o0[e0]) - lam * bf2f(o1[e0])) / sqrtf(ss / 128.f + LN_EPS) * ka->in[15][jj * 128 + e0] * (1.f - lam_init);
            bad |= !chk_close(bf2f(((const bf16*)(ws + WS_A))[(size_t)row * DD + h * 128 + e0]), v, 2e-2f, 1e-2f); } }
    } else if (op == 3) { CHK_FRESH
        if (wave == 0) { const int row = chk_row(lane), b = row / SQ, s = row - b * SQ; if (!(last && s < LC)) { const int col = (lane * 67 + 9) % 1024; const bf16* arow = (const bf16*)(ws + WS_A) + (size_t)row * DD;
            float val;
            if (kind == 2) { const float a = chk_dot(arow, ka->in[27], 2048, col), g = chk_dot(arow, ka->in[27], 2048, 1024 + col); val = a / (1.f + expf(-g)); }
            else val = chk_dot(arow, (kind == 0) ? ka->in[13] + (size_t)jj * 1024 * 1024 : ka->in[17], 1024, col);
            const float ref = DN_ALPHA * bf2f(((const bf16*)(ws + WS_LAT))[(size_t)row * DD + col]) + MOD[(size_t)((s < LC) ? 16 : b) * 6144 + 2048 + col] * val;
            bad |= !chk_close(bf2f(((const bf16*)(ws + WS_B))[(size_t)row * DD + col]), ref, 2e-2f, 2e-2f); } }
    } else if (op == 4) { CHK_FRESH
        if (wave == 0) { const int row = chk_row(lane), b = row / SQ, s = row - b * SQ; if (!(last && s < LC)) { const int col = (lane * 67 + 9) % 1024; const bf16* r = (const bf16*)(ws + WS_B) + (size_t)row * DD;
            float s1 = 0.f, s2 = 0.f;
#pragma clang loop vectorize(disable) unroll(disable)
            for (int c = 0; c < 1024; ++c) { float v = bf2f(r[c]); asm volatile("" : "+v"(v)); s1 += v; s2 = fmaf(v, v, s2); }
            const float mu = s1 / 1024.f, var = s2 / 1024.f - mu * mu;
            float y = (bf2f(r[col]) - mu) / sqrtf(var + LN_EPS); asm volatile("" : "+v"(y)); y = fmaf(y, ka->in[6][(layer * 2) * 1024 + col], ka->in[7][(layer * 2) * 1024 + col]); asm volatile("" : "+v"(y)); const float* md = MOD + (size_t)((s < LC) ? 16 : b) * 6144;
            float hm = fmaf(y, md[4096 + col], y); asm volatile("" : "+v"(hm)); hm += md[3072 + col]; asm volatile("" : "+v"(hm));
            bad |= !chk_close(bf2f(((const bf16*)(ws + WS_LAT))[(size_t)row * DD + col]), y, 1e-2f, 1e-2f); bad |= !chk_close(bf2f(((const bf16*)(ws + WS_H))[(size_t)row * DD + col]), hm, 1e-2f, 1e-2f); } }
    } else if (op == 5) { CHK_FRESH
        if (wave == 0) { const int row = chk_row(lane), s = row % SQ; if (!(last && s < LC)) { const int col = (lane * 139 + 9) % 2048;
            const float ref = chk_dot((const bf16*)(ws + WS_H) + (size_t)row * DD, ka->in[8] + (size_t)layer * 1024 * 2048, 2048, col);
            bad |= !chk_close(bf2f(((const bf16*)(ws + WS_A))[(size_t)row * 2048 + col]), ref, 2e-2f, 2e-2f); } }
    } else if (op == 6) { CHK_FRESH
        if (wave == 0) { const int row = chk_row(lane), s = row % SQ; const int h = (lane * 3 + 1) & 7; LAS float* sc = (LAS float*)lds + lane * 257; LAS unsigned char* used = lds + 66048 + lane * 260;
            if (!(last && s < LC)) {
                const bf16* q = (const bf16*)(ws + WS_A) + (size_t)row * 2048 + h * 256; const bf16* KEYS = (const bf16*)(ws + WS_KEYS) + (size_t)layer * 2 * 8 * 128 * 128;
                for (int j = 0; j < 2; ++j) for (int k = 0; k < 128; ++k) { float a = 0.f; for (int c = 0; c < 128; ++c) a += bf2f(q[j * 128 + c]) * bf2f(KEYS[((size_t)(j * 8 + h) * 128 + k) * 128 + c]); sc[j * 128 + k] = a; }
                LAS float* tv = (LAS float*)(lds + 83200) + lane * 65; LAS int* ti = (LAS int*)(lds + 100096) + lane * 65;
                for (int j = 0; j < 2; ++j) for (int it = 0; it < 16; ++it) { float bv = -INFINITY; int bi = 0; for (int k = 0; k < 128; ++k) { const float v = sc[j * 128 + k]; if (v > bv) { bv = v; bi = k; } } tv[j * 16 + it] = bv; ti[j * 16 + it] = bi; sc[j * 128 + bi] = -INFINITY; }
                for (int i = 0; i < 256; ++i) used[i] = 0;
                float rs[1]; int nmatch = 0; float gsum_err = 0.f; (void)rs;
                const int* E = (const int*)(ws + WS_B) + ((size_t)row * 8 + h) * 16; const float* Gt = (const float*)(ws + WS_B + (size_t)MR * 128 * 4) + ((size_t)row * 8 + h) * 16;
                float topv0 = 0.f, den = 0.f;
                for (int it = 0; it < 16; ++it) { float bv = -INFINITY; int bi = 0; for (int i = 0; i < 256; ++i) if (!used[i]) { const float v = tv[i >> 4] + tv[16 + (i & 15)]; if (v > bv) { bv = v; bi = i; } } used[bi] = (unsigned char)(it + 1); if (it == 0) topv0 = bv; den += expf(bv - topv0); }
                for (int i = 0; i < 256; ++i) if (used[i]) { const float v = tv[i >> 4] + tv[16 + (i & 15)]; const int e = ti[i >> 4] * 128 + ti[16 + (i & 15)]; const float g = expf(v - topv0) / den;
                        for (int r = 0; r < 16; ++r) if (E[r] == e) { ++nmatch; gsum_err += fabsf(Gt[r] - g); } }
                float gs = 0.f; for (int r = 0; r < 16; ++r) { gs += Gt[r]; bad |= (E[r] < 0 || E[r] >= 16384); }
                bad |= (nmatch < 14) || (gsum_err > 0.05f) || !chk_close(gs, 1.f, 0.f, 1e-3f);
            } }
        __syncthreads(); check_pre_peer(ws, layer, tid);
    } else if (op == (PEER_SLICED ? 12 : (PEER_SPLIT ? 11 : 7))) { CHK_FRESH
        const int row = chk_row(3 + 2 * layer), b = row / SQ, s = row - b * SQ;
        if (!(last && s < LC)) {
            LAS float* act = (LAS float*)lds; LAS float* rr = (LAS float*)lds + 256; LAS float* red = (LAS float*)lds + 256 + 1024;
            const bf16* hrow = (const bf16*)(ws + WS_H) + (size_t)row * DD; const float* latold = (const float*)(ws + WS_CTL + 262144);
            const bf16* hold = (const bf16*)(ws + WS_CTL + 262144 + 4096);
            const int* E = (const int*)(ws + WS_B) + (size_t)row * 128; const float* Gt = (const float*)(ws + WS_B + (size_t)MR * 128 * 4) + (size_t)row * 128;
            const unsigned char* PU = ws + WS_PU + (size_t)layer * 16384 * 1024; const unsigned char* PV = ws + WS_PV + (size_t)layer * 16384 * 1024;
            (void)hrow;
            if (tid < 128) { const int e = E[tid]; float a = 0.f; for (int dd = 0; dd < 1024; ++dd) a += bf2f(hold[dd]) * fp8f(PU[PEER_SLICED ? (((size_t)(dd >> 7) << 21) + (size_t)e * 128 + (dd & 127)) : ((size_t)e * 1024 + dd)]); act[tid] = Gt[tid] * gelu_tanh(a * (1.f / PU_SCALE)) * (1.f / PV_SCALE); }
            __syncthreads();
            for (int c = tid; c < 1024; c += NTHR) { float o = 0.f; for (int k = 0; k < 128; ++k) o += act[k] * fp8f(PV[PEER_SLICED ? (((size_t)(c >> 7) << 21) + (size_t)E[k] * 128 + (c & 127)) : ((size_t)E[k] * 1024 + c)]); rr[c] = DN_ALPHA * latold[c] + MOD[(size_t)((s < LC) ? 16 : b) * 6144 + 5120 + c] * o; }
            __syncthreads();
            if (tid == 0) { float mu = 0.f; for (int c = 0; c < 1024; ++c) mu += rr[c]; mu /= 1024.f; float var = 0.f; for (int c = 0; c < 1024; ++c) var += (rr[c] - mu) * (rr[c] - mu); red[0] = mu; red[1] = 1.f / sqrtf(var / 1024.f + LN_EPS); }
            __syncthreads();
            for (int c = tid; c < 1024; c += NTHR) { const float y = (rr[c] - red[0]) * red[1] * ka->in[6][(layer * 2 + 1) * 1024 + c] + ka->in[7][(layer * 2 + 1) * 1024 + c];
                const float got = last ? ka->out[((size_t)b * TL + s - LC) * DD + c] : bf2f(((const bf16*)(ws + WS_LAT))[(size_t)row * DD + c]); bad |= !chk_close(got, y, 2e-2f, 2e-2f); }
            __syncthreads();
        }
    } else if (op == 8) { CHK_FRESH
        { const int b = (wave * 5 + 1) & 15, g = (wave * 23 + 7) & 63; const int p = lane; const bf16* U = (const bf16*)(ws + WS_H); const bf16* YG = (const bf16*)(ws + WS_A);
          float yacc[3][16];
#pragma unroll
          for (int a = 0; a < 3; ++a)
#pragma unroll
              for (int h = 0; h < 16; ++h) yacc[a][h] = 0.f;
          for (int dir = 0; dir < 2; ++dir) { const int rg = dir * 64 + g; const float re = ka->in[19][rg * 64 + p], im = ka->in[20][rg * 64 + p], stp = expf(ka->in[21][rg]);
              const float mag = expf(re * stp), lbr = mag * cosf(im * stp), lbi = mag * sinf(im * stp); const float aa = lbr - 1.f, bb = lbi, den = re * re + im * im, qr = (aa * re + bb * im) / den, qi = (bb * re - aa * im) / den;
              float bbr[16], bbi[16], cr[16], ci[16];
#pragma unroll
              for (int h = 0; h < 16; ++h) { const float br = ka->in[22][((size_t)rg * 64 + p) * 16 + h], bi = ka->in[23][((size_t)rg * 64 + p) * 16 + h]; bbr[h] = br * qr - bi * qi; bbi[h] = br * qi + bi * qr; cr[h] = ka->in[24][((size_t)rg * 16 + h) * 64 + p]; ci[h] = ka->in[25][((size_t)rg * 16 + h) * 64 + p]; }
              float xr = 0.f, xi = 0.f;
              for (int step = 0; step < SQ; ++step) { const int pos = s5_pos(dir, step); const bf16* u = U + ((size_t)b * SQ + pos) * DD + g * 16; float bur = 0.f, bui = 0.f;
#pragma unroll
                  for (int h = 0; h < 16; ++h) { const float uv = bf2f(u[h]); bur += uv * bbr[h]; bui += uv * bbi[h]; }
                  const float nr = lbr * xr - lbi * xi + bur, ni = lbr * xi + lbi * xr + bui; xr = nr; xi = ni;
                  const int a = (pos == 255) ? 0 : (pos == 256) ? 1 : (pos == 1777) ? 2 : -1;
                  if (a >= 0) {
#pragma unroll
                      for (int aa2 = 0; aa2 < 3; ++aa2) if (aa2 == a) {
#pragma unroll
                          for (int h = 0; h < 16; ++h) yacc[aa2][h] += wave_sum(xr * cr[h] - xi * ci[h]); } } } }
#pragma unroll
          for (int a = 0; a < 3; ++a) { const int pos = (a == 0) ? 255 : (a == 1) ? 256 : 1777; const bf16* u = U + ((size_t)b * SQ + pos) * DD + g * 16;
#pragma unroll
              for (int h = 0; h < 16; ++h) { const float y = gelu_tanh(yacc[a][h] + ka->in[26][g * 16 + h] * bf2f(u[h])); bad |= !chk_close(bf2f(YG[((size_t)b * SQ + pos) * DD + g * 16 + h]), y, 3e-2f, 2e-2f); } } }
    }
    if (bad) chk_fail((gu32*)(ws + WS_CTL), (unsigned)code);
#undef CHK_FRESH
#undef MOD
}
#endif
__device__ __forceinline__ void attn_phase_da(unsigned char* ws, int last, LAS unsigned char* lds, int vcu, int G, int tid) {
    typedef attn_body::bf16 abf;
    const abf* Qb = (const abf*)(ws + WS_A); const abf* Kb = (const abf*)(ws + WS_A + SZ72); const abf* Vb = (const abf*)(ws + WS_A + 2 * SZ72);
    abf* O0 = (abf*)(ws + WS_B); abf* O1 = (abf*)(ws + WS_B + SZ72);
    const int nlat = NB * 16 * 8, nctx = last ? 0 : NB * 16;
    for (int u = vcu; u < nlat + nctx; u += G) {
        int b, hh, qb;
        if (u < nlat) { const int idx = u >> 3; b = idx >> 4; hh = idx & 15; qb = (u & 7) + 1; } else { const int v = u - nlat; b = v >> 4; hh = v & 15; qb = 0; }
        const int h = hh >> 1, j = hh & 1;
        attn_body::UnitDesc d;
        const size_t qrow = (size_t)b * SQ + 256 * qb, krow = (size_t)b * SQ;
        d.Q = Qb + qrow * DD + h * 128 + j * 64; d.K = Kb + krow * DD + h * 128 + j * 64; d.V = Vb + krow * DD + h * 128;
        d.O = (j ? O1 : O0) + qrow * DD + h * 128;
        d.NT = qb ? 36 : 4; d.latoff = 256; d.kpos4 = 0; d.qpos0 = 0; d.sink2 = -INFINITY;
        attn_body::attn_unit_v128<8>(d, (char*)lds, tid);
    }
}
__device__ __forceinline__ void attn_phase_wa(unsigned char* ws, const float* sink, int last, LAS unsigned char* lds, int vcu, int G, int tid) {
    typedef attn_body::bf16 abf;
    const abf* Qb = (const abf*)(ws + WS_A); const abf* Kb = (const abf*)(ws + WS_A + SZ72); const abf* Vb = (const abf*)(ws + WS_A + 2 * SZ72);
    abf* OC = (abf*)(ws + WS_A);
    const int nlat = NB * 16 * 8, nctx = last ? 0 : NB * 16;
    for (int u = vcu; u < nlat + nctx; u += G) {
        int b, hq, qb;
        if (u < nlat) { const int idx = u >> 3; b = idx >> 4; hq = idx & 15; qb = (u & 7) + 1; } else { const int v = u - nlat; b = v >> 4; hq = v & 15; qb = 0; }
        attn_body::UnitDesc d;
        const size_t qrow = (size_t)b * SQ + 256 * qb, krow = (size_t)b * SQ;
        d.Q = Qb + qrow * DD + hq * 64; d.K = Kb + krow * DD + (hq >> 2) * 64; d.V = Vb + krow * DD + (hq >> 2) * 64; d.O = OC + qrow * DD + hq * 64;
        if (qb) { const int qpos0 = 256 * (qb - 1); const int ks = (qpos0 - 128) < 0 ? 0 : (qpos0 - 128), ke = (qpos0 + 384) > TL ? TL : (qpos0 + 384);
            d.NT = 4 + (ke - ks) / 64; d.latoff = 256 + ks; d.kpos4 = ks; d.qpos0 = qpos0; }
        else { d.NT = 4; d.latoff = 256; d.kpos4 = 0; d.qpos0 = 0; }
        d.sink2 = sink[hq] * LOG2E;
        attn_body::attn_unit<8, true>(d, (char*)lds, tid);
    }
}

#ifndef PHM
#define PHM 0xFFFFF
#endif
#define PH_ON(k) (((PHM) >> (k)) & 1)
#ifndef PEER_SLICED
#define PEER_SLICED 0
#endif
#ifndef PEER_SPLIT
#define PEER_SPLIT 0
#endif
constexpr int NSTEPS = PEER_SLICED ? (3 + 11 + 10 + 9 + 11) : (PEER_SPLIT ? (3 + 10 + 9 + 8 + 10) : (3 + 8 + 7 + 6 + 8));
struct Args { const float* in[28]; float* out; unsigned char* ws; int ph_lo, ph_hi; };
static_assert(sizeof(Args) == 28 * 8 + 8 + 8 + 8, "Args has no padding");

__global__ void __launch_bounds__(NTHR, 2) mk_fwd(Args args) {
    extern __shared__ __attribute__((aligned(16))) unsigned char lds_raw[];
    volatile LAS unsigned* MISC = (volatile LAS unsigned*)((LAS unsigned char*)lds_raw + MISC_OFF);
    typedef const __attribute__((address_space(4))) Args* KArgP;
    KArgP ka = (KArgP)__builtin_amdgcn_kernarg_segment_ptr();
#define KA_IN(k) (ka->in[k])
#define KA_FRESH() asm volatile("" : "+s"(ka))
    const int wave0 = __builtin_amdgcn_readfirstlane(threadIdx.x >> 6);
    { const int t0 = threadIdx.x; for (int u = t0; u < (LDS_BYTES - LDSCTL_OFF) / 4; u += NTHR) ((LAS unsigned*)((LAS unsigned char*)lds_raw + LDSCTL_OFF))[u] = 0u; }
    __syncthreads();
    const int lo = ka->ph_lo, hi = ka->ph_hi;
    const bool multi = (hi - lo) > 1 || MK_DEBUG;
    XcdBarrier bar; bar.bar = (unsigned*)((gu32*)(ka->ws + WS_CTL) + CW_BAR); bar.x = 0; bar.st = nullptr;
    if (multi) bar = xcd_barrier_post((unsigned*)((gu32*)(ka->ws + WS_CTL) + CW_BAR), MISC + 8, (int)threadIdx.x);
#if 1
    if (threadIdx.x == 0) { const unsigned xcc = xb_xcc_id() & 7u; MISC[12] = xcc; MISC[13] = __hip_atomic_fetch_add((unsigned*)((gu32*)(ka->ws + WS_CTL) + 2048 + 64 * xcc), 1u, __ATOMIC_RELAXED, __HIP_MEMORY_SCOPE_AGENT); }
    __syncthreads();
#endif
#define PH_TID int wv_b = wave0; asm volatile("" : "+s"(wv_b)); int ln_b = (int)__builtin_amdgcn_mbcnt_hi(~0u, __builtin_amdgcn_mbcnt_lo(~0u, 0u)); asm volatile("" : "+v"(ln_b)); const int tid_b = wv_b * 64 + ln_b;
#define PS_MAP int ps_slice = bx & 7, ps_widx = bx >> 3; const int ps_n = G >> 3; { bool even_ = true; for (int j_ = 0; j_ < 8; ++j_) even_ = even_ && (__hip_atomic_load((unsigned*)((gu32*)(ws + WS_CTL) + 2048 + 64 * j_), __ATOMIC_RELAXED, __HIP_MEMORY_SCOPE_AGENT) == (unsigned)ps_n); if (even_) { ps_slice = (int)MISC[12]; ps_widx = (int)MISC[13]; } }
#define UQ_MAP int uq_x = bx & 7, uq_r = bx >> 3; { bool even_ = true; for (int j_ = 0; j_ < 8; ++j_) even_ = even_ && (__hip_atomic_load((unsigned*)((gu32*)(ws + WS_CTL) + 2048 + 64 * j_), __ATOMIC_RELAXED, __HIP_MEMORY_SCOPE_AGENT) == (unsigned)(G >> 3)); if (even_) { uq_x = (int)MISC[12]; uq_r = (int)MISC[13]; } } \
    int uq_quarter = uq_x >> 1, uq_widx = ((uq_x & 1) * (G >> 3) + uq_r) * NWAVES + wave, uq_n = (G >> 2) * NWAVES; \
    if ((G & 7) != 0) { uq_quarter = bx & 3; uq_widx = (bx >> 2) * NWAVES + wave; uq_n = ((G - (bx & 3) + 3) >> 2) * NWAVES; }
#define PH_LOCALS \
    int wave = wave0; asm volatile("" : "+s"(wave)); \
    int lane = (int)__builtin_amdgcn_mbcnt_hi(~0u, __builtin_amdgcn_mbcnt_lo(~0u, 0u)); asm volatile("" : "+v"(lane)); const int tid = wave * 64 + lane; \
    int G = gridDim.x, bx = blockIdx.x; asm volatile("" : "+s"(G), "+s"(bx)); \
    const int vcu = (G % 8 == 0) ? (bx % 8) * (G / 8) + bx / 8 : bx; \
    const int gw = vcu * NWAVES + wave, NGW = G * NWAVES; \
    KA_FRESH(); unsigned char* ws = ka->ws; \
    unsigned ldsb = 0; asm volatile("" : "+s"(ldsb)); \
    LAS unsigned char* lds = (LAS unsigned char*)lds_raw + ldsb; \
    (void)lane; (void)wave; (void)vcu; (void)gw; (void)NGW; (void)ws; (void)lds; (void)tid;
#if MK_DEBUG
    for (int it = 0; it <= 2 * NSTEPS; ++it) { const int step = it >> 1; const bool is_check = (it & 1) != 0; const bool is_report = (it == 2 * NSTEPS);
#else
    for (int step = lo; step < hi; ++step) {
#endif
        KA_FRESH();
        int layer = 0, op;
        if (step < 3) op = (step == 0) ? 9 : (step == 1) ? 16 : 10;
#if PEER_SLICED
        else { const int s = step - 3;
            int k, base;
            if (s < 11) { layer = 0; k = s; } else if (s < 21) { layer = 1; k = s - 11; } else if (s < 30) { layer = 2; k = s - 21; } else { layer = 3; k = s - 30; }
            const int kd = layer % 3; base = (kd == 0) ? 4 : (kd == 1) ? 3 : 2;
            if (k < base) { op = (kd == 0) ? k : (kd == 1) ? ((k < 2) ? k : 3) : ((k == 0) ? 8 : 3); }
            else { const int j = k - base; op = (j == 0) ? 4 : (j == 1) ? 5 : (j == 2) ? 6 : (j == 3) ? 7 : (j == 4) ? 13 : (j == 5) ? 11 : 12; } }
#elif PEER_SPLIT
        else { const int s = step - 3;
            int k;
            if (s < 10) { layer = 0; k = s; } else if (s < 19) { layer = 1; k = s - 10; } else if (s < 27) { layer = 2; k = s - 19; } else { layer = 3; k = s - 27; }
            const int kd = layer % 3, nh = (kd == 0) ? 4 : (kd == 1) ? 3 : 2;
            if (k < nh) { op = (kd == 0) ? k : (kd == 1) ? ((k < 2) ? k : 3) : ((k == 0) ? 8 : 3); }
            else { const int j = k - nh; op = (j < 4) ? 4 + j : (j == 4) ? 11 : 14; } }
#else
        else { const int s = step - 3;
            if (s < 8) { layer = 0; op = s; }
            else if (s < 15) { layer = 1; op = s - 8; if (op >= 2) ++op; }
            else if (s < 21) { layer = 2; op = s - 15; op = (op == 0) ? 8 : op + 2; }
            else { layer = 3; op = s - 21; } }
#endif
        const int kind = layer % 3, jj = layer / 3, last = (layer == NLAYER - 1) ? 1 : 0;
#ifndef PROBE_REPEAT_OP
#define PROBE_REPEAT_OP -1
#endif
        const int nrep = (op == PROBE_REPEAT_OP && !(op == 1 && kind == 1)) ? 2 : 1;
        for (int rep = 0; rep < nrep; ++rep) {
        const int dry = (nrep == 2 && rep == 0) ? 1 : 0; (void)dry;
#if MK_DEBUG
        if (is_report) { PH_LOCALS const unsigned code = __hip_atomic_load((unsigned*)((gu32*)(ws + WS_CTL) + CW_ERR), __ATOMIC_RELAXED, __HIP_MEMORY_SCOPE_AGENT);
            if (code) { const float v = sqrtf((float)code); float* o = ka->out; for (size_t i = (size_t)vcu * NTHR + tid; i < (size_t)NB * TL * DD; i += (size_t)G * NTHR) o[i] = v; } }
        else if (is_check) { PH_LOCALS if (bx == 0) check_step(ka, ws, lds, op, layer, step + 1, tid, lane, wave); }
        else
#endif
        if (op == 9) { if constexpr (PH_ON(0)) { PH_LOCALS p0_prologue(ka, ws, lds, vcu, G, tid, lane, wave); } }
        else if (op == 10) { if constexpr (PH_ON(1)) { PH_LOCALS p1_embed(KA_IN(0), KA_IN(2), ws, gw, NGW, lane); } }
        else if (op == 16) { if constexpr (PH_ON(1)) { PH_LOCALS modred_phase(KA_IN(5), ws, gw, NGW, lane); } }
        else if (op == 0) { if constexpr (PH_ON(2)) { PH_LOCALS
            pg8::Gemm g; g.A = (const pg8::bf16_t*)(ws + WS_H); g.K = 1024; g.M = MR;
            pg8::EpiQKV E; E.Q = (pg8::bf16_t*)(ws + WS_A); E.K = (pg8::bf16_t*)(ws + WS_A + SZ72); E.V = (pg8::bf16_t*)(ws + WS_A + 2 * SZ72);
            E.cosT = (const float*)(ws + WS_ROPE); E.sinT = E.cosT + 2048 * 32; E.qscale = 0.125f * LOG2E;
            int nN;
            if (kind == 0) { g.Bt = (const pg8::bf16_t*)(ws + WS_WQKV_DA) + (size_t)jj * 3072 * 1024; g.N = 3072; E.nq = 4; E.nk = 4; nN = 12; }
            else { g.Bt = (const pg8::bf16_t*)(ws + WS_WQKV_WA); g.N = 1536; E.nq = 4; E.nk = 1; nN = 6; }
            pg8::RowOrder S; S.init(144, nN, G, bx, 0);
            pg8::gemm_phase<pg8::EpiQKV, pg8::RowOrder, true, true>(lds + RING_OFF, g, S, E, tid); } }
        else if (op == 1) { if (kind == 0) { if constexpr (PH_ON(3)) { PH_LOCALS attn_phase_da(ws, last, lds, vcu, G, tid); } } else { if constexpr (PH_ON(4)) { PH_LOCALS attn_phase_wa(ws, KA_IN(18), last, lds, vcu, G, tid); } } }
        else if (op == 2) { if constexpr (PH_ON(5)) { PH_LOCALS
            int ly = layer; asm volatile("" : "+s"(ly)); const float lam_init = (ly == 0) ? 0.2f : 0.55605820416f;
            da_combine_phase(ws, KA_IN(14) + jj * 256, KA_IN(15) + jj * 128, lam_init, last, gw, NGW, lane); } }
        else if (op == 8) { if constexpr (PH_ON(6)) { PH_LOCALS s5_phase(ws, KA_IN(26), lds, vcu, tid, lane, wave); } }
        else if (op == 3) {
            if (kind != 2) { if constexpr (PH_ON(7)) { PH_LOCALS
                pg8::Gemm g; g.A = (const pg8::bf16_t*)(ws + WS_A); g.K = 1024; g.M = MR; g.N = 1024;
                g.Bt = (kind == 0) ? (const pg8::bf16_t*)(ws + WS_WO_DA) + (size_t)jj * 1024 * 1024 : (const pg8::bf16_t*)(ws + WS_WO_WA);
                pg8::EpiRes E; E.lat = (const pg8::bf16_t*)(ws + WS_LAT); E.R = (pg8::bf16_t*)(ws + WS_B); E.mod = (const float*)(ws + WS_MOD) + (size_t)layer * 17 * 6144; E.alpha = DN_ALPHA;
                pg8::RowOrder S; S.init(last ? 128 : 144, 4, G, bx, last);
                pg8::gemm_phase<pg8::EpiRes, pg8::RowOrder, true, true>(lds + RING_OFF, g, S, E, tid);
                if (layer + 1 < NLAYER) { const int nfull = ((last ? 128 : 144) * 4) % G; if (nfull == 0 || bx >= nfull) cvt_tables_layer(ka, ws, layer + 1, nfull ? bx - nfull : bx, nfull ? G - nfull : G, tid); } } }
            else { if constexpr (PH_ON(8)) { PH_LOCALS
                pg8::Gemm g; g.A = (const pg8::bf16_t*)(ws + WS_A); g.K = 1024; g.M = MR; g.N = 2048; g.Bt = (const pg8::bf16_t*)(ws + WS_WGLU);
                pg8::EpiGlu E; E.lat = (const pg8::bf16_t*)(ws + WS_LAT); E.R = (pg8::bf16_t*)(ws + WS_B); E.mod = (const float*)(ws + WS_MOD) + (size_t)layer * 17 * 6144; E.alpha = DN_ALPHA;
                pg8::RowOrder S; S.init(144, 8, G, bx, 0);
                pg8::gemm_phase<pg8::EpiGlu, pg8::RowOrder, true, true>(lds + RING_OFF, g, S, E, tid);
                if (layer + 1 < NLAYER) { const int nfull = (144 * 8) % G; if (nfull == 0 || bx >= nfull) cvt_tables_layer(ka, ws, layer + 1, nfull ? bx - nfull : bx, nfull ? G - nfull : G, tid); } } } }
        else if (op == 4) { if constexpr (PH_ON(9)) { PH_LOCALS ln1_phase(ws, KA_IN(6) + (size_t)(layer * 2) * 1024, KA_IN(7) + (size_t)(layer * 2) * 1024, layer, last, gw, NGW, lane); } }
        else if (op == 5) { if constexpr (PH_ON(10)) { PH_LOCALS
            pg8::Gemm g; g.A = (const pg8::bf16_t*)(ws + WS_H); g.K = 1024; g.M = MR; g.N = 2048; g.Bt = (const pg8::bf16_t*)(ws + WS_WPQ) + (size_t)layer * 2048 * 1024;
            pg8::EpiPlain E; E.O = (pg8::bf16_t*)(ws + WS_A); E.ldc = 2048;
            pg8::RowOrder S; S.init(last ? 128 : 144, 8, G, bx, last);
            pg8::gemm_phase<pg8::EpiPlain, pg8::RowOrder, true, true>(lds + RING_OFF, g, S, E, tid); } }
        else if (op == 6) { if constexpr (PH_ON(11)) { PH_LOCALS topk_phase(ws, layer, last, lds, vcu, G, tid, lane, wave); } }
#if PEER_SLICED
        else if (op == 7) { if constexpr (PH_ON(12)) { PH_LOCALS PS_MAP peer_slice_pass<0>(ws, layer, last, ps_slice, ps_widx, ps_n, lane, wave); } }
#elif PEER_SPLIT
        else if (op == 7) { if constexpr (PH_ON(12)) { PH_LOCALS UQ_MAP peer_uq_phase(ws, layer, last, uq_quarter, uq_widx, uq_n, lane); } }
        else if (op == 11) { if constexpr (PH_ON(13)) { PH_LOCALS UQ_MAP peer_vq_phase(ws, layer, last, uq_quarter, uq_widx, uq_n, lane, wave, lds); } }
        else if (op == 14) { if constexpr (PH_ON(14)) { PH_LOCALS ln2q_phase(ws, ka->out, KA_IN(6) + (size_t)(layer * 2 + 1) * 1024, KA_IN(7) + (size_t)(layer * 2 + 1) * 1024, layer, last, gw, NGW, lane); } }
#else
        else if (op == 7) { if constexpr (PH_ON(12)) { PH_LOCALS peer_phase(ws, ka->out, KA_IN(6) + (size_t)(layer * 2 + 1) * 1024, KA_IN(7) + (size_t)(layer * 2 + 1) * 1024, layer, last, dry, gw, NGW, lane); } }
#endif
#if PEER_SLICED
        else if (op == 11) { if constexpr (PH_ON(13)) { PH_LOCALS PS_MAP peer_slice_pass<1>(ws, layer, last, ps_slice, ps_widx, ps_n, lane, wave); } }
        else if (op == 13) { if constexpr (PH_ON(15)) { PH_LOCALS peer_act_phase(ws, last, gw, NGW, lane); } }
        else { if constexpr (PH_ON(14)) { PH_LOCALS ln2_phase(ws, ka->out, KA_IN(6) + (size_t)(layer * 2 + 1) * 1024, KA_IN(7) + (size_t)(layer * 2 + 1) * 1024, layer, last, gw, NGW, lane); } }
#endif
        if (rep + 1 < nrep) { XcdBarrier b2 = bar; asm volatile("" : "+s"(b2.bar)); PH_TID xcd_barrier(b2, tid_b); }
        }
#if MK_DEBUG
        { XcdBarrier b2 = bar; asm volatile("" : "+s"(b2.bar)); PH_TID xcd_barrier(b2, tid_b); }
#else
        if (step + 1 < hi) { XcdBarrier b2 = bar; asm volatile("" : "+s"(b2.bar)); PH_TID xcd_barrier(b2, tid_b); }
#endif
    }
}

#ifndef MK_ONE_LAUNCH
#define MK_ONE_LAUNCH 1
#endif
extern "C" void kernel_launch(void* const* d_in, const int* in_sizes, int n_in, void* d_out, int out_size, void* d_ws, size_t ws_size, hipStream_t stream) {
    static int grid = 0;
    if (grid == 0) {
        if (n_in != 28 || ws_size < WS_END || out_size != NB * TL * DD) { fprintf(stderr, "kernel_launch: unexpected shapes (n_in %d, ws %zu, out %d); nothing launched\n", n_in, ws_size, out_size); grid = -1; return; }
        int dev = 0, cus = 0, per_cu = 0;
        if (hipGetDevice(&dev) != hipSuccess || hipDeviceGetAttribute(&cus, hipDeviceAttributeMultiprocessorCount, dev) != hipSuccess) { grid = -1; return; }
        if (hipFuncSetAttribute((const void*)mk_fwd, hipFuncAttributeMaxDynamicSharedMemorySize, LDS_BYTES) != hipSuccess) { fprintf(stderr, "kernel_launch: hipFuncSetAttribute failed\n"); grid = -1; return; }
        if (hipOccupancyMaxActiveBlocksPerMultiprocessor(&per_cu, (const void*)mk_fwd, NTHR, LDS_BYTES) != hipSuccess || per_cu < 1) fprintf(stderr, "kernel_launch: occupancy query reports %d\n", per_cu);
        (void)hipGetLastError();
        grid = cus;
    }
    if (grid < 0) return;
    if (hipMemsetAsync((char*)d_ws + WS_CTL, 0, CTL_ZERO_BYTES, stream) != hipSuccess) return;
    Args a{};
    for (int i = 0; i < 28; ++i) a.in[i] = (const float*)d_in[i];
    a.out = (float*)d_out; a.ws = (unsigned char*)d_ws;
#if MK_ONE_LAUNCH
    a.ph_lo = 0; a.ph_hi = NSTEPS;
    hipLaunchKernelGGL(mk_fwd, dim3(grid), dim3(NTHR), LDS_BYTES, stream, a);
#else
    for (int s = 0; s < NSTEPS; ++s) { a.ph_lo = s; a.ph_hi = s + 1; hipLaunchKernelGGL(mk_fwd, dim3(grid), dim3(NTHR), LDS_BYTES, stream, a); }
#endif
}
```
